# Optimizing an MI355X kernel written in HIP

```python
import math
import jax, jax.numpy as jnp
from jax import lax
import numpy as np

D_MODEL = 2048
BATCH = 4
SEQ = 2048
DEPTH = 1

MIX_WIDTH = D_MODEL
SB_HEADS = 8
SB_HEAD_DIM = MIX_WIDTH // 2 // SB_HEADS
SB_WIDTH = SB_HEADS * SB_HEAD_DIM
SB_BLOCK = 128
GLA_HEADS = 4
GLA_V_DIM = (MIX_WIDTH - SB_WIDTH) // GLA_HEADS
GLA_K_DIM = GLA_V_DIM // 2
GLA_V_WIDTH = GLA_HEADS * GLA_V_DIM
GLA_K_WIDTH = GLA_HEADS * GLA_K_DIM
GLA_GATE_RANK = 16
GLA_GATE_TAU = 16.0
GLA_CHUNK = 64
IN_COLS = 3 * SB_WIDTH + 2 * GLA_K_WIDTH + 2 * GLA_V_WIDTH + GLA_GATE_RANK
MEM_LEN = 256
CROSS_HEADS = 4
CROSS_HEAD_DIM = D_MODEL // CROSS_HEADS
N_EXPERTS = 32
TOP_K = 4
D_FF = D_MODEL
SWIGLU_LIMIT = 7.0
SWIGLU_ALPHA = 1.702
MOE_BLOCK = 128
EPS = 1e-6

kernel_name = 'hybrid_stickbreak_gla_moe_block'


def rms_norm(x, g):
    xf = x.astype(jnp.float32)
    y = xf * lax.rsqrt(jnp.mean(xf * xf, axis=-1, keepdims=True) + EPS)
    return (y * g.astype(jnp.float32)).astype(x.dtype)


def split_heads(t, n_heads):
    b, s, _ = t.shape
    return t.reshape(b, s, n_heads, -1).transpose(0, 2, 1, 3)


def head_rms_norm(o, g):
    b, h, s, d = o.shape
    of = o.astype(jnp.float32)
    y = of * lax.rsqrt(jnp.mean(of * of, axis=-1, keepdims=True) + EPS)
    y = y * g.astype(jnp.float32).reshape(1, h, 1, d)
    return y.transpose(0, 2, 1, 3).reshape(b, s, h * d).astype(o.dtype)


def stick_breaking_attention(q, k, v):
    s_len, dh = q.shape[2], q.shape[3]
    scale = dh ** -0.5
    outs = []
    for start in range(0, s_len, SB_BLOCK):
        end = start + SB_BLOCK
        z = jnp.einsum('bhqd,bhkd->bhqk', q[:, :, start:end], k[:, :, :end]).astype(jnp.float32) * scale
        t_pos = start + jnp.arange(SB_BLOCK)[:, None]
        s_pos = jnp.arange(end)[None, :]
        causal = s_pos < t_pos
        log_beta = jax.nn.log_sigmoid(z)
        log_1m = jnp.where(causal, log_beta - z, 0.0)
        between = lax.cumsum(log_1m, axis=3, reverse=True) - log_1m
        a = jnp.where(causal, jnp.exp(log_beta + between), 0.0)
        outs.append(jnp.einsum('bhqk,bhkd->bhqd', a.astype(v.dtype), v[:, :, :end]))
    return jnp.concatenate(outs, axis=2)


def gla_chunked(q, k, v, log_a):
    b, h, s_len, dk = q.shape
    dv = v.shape[-1]
    c = GLA_CHUNK
    n = s_len // c
    f32 = jnp.float32
    qc = q.reshape(b, h, n, c, dk).astype(f32) * dk ** -0.5
    kc = k.reshape(b, h, n, c, dk).astype(f32)
    vc = v.reshape(b, h, n, c, dv).astype(f32)
    g = jnp.cumsum(log_a.reshape(b, h, n, c, dk).astype(f32), axis=3)
    q_in = qc * jnp.exp(g)
    k_in = kc * jnp.exp(-g)
    scores = jnp.einsum('bhncd,bhnsd->bhncs', q_in, k_in)
    mask = jnp.tril(jnp.ones((c, c), dtype=bool))
    scores = jnp.where(mask, scores, 0.0)
    o_intra = jnp.einsum('bhncs,bhnsv->bhncv', scores, vc)
    g_last = g[:, :, :, -1:, :]
    kv_chunk = jnp.einsum('bhncd,bhncv->bhndv', kc * jnp.exp(g_last - g), vc)
    decay = jnp.exp(g_last[:, :, :, 0, :])

    def step(state, inp):
        kv_n, decay_n = inp
        return decay_n[..., None] * state + kv_n, state

    init = jnp.zeros((b, h, dk, dv), f32)
    _, prev_states = lax.scan(step, init, (jnp.moveaxis(kv_chunk, 2, 0), jnp.moveaxis(decay, 2, 0)))
    prev_states = jnp.moveaxis(prev_states, 0, 2)
    o_inter = jnp.einsum('bhncd,bhndv->bhncv', q_in, prev_states)
    return (o_intra + o_inter).reshape(b, h, s_len, dv).astype(v.dtype)


def hybrid_mixer(h, w_in, w_gla_gate_up, b_gla_gate, sb_norm_g, gla_norm_g, w_out):
    proj = h @ w_in
    widths = [SB_WIDTH, SB_WIDTH, SB_WIDTH, GLA_K_WIDTH, GLA_K_WIDTH, GLA_V_WIDTH, GLA_V_WIDTH]
    cuts = list(np.cumsum(widths))
    sb_q, sb_k, sb_v, gla_q, gla_k, gla_v, gla_r, gla_low = jnp.split(proj, cuts, axis=-1)
    sb_o = stick_breaking_attention(split_heads(sb_q, SB_HEADS), split_heads(sb_k, SB_HEADS), split_heads(sb_v, SB_HEADS))
    sb_o = head_rms_norm(sb_o, sb_norm_g)
    log_a = jax.nn.log_sigmoid((gla_low @ w_gla_gate_up + b_gla_gate).astype(jnp.float32)) / GLA_GATE_TAU
    gla_o = gla_chunked(split_heads(gla_q, GLA_HEADS), split_heads(gla_k, GLA_HEADS), split_heads(gla_v, GLA_HEADS), split_heads(log_a, GLA_HEADS))
    gla_o = head_rms_norm(gla_o, gla_norm_g) * jax.nn.silu(gla_r)
    return jnp.concatenate([sb_o, gla_o], axis=-1) @ w_out


def memory_cross_attention(h, mem_n, w_cq, w_ckv, w_co):
    b, s_len, _ = h.shape
    q = (h @ w_cq).reshape(b, s_len, CROSS_HEADS, CROSS_HEAD_DIM)
    k, v = jnp.split(mem_n @ w_ckv, 2, axis=-1)
    k = k.reshape(b, -1, CROSS_HEADS, CROSS_HEAD_DIM)
    v = v.reshape(b, -1, CROSS_HEADS, CROSS_HEAD_DIM)
    scores = jnp.einsum('bqhd,bkhd->bhqk', q, k).astype(jnp.float32) * CROSS_HEAD_DIM ** -0.5
    p = jax.nn.softmax(scores, axis=-1).astype(v.dtype)
    o = jnp.einsum('bhqk,bkhd->bqhd', p, v).reshape(b, s_len, D_MODEL)
    return o @ w_co


def moe_ffn(h, w_router, b_router, w_gate_up, b_gate_up, w_down, b_down):
    b, s_len, d = h.shape
    n_tok = b * s_len
    hf = h.reshape(n_tok, d)
    logits = (hf @ w_router + b_router).astype(jnp.float32)
    top_logits, top_idx = lax.top_k(logits, TOP_K)
    top_w = jax.nn.softmax(top_logits, axis=-1)
    n_assign = n_tok * TOP_K
    expert_flat = top_idx.reshape(n_assign)
    token_flat = jnp.arange(n_assign, dtype=jnp.int32) // TOP_K
    weight_flat = top_w.reshape(n_assign)
    order = jnp.argsort(expert_flat)
    sorted_expert = expert_flat[order]
    counts = jnp.bincount(expert_flat, length=N_EXPERTS)
    padded = ((counts + MOE_BLOCK - 1) // MOE_BLOCK) * MOE_BLOCK
    start = jnp.cumsum(counts) - counts
    pend = jnp.cumsum(padded)
    pstart = pend - padded
    dest = pstart[sorted_expert] + (jnp.arange(n_assign) - start[sorted_expert])
    n_blocks = -(-(n_assign + N_EXPERTS * (MOE_BLOCK - 1)) // MOE_BLOCK)
    n_slots = n_blocks * MOE_BLOCK
    slot_token = jnp.full((n_slots,), n_tok, jnp.int32).at[dest].set(token_flat[order])
    slot_weight = jnp.zeros((n_slots,), jnp.float32).at[dest].set(weight_flat[order])
    block_expert = jnp.minimum(jnp.searchsorted(pend, jnp.arange(n_blocks) * MOE_BLOCK, side='right'), N_EXPERTS - 1)
    h_pad = jnp.concatenate([hf, jnp.zeros((1, d), hf.dtype)], axis=0)
    xs = h_pad[slot_token].reshape(n_blocks, MOE_BLOCK, d)

    def expert_block(args):
        xb, e = args
        gu = xb @ w_gate_up[e] + b_gate_up[e]
        gate, lin = jnp.split(gu, 2, axis=-1)
        gate = jnp.minimum(gate, SWIGLU_LIMIT)
        lin = jnp.clip(lin, -SWIGLU_LIMIT, SWIGLU_LIMIT)
        act = gate * jax.nn.sigmoid(SWIGLU_ALPHA * gate) * (lin + 1.0)
        return act @ w_down[e] + b_down[e]

    ys = lax.map(expert_block, (xs, block_expert)).reshape(n_slots, d)
    ys = ys * slot_weight[:, None].astype(ys.dtype)
    out = jax.ops.segment_sum(ys, slot_token, num_segments=n_tok + 1)[:n_tok]
    return out.reshape(b, s_len, d)


def setup_inputs(seed: int = 0) -> dict:
    key = jax.random.key(seed)
    ks = jax.random.split(key, 24)
    f32 = jnp.float32
    L = DEPTH

    def nrm(k, shape, scale):
        return jax.random.normal(k, shape, f32) * scale

    def gain(k, shape):
        return 1.0 + 0.02 * jax.random.normal(k, shape, f32)

    return {
        'x': nrm(ks[0], (BATCH, SEQ, D_MODEL), 1.0),
        'mem': nrm(ks[1], (BATCH, MEM_LEN, D_MODEL), 1.0),
        'norm_mix_g': gain(ks[2], (L, D_MODEL)),
        'w_in': nrm(ks[3], (L, D_MODEL, IN_COLS), D_MODEL ** -0.5),
        'w_gla_gate_up': nrm(ks[4], (L, GLA_GATE_RANK, GLA_K_WIDTH), GLA_GATE_RANK ** -0.5),
        'b_gla_gate': nrm(ks[5], (L, GLA_K_WIDTH), 0.1),
        'sb_norm_g': gain(ks[6], (L, SB_WIDTH)),
        'gla_norm_g': gain(ks[7], (L, GLA_V_WIDTH)),
        'w_out': nrm(ks[8], (L, MIX_WIDTH, D_MODEL), MIX_WIDTH ** -0.5),
        'norm_cross_g': gain(ks[9], (L, D_MODEL)),
        'norm_mem_g': gain(ks[10], (L, D_MODEL)),
        'w_cq': nrm(ks[11], (L, D_MODEL, D_MODEL), D_MODEL ** -0.5),
        'w_ckv': nrm(ks[12], (L, D_MODEL, 2 * D_MODEL), D_MODEL ** -0.5),
        'w_co': nrm(ks[13], (L, D_MODEL, D_MODEL), D_MODEL ** -0.5),
        'norm_moe_g': gain(ks[14], (L, D_MODEL)),
        'w_router': nrm(ks[15], (L, D_MODEL, N_EXPERTS), D_MODEL ** -0.5),
        'b_router': nrm(ks[16], (L, N_EXPERTS), 0.01),
        'w_gate_up': nrm(ks[17], (L, N_EXPERTS, D_MODEL, 2 * D_FF), D_MODEL ** -0.5),
        'b_gate_up': nrm(ks[18], (L, N_EXPERTS, 2 * D_FF), 0.02),
        'w_down': nrm(ks[19], (L, N_EXPERTS, D_FF, D_MODEL), D_FF ** -0.5),
        'b_down': nrm(ks[20], (L, N_EXPERTS, D_MODEL), 0.02),
        'norm_final_g': gain(ks[21], (D_MODEL,)),
    }


def reference(x, mem, norm_mix_g, w_in, w_gla_gate_up, b_gla_gate, sb_norm_g, gla_norm_g, w_out,
              norm_cross_g, norm_mem_g, w_cq, w_ckv, w_co,
              norm_moe_g, w_router, b_router, w_gate_up, b_gate_up, w_down, b_down,
              norm_final_g):
    for layer in range(DEPTH):
        h = rms_norm(x, norm_mix_g[layer])
        x = x + hybrid_mixer(h, w_in[layer], w_gla_gate_up[layer], b_gla_gate[layer],
                             sb_norm_g[layer], gla_norm_g[layer], w_out[layer])
        h = rms_norm(x, norm_cross_g[layer])
        mem_n = rms_norm(mem, norm_mem_g[layer])
        x = x + memory_cross_attention(h, mem_n, w_cq[layer], w_ckv[layer], w_co[layer])
        h = rms_norm(x, norm_moe_g[layer])
        x = x + moe_ffn(h, w_router[layer], b_router[layer], w_gate_up[layer], b_gate_up[layer],
                        w_down[layer], b_down[layer])
    return rms_norm(x, norm_final_g)
```

```cpp
#include <hip/hip_runtime.h>
#include <cstdio>
#include <cstdint>

#ifndef MK_N_LAUNCHES
#define MK_N_LAUNCHES 1
#endif
#ifndef MOE_FP8
#define MOE_FP8 1
#endif
#ifndef CONV_LD_AUX
#define CONV_LD_AUX 18
#endif
#ifndef Y_FP8
#define Y_FP8 1
#endif
#ifndef MX_UNSCALED
#define MX_UNSCALED 1
#endif
#ifndef DUP_MASK
#define DUP_MASK 0
#endif

#define GAS __attribute__((address_space(1)))
#define LAS __attribute__((address_space(3)))
typedef unsigned short bf16;
typedef short bf16x8 __attribute__((ext_vector_type(8)));
typedef float f32x2 __attribute__((ext_vector_type(2)));
typedef float f32x4 __attribute__((ext_vector_type(4)));
typedef float f32x16 __attribute__((ext_vector_type(16)));
typedef unsigned u32x2 __attribute__((ext_vector_type(2)));
typedef unsigned u32x4 __attribute__((ext_vector_type(4)));
typedef GAS unsigned gu32;

#define LDS_WAIT() asm volatile("s_waitcnt lgkmcnt(0)" ::: "memory")
#define VM_WAIT() asm volatile("s_waitcnt vmcnt(0)" ::: "memory")

constexpr int DM = 2048, NB = 4, SEQ = 2048, NT = NB * SEQ;
constexpr int INC = 6160, NPROJ = 6144;
constexpr int MEMLEN = 256, NMEM = NB * MEMLEN;
constexpr int NEXP = 32, TOPK = 4, NASSIGN = NT * TOPK, DFF = 2048;
constexpr float EPS = 1e-6f;
constexpr float LOG2E = 1.4426950408889634f, LN2 = 0.6931471805599453f;
constexpr int KD = 2048;

typedef __bf16 bf16x2_t __attribute__((ext_vector_type(2)));
__device__ __forceinline__ unsigned cvt_pk_bf16(float lo, float hi) { const f32x2 v = {lo, hi}; const bf16x2_t b = __builtin_convertvector(v, bf16x2_t); return __builtin_bit_cast(unsigned, b); }
__device__ __forceinline__ bf16 f2bf(float f) { return (bf16)(cvt_pk_bf16(f, 0.f) & 0xffffu); }
__device__ __forceinline__ float bf2f(unsigned b) { return __uint_as_float(b << 16); }
__device__ __forceinline__ float bflo(unsigned w) { return __uint_as_float(w << 16); }
__device__ __forceinline__ float bfhi(unsigned w) { return __uint_as_float(w & 0xffff0000u); }
__device__ __forceinline__ void st_bf16x4(bf16* p, f32x4 v) { u32x2 w; w.x = cvt_pk_bf16(v.x, v.y); w.y = cvt_pk_bf16(v.z, v.w); *(u32x2*)p = w; }
__device__ __forceinline__ float wave_sum(float v) {
#pragma unroll
    for (int o = 1; o < 64; o <<= 1) v += __shfl_xor(v, o);
    return v;
}
__device__ __forceinline__ float fexp2(float x) { return __builtin_amdgcn_exp2f(x); }
__device__ __forceinline__ float flog2(float x) { return __builtin_amdgcn_logf(x); }
__device__ __forceinline__ float frcp(float x) { return __builtin_amdgcn_rcpf(x); }
__device__ __forceinline__ float log2_sigmoid2(float z2) { return -(fmaxf(-z2, 0.f) + flog2(1.f + fexp2(-fabsf(z2)))); }

namespace pg8 {
constexpr int BM = 256, BK = 64, HALF = 128, HTB = HALF * BK * 2, STAGE_BYTES = 8 * HTB, NXCD = 8, WGM = 8;
__host__ __device__ __forceinline__ int lds_byte(int r, int c) { const int st = (r >> 4) * 2 + (c >> 5), rr = r & 15, cc = c & 31, ob = rr * 64 + cc * 2; return st * 1024 + (ob ^ (((ob >> 9) & 1) << 5)); }
__host__ __device__ __forceinline__ void stage_rc(int b, int& R, int& C) { const int st = b / 1024, sb = b % 1024, swz = sb ^ (((sb >> 9) & 1) << 5); R = (st >> 1) * 16 + swz / 64; C = (st & 1) * 32 + (swz % 64) / 2; }

typedef int v8i __attribute__((ext_vector_type(8)));
typedef int v4i __attribute__((ext_vector_type(4)));
__device__ __forceinline__ v8i cat8(bf16x8 lo, bf16x8 hi) { const v4i a = __builtin_bit_cast(v4i, lo), b = __builtin_bit_cast(v4i, hi); return (v8i){a.x, a.y, a.z, a.w, b.x, b.y, b.z, b.w}; }
__host__ __device__ __forceinline__ int perm32(int rho) { const int n = rho >> 4, i = rho & 15; return 8 * (i >> 2) + 4 * n + (i & 3); }
struct Unit { const char* a; const char* b; int r0, c0, rows, e, nt; };

struct DenseOrder {
    const char* A; const char* Bt; int nM, nN, nwg, G, c;
    __device__ void init(const void* A_, const void* Bt_, int M, int N, int G_, int c_) { A = (const char*)A_; Bt = (const char*)Bt_; nM = M / BM; nN = N / BM; nwg = nM * nN; G = G_; c = c_; }
    __device__ bool next(int i, Unit& u) const {
        const long L = (long)i * G + c; if (L >= nwg) return false;
        int wgid = (int)L; { const int q = nwg / NXCD, r = nwg % NXCD, xcd = wgid % NXCD, off = wgid / NXCD; wgid = (xcd < r ? xcd * (q + 1) : r * (q + 1) + (xcd - r) * q) + off; }
        const int nig = WGM * nN, gid = wgid / nig, fm = gid * WGM, gsz = (nM - fm) < WGM ? (nM - fm) : WGM;
        const int pm = fm + ((wgid % nig) % gsz), pn = (wgid % nig) / gsz;
        u.a = A + (size_t)pm * BM * KD * 2; u.b = Bt + (size_t)pn * BM * KD * 2; u.r0 = pm * BM; u.c0 = pn * BM; u.rows = BM; u.e = 0; return true;
    }
    __device__ __forceinline__ void a_ready(const Unit&) const {}
};

template <int PITCHB, int NTILES, bool FP8, class Epi, class Sched>
__device__ __forceinline__ void gemm_phase(LAS unsigned char* lds, const Sched& S, const Epi& E) {
    const int tid = threadIdx.x, wid = __builtin_amdgcn_readfirstlane(tid >> 6), lane = tid & 63, wr = wid >> 2, wc = wid & 3, fr = lane & 15, fq = lane >> 4;
    unsigned voffA[2], voffB[2];
#pragma unroll
    for (int i = 0; i < 2; ++i) { int R, C; stage_rc(tid * 16 + i * 8192, R, C); const int Rb = Epi::PERM ? ((R & ~31) + perm32(R & 31)) : R;
        voffA[i] = (unsigned)(R * PITCHB + C * 2); voffB[i] = (unsigned)(Rb * PITCHB + C * 2); }
    const size_t kstep = (size_t)(BK * 2);
    const size_t hstep = (size_t)HALF * PITCHB;
    const unsigned ldsw = (unsigned)wid * 1024u;
    const int aoff = lds_byte(wr * 64 + fr, fq * 8), boff = lds_byte(wc * 32 + fr, fq * 8);
#define PG8_SA(b, h) (((b) * 2 + (h)) * HTB)
#define PG8_SB(b, h) ((4 + (b) * 2 + (h)) * HTB)
#define PG8_STAGE_X(bufoff, gbase, voff) do { _Pragma("unroll") for (int _i = 0; _i < 2; ++_i) \
        __builtin_amdgcn_global_load_lds((const unsigned*)((const char*)(gbase) + (voff)[_i]), (LAS unsigned*)(lds + (bufoff) + ldsw + _i * 8192), 16, 0, 0); } while (0)
#define PG8_STAGE_A(bufoff, gbase) PG8_STAGE_X(bufoff, gbase, voffA)
#define PG8_STAGE_B(bufoff, gbase) PG8_STAGE_X(bufoff, gbase, voffB)
#define PG8_LDA(dst, b, h) do { _Pragma("unroll") for (int m = 0; m < 4; ++m) { if constexpr (FP8) { const v4i _lo = *(const LAS v4i*)(lds + PG8_SA(b, h) + aoff + m * 2048), _hi = *(const LAS v4i*)(lds + PG8_SA(b, h) + aoff + m * 2048 + 1024); \
            dst##8[m] = (v8i){_lo.x, _lo.y, _lo.z, _lo.w, _hi.x, _hi.y, _hi.z, _hi.w}; } \
        else { _Pragma("unroll") for (int k = 0; k < 2; ++k) dst[m][k] = *(const LAS bf16x8*)(lds + PG8_SA(b, h) + aoff + m * 2048 + k * 1024); } } } while (0)
#define PG8_LDB(dst, b, h) do { _Pragma("unroll") for (int n = 0; n < 2; ++n) { if constexpr (FP8) { const v4i _lo = *(const LAS v4i*)(lds + PG8_SB(b, h) + boff + n * 2048), _hi = *(const LAS v4i*)(lds + PG8_SB(b, h) + boff + n * 2048 + 1024); \
            dst##8[n] = (v8i){_lo.x, _lo.y, _lo.z, _lo.w, _hi.x, _hi.y, _hi.z, _hi.w}; } \
        else { _Pragma("unroll") for (int k = 0; k < 2; ++k) dst[n][k] = *(const LAS bf16x8*)(lds + PG8_SB(b, h) + boff + n * 2048 + k * 1024); } } } while (0)
#define PG8_MMA(ai, bj, At, Bt) do { __builtin_amdgcn_s_setprio(1); _Pragma("unroll") for (int m = 0; m < 4; ++m) _Pragma("unroll") for (int n = 0; n < 2; ++n) { \
        if constexpr (FP8) { if constexpr (MX_UNSCALED != 0) asm volatile("v_mfma_f32_16x16x128_f8f6f4 %0, %1, %2, %0" : "+v"(acc[ai][bj][m][n]) : "v"(Bt##8[n]), "v"(At##8[m])); \
            else asm volatile("v_mfma_scale_f32_16x16x128_f8f6f4 %0, %1, %2, %0, %3, %4 op_sel_hi:[0,0,0]" : "+v"(acc[ai][bj][m][n]) : "v"(Bt##8[n]), "v"(At##8[m]), "v"(sclW), "v"(sclA)); } \
        else { _Pragma("unroll") for (int k = 0; k < 2; ++k) acc[ai][bj][m][n] = __builtin_amdgcn_mfma_f32_16x16x32_bf16(Bt[n][k], At[m][k], acc[ai][bj][m][n], 0, 0, 0); } } \
        __builtin_amdgcn_s_setprio(0); } while (0)
#define PG8_WAIT_V(n) asm volatile("s_waitcnt vmcnt(" #n ")" ::: "memory")
#define PG8_WAIT_L(n) asm volatile("s_waitcnt lgkmcnt(" #n ")" ::: "memory")
#define PG8_BAR __builtin_amdgcn_s_barrier()
#define PG8_SCHED __builtin_amdgcn_sched_barrier(0)
    Unit cur, nxt; int ui = 0;
    if (!S.next(0, cur)) return;
    f32x4 acc[2][2][4][2];
#pragma unroll
    for (int a = 0; a < 2; ++a)
#pragma unroll
        for (int b = 0; b < 2; ++b)
#pragma unroll
            for (int m = 0; m < 4; ++m)
#pragma unroll
                for (int n = 0; n < 2; ++n) acc[a][b][m][n] = (f32x4){0.f, 0.f, 0.f, 0.f};
    const int sclW = 0x79797979, sclA = 0x7f7f7f7f;
    bf16x8 At[4][2], B0[2][2], B1[2][2]; v8i At8[4], B08[2], B18[2];
    const char* cA = cur.a; const char* cB = cur.b;
    S.a_ready(cur);
    PG8_STAGE_B(PG8_SB(0, 0), cB); PG8_STAGE_B(PG8_SB(0, 1), cB + hstep); PG8_STAGE_A(PG8_SA(0, 0), cA); PG8_STAGE_A(PG8_SA(0, 1), cA + hstep);
    if (wr == 1) PG8_BAR;
    PG8_WAIT_V(2); PG8_BAR;
    PG8_STAGE_B(PG8_SB(1, 0), cB + kstep); PG8_STAGE_A(PG8_SA(1, 0), cA + kstep); PG8_STAGE_B(PG8_SB(1, 1), cB + hstep + kstep);
    PG8_WAIT_V(6); PG8_BAR;
    for (;;) {
        const bool has_next = S.next(ui + 1, nxt);
        const char* nA = has_next ? nxt.a : cA; const char* nB = has_next ? nxt.b : cB;
        const int nt = NTILES > 0 ? NTILES : cur.nt;
#pragma nounroll
        for (int t = 0; t < nt; t += 2) {
            const bool last = (t == nt - 2);
            const char* a1 = cA + (size_t)(t + 1) * kstep;
            const char* a2 = last ? nA : cA + (size_t)(t + 2) * kstep; const char* b2 = last ? nB : cB + (size_t)(t + 2) * kstep;
            const char* a3 = a2 + kstep; const char* b3 = b2 + kstep;
            if (last && has_next) S.a_ready(nxt);
            PG8_LDB(B0, 0, 0); PG8_LDB(B1, 0, 1); PG8_SCHED; PG8_LDA(At, 0, 0); PG8_STAGE_A(PG8_SA(1, 1), a1 + hstep);
            PG8_WAIT_V(8); PG8_WAIT_L(0); PG8_BAR; PG8_MMA(0, 0, At, B0); PG8_MMA(0, 1, At, B1); PG8_BAR; PG8_SCHED;
            PG8_LDA(At, 0, 1); PG8_STAGE_B(PG8_SB(0, 0), b2); PG8_STAGE_B(PG8_SB(0, 1), b2 + hstep); PG8_STAGE_A(PG8_SA(0, 0), a2);
            PG8_WAIT_V(8); PG8_WAIT_L(0); PG8_BAR; PG8_MMA(1, 0, At, B0); PG8_MMA(1, 1, At, B1); PG8_BAR; PG8_SCHED;
            PG8_LDB(B0, 1, 0); PG8_LDB(B1, 1, 1); PG8_SCHED; PG8_LDA(At, 1, 0); PG8_STAGE_A(PG8_SA(0, 1), a2 + hstep);
            PG8_WAIT_V(8); PG8_WAIT_L(0); PG8_BAR; PG8_MMA(0, 0, At, B0); PG8_MMA(0, 1, At, B1); PG8_BAR; PG8_SCHED;
            PG8_LDA(At, 1, 1); PG8_STAGE_B(PG8_SB(1, 0), b3); PG8_STAGE_B(PG8_SB(1, 1), b3 + hstep); PG8_STAGE_A(PG8_SA(1, 0), a3);
            PG8_WAIT_V(8); PG8_WAIT_L(0); PG8_BAR; PG8_MMA(1, 0, At, B0); PG8_MMA(1, 1, At, B1); PG8_BAR; PG8_SCHED;
        }
        if constexpr (FP8) {
            asm volatile("s_nop 15\n\ts_nop 15" : "+v"(acc[0][0][0][0]), "+v"(acc[0][0][0][1]), "+v"(acc[0][0][1][0]), "+v"(acc[0][0][1][1]), "+v"(acc[0][0][2][0]), "+v"(acc[0][0][2][1]), "+v"(acc[0][0][3][0]), "+v"(acc[0][0][3][1]) :: "memory");
            asm volatile("" : "+v"(acc[0][1][0][0]), "+v"(acc[0][1][0][1]), "+v"(acc[0][1][1][0]), "+v"(acc[0][1][1][1]), "+v"(acc[0][1][2][0]), "+v"(acc[0][1][2][1]), "+v"(acc[0][1][3][0]), "+v"(acc[0][1][3][1]));
            asm volatile("" : "+v"(acc[1][0][0][0]), "+v"(acc[1][0][0][1]), "+v"(acc[1][0][1][0]), "+v"(acc[1][0][1][1]), "+v"(acc[1][0][2][0]), "+v"(acc[1][0][2][1]), "+v"(acc[1][0][3][0]), "+v"(acc[1][0][3][1]));
            asm volatile("" : "+v"(acc[1][1][0][0]), "+v"(acc[1][1][0][1]), "+v"(acc[1][1][1][0]), "+v"(acc[1][1][1][1]), "+v"(acc[1][1][2][0]), "+v"(acc[1][1][2][1]), "+v"(acc[1][1][3][0]), "+v"(acc[1][1][3][1]));
        }
        if (wr == 0) PG8_BAR;
        E(acc, cur, wr, wc, fr, fq);
        if (!has_next) break;
#pragma unroll
        for (int a = 0; a < 2; ++a)
#pragma unroll
            for (int b = 0; b < 2; ++b)
#pragma unroll
                for (int m = 0; m < 4; ++m)
#pragma unroll
                    for (int n = 0; n < 2; ++n) acc[a][b][m][n] = (f32x4){0.f, 0.f, 0.f, 0.f};
        cur = nxt; cA = nA; cB = nB; ++ui;
        if (wr == 1) PG8_BAR;
    }
    PG8_WAIT_V(0);
    PG8_BAR;
#undef PG8_SA
#undef PG8_SB
#undef PG8_STAGE_X
#undef PG8_STAGE_A
#undef PG8_STAGE_B
#undef PG8_LDA
#undef PG8_LDB
#undef PG8_MMA
#undef PG8_WAIT_V
#undef PG8_WAIT_L
#undef PG8_BAR
#undef PG8_SCHED
}
}
using pg8::Unit;

#define XB_TMO      128
#define XB_XCNT(j)  (256  + 64 * (j))
#define XB_XSUB(j)  (1280 + 64 * (j))
#define XB_XGEN(j)  (2304 + 64 * (j))
#define XB_TOP      3328
#define XB_TOPGEN   3392
#define XCD_BAR_WORDS 3456
#define XB_SPIN_CAP (1u << 22)
__device__ __forceinline__ unsigned xb_ld(unsigned* p)              { return __hip_atomic_load(p, __ATOMIC_RELAXED, __HIP_MEMORY_SCOPE_AGENT); }
__device__ __forceinline__ unsigned xb_add(unsigned* p, unsigned v) { return __hip_atomic_fetch_add(p, v, __ATOMIC_RELAXED, __HIP_MEMORY_SCOPE_AGENT); }
__device__ __forceinline__ unsigned xb_xcc_id() { return (unsigned)__builtin_amdgcn_s_getreg((3 << 11) | 20) & 0xFu; }
#define XB_SPIN(cond, bar) do { unsigned _sp = 0; while (cond) { __builtin_amdgcn_s_sleep(1); \
    if ((++_sp & 255u) == 0u) { if (xb_ld(&(bar)[XB_TMO])) break; if (_sp > XB_SPIN_CAP) { atomicAdd(&(bar)[XB_TMO], 1u); break; } } } } while (0)
struct XcdBarrier { unsigned* bar; unsigned x; volatile LAS unsigned* st; };
__device__ __forceinline__ XcdBarrier xcd_barrier_post(unsigned* bar, volatile LAS unsigned* st) {
    XcdBarrier b; b.bar = bar; b.x = xb_xcc_id(); b.st = st;
    if (threadIdx.x == 0) (void)xb_add(&bar[XB_XCNT(b.x)], 1u);
    return b;
}
__device__ __forceinline__ void xcd_barrier_complete(unsigned* bar, unsigned x, unsigned& nloc, unsigned& nx) {
    const unsigned G = gridDim.x * gridDim.y * gridDim.z;
    unsigned sum, cnt, mine, sp = 0u;
    for (;;) {
        sum = 0u; cnt = 0u; mine = 0u;
#pragma unroll
        for (unsigned j = 0; j < 16; ++j) { const unsigned c = xb_ld(&bar[XB_XCNT(j)]); sum += c; cnt += (c > 0u) ? 1u : 0u; mine = (j == x) ? c : mine; }
        if (sum == G) break;
        __builtin_amdgcn_s_sleep(1);
        if ((++sp & 255u) == 0u) { if (xb_ld(&bar[XB_TMO])) break; if (sp > XB_SPIN_CAP) { atomicAdd(&bar[XB_TMO], 1u); break; } }
    }
    nloc = mine > 0u ? mine : 1u; nx = cnt > 0u ? cnt : 1u;
}
__device__ __forceinline__ void xcd_barrier(const XcdBarrier& b) {
    asm volatile("s_waitcnt vmcnt(0)" ::: "memory");
    __syncthreads();
    if (threadIdx.x == 0) {
        unsigned* bar = b.bar;
        __builtin_amdgcn_s_waitcnt(0);
        unsigned nloc = b.st[0], nx = b.st[1];
        if (nloc == 0u) { xcd_barrier_complete(bar, b.x, nloc, nx); b.st[0] = nloc; b.st[1] = nx; }
        const unsigned old = xb_add(&bar[XB_XSUB(b.x)], 1u);
        const unsigned gen = old / nloc;
        if (old + 1u == (gen + 1u) * nloc) {
            __builtin_amdgcn_fence(__ATOMIC_RELEASE, "agent");
            asm volatile("s_waitcnt vmcnt(0)" ::: "memory");
            const unsigned og = xb_add(&bar[XB_TOP], 1u);
            const unsigned tg = og / nx;
            if (og + 1u == (tg + 1u) * nx) xb_add(&bar[XB_TOPGEN], 1u);
            else XB_SPIN(xb_ld(&bar[XB_TOPGEN]) == tg, bar);
            __builtin_amdgcn_fence(__ATOMIC_ACQUIRE, "agent");
            xb_add(&bar[XB_XGEN(b.x)], 1u);
            asm volatile("s_waitcnt vmcnt(0)" ::: "memory");
        } else {
            XB_SPIN(xb_ld(&bar[XB_XGEN(b.x)]) == gen, bar);
            __builtin_amdgcn_fence(__ATOMIC_ACQUIRE, "agent");
            asm volatile("s_waitcnt vmcnt(0)" ::: "memory");
        }
    }
    __syncthreads();
}

constexpr size_t MiB = 1u << 20;
constexpr size_t al(size_t x) { return (x + 255) & ~(size_t)255; }
constexpr size_t WS_CTL = 0, CTL_ZERO_BYTES = 1 * MiB;
constexpr size_t WS_WIN = 1 * MiB;
constexpr size_t WS_WLOW = WS_WIN + (size_t)NPROJ * KD * 2;
constexpr size_t WS_WRH = WS_WLOW + 16 * KD * 2;
constexpr size_t WS_WRL = WS_WRH + 32 * KD * 2;
constexpr size_t WS_WOUT = WS_WRL + 32 * KD * 2;
constexpr size_t WS_WCQ = WS_WOUT + (size_t)DM * KD * 2;
constexpr size_t WS_WCKV = WS_WCQ + (size_t)DM * KD * 2;
constexpr size_t WS_WCO = WS_WCKV + (size_t)2 * DM * KD * 2;
constexpr size_t WS_WGU = WS_WCO + (size_t)DM * KD * 2;
constexpr size_t WS_WD = WS_WGU + (size_t)NEXP * 2 * DFF * KD * 2;
constexpr size_t WS_H1 = WS_WD + (size_t)NEXP * DM * KD * 2;
constexpr size_t WS_MEMN = WS_H1 + (size_t)NT * DM * 2;
constexpr size_t WS_SBQ = WS_MEMN + (size_t)NMEM * DM * 2;
constexpr size_t WS_SBK = WS_SBQ + (size_t)NT * 1024 * 2;
constexpr size_t WS_SBVT = WS_SBK + (size_t)NT * 1024 * 2;
constexpr size_t WS_GQ = WS_SBVT + (size_t)NT * 1024 * 2;
constexpr size_t WS_GK = WS_GQ + (size_t)NT * 512 * 2;
constexpr size_t WS_GVT = WS_GK + (size_t)NT * 512 * 2;
constexpr size_t WS_GR = WS_GVT + (size_t)NT * 1024 * 2;
constexpr size_t WS_GLOW = WS_GR + (size_t)NT * 1024 * 2;
constexpr size_t WS_KVK = WS_GLOW + (size_t)NT * 16 * 4;
constexpr size_t WS_KVVT = WS_KVK + (size_t)NMEM * DM * 2;
constexpr size_t WS_QIN = WS_KVVT + (size_t)NMEM * DM * 2;
constexpr size_t WS_OINTRA = WS_QIN + (size_t)NT * 512 * 2;
constexpr size_t WS_KVN = WS_OINTRA + (size_t)512 * 16384 * 4;
constexpr size_t WS_DECAY = WS_KVN + (size_t)512 * 32768 * 4;
constexpr size_t WS_STATE = WS_DECAY + (size_t)512 * 128 * 4;
constexpr size_t WS_MIXO = WS_STATE + (size_t)512 * 32768 * 2;
constexpr size_t WS_X1 = WS_MIXO + (size_t)NT * DM * 2;
constexpr size_t WS_X1B = WS_X1 + (size_t)NT * DM * 4;
constexpr size_t WS_SSQ = WS_X1B + (size_t)NT * DM * 2;
constexpr size_t WS_CQ = WS_SSQ + (size_t)32 * NT * 4;
constexpr size_t WS_ATTO = WS_CQ + (size_t)NT * DM * 2;
constexpr size_t WS_X2 = WS_ATTO + (size_t)NT * DM * 2;
constexpr size_t WS_TOPE = WS_X2 + (size_t)NT * DM * 4;
constexpr size_t WS_TOPW = WS_TOPE + (size_t)NT * 4 * 4;
constexpr size_t WS_RSTD3 = WS_TOPW + (size_t)NT * 4 * 4;
constexpr size_t WS_HIST = WS_RSTD3 + (size_t)NT * 4;
constexpr size_t WS_SLOTW = WS_HIST + (size_t)256 * 32 * 4;
constexpr size_t WS_TOKSLOT = WS_SLOTW + (size_t)(NASSIGN + 256) * 4;
constexpr size_t WS_CNT = WS_TOKSLOT + (size_t)NT * 4 * 4;
constexpr size_t WS_XS = al(WS_CNT + 256);
constexpr size_t WS_ACT = WS_XS + (size_t)(NASSIGN + 256) * DM * 2;
constexpr size_t WS_Y = WS_ACT + (size_t)(NASSIGN + 256) * DM * 2;
constexpr size_t WS_P = WS_Y + (size_t)(NASSIGN + 256) * DM * 2;
constexpr size_t WS_MT = WS_P + (size_t)16 * SEQ * MEMLEN * 2;
constexpr size_t WS_VWT = WS_MT + (size_t)16 * MEMLEN * DM * 2;
constexpr size_t WS_END = WS_VWT + (size_t)NB * DM * 1024 * 2;

constexpr int CW_BAR = 4096;
static_assert((CW_BAR + XCD_BAR_WORDS) * 4 <= (int)CTL_ZERO_BYTES, "ctl");

constexpr int RING_BYTES = 131072, LDSCTL_OFF = RING_BYTES, MISC_OFF = LDSCTL_OFF + 64, TAB_OFF = LDSCTL_OFF + 256;
constexpr int RED1_OFF = LDSCTL_OFF + 2048, RED2_OFF = RED1_OFF + 4096;
constexpr int LDS_BYTES = 147456;

constexpr int NWAVES = 8, NTHR = 512;

struct Args { const float* in[22]; float* out; unsigned char* ws; int ph_lo, ph_hi; };

struct Frame {
    LAS unsigned char* lds;
    int tid, lane, wave, G, bid;
    unsigned char* ws;
};

__device__ __forceinline__ void cvt_tile(const float* __restrict__ W, int ldn, int k0, int n0, bf16* __restrict__ dst, int dst_row0, const float* __restrict__ gk, LAS unsigned* scr, int lane) {
    const int q = lane >> 4, c4 = lane & 15;
    f32x4 v[16];
#pragma unroll
    for (int i = 0; i < 16; ++i) { const int k = k0 + 8 * (i >> 1) + 2 * q + (i & 1); v[i] = *(const f32x4*)(W + (size_t)k * ldn + n0 + 4 * c4); if (gk) v[i] = v[i] * gk[k]; }
#pragma unroll
    for (int p = 0; p < 8; ++p)
#pragma unroll
        for (int j = 0; j < 4; ++j) { const int n = 4 * c4 + j, kd = 4 * p + q; scr[n * 32 + (kd ^ ((c4 & 7) << 2))] = cvt_pk_bf16(v[2 * p][j], v[2 * p + 1][j]); }
    LDS_WAIT();
#pragma unroll
    for (int jj = 0; jj < 8; ++jj) { const int n = 8 * jj + (lane >> 3), ch = lane & 7; const u32x4 w = *(const LAS u32x4*)(scr + n * 32 + ((ch ^ ((n >> 2) & 7)) << 2));
        *(u32x4*)(dst + (size_t)(dst_row0 + n) * KD + k0 + 8 * ch) = w; }
    LDS_WAIT();
}
__device__ __forceinline__ unsigned pk_fp8x4(float a, float b, float c, float d) { int r = __builtin_amdgcn_cvt_pk_fp8_f32(a, b, 0, false); r = __builtin_amdgcn_cvt_pk_fp8_f32(c, d, r, true); return (unsigned)r; }
__device__ __forceinline__ void rms_row_bf16(const float* __restrict__ xrow, const float* __restrict__ g, bf16* __restrict__ orow, int lane) {
    const f32x4* xr = (const f32x4*)xrow + lane; const f32x4* gr = (const f32x4*)g + lane;
    f32x4 v[8]; float s = 0.f;
#pragma unroll
    for (int j = 0; j < 8; ++j) { v[j] = xr[64 * j]; s += (v[j].x * v[j].x + v[j].y * v[j].y) + (v[j].z * v[j].z + v[j].w * v[j].w); }
    const float rstd = 1.0f / sqrtf(wave_sum(s) * (1.f / DM) + EPS);
    u32x2* o8 = (u32x2*)orow + lane;
#pragma unroll
    for (int j = 0; j < 8; ++j) { const f32x4 gg = gr[64 * j]; u32x2 w; w.x = cvt_pk_bf16(v[j].x * rstd * gg.x, v[j].y * rstd * gg.y); w.y = cvt_pk_bf16(v[j].z * rstd * gg.z, v[j].w * rstd * gg.w); o8[64 * j] = w; }
}

constexpr int MOE_ITEMS = NEXP * 64 * 16 + NEXP * 32 * 16;
#ifndef CONV_WGS
#define CONV_WGS 64
#endif
#ifndef E_P1
#define E_P1 9
#endif
constexpr int E_P7 = 7, E_PRE = E_P1 + E_P7;
#ifndef DN_IN_P11
#define DN_IN_P11 16
#endif
#ifndef E_P0
#define E_P0 0
#endif
#ifndef D_P0
#define D_P0 0
#endif
constexpr int NCOMP = 256 - CONV_WGS, CONV_NA = E_P1 * 1024, CONV_NB = E_P7 * 1024;
constexpr int CW_EXP = 8192;
static_assert(E_PRE + E_P0 <= 32 && DN_IN_P11 + D_P0 <= 32, "expert conversion ranges");
struct MoeItem { const float* W; int ldn, k0, n0; unsigned char* dst; int drow; };
__device__ __forceinline__ MoeItem moe_item_desc(const Frame& F, const Args& A, int it) {
    constexpr int J5 = NEXP * 64 * 16; MoeItem m;
    if (it < J5) { const int e = it >> 10, r = it & 1023, kt = r >> 6, n0 = (r & 63) * 64;
        m.W = A.in[17] + (size_t)e * DM * 2 * DFF; m.ldn = 2 * DFF; m.k0 = kt * 128; m.n0 = n0; m.dst = F.ws + WS_WGU + (size_t)e * 2 * DFF * KD;
        m.drow = (n0 < DFF) ? ((n0 >> 7) * 256 + (n0 & 127)) : (((n0 - DFF) >> 7) * 256 + 128 + ((n0 - DFF) & 127)); }
    else { const int q2 = it - J5, e = q2 >> 9, r = q2 & 511, kt = r >> 5, n0 = (r & 31) * 64;
        m.W = A.in[19] + (size_t)e * DFF * DM; m.ldn = DM; m.k0 = kt * 128; m.n0 = n0; m.dst = F.ws + WS_WD + (size_t)e * DM * KD; m.drow = n0; }
    return m;
}
template <bool SLD> __device__ __forceinline__ void moe_ld_half(f32x4 (&v)[16], const MoeItem& m, int half, int lane) {
    const int q = lane >> 4, c4 = lane & 15;
    if constexpr (SLD) { const __amdgpu_buffer_rsrc_t rw = __builtin_amdgcn_make_buffer_rsrc((void*)m.W, 0, 0x7fffffff, 0x00020000);
#pragma unroll
        for (int i = 0; i < 16; ++i) { const int k = m.k0 + 64 * half + 16 * (i >> 2) + 4 * q + (i & 3); v[i] = __builtin_bit_cast(f32x4, __builtin_amdgcn_raw_buffer_load_b128(rw, (k * m.ldn + m.n0 + 4 * c4) * 4, 0, CONV_LD_AUX)); } }
    else {
#pragma unroll
        for (int i = 0; i < 16; ++i) { const int k = m.k0 + 64 * half + 16 * (i >> 2) + 4 * q + (i & 3); v[i] = __builtin_nontemporal_load((const f32x4*)(m.W + (size_t)k * m.ldn + m.n0 + 4 * c4)); } }
}
__device__ __forceinline__ void moe_cv_half(const f32x4 (&v)[16], LAS unsigned* scr, int half, int lane) {
    const int q = lane >> 4, c4 = lane & 15;
#pragma unroll
    for (int pp = 0; pp < 4; ++pp)
#pragma unroll
        for (int j = 0; j < 4; ++j) scr[(4 * c4 + j) * 33 + 16 * half + 4 * pp + q] = pk_fp8x4(v[4 * pp][j] * 64.0f, v[4 * pp + 1][j] * 64.0f, v[4 * pp + 2][j] * 64.0f, v[4 * pp + 3][j] * 64.0f);
}
template <bool SC1> __device__ __forceinline__ void moe_flush(const MoeItem& m, LAS unsigned* scr, int lane) {
#pragma unroll
    for (int jj = 0; jj < 8; ++jj) { const int n = 8 * jj + (lane >> 3), ch = lane & 7; u32x4 w; const LAS unsigned* sp = scr + n * 33 + 4 * ch; w.x = sp[0]; w.y = sp[1]; w.z = sp[2]; w.w = sp[3];
        if constexpr (SC1) { const __amdgpu_buffer_rsrc_t rs = __builtin_amdgcn_make_buffer_rsrc(m.dst, 0, 0x7fffffff, 0x00020000);
            __builtin_amdgcn_raw_buffer_store_b128(w, rs, (m.drow + n) * KD + m.k0 + 16 * ch, 0, 16); }
        else __builtin_nontemporal_store(w, (u32x4*)(m.dst + (size_t)(m.drow + n) * KD + m.k0 + 16 * ch)); }
}
template <bool SC1, bool SLD> __device__ __forceinline__ void moe_items_stream(const Frame& F, const Args& A, int it0, int stride, int count, LAS unsigned* scr) {
    if (count <= 0) return;
    f32x4 va[16], vb[16];
    MoeItem cur = moe_item_desc(F, A, it0);
    moe_ld_half<SLD>(va, cur, 0, F.lane);
    for (int i = 0; i < count; ++i) {
        moe_ld_half<SLD>(vb, cur, 1, F.lane);
        moe_cv_half(va, scr, 0, F.lane);
        MoeItem nxt = cur;
        if (i + 1 < count) { nxt = moe_item_desc(F, A, it0 + (i + 1) * stride); moe_ld_half<SLD>(va, nxt, 0, F.lane); }
        moe_cv_half(vb, scr, 1, F.lane);
        LDS_WAIT();
        moe_flush<SC1>(cur, scr, F.lane);
        LDS_WAIT();
        cur = nxt;
    }
}
template <bool SC1, bool SLD = SC1> __device__ __forceinline__ void moe_item_fp8(const Frame& F, const Args& A, int it, LAS unsigned* scr) { moe_items_stream<SC1, SLD>(F, A, it, 0, 1, scr); }
__device__ __forceinline__ void p0_prologue(const Frame& F, const Args& A) {
    LAS unsigned* scr = (LAS unsigned*)(F.lds + F.wave * 16384);
    const int gw = F.bid * NWAVES + F.wave, NGW = F.G * NWAVES;
    const float* w_in = A.in[3]; const float* w_out = A.in[8]; const float* w_cq = A.in[11]; const float* w_ckv = A.in[12]; const float* w_co = A.in[13];
    const float* w_gu = A.in[17]; const float* w_dn = A.in[19]; (void)w_gu; (void)w_dn;
    constexpr int I0 = 96 * 32, I1 = 32 * 32, I2 = 0, I3 = 64 * 32, I4 = 32 * 32, I5 = MOE_FP8 ? 0 : NEXP * 64 * 32, I6 = MOE_FP8 ? 0 : NEXP * 32 * 32;
    constexpr int NITEMS = I0 + I1 + I2 + I3 + I4 + I5 + I6;
    for (int it = gw; it < NITEMS; it += NGW) {
        int r = it; const float* W; int ldn, nct; bf16* dst; const float* gk = nullptr; int mode = 0;
        if (r < I0) { W = w_in; ldn = INC; nct = 96; dst = (bf16*)(F.ws + WS_WIN); }
        else if ((r -= I0) < I1) { W = w_out; ldn = DM; nct = 32; dst = (bf16*)(F.ws + WS_WOUT); }
        else if ((r -= I1) < I3) { W = w_ckv; ldn = 2 * DM; nct = 64; dst = (bf16*)(F.ws + WS_WCKV); }
        else if ((r -= I3) < I4) { W = w_co; ldn = DM; nct = 32; dst = (bf16*)(F.ws + WS_WCO); }
        else if ((r -= I4) < I5) { const int e = r / (64 * 32); r -= e * (64 * 32); W = w_gu + (size_t)e * DM * 2 * DFF; ldn = 2 * DFF; nct = 64; dst = (bf16*)(F.ws + WS_WGU) + (size_t)e * 2 * DFF * KD; mode = 1; }
        else { r -= I5; const int e = r / (32 * 32); r -= e * (32 * 32); W = w_dn + (size_t)e * DFF * DM; ldn = DM; nct = 32; dst = (bf16*)(F.ws + WS_WD) + (size_t)e * DM * KD; }
        const int kt = r / nct, ct = r - kt * nct; const int n0 = ct * 64;
        int drow = n0;
        if (mode == 1) drow = (n0 < DFF) ? ((n0 >> 7) * 256 + (n0 & 127)) : (((n0 - DFF) >> 7) * 256 + 128 + ((n0 - DFF) & 127));
        cvt_tile(W, ldn, kt * 64, n0, dst, drow, gk, scr, F.lane);
    }
#if MOE_FP8
    if (CONV_WGS) {
        for (int it = (32 - E_P0) * 1024 + gw; it < 32768; it += NGW) moe_item_fp8<false>(F, A, it, scr);
        for (int it = 32768 + (32 - D_P0) * 512 + gw; it < MOE_ITEMS; it += NGW) moe_item_fp8<false>(F, A, it, scr);
    }
#endif
    {
        const int gt = F.bid * NTHR + F.tid, NGT = F.G * NTHR;
        bf16* wlow = (bf16*)(F.ws + WS_WLOW); bf16* wrh = (bf16*)(F.ws + WS_WRH); bf16* wrl = (bf16*)(F.ws + WS_WRL);
        const float* w_r = A.in[15]; const float* g_moe = A.in[14];
        { const float* g_cross = A.in[9]; bf16* wcqn = (bf16*)(F.ws + WS_WCQ);
          for (int i = gt; i < DM * DM / 4; i += NGT) { const int k = i >> 9; const f32x4 v = *((const f32x4*)w_cq + i) * g_cross[k]; st_bf16x4(wcqn + (size_t)i * 4, v); } }
        for (int i = gt; i < 16 * KD; i += NGT) { const int k = i >> 4, r = i & 15; wlow[r * KD + k] = f2bf(w_in[(size_t)k * INC + NPROJ + r]); }
        for (int i = gt; i < 32 * KD; i += NGT) { const int k = i >> 5, e = i & 31; const float w = w_r[k * 32 + e] * g_moe[k]; const bf16 h = f2bf(w); wrh[e * KD + k] = h; wrl[e * KD + k] = f2bf(w - bf2f(h)); }
    }
    for (int m = gw; m < NT + NMEM; m += NGW) {
        if (m < NT) rms_row_bf16(A.in[0] + (size_t)m * DM, A.in[2], (bf16*)(F.ws + WS_H1) + (size_t)m * DM, F.lane);
        else rms_row_bf16(A.in[1] + (size_t)(m - NT) * DM, A.in[10], (bf16*)(F.ws + WS_MEMN) + (size_t)(m - NT) * DM, F.lane);
    }
}

__device__ __forceinline__ void conv_step(const Frame& F, const Args& A, int seq) {
    LAS unsigned* scr = (LAS unsigned*)(F.lds + F.wave * 16384);
    const int cw = F.bid - NCOMP;
    if (seq < 32) moe_items_stream<true, true>(F, A, seq * 1024 + (cw * NWAVES + F.wave) * 2, 1, 2, scr);
    else moe_item_fp8<true>(F, A, 32768 + (seq - 32) * 512 + cw * NWAVES + F.wave, scr);
    VM_WAIT(); __syncthreads();
    if (F.tid == 0) __hip_atomic_fetch_add((unsigned*)(F.ws + WS_CTL) + CW_EXP + 64 * seq, 1u, __ATOMIC_RELAXED, __HIP_MEMORY_SCOPE_AGENT);
}

#define EPI_LOOP(...) _Pragma("unroll") for (int ai = 0; ai < 2; ++ai) _Pragma("unroll") for (int m = 0; m < 4; ++m) { const int rl = ai * 128 + wr * 64 + m * 16 + fr; \
        _Pragma("unroll") for (int bj = 0; bj < 2; ++bj) _Pragma("unroll") for (int n = 0; n < 2; ++n) { const int cl = bj * 128 + wc * 32 + n * 16 + 4 * fq; const f32x4 v = acc[ai][bj][m][n]; __VA_ARGS__ } }
#define EPI_LOOP_P(...) _Pragma("unroll") for (int ai = 0; ai < 2; ++ai) _Pragma("unroll") for (int m = 0; m < 4; ++m) { const int rl = ai * 128 + wr * 64 + m * 16 + fr; \
        _Pragma("unroll") for (int bj = 0; bj < 2; ++bj) { const int cl = bj * 128 + wc * 32 + 8 * fq; const f32x4 v0 = acc[ai][bj][m][0], v1 = acc[ai][bj][m][1]; __VA_ARGS__ } }
__device__ __forceinline__ void st_bf16x8(bf16* p, f32x4 a, f32x4 b) { u32x4 w; w.x = cvt_pk_bf16(a.x, a.y); w.y = cvt_pk_bf16(a.z, a.w); w.z = cvt_pk_bf16(b.x, b.y); w.w = cvt_pk_bf16(b.z, b.w); *(u32x4*)p = w; }

struct EpiInProj {
    static constexpr bool PERM = true;
    unsigned char* ws;
    __device__ __forceinline__ void operator()(f32x4 (&acc)[2][2][4][2], const Unit& u, int wr, int wc, int fr, int fq) const {
        const int c0 = u.c0;
        if (c0 < 2048 || (c0 >= 3072 && c0 < 4096) || c0 >= 5120) {
            bf16* base; int ld, cc;
            if (c0 < 1024) { base = (bf16*)(ws + WS_SBQ); ld = 1024; cc = c0; }
            else if (c0 < 2048) { base = (bf16*)(ws + WS_SBK); ld = 1024; cc = c0 - 1024; }
            else if (c0 < 3584) { base = (bf16*)(ws + WS_GQ); ld = 512; cc = c0 - 3072; }
            else if (c0 < 4096) { base = (bf16*)(ws + WS_GK); ld = 512; cc = c0 - 3584; }
            else { base = (bf16*)(ws + WS_GR); ld = 1024; cc = c0 - 5120; }
            EPI_LOOP_P( st_bf16x8(base + (size_t)(u.r0 + rl) * ld + cc + cl, v0, v1); )
        } else {
            bf16* base = (bf16*)(ws + (c0 < 3072 ? WS_SBVT : WS_GVT)); const int cc = c0 - (c0 < 3072 ? 2048 : 4096);
            EPI_LOOP_P( const int r = u.r0 + rl, b = r >> 11, sq = r & 2047; const int c = cc + cl;
                _Pragma("unroll") for (int j = 0; j < 4; ++j) { base[((size_t)(b * 1024 + c + j)) * SEQ + sq] = f2bf(v0[j]); base[((size_t)(b * 1024 + c + 4 + j)) * SEQ + sq] = f2bf(v1[j]); } )
        }
    }
};
struct EpiKV {
    static constexpr bool PERM = true;
    unsigned char* ws;
    __device__ __forceinline__ void operator()(f32x4 (&acc)[2][2][4][2], const Unit& u, int wr, int wc, int fr, int fq) const {
        bf16* base = (bf16*)(ws + (u.c0 < 2048 ? WS_KVK : WS_KVVT)); const int cc = u.c0 < 2048 ? u.c0 : u.c0 - 2048;
        EPI_LOOP_P( st_bf16x8(base + (size_t)(u.r0 + rl) * DM + cc + cl, v0, v1); )
    }
};
struct EpiRes1 {
    static constexpr bool PERM = true;
    const float* x; float* x1; bf16* x1b; float* ssq;
    __device__ __forceinline__ void operator()(f32x4 (&acc)[2][2][4][2], const Unit& u, int wr, int wc, int fr, int fq) const {
#pragma unroll
        for (int ai = 0; ai < 2; ++ai)
#pragma unroll
            for (int m = 0; m < 4; ++m) { const int r = u.r0 + ai * 128 + wr * 64 + m * 16 + fr; float s = 0.f;
#pragma unroll
                for (int bj = 0; bj < 2; ++bj) { const int c = u.c0 + bj * 128 + wc * 32 + 8 * fq; const size_t o = (size_t)r * DM + c;
                    const f32x4 a = acc[ai][bj][m][0] + *(const f32x4*)(x + o), b = acc[ai][bj][m][1] + *(const f32x4*)(x + o + 4);
                    *(f32x4*)(x1 + o) = a; *(f32x4*)(x1 + o + 4) = b; st_bf16x8(x1b + o, a, b);
                    s += ((a.x * a.x + a.y * a.y) + (a.z * a.z + a.w * a.w)) + ((b.x * b.x + b.y * b.y) + (b.z * b.z + b.w * b.w)); }
                s += __shfl_xor(s, 16); s += __shfl_xor(s, 32);
                if (fq == 0) ssq[(size_t)((u.c0 >> 8) * 4 + wc) * NT + r] = s; }
    }
};
struct EpiRes2 {
    static constexpr bool PERM = false;
    const float* x1; float* x2;
    __device__ __forceinline__ void operator()(f32x4 (&acc)[2][2][4][2], const Unit& u, int wr, int wc, int fr, int fq) const {
        EPI_LOOP( const size_t o = (size_t)(u.r0 + rl) * DM + u.c0 + cl; *(f32x4*)(x2 + o) = v + *(const f32x4*)(x1 + o); )
    }
};
constexpr float WUNSC = (MOE_FP8 && MX_UNSCALED) ? (1.0f / 64.0f) : 1.0f;
struct EpiAct {
    static constexpr bool PERM = true;
    const float* bgu; bf16* act;
    __device__ __forceinline__ void operator()(f32x4 (&acc)[2][2][4][2], const Unit& u, int wr, int wc, int fr, int fq) const {
        const float* bg = bgu + (size_t)u.e * 2 * DFF; const int j0 = u.c0 + wc * 32 + 8 * fq;
        f32x4 b0[2], b1[2];
#pragma unroll
        for (int n = 0; n < 2; ++n) { b0[n] = *(const f32x4*)(bg + j0 + 4 * n); b1[n] = *(const f32x4*)(bg + DFF + j0 + 4 * n); }
#pragma unroll
        for (int ai = 0; ai < 2; ++ai)
#pragma unroll
            for (int m = 0; m < 4; ++m) { const int rl = ai * 128 + wr * 64 + m * 16 + fr; if (rl < u.rows) { f32x4 a[2];
#pragma unroll
                for (int n = 0; n < 2; ++n) { const f32x4 g = acc[ai][0][m][n] * WUNSC + b0[n], l = acc[ai][1][m][n] * WUNSC + b1[n];
#pragma unroll
                    for (int j = 0; j < 4; ++j) { const float gg = fminf(g[j], 7.0f), ll = fminf(fmaxf(l[j], -7.0f), 7.0f); a[n][j] = gg * frcp(1.0f + fexp2(-1.702f * LOG2E * gg)) * (ll + 1.0f); } }
#if MOE_FP8
                u32x2 w; w.x = pk_fp8x4(a[0].x, a[0].y, a[0].z, a[0].w); w.y = pk_fp8x4(a[1].x, a[1].y, a[1].z, a[1].w);
                *(u32x2*)((unsigned char*)act + (size_t)(u.r0 + rl) * DFF + j0) = w;
#else
                st_bf16x8(act + (size_t)(u.r0 + rl) * DFF + j0, a[0], a[1]);
#endif
                } }
    }
};
struct EpiY {
    static constexpr bool PERM = true;
    const float* bd; const float* sw; bf16* y;
    __device__ __forceinline__ void operator()(f32x4 (&acc)[2][2][4][2], const Unit& u, int wr, int wc, int fr, int fq) const {
        const float* bb = bd + (size_t)u.e * DM;
        f32x4 bv[2][2];
#pragma unroll
        for (int bj = 0; bj < 2; ++bj)
#pragma unroll
            for (int n = 0; n < 2; ++n) bv[bj][n] = *(const f32x4*)(bb + u.c0 + bj * 128 + wc * 32 + 8 * fq + 4 * n);
#pragma unroll
        for (int ai = 0; ai < 2; ++ai)
#pragma unroll
            for (int m = 0; m < 4; ++m) { const int rl = ai * 128 + wr * 64 + m * 16 + fr; if (rl < u.rows) { const float w = sw[u.r0 + rl];
#pragma unroll
                for (int bj = 0; bj < 2; ++bj) { const int c = u.c0 + bj * 128 + wc * 32 + 8 * fq; const f32x4 y0 = (acc[ai][bj][m][0] * WUNSC + bv[bj][0]) * w, y1 = (acc[ai][bj][m][1] * WUNSC + bv[bj][1]) * w;
#if Y_FP8
                    u32x2 yw; yw.x = pk_fp8x4(y0.x * 16.0f, y0.y * 16.0f, y0.z * 16.0f, y0.w * 16.0f); yw.y = pk_fp8x4(y1.x * 16.0f, y1.y * 16.0f, y1.z * 16.0f, y1.w * 16.0f);
                    *(u32x2*)((unsigned char*)y + (size_t)(u.r0 + rl) * DM + c) = yw;
#else
                    st_bf16x8(y + (size_t)(u.r0 + rl) * DM + c, y0, y1);
#endif
                    } } }
    }
};

constexpr int RSC_OFF = RED2_OFF + 4096;
__device__ __forceinline__ void xattn_row_scales(LAS unsigned char* lds, const float* __restrict__ ssq, int r0) {
    const int t = threadIdx.x, row = t >> 1, hf = t & 1; float q = 0.f;
#pragma unroll
    for (int pp = 0; pp < 16; ++pp) q += ssq[(size_t)(16 * hf + pp) * NT + r0 + row];
    q += __shfl_xor(q, 1);
    if (hf == 0) ((LAS float*)(lds + RSC_OFF))[row] = (0.04419417382415922f * LOG2E) / sqrtf(q * (1.f / DM) + EPS);
    __syncthreads();
}
struct EpiSoftmax {
    static constexpr bool PERM = true;
    LAS unsigned char* lds; bf16* P;
    __device__ __forceinline__ void operator()(f32x4 (&acc)[2][2][4][2], const Unit& u, int wr, int wc, int fr, int fq) const {
        LAS float* red1 = (LAS float*)(lds + RED1_OFF); LAS float* red2 = (LAS float*)(lds + RED2_OFF);
        float rs[2][4];
#pragma unroll
        for (int ai = 0; ai < 2; ++ai)
#pragma unroll
            for (int m = 0; m < 4; ++m) rs[ai][m] = ((const LAS float*)(lds + RSC_OFF))[ai * 128 + wr * 64 + m * 16 + fr];
#pragma unroll
        for (int ai = 0; ai < 2; ++ai)
#pragma unroll
            for (int m = 0; m < 4; ++m) { const int rl = ai * 128 + wr * 64 + m * 16 + fr; float mx = -3.0e38f;
#pragma unroll
                for (int bj = 0; bj < 2; ++bj)
#pragma unroll
                    for (int n = 0; n < 2; ++n) { const f32x4 v = acc[ai][bj][m][n]; mx = fmaxf(fmaxf(mx, fmaxf(v.x, v.y)), fmaxf(v.z, v.w)); }
                mx = fmaxf(mx, __shfl_xor(mx, 16)); mx = fmaxf(mx, __shfl_xor(mx, 32));
                if (fq == 0) red1[rl * 4 + wc] = mx; }
        asm volatile("s_waitcnt lgkmcnt(0)" ::: "memory"); __builtin_amdgcn_s_barrier(); asm volatile("" ::: "memory");
#pragma unroll
        for (int ai = 0; ai < 2; ++ai)
#pragma unroll
            for (int m = 0; m < 4; ++m) { const int rl = ai * 128 + wr * 64 + m * 16 + fr; const f32x4 mv = *(const LAS f32x4*)(red1 + rl * 4);
                const float mx = fmaxf(fmaxf(mv.x, mv.y), fmaxf(mv.z, mv.w)); float sum = 0.f;
#pragma unroll
                for (int bj = 0; bj < 2; ++bj)
#pragma unroll
                    for (int n = 0; n < 2; ++n) { f32x4 v = acc[ai][bj][m][n];
#pragma unroll
                        for (int j = 0; j < 4; ++j) { v[j] = fexp2((v[j] - mx) * rs[ai][m]); sum += v[j]; }
                        acc[ai][bj][m][n] = v; }
                sum += __shfl_xor(sum, 16); sum += __shfl_xor(sum, 32);
                if (fq == 0) red2[rl * 4 + wc] = sum; }
        asm volatile("s_waitcnt lgkmcnt(0)" ::: "memory"); __builtin_amdgcn_s_barrier(); asm volatile("" ::: "memory");
#pragma unroll
        for (int ai = 0; ai < 2; ++ai)
#pragma unroll
            for (int m = 0; m < 4; ++m) { const int rl = ai * 128 + wr * 64 + m * 16 + fr; const f32x4 sv = *(const LAS f32x4*)(red2 + rl * 4);
                const float inv = 1.0f / ((sv.x + sv.y) + (sv.z + sv.w));
#pragma unroll
                for (int bj = 0; bj < 2; ++bj) st_bf16x8(P + (size_t)(u.r0 + rl) * 1024 + u.c0 + bj * 128 + wc * 32 + 8 * fq, acc[ai][bj][m][0] * inv, acc[ai][bj][m][1] * inv); }
        asm volatile("s_waitcnt lgkmcnt(0)" ::: "memory"); __builtin_amdgcn_s_barrier(); asm volatile("" ::: "memory");
    }
};
struct XpreOrder {
    const char* Kk; const char* Wcqn; const char* Wcot; const char* Vv; int c;
    __device__ bool next(int i, Unit& u) const { if (i > 0 || c >= 256) return false; u.rows = 256; u.e = 0;
        if (c < 128) { const int bh = c >> 3, nt = c & 7, b = bh >> 2, h = bh & 3;
            u.a = Kk + ((size_t)(b * MEMLEN) * DM + h * 512) * 2; u.b = Wcqn + ((size_t)(nt * 256) * DM + h * 512) * 2; u.r0 = bh * 256; u.c0 = nt * 256; u.e = 0; }
        else { const int q = c - 128, bh = q >> 3, nt = q & 7, b = bh >> 2, h = bh & 3;
            u.a = Wcot + ((size_t)(nt * 256) * DM + h * 512) * 2; u.b = Vv + ((size_t)(b * MEMLEN) * DM + h * 512) * 2; u.r0 = b * DM + nt * 256; u.c0 = h * 256; u.e = 1; }
        return true; }
    __device__ __forceinline__ void a_ready(const Unit&) const {}
};
struct EpiXpre {
    static constexpr bool PERM = true;
    bf16* MT; bf16* VWT;
    __device__ __forceinline__ void operator()(f32x4 (&acc)[2][2][4][2], const Unit& u, int wr, int wc, int fr, int fq) const {
        bf16* O = u.e ? VWT : MT; const int ld = u.e ? 1024 : DM;
        EPI_LOOP_P( st_bf16x8(O + (size_t)(u.r0 + rl) * ld + u.c0 + cl, v0, v1); )
    }
};
struct MixOrder {
    pg8::DenseOrder D; XpreOrder X; int c;
    __device__ bool next(int i, Unit& u) const { if (i > 1) return false; const bool first_dense = true;
        if ((i == 0) == first_dense) { const bool ok = D.next(0, u); u.e = 0; u.nt = 32; return ok; }
        const bool ok = X.next(0, u); u.e = u.e + 1; u.nt = 8; return ok; }
    __device__ __forceinline__ void a_ready(const Unit&) const {}
};
struct EpiMix {
    static constexpr bool PERM = true;
    EpiRes1 R; EpiXpre Xp;
    __device__ __forceinline__ void operator()(f32x4 (&acc)[2][2][4][2], const Unit& u, int wr, int wc, int fr, int fq) const {
        if (u.e == 0) R(acc, u, wr, wc, fr, fq); else { Unit v = u; v.e = u.e - 1; Xp(acc, v, wr, wc, fr, fq); }
    }
};
struct XsOrder {
    const char* X; const char* MT; int c;
    __device__ bool next(int i, Unit& u) const { if (i > 0 || c >= 128) return false; const int bh = c >> 3, qt = c & 7, b = bh >> 2, h = bh & 3;
        u.a = X + ((size_t)(b * SEQ + 256 * qt) * DM) * 2; u.b = MT + ((size_t)(bh * 256) * DM) * 2; u.r0 = b * SEQ + 256 * qt; u.c0 = h * 256; u.rows = 256; u.e = 0; return true; }
    __device__ __forceinline__ void a_ready(const Unit&) const {}
};
struct XoutOrder {
    const char* P; const char* VWT; int c;
    __device__ bool next(int i, Unit& u) const { if (i > 0 || c >= 256) return false; const int b = c >> 6, pm = (c >> 3) & 7, pn = c & 7;
        u.a = P + ((size_t)(b * SEQ + 256 * pm) * 1024) * 2; u.b = VWT + ((size_t)(b * DM + 256 * pn) * 1024) * 2; u.r0 = b * SEQ + 256 * pm; u.c0 = 256 * pn; u.rows = 256; u.e = 0; return true; }
    __device__ __forceinline__ void a_ready(const Unit&) const {}
};
struct KvOrder {
    const char* A; const char* Bt; int c;
    __device__ bool next(int i, Unit& u) const { if (i > 0 || c >= 64) return false; const int pm = c >> 4, pn = c & 15;
        u.a = A + (size_t)pm * 256 * KD * 2; u.b = Bt + (size_t)pn * 256 * KD * 2; u.r0 = pm * 256; u.c0 = pn * 256; u.rows = 256; u.e = 0; return true; }
    __device__ __forceinline__ void a_ready(const Unit&) const {}
};
struct MoeOrder {
    const LAS int* tab; const char* A; const char* Bt; int ntn, G, c; size_t bstride; int ocol; int pitchb;
    __device__ bool next(int i, Unit& u) const {
        const int idx = i * G + c; const int total = __builtin_amdgcn_readfirstlane(tab[32]);
        if (idx >= total) return false;
        int e = 0;
        for (int q = 1; q < 32; ++q) { const int p = __builtin_amdgcn_readfirstlane(tab[q]); if (idx >= p) e = q; }
        const int ue = __builtin_amdgcn_readfirstlane(tab[e]), st = __builtin_amdgcn_readfirstlane(tab[64 + e]), cn = __builtin_amdgcn_readfirstlane(tab[128 + e]);
        const int local = idx - ue, mt = local / ntn, nt = local - mt * ntn;
        u.a = A + (size_t)(st + 256 * mt) * pitchb; u.b = Bt + (size_t)e * bstride + (size_t)nt * 256 * pitchb;
        u.r0 = st + 256 * mt; u.c0 = nt * ocol; u.rows = (cn - 256 * mt) < 256 ? (cn - 256 * mt) : 256; u.e = e; return true;
    }
    const unsigned* ecnt; int* ready; int hi_ready;
    __device__ __forceinline__ void a_ready(const Unit& u) const {
        if (ecnt == nullptr || u.e <= *ready || u.e >= hi_ready) return;
        if (threadIdx.x < 64) { unsigned sp = 0;
            while ((unsigned)__builtin_amdgcn_readfirstlane(__hip_atomic_load(ecnt + 64 * u.e, __ATOMIC_RELAXED, __HIP_MEMORY_SCOPE_AGENT)) < (unsigned)CONV_WGS) { __builtin_amdgcn_s_sleep(4); if (++sp > (1u << 22)) break; }
            __builtin_amdgcn_fence(__ATOMIC_ACQUIRE, "agent");
            asm volatile("s_waitcnt vmcnt(0)" ::: "memory"); }
        asm volatile("" ::: "memory"); __builtin_amdgcn_s_barrier(); asm volatile("" ::: "memory");
        *ready = u.e;
    }
};
__device__ __forceinline__ void moe_table(const Frame& F, int ntn) {
    LAS int* tab = (LAS int*)(F.lds + TAB_OFF); const int* cs = (const int*)(F.ws + WS_CNT);
    if (F.tid < 32) { tab[64 + F.tid] = cs[32 + F.tid]; tab[128 + F.tid] = cs[F.tid]; }
    __syncthreads();
    if (F.tid == 0) { int p = 0; for (int e = 0; e < 32; ++e) { tab[e] = p; p += ((tab[128 + e] + 255) >> 8) * ntn; } tab[32] = p; }
    __syncthreads();
}

__device__ __forceinline__ void gla_low_job(const Frame& F) {
    const bf16* h1 = (const bf16*)(F.ws + WS_H1); const bf16* wl = (const bf16*)(F.ws + WS_WLOW); float* glow = (float*)(F.ws + WS_GLOW);
    LAS float* red = (LAS float*)F.lds;
    const int l = F.lane, r16 = l & 15, quad = l >> 4;
    for (int rb = F.bid; rb < NT / 32; rb += F.G) {
        f32x4 acc[2] = {{0.f, 0.f, 0.f, 0.f}, {0.f, 0.f, 0.f, 0.f}};
#pragma unroll
        for (int st = 0; st < 8; ++st) { const int k0 = 256 * F.wave + 32 * st + 8 * quad;
            const bf16x8 bfr = *(const bf16x8*)(wl + (size_t)r16 * KD + k0);
#pragma unroll
            for (int tb = 0; tb < 2; ++tb) { const bf16x8 afr = *(const bf16x8*)(h1 + (size_t)(rb * 32 + tb * 16 + r16) * KD + k0);
                acc[tb] = __builtin_amdgcn_mfma_f32_16x16x32_bf16(afr, bfr, acc[tb], 0, 0, 0); } }
#pragma unroll
        for (int tb = 0; tb < 2; ++tb)
#pragma unroll
            for (int j = 0; j < 4; ++j) red[(F.wave * 32 + tb * 16 + 4 * quad + j) * 16 + r16] = acc[tb][j];
        __syncthreads();
        { const int tok = F.tid >> 4, r = F.tid & 15; float s = 0.f;
#pragma unroll
          for (int w = 0; w < 8; ++w) s += red[(w * 32 + tok) * 16 + r];
          glow[(size_t)(rb * 32 + tok) * 16 + r] = s; }
        __syncthreads();
    }
}

__device__ __forceinline__ void sb_attn_wave(const Frame& F, const float* __restrict__ sb_g, int wu) {
    const bf16* Q = (const bf16*)(F.ws + WS_SBQ); const bf16* Kp = (const bf16*)(F.ws + WS_SBK); const bf16* VT = (const bf16*)(F.ws + WS_SBVT); bf16* O = (bf16*)(F.ws + WS_MIXO);
    const int l = F.lane, r = l & 31, hh = l >> 5;
    const int qb = 63 - (wu & 63), bh = wu >> 6, b = bh >> 3, h = bh & 7;
    const int t0 = qb * 32;
    bf16x8 qf[8];
#pragma unroll
    for (int st = 0; st < 8; ++st) qf[st] = *(const bf16x8*)(Q + (size_t)(b * SEQ + t0 + r) * 1024 + h * 128 + 16 * st + 8 * hh);
    f32x16 o[4];
#pragma unroll
    for (int d = 0; d < 4; ++d)
#pragma unroll
        for (int i = 0; i < 16; ++i) o[d][i] = 0.f;
    float R = 0.f;
    const float zs = 0.08838834764831845f * LOG2E;
    const int qpos = t0 + r;
    for (int kt = qb; kt >= 0; --kt) {
        f32x16 s;
#pragma unroll
        for (int i = 0; i < 16; ++i) s[i] = 0.f;
#pragma unroll
        for (int st = 0; st < 8; ++st) { const bf16x8 kf = *(const bf16x8*)(Kp + (size_t)(b * SEQ + kt * 32 + r) * 1024 + h * 128 + 16 * st + 8 * hh);
            s = __builtin_amdgcn_mfma_f32_32x32x16_bf16(kf, qf[st], s, 0, 0, 0); }
        float lm[16], lb[16];
#pragma unroll
        for (int i = 0; i < 16; ++i) { const int key = kt * 32 + (i & 3) + 8 * (i >> 2) + 4 * hh; const float z2 = s[i] * zs; const bool valid = key < qpos;
            const float sp = fmaxf(z2, 0.f) + flog2(1.f + fexp2(-fabsf(z2)));
            lm[i] = valid ? -sp : 0.f; lb[i] = z2 - sp; }
        float Gown[4], Gpar[4];
#pragma unroll
        for (int c = 0; c < 4; ++c) { Gown[c] = (lm[4 * c] + lm[4 * c + 1]) + (lm[4 * c + 2] + lm[4 * c + 3]); Gpar[c] = __shfl_xor(Gown[c], 32); }
        float sufT[4]; sufT[3] = 0.f;
#pragma unroll
        for (int c = 2; c >= 0; --c) sufT[c] = sufT[c + 1] + (Gown[c + 1] + Gpar[c + 1]);
        float p[16];
#pragma unroll
        for (int c = 0; c < 4; ++c) { float run = R + sufT[c] + (hh == 0 ? Gpar[c] : 0.f);
#pragma unroll
            for (int e = 3; e >= 0; --e) { const int i = 4 * c + e; const int key = kt * 32 + e + 8 * c + 4 * hh;
                p[i] = (key < qpos) ? fexp2(lb[i] + run) : 0.f; run += lm[i]; } }
        R += (Gown[0] + Gpar[0]) + (Gown[1] + Gpar[1]) + (Gown[2] + Gpar[2]) + (Gown[3] + Gpar[3]);
#pragma unroll
        for (int s2 = 0; s2 < 2; ++s2) {
            u32x4 pw; pw.x = cvt_pk_bf16(p[8 * s2 + 0], p[8 * s2 + 1]); pw.y = cvt_pk_bf16(p[8 * s2 + 2], p[8 * s2 + 3]); pw.z = cvt_pk_bf16(p[8 * s2 + 4], p[8 * s2 + 5]); pw.w = cvt_pk_bf16(p[8 * s2 + 6], p[8 * s2 + 7]);
            const bf16x8 pb = __builtin_bit_cast(bf16x8, pw);
#pragma unroll
            for (int d = 0; d < 4; ++d) { const bf16* vp = VT + ((size_t)(bh * 128 + d * 32 + r)) * SEQ + kt * 32 + 16 * s2 + 4 * hh;
                u32x4 vw; const u32x2 v0 = *(const u32x2*)vp, v1 = *(const u32x2*)(vp + 8); vw.x = v0.x; vw.y = v0.y; vw.z = v1.x; vw.w = v1.y;
                o[d] = __builtin_amdgcn_mfma_f32_32x32x16_bf16(__builtin_bit_cast(bf16x8, vw), pb, o[d], 0, 0, 0); } }
        if (__all(R < -40.f)) break;
    }
    float ss = 0.f;
#pragma unroll
    for (int d = 0; d < 4; ++d)
#pragma unroll
        for (int i = 0; i < 16; ++i) ss += o[d][i] * o[d][i];
    ss += __shfl_xor(ss, 32);
    const float rstd = 1.0f / sqrtf(ss * (1.f / 128.f) + EPS);
#pragma unroll
    for (int d = 0; d < 4; ++d)
#pragma unroll
        for (int c = 0; c < 4; ++c) { const int dim = 32 * d + 8 * c + 4 * hh; const f32x4 g = *(const f32x4*)(sb_g + h * 128 + dim);
            f32x4 v; v.x = o[d][4 * c] * rstd * g.x; v.y = o[d][4 * c + 1] * rstd * g.y; v.z = o[d][4 * c + 2] * rstd * g.z; v.w = o[d][4 * c + 3] * rstd * g.w;
            st_bf16x4(O + (size_t)(b * SEQ + qpos) * DM + h * 128 + dim, v); }
}

constexpr int G1_QIN = 0, G1_KIN = 64 * 136 * 2, G1_KDT = 2 * 64 * 136 * 2, G1_LOW = G1_KDT + 128 * 72 * 2, G1_SEG = G1_LOW + 64 * 16 * 4, G1_QRAW = G1_SEG + 4 * 128 * 4, G1_KRAW = G1_QRAW + 64 * 128 * 2, G1_END = G1_KRAW + 64 * 128 * 2;
constexpr int G1_KVT = G1_QRAW;
static_assert(G1_END <= RING_BYTES && G1_KVT + 65536 <= RING_BYTES && (G1_KVT & 15) == 0, "g1 lds");
__device__ __forceinline__ void gla_g1_unit(const Frame& F, const float* __restrict__ w2, const float* __restrict__ b2, int unit) {
    const int n = unit & 31, bh = unit >> 5, b = bh >> 2, h = bh & 3;
    const int t0 = b * SEQ + 64 * n;
    const bf16* GQ = (const bf16*)(F.ws + WS_GQ); const bf16* GK = (const bf16*)(F.ws + WS_GK); const bf16* GVT = (const bf16*)(F.ws + WS_GVT); const float* GLOW = (const float*)(F.ws + WS_GLOW);
    LAS bf16* qin = (LAS bf16*)(F.lds + G1_QIN); LAS bf16* kin = (LAS bf16*)(F.lds + G1_KIN); LAS bf16* kdt = (LAS bf16*)(F.lds + G1_KDT);
    LAS float* lowl = (LAS float*)(F.lds + G1_LOW); LAS float* seg = (LAS float*)(F.lds + G1_SEG);
    for (int i = F.tid; i < 64 * 16; i += NTHR) lowl[i] = GLOW[(size_t)t0 * 16 + i];
    LAS bf16* qraw = (LAS bf16*)(F.lds + G1_QRAW); LAS bf16* kraw = (LAS bf16*)(F.lds + G1_KRAW);
#pragma unroll
    for (int q2 = 0; q2 < 2; ++q2) { const int id = F.tid + 512 * q2, row = id >> 4, ch = id & 15;
        *(LAS u32x4*)(qraw + row * 128 + ch * 8) = *(const u32x4*)(GQ + (size_t)(t0 + row) * 512 + h * 128 + ch * 8);
        *(LAS u32x4*)(kraw + row * 128 + ch * 8) = *(const u32x4*)(GK + (size_t)(t0 + row) * 512 + h * 128 + ch * 8); }
    __syncthreads();
    const int d = F.tid & 127, sg = F.tid >> 7, dd = h * 128 + d;
    float wcol[16];
#pragma unroll
    for (int r = 0; r < 16; ++r) wcol[r] = w2[r * 512 + dd];
    const float bias = b2[dd];
    float pre[16]; float run = 0.f;
#pragma unroll
    for (int i = 0; i < 16; ++i) { const int c = 16 * sg + i; float z = bias;
#pragma unroll
        for (int r4 = 0; r4 < 4; ++r4) { const f32x4 lv = *(const LAS f32x4*)(lowl + c * 16 + 4 * r4); z += lv.x * wcol[4 * r4] + lv.y * wcol[4 * r4 + 1] + lv.z * wcol[4 * r4 + 2] + lv.w * wcol[4 * r4 + 3]; }
        run += log2_sigmoid2(z * LOG2E) * (1.0f / 16.0f);
        pre[i] = run; }
    seg[sg * 128 + d] = run;
    __syncthreads();
    float off = 0.f, tot = 0.f;
#pragma unroll
    for (int s = 0; s < 4; ++s) { const float v = seg[s * 128 + d]; tot += v; if (s < sg) off += v; }
    bf16* QIN = (bf16*)(F.ws + WS_QIN);
#pragma unroll
    for (int i = 0; i < 16; ++i) { const int c = 16 * sg + i; const float g = off + pre[i];
        const float qv = bf2f(qraw[c * 128 + d]), kv = bf2f(kraw[c * 128 + d]);
        const bf16 qi = f2bf(qv * 0.08838834764831845f * fexp2(g));
        qin[c * 136 + d] = qi;
        kin[c * 136 + d] = f2bf(kv * fexp2(-g));
        kdt[d * 72 + c] = f2bf(kv * fexp2(tot - g)); }
    if (sg == 0) ((float*)(F.ws + WS_DECAY))[(size_t)unit * 128 + d] = fexp2(tot);
    __syncthreads();
#pragma unroll
    for (int q2 = 0; q2 < 2; ++q2) { const int id = F.tid + 512 * q2, row = id >> 4, ch = id & 15;
        *(u32x4*)(QIN + (size_t)(t0 + row) * 512 + h * 128 + ch * 8) = *(const LAS u32x4*)(qin + row * 136 + ch * 8); }
    const int w = F.wave, l = F.lane, r = l & 31, hh = l >> 5, cb = w & 1, dvp = w >> 1;
    f32x16 X[2];
#pragma unroll
    for (int sb = 0; sb < 2; ++sb) {
#pragma unroll
        for (int i = 0; i < 16; ++i) X[sb][i] = 0.f;
#pragma unroll
        for (int st = 0; st < 8; ++st) { const bf16x8 af = *(const LAS bf16x8*)(kin + (32 * sb + r) * 136 + 16 * st + 8 * hh), bfq = *(const LAS bf16x8*)(qin + (32 * cb + r) * 136 + 16 * st + 8 * hh);
            X[sb] = __builtin_amdgcn_mfma_f32_32x32x16_bf16(af, bfq, X[sb], 0, 0, 0); }
#pragma unroll
        for (int i = 0; i < 16; ++i) { const int s = 32 * sb + (i & 3) + 8 * (i >> 2) + 4 * hh; if (32 * cb + r < s) X[sb][i] = 0.f; }
    }
    u32x4* OI = (u32x4*)(F.ws + WS_OINTRA) + ((size_t)unit * 8 + w) * 256;
#pragma unroll
    for (int dbi = 0; dbi < 2; ++dbi) { const int db = 2 * dvp + dbi; f32x16 oacc;
#pragma unroll
        for (int i = 0; i < 16; ++i) oacc[i] = 0.f;
#pragma unroll
        for (int sb = 0; sb < 2; ++sb)
#pragma unroll
            for (int s2 = 0; s2 < 2; ++s2) {
                u32x4 pw; pw.x = cvt_pk_bf16(X[sb][8 * s2 + 0], X[sb][8 * s2 + 1]); pw.y = cvt_pk_bf16(X[sb][8 * s2 + 2], X[sb][8 * s2 + 3]); pw.z = cvt_pk_bf16(X[sb][8 * s2 + 4], X[sb][8 * s2 + 5]); pw.w = cvt_pk_bf16(X[sb][8 * s2 + 6], X[sb][8 * s2 + 7]);
                const bf16* vp = GVT + ((size_t)(bh * 256 + db * 32 + r)) * SEQ + 64 * n + 32 * sb + 16 * s2 + 4 * hh;
                u32x4 vw; const u32x2 v0 = *(const u32x2*)vp, v1 = *(const u32x2*)(vp + 8); vw.x = v0.x; vw.y = v0.y; vw.z = v1.x; vw.w = v1.y;
                oacc = __builtin_amdgcn_mfma_f32_32x32x16_bf16(__builtin_bit_cast(bf16x8, vw), __builtin_bit_cast(bf16x8, pw), oacc, 0, 0, 0); }
#pragma unroll
        for (int q4 = 0; q4 < 2; ++q4) { u32x4 ow; ow.x = cvt_pk_bf16(oacc[8 * q4], oacc[8 * q4 + 1]); ow.y = cvt_pk_bf16(oacc[8 * q4 + 2], oacc[8 * q4 + 3]); ow.z = cvt_pk_bf16(oacc[8 * q4 + 4], oacc[8 * q4 + 5]); ow.w = cvt_pk_bf16(oacc[8 * q4 + 6], oacc[8 * q4 + 7]);
            OI[(dbi * 2 + q4) * 64 + l] = ow; } }
    bf16* KVN = (bf16*)(F.ws + WS_KVN) + (size_t)unit * 32768; LAS bf16* kvt = (LAS bf16*)(F.lds + G1_KVT);
    bf16x8 vf[4];
#pragma unroll
    for (int st = 0; st < 4; ++st) vf[st] = *(const bf16x8*)(GVT + ((size_t)(bh * 256 + w * 32 + r)) * SEQ + 64 * n + 16 * st + 8 * hh);
#pragma unroll
    for (int dkb = 0; dkb < 4; ++dkb) { f32x16 kacc;
#pragma unroll
        for (int i = 0; i < 16; ++i) kacc[i] = 0.f;
#pragma unroll
        for (int st = 0; st < 4; ++st) { const bf16x8 bk = *(const LAS bf16x8*)(kdt + (32 * dkb + r) * 72 + 16 * st + 8 * hh);
            kacc = __builtin_amdgcn_mfma_f32_32x32x16_bf16(vf[st], bk, kacc, 0, 0, 0); }
#pragma unroll
        for (int i = 0; i < 16; ++i) kvt[(32 * w + (i & 3) + 8 * (i >> 2) + 4 * hh) * 128 + 32 * dkb + r] = f2bf(kacc[i]); }
    LDS_WAIT();
#pragma unroll
    for (int q8 = 0; q8 < 8; ++q8) { const int row = 32 * w + 4 * q8 + (l >> 4), ch = l & 15;
        *(u32x4*)(KVN + (size_t)row * 128 + ch * 8) = *(const LAS u32x4*)(kvt + row * 128 + ch * 8); }
    __syncthreads();
}

__device__ __forceinline__ void gla_scan(const Frame& F) {
    const bf16* KVN = (const bf16*)(F.ws + WS_KVN); const float* DEC = (const float*)(F.ws + WS_DECAY); bf16* ST = (bf16*)(F.ws + WS_STATE);
    for (int g = F.bid * NTHR + F.tid; g < 16 * 8192; g += F.G * NTHR) {
        const int bh = g >> 13, e4 = (g & 8191) * 4, dk = e4 & 127;
        f32x4 S = {0.f, 0.f, 0.f, 0.f};
#pragma unroll 8
        for (int n = 0; n < 32; ++n) { const size_t u = (size_t)(bh * 32 + n);
            st_bf16x4(ST + u * 32768 + e4, S);
            const u32x2 kw = *(const u32x2*)(KVN + u * 32768 + e4); const f32x4 kv = {bflo(kw.x), bfhi(kw.x), bflo(kw.y), bfhi(kw.y)}, dc = *(const f32x4*)(DEC + u * 128 + dk);
            S = S * dc + kv; }
    }
}

__device__ __forceinline__ void gla_g3_unit(const Frame& F, const float* __restrict__ gn, int unit) {
    const int n = unit & 31, bh = unit >> 5, b = bh >> 2, h = bh & 3; const int t0 = b * SEQ + 64 * n;
    const int w = F.wave, l = F.lane, r = l & 31, hh = l >> 5, cb = w & 1, dvp = w >> 1;
    const bf16* QIN = (const bf16*)(F.ws + WS_QIN); const bf16* ST = (const bf16*)(F.ws + WS_STATE) + (size_t)unit * 32768; const bf16* GR = (const bf16*)(F.ws + WS_GR); bf16* O = (bf16*)(F.ws + WS_MIXO);
    const u32x4* OI = (const u32x4*)(F.ws + WS_OINTRA) + ((size_t)unit * 8 + w) * 256;
    LAS float* part = (LAS float*)F.lds;
    bf16x8 qf[8];
#pragma unroll
    for (int st = 0; st < 8; ++st) qf[st] = *(const bf16x8*)(QIN + (size_t)(t0 + 32 * cb + r) * 512 + h * 128 + 16 * st + 8 * hh);
    f32x16 o[2]; float ss = 0.f;
#pragma unroll
    for (int dbi = 0; dbi < 2; ++dbi) { const int db = 2 * dvp + dbi;
#pragma unroll
        for (int q4 = 0; q4 < 2; ++q4) { const u32x4 ow = OI[(dbi * 2 + q4) * 64 + l];
            o[dbi][8 * q4] = bflo(ow.x); o[dbi][8 * q4 + 1] = bfhi(ow.x); o[dbi][8 * q4 + 2] = bflo(ow.y); o[dbi][8 * q4 + 3] = bfhi(ow.y); o[dbi][8 * q4 + 4] = bflo(ow.z); o[dbi][8 * q4 + 5] = bfhi(ow.z); o[dbi][8 * q4 + 6] = bflo(ow.w); o[dbi][8 * q4 + 7] = bfhi(ow.w); }
#pragma unroll
        for (int st = 0; st < 8; ++st) { const bf16x8 sf = *(const bf16x8*)(ST + (size_t)(32 * db + r) * 128 + 16 * st + 8 * hh);
            o[dbi] = __builtin_amdgcn_mfma_f32_32x32x16_bf16(sf, qf[st], o[dbi], 0, 0, 0); }
#pragma unroll
        for (int i = 0; i < 16; ++i) ss += o[dbi][i] * o[dbi][i]; }
    ss += __shfl_xor(ss, 32);
    if (hh == 0) part[w * 32 + r] = ss;
    __syncthreads();
    float tot = 0.f;
#pragma unroll
    for (int q = 0; q < 4; ++q) tot += part[(2 * q + cb) * 32 + r];
    const float rstd = 1.0f / sqrtf(tot * (1.f / 256.f) + EPS);
    const int tok = t0 + 32 * cb + r;
#pragma unroll
    for (int dbi = 0; dbi < 2; ++dbi)
#pragma unroll
        for (int c = 0; c < 4; ++c) { const int dv = 32 * (2 * dvp + dbi) + 8 * c + 4 * hh; const f32x4 g = *(const f32x4*)(gn + h * 256 + dv);
            const u32x2 rw = *(const u32x2*)(GR + (size_t)tok * 1024 + h * 256 + dv);
            const float r0 = bflo(rw.x), r1 = bfhi(rw.x), r2 = bflo(rw.y), r3 = bfhi(rw.y);
            f32x4 v; v.x = o[dbi][4 * c] * rstd * g.x * (r0 * frcp(1.f + fexp2(-r0 * LOG2E))); v.y = o[dbi][4 * c + 1] * rstd * g.y * (r1 * frcp(1.f + fexp2(-r1 * LOG2E)));
            v.z = o[dbi][4 * c + 2] * rstd * g.z * (r2 * frcp(1.f + fexp2(-r2 * LOG2E))); v.w = o[dbi][4 * c + 3] * rstd * g.w * (r3 * frcp(1.f + fexp2(-r3 * LOG2E)));
            st_bf16x4(O + (size_t)tok * DM + 1024 + h * 256 + dv, v); }
    __syncthreads();
}
__device__ __forceinline__ void gla_g3_pair(const Frame& F, const float* __restrict__ gn, int uA, int uB) {
    const int w = F.wave, l = F.lane, r = l & 31, hh = l >> 5, w4 = w & 3, cb = w4 & 1, dvh = w4 >> 1;
    const int unit = (w < 4) ? uA : uB; const bool act = unit >= 0;
    const int uu = act ? unit : 0, n = uu & 31, bh = uu >> 5, b = bh >> 2, h = bh & 3; const int t0 = b * SEQ + 64 * n;
    const bf16* QIN = (const bf16*)(F.ws + WS_QIN); const bf16* ST = (const bf16*)(F.ws + WS_STATE) + (size_t)uu * 32768; const bf16* GR = (const bf16*)(F.ws + WS_GR); bf16* O = (bf16*)(F.ws + WS_MIXO);
    LAS float* part = (LAS float*)F.lds;
    f32x16 o[4]; float ss = 0.f;
    if (act) {
        bf16x8 qf[8];
#pragma unroll
        for (int st = 0; st < 8; ++st) qf[st] = *(const bf16x8*)(QIN + (size_t)(t0 + 32 * cb + r) * 512 + h * 128 + 16 * st + 8 * hh);
#pragma unroll
        for (int dbi = 0; dbi < 4; ++dbi) { const int db = 4 * dvh + dbi;
            const u32x4* OI = (const u32x4*)(F.ws + WS_OINTRA) + ((size_t)uu * 8 + (2 * (db >> 1) + cb)) * 256 + ((db & 1) * 2) * 64 + l;
#pragma unroll
            for (int q4 = 0; q4 < 2; ++q4) { const u32x4 ow = OI[q4 * 64];
                o[dbi][8 * q4] = bflo(ow.x); o[dbi][8 * q4 + 1] = bfhi(ow.x); o[dbi][8 * q4 + 2] = bflo(ow.y); o[dbi][8 * q4 + 3] = bfhi(ow.y); o[dbi][8 * q4 + 4] = bflo(ow.z); o[dbi][8 * q4 + 5] = bfhi(ow.z); o[dbi][8 * q4 + 6] = bflo(ow.w); o[dbi][8 * q4 + 7] = bfhi(ow.w); }
#pragma unroll
            for (int st = 0; st < 8; ++st) { const bf16x8 sf = *(const bf16x8*)(ST + (size_t)(32 * db + r) * 128 + 16 * st + 8 * hh);
                o[dbi] = __builtin_amdgcn_mfma_f32_32x32x16_bf16(sf, qf[st], o[dbi], 0, 0, 0); }
#pragma unroll
            for (int i = 0; i < 16; ++i) ss += o[dbi][i] * o[dbi][i]; }
        ss += __shfl_xor(ss, 32);
        if (hh == 0) part[w * 32 + r] = ss;
    }
    __syncthreads();
    if (act) {
        const float tot = part[((w & 4) + cb) * 32 + r] + part[((w & 4) + cb + 2) * 32 + r];
        const float rstd = 1.0f / sqrtf(tot * (1.f / 256.f) + EPS);
        const int tok = t0 + 32 * cb + r;
#pragma unroll
        for (int dbi = 0; dbi < 4; ++dbi)
#pragma unroll
            for (int c = 0; c < 4; ++c) { const int dv = 32 * (4 * dvh + dbi) + 8 * c + 4 * hh; const f32x4 g = *(const f32x4*)(gn + h * 256 + dv);
                const u32x2 rw = *(const u32x2*)(GR + (size_t)tok * 1024 + h * 256 + dv);
                const float r0 = bflo(rw.x), r1 = bfhi(rw.x), r2 = bflo(rw.y), r3 = bfhi(rw.y);
                f32x4 v; v.x = o[dbi][4 * c] * rstd * g.x * (r0 * frcp(1.f + fexp2(-r0 * LOG2E))); v.y = o[dbi][4 * c + 1] * rstd * g.y * (r1 * frcp(1.f + fexp2(-r1 * LOG2E)));
                v.z = o[dbi][4 * c + 2] * rstd * g.z * (r2 * frcp(1.f + fexp2(-r2 * LOG2E))); v.w = o[dbi][4 * c + 3] * rstd * g.w * (r3 * frcp(1.f + fexp2(-r3 * LOG2E)));
                st_bf16x4(O + (size_t)tok * DM + 1024 + h * 256 + dv, v); }
    }
    __syncthreads();
}

__device__ __forceinline__ void router_phase(const Frame& F, const float* __restrict__ b_router) {
    const float* X2 = (const float*)(F.ws + WS_X2); const bf16* WH = (const bf16*)(F.ws + WS_WRH); const bf16* WL = (const bf16*)(F.ws + WS_WRL);
    int* TOPE = (int*)(F.ws + WS_TOPE); float* TOPW = (float*)(F.ws + WS_TOPW); float* RSTD = (float*)(F.ws + WS_RSTD3); int* HIST = (int*)(F.ws + WS_HIST);
    LAS float* part = (LAS float*)F.lds;
    LAS float* sq = (LAS float*)(F.lds + 32768);
    LAS int* hist = (LAS int*)(F.lds + 33792);
    const int w = F.wave, l = F.lane, r16 = l & 15, quad = l >> 4;
    for (int rb = F.bid; rb < NT / 32; rb += F.G) {
        if (F.tid < 32) hist[F.tid] = 0;
        f32x4 acc[2][2] = {{{0.f, 0.f, 0.f, 0.f}, {0.f, 0.f, 0.f, 0.f}}, {{0.f, 0.f, 0.f, 0.f}, {0.f, 0.f, 0.f, 0.f}}}; float ssq[2] = {0.f, 0.f};
#pragma unroll 4
        for (int st = 0; st < 8; ++st) { const int k0 = 256 * w + 32 * st + 8 * quad;
            bf16x8 bh[2], bl[2];
#pragma unroll
            for (int eb = 0; eb < 2; ++eb) { bh[eb] = *(const bf16x8*)(WH + (size_t)(16 * eb + r16) * KD + k0); bl[eb] = *(const bf16x8*)(WL + (size_t)(16 * eb + r16) * KD + k0); }
#pragma unroll
            for (int tg = 0; tg < 2; ++tg) { const int row = rb * 32 + 16 * tg + r16;
                const f32x4 xa = *(const f32x4*)(X2 + (size_t)row * DM + k0), xb = *(const f32x4*)(X2 + (size_t)row * DM + k0 + 4);
                ssq[tg] += (xa.x * xa.x + xa.y * xa.y) + (xa.z * xa.z + xa.w * xa.w) + (xb.x * xb.x + xb.y * xb.y) + (xb.z * xb.z + xb.w * xb.w);
                u32x4 hw; hw.x = cvt_pk_bf16(xa.x, xa.y); hw.y = cvt_pk_bf16(xa.z, xa.w); hw.z = cvt_pk_bf16(xb.x, xb.y); hw.w = cvt_pk_bf16(xb.z, xb.w);
                u32x4 lw; lw.x = cvt_pk_bf16(xa.x - bflo(hw.x), xa.y - bfhi(hw.x)); lw.y = cvt_pk_bf16(xa.z - bflo(hw.y), xa.w - bfhi(hw.y));
                lw.z = cvt_pk_bf16(xb.x - bflo(hw.z), xb.y - bfhi(hw.z)); lw.w = cvt_pk_bf16(xb.z - bflo(hw.w), xb.w - bfhi(hw.w));
                const bf16x8 ah = __builtin_bit_cast(bf16x8, hw), alo = __builtin_bit_cast(bf16x8, lw);
#pragma unroll
                for (int eb = 0; eb < 2; ++eb) {
                    acc[tg][eb] = __builtin_amdgcn_mfma_f32_16x16x32_bf16(ah, bh[eb], acc[tg][eb], 0, 0, 0);
                    acc[tg][eb] = __builtin_amdgcn_mfma_f32_16x16x32_bf16(ah, bl[eb], acc[tg][eb], 0, 0, 0);
                    acc[tg][eb] = __builtin_amdgcn_mfma_f32_16x16x32_bf16(alo, bh[eb], acc[tg][eb], 0, 0, 0); } } }
#pragma unroll
        for (int tg = 0; tg < 2; ++tg) { float q = ssq[tg]; q += __shfl_xor(q, 16); q += __shfl_xor(q, 32);
            if (quad == 0) sq[w * 32 + 16 * tg + r16] = q;
#pragma unroll
            for (int eb = 0; eb < 2; ++eb)
#pragma unroll
                for (int j = 0; j < 4; ++j) part[(w * 32 + 16 * tg + 4 * quad + j) * 32 + 16 * eb + r16] = acc[tg][eb][j]; }
        __syncthreads();
        for (int q2 = 0; q2 < 2; ++q2) { const int hf = l >> 5, e = l & 31; const int ti = 4 * w + 2 * q2 + hf; const int tok = rb * 32 + ti;
            LAS float* lg = (LAS float*)(F.lds + 36864) + (w * 2 + hf) * 32; LAS float* tvr = (LAS float*)(F.lds + 40960) + (w * 2 + hf) * 4;
            float s2 = 0.f, a = 0.f;
#pragma unroll
            for (int k = 0; k < 8; ++k) { s2 += sq[k * 32 + ti]; a += part[(k * 32 + ti) * 32 + e]; }
            const float rstd = 1.0f / sqrtf(s2 * (1.f / DM) + EPS);
            float v = a * rstd + b_router[e]; v = (v == v) ? v : -3.0e38f;
            lg[e] = v;
            LDS_WAIT();
            int rank = 0;
#pragma unroll
            for (int j4 = 0; j4 < 8; ++j4) { const f32x4 o = *(const LAS f32x4*)(lg + 4 * j4);
                rank += (o.x > v || (o.x == v && 4 * j4 + 0 < e)) ? 1 : 0; rank += (o.y > v || (o.y == v && 4 * j4 + 1 < e)) ? 1 : 0;
                rank += (o.z > v || (o.z == v && 4 * j4 + 2 < e)) ? 1 : 0; rank += (o.w > v || (o.w == v && 4 * j4 + 3 < e)) ? 1 : 0; }
            if (rank < 4) tvr[rank] = v;
            LDS_WAIT();
            const f32x4 t = *(const LAS f32x4*)tvr;
            const float e1 = fexp2((t.y - t.x) * LOG2E), e2 = fexp2((t.z - t.x) * LOG2E), e3 = fexp2((t.w - t.x) * LOG2E); const float inv = 1.0f / (1.0f + e1 + e2 + e3);
            if (rank < 4) { TOPE[tok * 4 + rank] = e; TOPW[tok * 4 + rank] = fexp2((v - t.x) * LOG2E) * inv; atomicAdd((int*)&hist[e], 1); }
            if (e == 0) RSTD[tok] = rstd;
            LDS_WAIT(); }
        __syncthreads();
        if (F.tid < 32) HIST[rb * 32 + F.tid] = hist[F.tid];
        __syncthreads();
    }
}

__device__ __forceinline__ void slots_phase(const Frame& F, const float* __restrict__ g_moe) {
    const float* X2 = (const float*)(F.ws + WS_X2); const int* TOPE = (const int*)(F.ws + WS_TOPE); const float* TOPW = (const float*)(F.ws + WS_TOPW); const float* RSTD = (const float*)(F.ws + WS_RSTD3);
    const int* HIST = (const int*)(F.ws + WS_HIST); float* SLOTW = (float*)(F.ws + WS_SLOTW); int* TOKSLOT = (int*)(F.ws + WS_TOKSLOT); int* CNT = (int*)(F.ws + WS_CNT); bf16* XS = (bf16*)(F.ws + WS_XS);
    LAS int* ptot = (LAS int*)F.lds;
    LAS int* pbel = ptot + 512;
    LAS int* base = pbel + 512;
    LAS int* asg = base + 32;
    LAS int* aslot = asg + 128;
    for (int rb = F.bid; rb < NT / 32; rb += F.G) {
        { const int e = F.tid & 31, p = F.tid >> 5; int t = 0, bl = 0;
          for (int q = 0; q < 16; ++q) { const int bb = 16 * p + q; const int hv = HIST[bb * 32 + e]; t += hv; if (bb < rb) bl += hv; }
          ptot[p * 32 + e] = t; pbel[p * 32 + e] = bl; }
        if (F.tid < 128) asg[F.tid] = TOPE[rb * 128 + F.tid];
        __syncthreads();
        if (F.tid < 32) { int t = 0, bl = 0; for (int p = 0; p < 16; ++p) { t += ptot[p * 32 + F.tid]; bl += pbel[p * 32 + F.tid]; }
            ptot[F.tid] = t; pbel[F.tid] = bl; }
        __syncthreads();
        if (F.tid < 32) { int st = 0; for (int e = 0; e < F.tid; ++e) st += ptot[e]; base[F.tid] = st + pbel[F.tid];
            if (rb == 0) { CNT[F.tid] = ptot[F.tid]; CNT[32 + F.tid] = st; }
            int run = base[F.tid]; for (int i = 0; i < 128; ++i) if (asg[i] == F.tid) { aslot[i] = run; ++run; } }
        __syncthreads();
        if (F.tid < 128) { const int sl = aslot[F.tid]; TOKSLOT[rb * 128 + F.tid] = sl; SLOTW[sl] = TOPW[rb * 128 + F.tid]; }
        for (int q = 0; q < 4; ++q) { const int ti = 4 * F.wave + q, tok = rb * 32 + ti; const float rstd = RSTD[tok];
            const f32x4* xr = (const f32x4*)(X2 + (size_t)tok * DM) + F.lane; const f32x4* gr = (const f32x4*)g_moe + F.lane;
#if MOE_FP8
            unsigned hw[8];
#pragma unroll
            for (int j = 0; j < 8; ++j) { const f32x4 v = xr[64 * j], g = gr[64 * j]; hw[j] = pk_fp8x4(v.x * rstd * g.x, v.y * rstd * g.y, v.z * rstd * g.z, v.w * rstd * g.w); }
            LAS unsigned* rowb = (LAS unsigned*)(F.lds + 16384 + F.wave * 2048);
#pragma unroll
            for (int j = 0; j < 8; ++j) rowb[64 * j + F.lane] = hw[j];
            LDS_WAIT();
            const u32x4 w0 = *(const LAS u32x4*)(rowb + 4 * F.lane), w1 = *(const LAS u32x4*)(rowb + 256 + 4 * F.lane);
#pragma unroll
            for (int k = 0; k < 4; ++k) { const int sl = aslot[ti * 4 + k]; u32x4* o16 = (u32x4*)((unsigned char*)XS + (size_t)sl * DM) + F.lane;
                o16[0] = w0; o16[64] = w1; }
            LDS_WAIT();
#else
            u32x2 hw[8];
#pragma unroll
            for (int j = 0; j < 8; ++j) { const f32x4 v = xr[64 * j], g = gr[64 * j]; hw[j].x = cvt_pk_bf16(v.x * rstd * g.x, v.y * rstd * g.y); hw[j].y = cvt_pk_bf16(v.z * rstd * g.z, v.w * rstd * g.w); }
#pragma unroll
            for (int k = 0; k < 4; ++k) { const int sl = aslot[ti * 4 + k]; u32x2* o8 = (u32x2*)(XS + (size_t)sl * DM) + F.lane;
#pragma unroll
                for (int j = 0; j < 8; ++j) o8[64 * j] = hw[j]; }
#endif
            }
        __syncthreads();
    }
}

__device__ __forceinline__ void final_phase(const Frame& F, const float* __restrict__ g_fin, float* __restrict__ out) {
    const float* X2 = (const float*)(F.ws + WS_X2); const bf16* Y = (const bf16*)(F.ws + WS_Y); const int* TOKSLOT = (const int*)(F.ws + WS_TOKSLOT);
    const int gw = F.bid * NWAVES + F.wave, NGW = F.G * NWAVES;
    for (int tok = gw; tok < NT; tok += NGW) {
        const f32x4* xr = (const f32x4*)(X2 + (size_t)tok * DM) + F.lane;
        f32x4 v[8];
#pragma unroll
        for (int j = 0; j < 8; ++j) v[j] = xr[64 * j];
#pragma unroll
#if Y_FP8
        for (int k = 0; k < 4; ++k) { const int sl = TOKSLOT[tok * 4 + k]; const unsigned* yr = (const unsigned*)((const unsigned char*)Y + (size_t)sl * DM) + F.lane;
#pragma unroll
            for (int j = 0; j < 8; ++j) { const int yw = (int)yr[64 * j]; const f32x2 lo = __builtin_amdgcn_cvt_pk_f32_fp8(yw, false), hi = __builtin_amdgcn_cvt_pk_f32_fp8(yw, true);
                v[j].x += lo.x * 0.0625f; v[j].y += lo.y * 0.0625f; v[j].z += hi.x * 0.0625f; v[j].w += hi.y * 0.0625f; } }
#else
        for (int k = 0; k < 4; ++k) { const int sl = TOKSLOT[tok * 4 + k]; const u32x2* yr = (const u32x2*)(Y + (size_t)sl * DM) + F.lane;
#pragma unroll
            for (int j = 0; j < 8; ++j) { const u32x2 yw = yr[64 * j]; v[j].x += bflo(yw.x); v[j].y += bfhi(yw.x); v[j].z += bflo(yw.y); v[j].w += bfhi(yw.y); } }
#endif
        float s = 0.f;
#pragma unroll
        for (int j = 0; j < 8; ++j) s += (v[j].x * v[j].x + v[j].y * v[j].y) + (v[j].z * v[j].z + v[j].w * v[j].w);
        const float rstd = 1.0f / sqrtf(wave_sum(s) * (1.f / DM) + EPS);
        f32x4* orow = (f32x4*)(out + (size_t)tok * DM) + F.lane; const f32x4* gr = (const f32x4*)g_fin + F.lane;
#pragma unroll
        for (int j = 0; j < 8; ++j) orow[64 * j] = v[j] * rstd * gr[64 * j];
    }
}

constexpr int N_PHASES = 14;
__global__ void __launch_bounds__(NTHR, 2) fwd_kernel(Args args) {
    extern __shared__ __attribute__((aligned(16))) unsigned char lds[];
    Frame F;
    F.lds = (LAS unsigned char*)lds;
    F.tid = threadIdx.x; F.lane = F.tid & 63; F.wave = __builtin_amdgcn_readfirstlane(F.tid >> 6);
    F.G = gridDim.x; F.bid = blockIdx.x; F.ws = args.ws;
    for (int u = F.tid; u < (LDS_BYTES - LDSCTL_OFF) / 4; u += NTHR) ((LAS unsigned*)(F.lds + LDSCTL_OFF))[u] = 0u;
    __syncthreads();
    unsigned* ctl = (unsigned*)(args.ws + WS_CTL);
    XcdBarrier bar; bar.bar = ctl + CW_BAR; bar.x = 0; bar.st = nullptr;
    const bool fused = (args.ph_hi - args.ph_lo) > 1;
    if (fused) bar = xcd_barrier_post(ctl + CW_BAR, (volatile LAS unsigned*)(F.lds + MISC_OFF));
    const int lo = args.ph_lo, hi = args.ph_hi;
    const bool conv_on = fused && CONV_WGS > 0 && F.G == 256;
    const bool conv_wg = conv_on && F.bid >= NCOMP;
    Frame FC = F; if (conv_on) FC.G = NCOMP;
#define IN(k) (lo <= (k) && (k) < hi)
#define REP(k) _Pragma("unroll") for (int _r = 0; _r < 1 + ((DUP_MASK >> (k)) & 1); ++_r)
#define SEAM(k) do { if (IN(k) && IN((k) + 1)) xcd_barrier(bar); } while (0)

    if (IN(0)) REP(0) { p0_prologue(F, args);
        if (!conv_on) { LAS unsigned* scr = (LAS unsigned*)(F.lds + F.wave * 16384);
            for (int it = F.bid * NWAVES + F.wave; it < MOE_ITEMS; it += F.G * NWAVES) if (!CONV_WGS || !((it >= (32 - E_P0) * 1024 && it < 32768) || it >= 32768 + (32 - D_P0) * 512)) moe_item_fp8<false>(F, args, it, scr); }
    } SEAM(0);

    if (IN(1)) REP(1) {
        if (conv_wg) {
            { KvOrder S{(const char*)(F.ws + WS_MEMN), (const char*)(F.ws + WS_WCKV), F.bid - NCOMP}; EpiKV E{F.ws}; pg8::gemm_phase<4096, 32, false>(F.lds, S, E); }
            LAS unsigned* scr = (LAS unsigned*)(F.lds + F.wave * 16384); const int w2 = (F.bid - NCOMP) * NWAVES + F.wave;
            moe_items_stream<false, true>(F, args, w2, CONV_WGS * NWAVES, CONV_NA / (CONV_WGS * NWAVES), scr); }
        else {
        pg8::DenseOrder S; S.init(F.ws + WS_H1, F.ws + WS_WIN, NT, NPROJ, FC.G, F.bid);
        EpiInProj E{F.ws};
        pg8::gemm_phase<4096, 32, false>(F.lds, S, E);
        gla_low_job(FC);
        }
    } SEAM(1);

    if (IN(2)) REP(2) {
        {
        const bool kv_here = !(conv_on && CONV_WGS == 64);
        if (kv_here && F.bid < 64) { KvOrder S{(const char*)(F.ws + WS_MEMN), (const char*)(F.ws + WS_WCKV), F.bid}; EpiKV E{F.ws}; pg8::gemm_phase<4096, 32, false>(F.lds, S, E); }
        REP(14) { if (kv_here && F.G > 64) { if (F.bid >= 64) for (int u = F.bid - 64; u < 512; u += F.G - 64) gla_g1_unit(F, args.in[4], args.in[5], u); }
        else { for (int u = F.bid; u < 512; u += F.G) gla_g1_unit(F, args.in[4], args.in[5], u); } }
        REP(15) { for (int wu = F.bid * NWAVES + F.wave; wu < 2048; wu += F.G * NWAVES) sb_attn_wave(F, args.in[6], wu); }
        }
    } SEAM(2);

    if (IN(3)) REP(3) { gla_scan(F); } SEAM(3);

    if (IN(4)) REP(4) { for (int u = F.bid; u < 512; u += 2 * F.G) gla_g3_pair(F, args.in[7], u, (u + F.G < 512) ? u + F.G : -1); } SEAM(4);

    if (IN(5)) REP(5) {
        if (F.G == 256) {
            MixOrder S; S.D.init(F.ws + WS_MIXO, F.ws + WS_WOUT, NT, DM, F.G, F.bid); S.X = XpreOrder{(const char*)(F.ws + WS_KVK), (const char*)(F.ws + WS_WCQ), (const char*)(F.ws + WS_WCO), (const char*)(F.ws + WS_KVVT), F.bid}; S.c = F.bid;
            EpiMix E{EpiRes1{args.in[0], (float*)(F.ws + WS_X1), (bf16*)(F.ws + WS_X1B), (float*)(F.ws + WS_SSQ)}, EpiXpre{(bf16*)(F.ws + WS_MT), (bf16*)(F.ws + WS_VWT)}};
            pg8::gemm_phase<4096, 0, false>(F.lds, S, E);
        } else {
            { pg8::DenseOrder S; S.init(F.ws + WS_MIXO, F.ws + WS_WOUT, NT, DM, F.G, F.bid); EpiRes1 E{args.in[0], (float*)(F.ws + WS_X1), (bf16*)(F.ws + WS_X1B), (float*)(F.ws + WS_SSQ)}; pg8::gemm_phase<4096, 32, false>(F.lds, S, E); }
            for (int c = F.bid; c < 256; c += F.G) { XpreOrder S{(const char*)(F.ws + WS_KVK), (const char*)(F.ws + WS_WCQ), (const char*)(F.ws + WS_WCO), (const char*)(F.ws + WS_KVVT), c}; EpiXpre E{(bf16*)(F.ws + WS_MT), (bf16*)(F.ws + WS_VWT)}; pg8::gemm_phase<4096, 8, false>(F.lds, S, E); }
        }
    } SEAM(5);

    if (IN(7)) REP(7) {
        if (F.bid < 128) { const int bh = F.bid >> 3, qt = F.bid & 7; xattn_row_scales(F.lds, (const float*)(F.ws + WS_SSQ), (bh >> 2) * SEQ + 256 * qt); }
        { XsOrder S{(const char*)(F.ws + WS_X1B), (const char*)(F.ws + WS_MT), F.bid}; EpiSoftmax E{F.lds, (bf16*)(F.ws + WS_P)};
          pg8::gemm_phase<4096, 32, false>(F.lds, S, E); }
        if (conv_on && F.bid >= 128) {
            LAS unsigned* scr = (LAS unsigned*)(F.lds + F.wave * 16384); const int w2 = (F.bid - 128) * NWAVES + F.wave;
            moe_items_stream<false, true>(F, args, CONV_NA + w2, 1024, CONV_NB / 1024, scr); }
    } SEAM(7);

    if (IN(8)) REP(8) {
        XoutOrder S{(const char*)(F.ws + WS_P), (const char*)(F.ws + WS_VWT), F.bid};
        EpiRes2 E{(const float*)(F.ws + WS_X1), (float*)(F.ws + WS_X2)};
        pg8::gemm_phase<2048, 16, false>(F.lds, S, E);
    } SEAM(8);

    if (IN(9)) REP(9) { router_phase(F, args.in[16]); } SEAM(9);

    if (IN(10)) REP(10) { slots_phase(F, args.in[14]); } SEAM(10);

    if (IN(11)) REP(11) {
        moe_table(F, 16);
        constexpr int PB = MOE_FP8 ? 2048 : 4096;
        if (conv_wg) { for (int seq = E_PRE; seq < 32 - E_P0; ++seq) conv_step(F, args, seq); for (int seq = 32; seq < 32 + DN_IN_P11; ++seq) conv_step(F, args, seq); }
        else {
        int ready = conv_on ? E_PRE - 1 : 31;
        MoeOrder S{(const LAS int*)(F.lds + TAB_OFF), (const char*)(F.ws + WS_XS), (const char*)(F.ws + WS_WGU), 16, FC.G, F.bid, (size_t)2 * DFF * PB, 128, PB, conv_on ? (const unsigned*)(F.ws + WS_CTL) + CW_EXP : nullptr, &ready, 32 - E_P0};
        EpiAct E{args.in[18], (bf16*)(F.ws + WS_ACT)};
        pg8::gemm_phase<PB, MOE_FP8 ? 16 : 32, MOE_FP8 != 0>(F.lds, S, E);
        }
    } SEAM(11);

    if (IN(12)) REP(12) {
        moe_table(F, 8);
        constexpr int PB = MOE_FP8 ? 2048 : 4096;
        if (conv_wg) { for (int seq = 32 + DN_IN_P11; seq < 64 - D_P0; ++seq) conv_step(F, args, seq); }
        else {
        int ready = conv_on ? DN_IN_P11 - 1 : 31;
        MoeOrder S{(const LAS int*)(F.lds + TAB_OFF), (const char*)(F.ws + WS_ACT), (const char*)(F.ws + WS_WD), 8, FC.G, F.bid, (size_t)DM * PB, 256, PB, conv_on ? (const unsigned*)(F.ws + WS_CTL) + CW_EXP + 64 * 32 : nullptr, &ready, 32 - D_P0};
        EpiY E{args.in[20], (const float*)(F.ws + WS_SLOTW), (bf16*)(F.ws + WS_Y)};
        pg8::gemm_phase<PB, MOE_FP8 ? 16 : 32, MOE_FP8 != 0>(F.lds, S, E);
        }
    } SEAM(12);

#ifdef EXTRA_BARS
    if (fused) { for (int i = 0; i < EXTRA_BARS; ++i) xcd_barrier(bar); }
#endif
    if (IN(13)) REP(13) { final_phase(F, args.in[21], args.out); }
#undef IN
#undef SEAM
}

extern "C" void kernel_launch(void* const* d_in, const int* in_sizes, int n_in, void* d_out, int out_size, void* d_ws, size_t ws_size, hipStream_t stream) {
    static int grid = 0;
    if (grid == 0) {
        if (n_in != 22 || out_size != NT * DM || ws_size < WS_END) { fprintf(stderr, "kernel_launch: unexpected problem (n_in %d out %d ws %zu need %zu)\n", n_in, out_size, ws_size, (size_t)WS_END); grid = -1; return; }
        int dev = 0, cus = 0, per_cu = 0;
        if (hipGetDevice(&dev) != hipSuccess || hipDeviceGetAttribute(&cus, hipDeviceAttributeMultiprocessorCount, dev) != hipSuccess) { grid = -1; return; }
        if (hipFuncSetAttribute((const void*)fwd_kernel, hipFuncAttributeMaxDynamicSharedMemorySize, LDS_BYTES) != hipSuccess) { fprintf(stderr, "kernel_launch: hipFuncSetAttribute failed\n"); grid = -1; return; }
        if (hipOccupancyMaxActiveBlocksPerMultiprocessor(&per_cu, (const void*)fwd_kernel, NTHR, LDS_BYTES) != hipSuccess || per_cu < 1) fprintf(stderr, "kernel_launch: occupancy query reports %d\n", per_cu);
        (void)hipGetLastError();
        grid = cus;
    }
    if (grid < 0) return;
    (void)hipMemsetAsync((char*)d_ws + WS_CTL, 0, CTL_ZERO_BYTES, stream);
    Args a{};
    for (int i = 0; i < 22; ++i) a.in[i] = (const float*)d_in[i];
    a.out = (float*)d_out; a.ws = (unsigned char*)d_ws;
#if MK_N_LAUNCHES == 1
    a.ph_lo = 0; a.ph_hi = N_PHASES;
    hipLaunchKernelGGL(fwd_kernel, dim3(grid), dim3(NTHR), LDS_BYTES, stream, a);
#else
    for (int p = 0; p < N_PHASES; ++p) { a.ph_lo = p; a.ph_hi = p + 1; hipLaunchKernelGGL(fwd_kernel, dim3(grid), dim3(NTHR), LDS_BYTES, stream, a); }
#endif
}
```

```cpp
#include <hip/hip_runtime.h>
#include <cstdio>
#include <cstdint>

#ifndef MK_N_LAUNCHES
#define MK_N_LAUNCHES 1
#endif
#ifndef MOE_FP8
#define MOE_FP8 1
#endif
#ifndef CONV_LD_AUX
#define CONV_LD_AUX 18
#endif
#ifndef Y_FP8
#define Y_FP8 1
#endif
#ifndef MX_UNSCALED
#define MX_UNSCALED 1
#endif
#ifndef WCVT_SCALE
#define WCVT_SCALE 0.015625f
#endif
#ifndef DUP_MASK
#define DUP_MASK 0
#endif

#define GAS __attribute__((address_space(1)))
#define LAS __attribute__((address_space(3)))
typedef unsigned short bf16;
typedef short bf16x8 __attribute__((ext_vector_type(8)));
typedef float f32x2 __attribute__((ext_vector_type(2)));
typedef float f32x4 __attribute__((ext_vector_type(4)));
typedef float f32x16 __attribute__((ext_vector_type(16)));
typedef unsigned u32x2 __attribute__((ext_vector_type(2)));
typedef unsigned u32x4 __attribute__((ext_vector_type(4)));
typedef GAS unsigned gu32;

#define LDS_WAIT() asm volatile("s_waitcnt lgkmcnt(0)" ::: "memory")
#define VM_WAIT() asm volatile("s_waitcnt vmcnt(0)" ::: "memory")

constexpr int DM = 2048, NB = 4, SEQ = 2048, NT = NB * SEQ;
constexpr int INC = 6160, NPROJ = 6144;
constexpr int MEMLEN = 256, NMEM = NB * MEMLEN;
constexpr int NEXP = 32, TOPK = 4, NASSIGN = NT * TOPK, DFF = 2048;
constexpr float EPS = 1e-6f;
constexpr float LOG2E = 1.4426950408889634f, LN2 = 0.6931471805599453f;
constexpr int KD = 2048;

typedef __bf16 bf16x2_t __attribute__((ext_vector_type(2)));
__device__ __forceinline__ unsigned cvt_pk_bf16(float lo, float hi) { const f32x2 v = {lo, hi}; const bf16x2_t b = __builtin_convertvector(v, bf16x2_t); return __builtin_bit_cast(unsigned, b); }
__device__ __forceinline__ bf16 f2bf(float f) { return (bf16)(cvt_pk_bf16(f, 0.f) & 0xffffu); }
__device__ __forceinline__ float bf2f(unsigned b) { return __uint_as_float(b << 16); }
__device__ __forceinline__ float bflo(unsigned w) { return __uint_as_float(w << 16); }
__device__ __forceinline__ float bfhi(unsigned w) { return __uint_as_float(w & 0xffff0000u); }
__device__ __forceinline__ void st_bf16x4(bf16* p, f32x4 v) { u32x2 w; w.x = cvt_pk_bf16(v.x, v.y); w.y = cvt_pk_bf16(v.z, v.w); *(u32x2*)p = w; }
__device__ __forceinline__ float wave_sum(float v) {
#pragma unroll
    for (int o = 1; o < 64; o <<= 1) v += __shfl_xor(v, o);
    return v;
}
__device__ __forceinline__ float fexp2(float x) { return __builtin_amdgcn_exp2f(x); }
__device__ __forceinline__ float flog2(float x) { return __builtin_amdgcn_logf(x); }
__device__ __forceinline__ float frcp(float x) { return __builtin_amdgcn_rcpf(x); }
__device__ __forceinline__ float log2_sigmoid2(float z2) { return -(fmaxf(-z2, 0.f) + flog2(1.f + fexp2(-fabsf(z2)))); }

namespace pg8 {
constexpr int BM = 256, BK = 64, HALF = 128, HTB = HALF * BK * 2, STAGE_BYTES = 8 * HTB, NXCD = 8, WGM = 8;
__host__ __device__ __forceinline__ int lds_byte(int r, int c) { const int st = (r >> 4) * 2 + (c >> 5), rr = r & 15, cc = c & 31, ob = rr * 64 + cc * 2; return st * 1024 + (ob ^ (((ob >> 9) & 1) << 5)); }
__host__ __device__ __forceinline__ void stage_rc(int b, int& R, int& C) { const int st = b / 1024, sb = b % 1024, swz = sb ^ (((sb >> 9) & 1) << 5); R = (st >> 1) * 16 + swz / 64; C = (st & 1) * 32 + (swz % 64) / 2; }

typedef int v8i __attribute__((ext_vector_type(8)));
typedef int v4i __attribute__((ext_vector_type(4)));
__device__ __forceinline__ v8i cat8(bf16x8 lo, bf16x8 hi) { const v4i a = __builtin_bit_cast(v4i, lo), b = __builtin_bit_cast(v4i, hi); return (v8i){a.x, a.y, a.z, a.w, b.x, b.y, b.z, b.w}; }
__host__ __device__ __forceinline__ int perm32(int rho) { const int n = rho >> 4, i = rho & 15; return 8 * (i >> 2) + 4 * n + (i & 3); }
struct Unit { const char* a; const char* b; int r0, c0, rows, e, nt; };

struct DenseOrder {
    const char* A; const char* Bt; int nM, nN, nwg, G, c;
    __device__ void init(const void* A_, const void* Bt_, int M, int N, int G_, int c_) { A = (const char*)A_; Bt = (const char*)Bt_; nM = M / BM; nN = N / BM; nwg = nM * nN; G = G_; c = c_; }
    __device__ bool next(int i, Unit& u) const {
        const long L = (long)i * G + c; if (L >= nwg) return false;
        int wgid = (int)L; { const int q = nwg / NXCD, r = nwg % NXCD, xcd = wgid % NXCD, off = wgid / NXCD; wgid = (xcd < r ? xcd * (q + 1) : r * (q + 1) + (xcd - r) * q) + off; }
        const int nig = WGM * nN, gid = wgid / nig, fm = gid * WGM, gsz = (nM - fm) < WGM ? (nM - fm) : WGM;
        const int pm = fm + ((wgid % nig) % gsz), pn = (wgid % nig) / gsz;
        u.a = A + (size_t)pm * BM * KD * 2; u.b = Bt + (size_t)pn * BM * KD * 2; u.r0 = pm * BM; u.c0 = pn * BM; u.rows = BM; u.e = 0; return true;
    }
    __device__ __forceinline__ void a_ready(const Unit&) const {}
};

template <int PITCHB, int NTILES, bool FP8, class Epi, class Sched>
__device__ __forceinline__ void gemm_phase(LAS unsigned char* lds, const Sched& S, const Epi& E) {
    const int tid = threadIdx.x, wid = __builtin_amdgcn_readfirstlane(tid >> 6), lane = tid & 63, wr = wid >> 2, wc = wid & 3, fr = lane & 15, fq = lane >> 4;
    unsigned voffA[2], voffB[2];
#pragma unroll
    for (int i = 0; i < 2; ++i) { int R, C; stage_rc(tid * 16 + i * 8192, R, C); const int Rb = Epi::PERM ? ((R & ~31) + perm32(R & 31)) : R;
        voffA[i] = (unsigned)(R * PITCHB + C * 2); voffB[i] = (unsigned)(Rb * PITCHB + C * 2); }
    const size_t kstep = (size_t)(BK * 2);
    const size_t hstep = (size_t)HALF * PITCHB;
    const unsigned ldsw = (unsigned)wid * 1024u;
    const int aoff = lds_byte(wr * 64 + fr, fq * 8), boff = lds_byte(wc * 32 + fr, fq * 8);
#define PG8_SA(b, h) (((b) * 2 + (h)) * HTB)
#define PG8_SB(b, h) ((4 + (b) * 2 + (h)) * HTB)
#define PG8_STAGE_X(bufoff, gbase, voff) do { _Pragma("unroll") for (int _i = 0; _i < 2; ++_i) \
        __builtin_amdgcn_global_load_lds((const unsigned*)((const char*)(gbase) + (voff)[_i]), (LAS unsigned*)(lds + (bufoff) + ldsw + _i * 8192), 16, 0, 0); } while (0)
#define PG8_STAGE_A(bufoff, gbase) PG8_STAGE_X(bufoff, gbase, voffA)
#define PG8_STAGE_B(bufoff, gbase) PG8_STAGE_X(bufoff, gbase, voffB)
#define PG8_LDA(dst, b, h) do { _Pragma("unroll") for (int m = 0; m < 4; ++m) { if constexpr (FP8) { const v4i _lo = *(const LAS v4i*)(lds + PG8_SA(b, h) + aoff + m * 2048), _hi = *(const LAS v4i*)(lds + PG8_SA(b, h) + aoff + m * 2048 + 1024); \
            dst##8[m] = (v8i){_lo.x, _lo.y, _lo.z, _lo.w, _hi.x, _hi.y, _hi.z, _hi.w}; } \
        else { _Pragma("unroll") for (int k = 0; k < 2; ++k) dst[m][k] = *(const LAS bf16x8*)(lds + PG8_SA(b, h) + aoff + m * 2048 + k * 1024); } } } while (0)
#define PG8_LDB(dst, b, h) do { _Pragma("unroll") for (int n = 0; n < 2; ++n) { if constexpr (FP8) { const v4i _lo = *(const LAS v4i*)(lds + PG8_SB(b, h) + boff + n * 2048), _hi = *(const LAS v4i*)(lds + PG8_SB(b, h) + boff + n * 2048 + 1024); \
            dst##8[n] = (v8i){_lo.x, _lo.y, _lo.z, _lo.w, _hi.x, _hi.y, _hi.z, _hi.w}; } \
        else { _Pragma("unroll") for (int k = 0; k < 2; ++k) dst[n][k] = *(const LAS bf16x8*)(lds + PG8_SB(b, h) + boff + n * 2048 + k * 1024); } } } while (0)
#define PG8_MMA(ai, bj, At, Bt) do { __builtin_amdgcn_s_setprio(1); _Pragma("unroll") for (int m = 0; m < 4; ++m) _Pragma("unroll") for (int n = 0; n < 2; ++n) { \
        if constexpr (FP8) { if constexpr (MX_UNSCALED != 0) asm volatile("v_mfma_f32_16x16x128_f8f6f4 %0, %1, %2, %0" : "+v"(acc[ai][bj][m][n]) : "v"(Bt##8[n]), "v"(At##8[m])); \
            else asm volatile("v_mfma_scale_f32_16x16x128_f8f6f4 %0, %1, %2, %0, %3, %4 op_sel_hi:[0,0,0]" : "+v"(acc[ai][bj][m][n]) : "v"(Bt##8[n]), "v"(At##8[m]), "v"(sclW), "v"(sclA)); } \
        else { _Pragma("unroll") for (int k = 0; k < 2; ++k) acc[ai][bj][m][n] = __builtin_amdgcn_mfma_f32_16x16x32_bf16(Bt[n][k], At[m][k], acc[ai][bj][m][n], 0, 0, 0); } } \
        __builtin_amdgcn_s_setprio(0); } while (0)
#define PG8_WAIT_V(n) asm volatile("s_waitcnt vmcnt(" #n ")" ::: "memory")
#define PG8_WAIT_L(n) asm volatile("s_waitcnt lgkmcnt(" #n ")" ::: "memory")
#define PG8_BAR __builtin_amdgcn_s_barrier()
#define PG8_SCHED __builtin_amdgcn_sched_barrier(0)
    Unit cur, nxt; int ui = 0;
    if (!S.next(0, cur)) return;
    f32x4 acc[2][2][4][2];
#pragma unroll
    for (int a = 0; a < 2; ++a)
#pragma unroll
        for (int b = 0; b < 2; ++b)
#pragma unroll
            for (int m = 0; m < 4; ++m)
#pragma unroll
                for (int n = 0; n < 2; ++n) acc[a][b][m][n] = (f32x4){0.f, 0.f, 0.f, 0.f};
    const int sclW = 0x79797979, sclA = 0x7f7f7f7f;
    bf16x8 At[4][2], B0[2][2], B1[2][2]; v8i At8[4], B08[2], B18[2];
    const char* cA = cur.a; const char* cB = cur.b;
    S.a_ready(cur);
    PG8_STAGE_B(PG8_SB(0, 0), cB); PG8_STAGE_B(PG8_SB(0, 1), cB + hstep); PG8_STAGE_A(PG8_SA(0, 0), cA); PG8_STAGE_A(PG8_SA(0, 1), cA + hstep);
    if (wr == 1) PG8_BAR;
    PG8_WAIT_V(2); PG8_BAR;
    PG8_STAGE_B(PG8_SB(1, 0), cB + kstep); PG8_STAGE_A(PG8_SA(1, 0), cA + kstep); PG8_STAGE_B(PG8_SB(1, 1), cB + hstep + kstep);
    PG8_WAIT_V(6); PG8_BAR;
    for (;;) {
        const bool has_next = S.next(ui + 1, nxt);
        const char* nA = has_next ? nxt.a : cA; const char* nB = has_next ? nxt.b : cB;
        const int nt = NTILES > 0 ? NTILES : cur.nt;
#pragma nounroll
        for (int t = 0; t < nt; t += 2) {
            const bool last = (t == nt - 2);
            const char* a1 = cA + (size_t)(t + 1) * kstep;
            const char* a2 = last ? nA : cA + (size_t)(t + 2) * kstep; const char* b2 = last ? nB : cB + (size_t)(t + 2) * kstep;
            const char* a3 = a2 + kstep; const char* b3 = b2 + kstep;
            if (last && has_next) S.a_ready(nxt);
            PG8_LDB(B0, 0, 0); PG8_LDB(B1, 0, 1); PG8_SCHED; PG8_LDA(At, 0, 0); PG8_STAGE_A(PG8_SA(1, 1), a1 + hstep);
            PG8_WAIT_V(8); PG8_WAIT_L(0); PG8_BAR; PG8_MMA(0, 0, At, B0); PG8_MMA(0, 1, At, B1); PG8_BAR; PG8_SCHED;
            PG8_LDA(At, 0, 1); PG8_STAGE_B(PG8_SB(0, 0), b2); PG8_STAGE_B(PG8_SB(0, 1), b2 + hstep); PG8_STAGE_A(PG8_SA(0, 0), a2);
            PG8_WAIT_V(8); PG8_WAIT_L(0); PG8_BAR; PG8_MMA(1, 0, At, B0); PG8_MMA(1, 1, At, B1); PG8_BAR; PG8_SCHED;
            PG8_LDB(B0, 1, 0); PG8_LDB(B1, 1, 1); PG8_SCHED; PG8_LDA(At, 1, 0); PG8_STAGE_A(PG8_SA(0, 1), a2 + hstep);
            PG8_WAIT_V(8); PG8_WAIT_L(0); PG8_BAR; PG8_MMA(0, 0, At, B0); PG8_MMA(0, 1, At, B1); PG8_BAR; PG8_SCHED;
            PG8_LDA(At, 1, 1); PG8_STAGE_B(PG8_SB(1, 0), b3); PG8_STAGE_B(PG8_SB(1, 1), b3 + hstep); PG8_STAGE_A(PG8_SA(1, 0), a3);
            PG8_WAIT_V(8); PG8_WAIT_L(0); PG8_BAR; PG8_MMA(1, 0, At, B0); PG8_MMA(1, 1, At, B1); PG8_BAR; PG8_SCHED;
        }
        if constexpr (FP8) {
            asm volatile("s_nop 15\n\ts_nop 15" : "+v"(acc[0][0][0][0]), "+v"(acc[0][0][0][1]), "+v"(acc[0][0][1][0]), "+v"(acc[0][0][1][1]), "+v"(acc[0][0][2][0]), "+v"(acc[0][0][2][1]), "+v"(acc[0][0][3][0]), "+v"(acc[0][0][3][1]) :: "memory");
            asm volatile("" : "+v"(acc[0][1][0][0]), "+v"(acc[0][1][0][1]), "+v"(acc[0][1][1][0]), "+v"(acc[0][1][1][1]), "+v"(acc[0][1][2][0]), "+v"(acc[0][1][2][1]), "+v"(acc[0][1][3][0]), "+v"(acc[0][1][3][1]));
            asm volatile("" : "+v"(acc[1][0][0][0]), "+v"(acc[1][0][0][1]), "+v"(acc[1][0][1][0]), "+v"(acc[1][0][1][1]), "+v"(acc[1][0][2][0]), "+v"(acc[1][0][2][1]), "+v"(acc[1][0][3][0]), "+v"(acc[1][0][3][1]));
            asm volatile("" : "+v"(acc[1][1][0][0]), "+v"(acc[1][1][0][1]), "+v"(acc[1][1][1][0]), "+v"(acc[1][1][1][1]), "+v"(acc[1][1][2][0]), "+v"(acc[1][1][2][1]), "+v"(acc[1][1][3][0]), "+v"(acc[1][1][3][1]));
        }
        if (wr == 0) PG8_BAR;
        E(acc, cur, wr, wc, fr, fq);
        if (!has_next) break;
#pragma unroll
        for (int a = 0; a < 2; ++a)
#pragma unroll
            for (int b = 0; b < 2; ++b)
#pragma unroll
                for (int m = 0; m < 4; ++m)
#pragma unroll
                    for (int n = 0; n < 2; ++n) acc[a][b][m][n] = (f32x4){0.f, 0.f, 0.f, 0.f};
        cur = nxt; cA = nA; cB = nB; ++ui;
        if (wr == 1) PG8_BAR;
    }
    PG8_WAIT_V(0);
    PG8_BAR;
#undef PG8_SA
#undef PG8_SB
#undef PG8_STAGE_X
#undef PG8_STAGE_A
#undef PG8_STAGE_B
#undef PG8_LDA
#undef PG8_LDB
#undef PG8_MMA
#undef PG8_WAIT_V
#undef PG8_WAIT_L
#undef PG8_BAR
#undef PG8_SCHED
}
}
using pg8::Unit;

#define XB_TMO      128
#define XB_XCNT(j)  (256  + 64 * (j))
#define XB_XSUB(j)  (1280 + 64 * (j))
#define XB_XGEN(j)  (2304 + 64 * (j))
#define XB_TOP      3328
#define XB_TOPGEN   3392
#define XCD_BAR_WORDS 3456
#define XB_SPIN_CAP (1u << 22)
__device__ __forceinline__ unsigned xb_ld(unsigned* p)              { return __hip_atomic_load(p, __ATOMIC_RELAXED, __HIP_MEMORY_SCOPE_AGENT); }
__device__ __forceinline__ unsigned xb_add(unsigned* p, unsigned v) { return __hip_atomic_fetch_add(p, v, __ATOMIC_RELAXED, __HIP_MEMORY_SCOPE_AGENT); }
__device__ __forceinline__ unsigned xb_xcc_id() { return (unsigned)__builtin_amdgcn_s_getreg((3 << 11) | 20) & 0xFu; }
#define XB_SPIN(cond, bar) do { unsigned _sp = 0; while (cond) { __builtin_amdgcn_s_sleep(1); \
    if ((++_sp & 255u) == 0u) { if (xb_ld(&(bar)[XB_TMO])) break; if (_sp > XB_SPIN_CAP) { atomicAdd(&(bar)[XB_TMO], 1u); break; } } } } while (0)
struct XcdBarrier { unsigned* bar; unsigned x; volatile LAS unsigned* st; };
__device__ __forceinline__ XcdBarrier xcd_barrier_post(unsigned* bar, volatile LAS unsigned* st) {
    XcdBarrier b; b.bar = bar; b.x = xb_xcc_id(); b.st = st;
    if (threadIdx.x == 0) (void)xb_add(&bar[XB_XCNT(b.x)], 1u);
    return b;
}
__device__ __forceinline__ void xcd_barrier_complete(unsigned* bar, unsigned x, unsigned& nloc, unsigned& nx) {
    const unsigned G = gridDim.x * gridDim.y * gridDim.z;
    unsigned sum, cnt, mine, sp = 0u;
    for (;;) {
        sum = 0u; cnt = 0u; mine = 0u;
#pragma unroll
        for (unsigned j = 0; j < 16; ++j) { const unsigned c = xb_ld(&bar[XB_XCNT(j)]); sum += c; cnt += (c > 0u) ? 1u : 0u; mine = (j == x) ? c : mine; }
        if (sum == G) break;
        __builtin_amdgcn_s_sleep(1);
        if ((++sp & 255u) == 0u) { if (xb_ld(&bar[XB_TMO])) break; if (sp > XB_SPIN_CAP) { atomicAdd(&bar[XB_TMO], 1u); break; } }
    }
    nloc = mine > 0u ? mine : 1u; nx = cnt > 0u ? cnt : 1u;
}
__device__ __forceinline__ void xcd_barrier(const XcdBarrier& b) {
    asm volatile("s_waitcnt vmcnt(0)" ::: "memory");
    __syncthreads();
    if (threadIdx.x == 0) {
        unsigned* bar = b.bar;
        __builtin_amdgcn_s_waitcnt(0);
        unsigned nloc = b.st[0], nx = b.st[1];
        if (nloc == 0u) { xcd_barrier_complete(bar, b.x, nloc, nx); b.st[0] = nloc; b.st[1] = nx; }
        const unsigned old = xb_add(&bar[XB_XSUB(b.x)], 1u);
        const unsigned gen = old / nloc;
        if (old + 1u == (gen + 1u) * nloc) {
            __builtin_amdgcn_fence(__ATOMIC_RELEASE, "agent");
            asm volatile("s_waitcnt vmcnt(0)" ::: "memory");
            const unsigned og = xb_add(&bar[XB_TOP], 1u);
            const unsigned tg = og / nx;
            if (og + 1u == (tg + 1u) * nx) xb_add(&bar[XB_TOPGEN], 1u);
            else XB_SPIN(xb_ld(&bar[XB_TOPGEN]) == tg, bar);
            __builtin_amdgcn_fence(__ATOMIC_ACQUIRE, "agent");
            xb_add(&bar[XB_XGEN(b.x)], 1u);
            asm volatile("s_waitcnt vmcnt(0)" ::: "memory");
        } else {
            XB_SPIN(xb_ld(&bar[XB_XGEN(b.x)]) == gen, bar);
            __builtin_amdgcn_fence(__ATOMIC_ACQUIRE, "agent");
            asm volatile("s_waitcnt vmcnt(0)" ::: "memory");
        }
    }
    __syncthreads();
}

constexpr size_t MiB = 1u << 20;
constexpr size_t al(size_t x) { return (x + 255) & ~(size_t)255; }
constexpr size_t WS_CTL = 0, CTL_ZERO_BYTES = 1 * MiB;
constexpr size_t WS_WIN = 1 * MiB;
constexpr size_t WS_WLOW = WS_WIN + (size_t)NPROJ * KD * 2;
constexpr size_t WS_WRH = WS_WLOW + 16 * KD * 2;
constexpr size_t WS_WRL = WS_WRH + 32 * KD * 2;
constexpr size_t WS_WOUT = WS_WRL + 32 * KD * 2;
constexpr size_t WS_WCQ = WS_WOUT + (size_t)DM * KD * 2;
constexpr size_t WS_WCKV = WS_WCQ + (size_t)DM * KD * 2;
constexpr size_t WS_WCO = WS_WCKV + (size_t)2 * DM * KD * 2;
constexpr size_t WS_WGU = WS_WCO + (size_t)DM * KD * 2;
constexpr size_t WS_WD = WS_WGU + (size_t)NEXP * 2 * DFF * KD * 2;
constexpr size_t WS_H1 = WS_WD + (size_t)NEXP * DM * KD * 2;
constexpr size_t WS_MEMN = WS_H1 + (size_t)NT * DM * 2;
constexpr size_t WS_SBQ = WS_MEMN + (size_t)NMEM * DM * 2;
constexpr size_t WS_SBK = WS_SBQ + (size_t)NT * 1024 * 2;
constexpr size_t WS_SBVT = WS_SBK + (size_t)NT * 1024 * 2;
constexpr size_t WS_GQ = WS_SBVT + (size_t)NT * 1024 * 2;
constexpr size_t WS_GK = WS_GQ + (size_t)NT * 512 * 2;
constexpr size_t WS_GVT = WS_GK + (size_t)NT * 512 * 2;
constexpr size_t WS_GR = WS_GVT + (size_t)NT * 1024 * 2;
constexpr size_t WS_GLOW = WS_GR + (size_t)NT * 1024 * 2;
constexpr size_t WS_KVK = WS_GLOW + (size_t)NT * 16 * 4;
constexpr size_t WS_KVVT = WS_KVK + (size_t)NMEM * DM * 2;
constexpr size_t WS_QIN = WS_KVVT + (size_t)NMEM * DM * 2;
constexpr size_t WS_OINTRA = WS_QIN + (size_t)NT * 512 * 2;
constexpr size_t WS_KVN = WS_OINTRA + (size_t)512 * 16384 * 4;
constexpr size_t WS_DECAY = WS_KVN + (size_t)512 * 32768 * 4;
constexpr size_t WS_STATE = WS_DECAY + (size_t)512 * 128 * 4;
constexpr size_t WS_MIXO = WS_STATE + (size_t)512 * 32768 * 2;
constexpr size_t WS_X1 = WS_MIXO + (size_t)NT * DM * 2;
constexpr size_t WS_X1B = WS_X1 + (size_t)NT * DM * 4;
constexpr size_t WS_SSQ = WS_X1B + (size_t)NT * DM * 2;
constexpr size_t WS_CQ = WS_SSQ + (size_t)32 * NT * 4;
constexpr size_t WS_ATTO = WS_CQ + (size_t)NT * DM * 2;
constexpr size_t WS_X2 = WS_ATTO + (size_t)NT * DM * 2;
constexpr size_t WS_TOPE = WS_X2 + (size_t)NT * DM * 4;
constexpr size_t WS_TOPW = WS_TOPE + (size_t)NT * 4 * 4;
constexpr size_t WS_RSTD3 = WS_TOPW + (size_t)NT * 4 * 4;
constexpr size_t WS_HIST = WS_RSTD3 + (size_t)NT * 4;
constexpr size_t WS_SLOTW = WS_HIST + (size_t)256 * 32 * 4;
constexpr size_t WS_TOKSLOT = WS_SLOTW + (size_t)(NASSIGN + 256) * 4;
constexpr size_t WS_CNT = WS_TOKSLOT + (size_t)NT * 4 * 4;
constexpr size_t WS_XS = al(WS_CNT + 256);
constexpr size_t WS_ACT = WS_XS + (size_t)(NASSIGN + 256) * DM * 2;
constexpr size_t WS_Y = WS_ACT + (size_t)(NASSIGN + 256) * DM * 2;
constexpr size_t WS_P = WS_Y + (size_t)(NASSIGN + 256) * DM * 2;
constexpr size_t WS_MT = WS_P + (size_t)16 * SEQ * MEMLEN * 2;
constexpr size_t WS_VWT = WS_MT + (size_t)16 * MEMLEN * DM * 2;
constexpr size_t WS_END = WS_VWT + (size_t)NB * DM * 1024 * 2;

constexpr int CW_BAR = 4096;
static_assert((CW_BAR + XCD_BAR_WORDS) * 4 <= (int)CTL_ZERO_BYTES, "ctl");

constexpr int RING_BYTES = 131072, LDSCTL_OFF = RING_BYTES, MISC_OFF = LDSCTL_OFF + 64, TAB_OFF = LDSCTL_OFF + 256;
constexpr int RED1_OFF = LDSCTL_OFF + 2048, RED2_OFF = RED1_OFF + 4096;
constexpr int LDS_BYTES = 147456;

constexpr int NWAVES = 8, NTHR = 512;

struct Args { const float* in[22]; float* out; unsigned char* ws; int ph_lo, ph_hi; };

struct Frame {
    LAS unsigned char* lds;
    int tid, lane, wave, G, bid;
    unsigned char* ws;
};

__device__ __forceinline__ void cvt_tile(const float* __restrict__ W, int ldn, int k0, int n0, bf16* __restrict__ dst, int dst_row0, const float* __restrict__ gk, LAS unsigned* scr, int lane) {
    const int q = lane >> 4, c4 = lane & 15;
    f32x4 v[16];
#pragma unroll
    for (int i = 0; i < 16; ++i) { const int k = k0 + 8 * (i >> 1) + 2 * q + (i & 1); v[i] = *(const f32x4*)(W + (size_t)k * ldn + n0 + 4 * c4); if (gk) v[i] = v[i] * gk[k]; }
#pragma unroll
    for (int p = 0; p < 8; ++p)
#pragma unroll
        for (int j = 0; j < 4; ++j) { const int n = 4 * c4 + j, kd = 4 * p + q; scr[n * 32 + (kd ^ ((c4 & 7) << 2))] = cvt_pk_bf16(v[2 * p][j], v[2 * p + 1][j]); }
    LDS_WAIT();
#pragma unroll
    for (int jj = 0; jj < 8; ++jj) { const int n = 8 * jj + (lane >> 3), ch = lane & 7; const u32x4 w = *(const LAS u32x4*)(scr + n * 32 + ((ch ^ ((n >> 2) & 7)) << 2));
        *(u32x4*)(dst + (size_t)(dst_row0 + n) * KD + k0 + 8 * ch) = w; }
    LDS_WAIT();
}
__device__ __forceinline__ unsigned pk_fp8x4(float a, float b, float c, float d) { int r = __builtin_amdgcn_cvt_pk_fp8_f32(a, b, 0, false); r = __builtin_amdgcn_cvt_pk_fp8_f32(c, d, r, true); return (unsigned)r; }
__device__ __forceinline__ void rms_row_bf16(const float* __restrict__ xrow, const float* __restrict__ g, bf16* __restrict__ orow, int lane) {
    const f32x4* xr = (const f32x4*)xrow + lane; const f32x4* gr = (const f32x4*)g + lane;
    f32x4 v[8]; float s = 0.f;
#pragma unroll
    for (int j = 0; j < 8; ++j) { v[j] = xr[64 * j]; s += (v[j].x * v[j].x + v[j].y * v[j].y) + (v[j].z * v[j].z + v[j].w * v[j].w); }
    const float rstd = 1.0f / sqrtf(wave_sum(s) * (1.f / DM) + EPS);
    u32x2* o8 = (u32x2*)orow + lane;
#pragma unroll
    for (int j = 0; j < 8; ++j) { const f32x4 gg = gr[64 * j]; u32x2 w; w.x = cvt_pk_bf16(v[j].x * rstd * gg.x, v[j].y * rstd * gg.y); w.y = cvt_pk_bf16(v[j].z * rstd * gg.z, v[j].w * rstd * gg.w); o8[64 * j] = w; }
}

constexpr int MOE_ITEMS = NEXP * 64 * 16 + NEXP * 32 * 16;
#ifndef CONV_WGS
#define CONV_WGS 64
#endif
#ifndef E_P1
#define E_P1 9
#endif
constexpr int E_P7 = 7, E_PRE = E_P1 + E_P7;
#ifndef DN_IN_P11
#define DN_IN_P11 16
#endif
#ifndef E_P0
#define E_P0 0
#endif
#ifndef D_P0
#define D_P0 0
#endif
constexpr int NCOMP = 256 - CONV_WGS, CONV_NA = E_P1 * 1024, CONV_NB = E_P7 * 1024;
constexpr int CW_EXP = 8192;
static_assert(E_PRE + E_P0 <= 32 && DN_IN_P11 + D_P0 <= 32, "expert conversion ranges");
struct MoeItem { const float* W; int ldn, k0, n0; unsigned char* dst; int drow; };
__device__ __forceinline__ MoeItem moe_item_desc(const Frame& F, const Args& A, int it) {
    constexpr int J5 = NEXP * 64 * 16; MoeItem m;
    if (it < J5) { const int e = it >> 10, r = it & 1023, kt = r >> 6, n0 = (r & 63) * 64;
        m.W = A.in[17] + (size_t)e * DM * 2 * DFF; m.ldn = 2 * DFF; m.k0 = kt * 128; m.n0 = n0; m.dst = F.ws + WS_WGU + (size_t)e * 2 * DFF * KD;
        m.drow = (n0 < DFF) ? ((n0 >> 7) * 256 + (n0 & 127)) : (((n0 - DFF) >> 7) * 256 + 128 + ((n0 - DFF) & 127)); }
    else { const int q2 = it - J5, e = q2 >> 9, r = q2 & 511, kt = r >> 5, n0 = (r & 31) * 64;
        m.W = A.in[19] + (size_t)e * DFF * DM; m.ldn = DM; m.k0 = kt * 128; m.n0 = n0; m.dst = F.ws + WS_WD + (size_t)e * DM * KD; m.drow = n0; }
    return m;
}
template <bool SLD> __device__ __forceinline__ void moe_ld_half(f32x4 (&v)[16], const MoeItem& m, int half, int lane) {
    const int q = lane >> 4, c4 = lane & 15;
    if constexpr (SLD) { const __amdgpu_buffer_rsrc_t rw = __builtin_amdgcn_make_buffer_rsrc((void*)m.W, 0, 0x7fffffff, 0x00020000);
#pragma unroll
        for (int i = 0; i < 16; ++i) { const int k = m.k0 + 64 * half + 16 * (i >> 2) + 4 * q + (i & 3); v[i] = __builtin_bit_cast(f32x4, __builtin_amdgcn_raw_buffer_load_b128(rw, (k * m.ldn + m.n0 + 4 * c4) * 4, 0, CONV_LD_AUX)); } }
    else {
#pragma unroll
        for (int i = 0; i < 16; ++i) { const int k = m.k0 + 64 * half + 16 * (i >> 2) + 4 * q + (i & 3); v[i] = __builtin_nontemporal_load((const f32x4*)(m.W + (size_t)k * m.ldn + m.n0 + 4 * c4)); } }
}
typedef short v2s16 __attribute__((ext_vector_type(2)));
__device__ __forceinline__ unsigned pk_fp8x4_scaled(float a, float b, float c, float d, float scale) { v2s16 r = {0, 0};
    r = __builtin_amdgcn_cvt_scalef32_pk_fp8_f32(r, a, b, scale, false); r = __builtin_amdgcn_cvt_scalef32_pk_fp8_f32(r, c, d, scale, true); return __builtin_bit_cast(unsigned, r); }
__device__ __forceinline__ void moe_cv_half(const f32x4 (&v)[16], LAS unsigned* scr, int half, int lane) {
    const int q = lane >> 4, c4 = lane & 15;
#pragma unroll
    for (int pp = 0; pp < 4; ++pp)
#pragma unroll
        for (int j = 0; j < 4; ++j) scr[(4 * c4 + j) * 33 + 16 * half + 4 * pp + q] = pk_fp8x4_scaled(v[4 * pp][j], v[4 * pp + 1][j], v[4 * pp + 2][j], v[4 * pp + 3][j], WCVT_SCALE);
}
template <bool SC1> __device__ __forceinline__ void moe_flush(const MoeItem& m, LAS unsigned* scr, int lane) {
#pragma unroll
    for (int jj = 0; jj < 8; ++jj) { const int n = 8 * jj + (lane >> 3), ch = lane & 7; u32x4 w; const LAS unsigned* sp = scr + n * 33 + 4 * ch; w.x = sp[0]; w.y = sp[1]; w.z = sp[2]; w.w = sp[3];
        if constexpr (SC1) { const __amdgpu_buffer_rsrc_t rs = __builtin_amdgcn_make_buffer_rsrc(m.dst, 0, 0x7fffffff, 0x00020000);
            __builtin_amdgcn_raw_buffer_store_b128(w, rs, (m.drow + n) * KD + m.k0 + 16 * ch, 0, 16); }
        else __builtin_nontemporal_store(w, (u32x4*)(m.dst + (size_t)(m.drow + n) * KD + m.k0 + 16 * ch)); }
}
template <bool SC1, bool SLD> __device__ __forceinline__ void moe_items_stream(const Frame& F, const Args& A, int it0, int stride, int count, LAS unsigned* scr) {
    if (count <= 0) return;
    f32x4 va[16], vb[16];
    MoeItem cur = moe_item_desc(F, A, it0);
    moe_ld_half<SLD>(va, cur, 0, F.lane);
    for (int i = 0; i < count; ++i) {
        moe_ld_half<SLD>(vb, cur, 1, F.lane);
        moe_cv_half(va, scr, 0, F.lane);
        MoeItem nxt = cur;
        if (i + 1 < count) { nxt = moe_item_desc(F, A, it0 + (i + 1) * stride); moe_ld_half<SLD>(va, nxt, 0, F.lane); }
        moe_cv_half(vb, scr, 1, F.lane);
        LDS_WAIT();
        moe_flush<SC1>(cur, scr, F.lane);
        LDS_WAIT();
        cur = nxt;
    }
}
template <bool SC1, bool SLD = SC1> __device__ __forceinline__ void moe_item_fp8(const Frame& F, const Args& A, int it, LAS unsigned* scr) { moe_items_stream<SC1, SLD>(F, A, it, 0, 1, scr); }
__device__ __forceinline__ void p0_prologue(const Frame& F, const Args& A) {
    LAS unsigned* scr = (LAS unsigned*)(F.lds + F.wave * 16384);
    const int gw = F.bid * NWAVES + F.wave, NGW = F.G * NWAVES;
    const float* w_in = A.in[3]; const float* w_out = A.in[8]; const float* w_cq = A.in[11]; const float* w_ckv = A.in[12]; const float* w_co = A.in[13];
    const float* w_gu = A.in[17]; const float* w_dn = A.in[19]; (void)w_gu; (void)w_dn;
    constexpr int I0 = 96 * 32, I1 = 32 * 32, I2 = 0, I3 = 64 * 32, I4 = 32 * 32, I5 = MOE_FP8 ? 0 : NEXP * 64 * 32, I6 = MOE_FP8 ? 0 : NEXP * 32 * 32;
    constexpr int NITEMS = I0 + I1 + I2 + I3 + I4 + I5 + I6;
    for (int it = gw; it < NITEMS; it += NGW) {
        int r = it; const float* W; int ldn, nct; bf16* dst; const float* gk = nullptr; int mode = 0;
        if (r < I0) { W = w_in; ldn = INC; nct = 96; dst = (bf16*)(F.ws + WS_WIN); }
        else if ((r -= I0) < I1) { W = w_out; ldn = DM; nct = 32; dst = (bf16*)(F.ws + WS_WOUT); }
        else if ((r -= I1) < I3) { W = w_ckv; ldn = 2 * DM; nct = 64; dst = (bf16*)(F.ws + WS_WCKV); }
        else if ((r -= I3) < I4) { W = w_co; ldn = DM; nct = 32; dst = (bf16*)(F.ws + WS_WCO); }
        else if ((r -= I4) < I5) { const int e = r / (64 * 32); r -= e * (64 * 32); W = w_gu + (size_t)e * DM * 2 * DFF; ldn = 2 * DFF; nct = 64; dst = (bf16*)(F.ws + WS_WGU) + (size_t)e * 2 * DFF * KD; mode = 1; }
        else { r -= I5; const int e = r / (32 * 32); r -= e * (32 * 32); W = w_dn + (size_t)e * DFF * DM; ldn = DM; nct = 32; dst = (bf16*)(F.ws + WS_WD) + (size_t)e * DM * KD; }
        const int kt = r / nct, ct = r - kt * nct; const int n0 = ct * 64;
        int drow = n0;
        if (mode == 1) drow = (n0 < DFF) ? ((n0 >> 7) * 256 + (n0 & 127)) : (((n0 - DFF) >> 7) * 256 + 128 + ((n0 - DFF) & 127));
        cvt_tile(W, ldn, kt * 64, n0, dst, drow, gk, scr, F.lane);
    }
#if MOE_FP8
    if (CONV_WGS) {
        for (int it = (32 - E_P0) * 1024 + gw; it < 32768; it += NGW) moe_item_fp8<false>(F, A, it, scr);
        for (int it = 32768 + (32 - D_P0) * 512 + gw; it < MOE_ITEMS; it += NGW) moe_item_fp8<false>(F, A, it, scr);
    }
#endif
    {
        const int gt = F.bid * NTHR + F.tid, NGT = F.G * NTHR;
        bf16* wlow = (bf16*)(F.ws + WS_WLOW); bf16* wrh = (bf16*)(F.ws + WS_WRH); bf16* wrl = (bf16*)(F.ws + WS_WRL);
        const float* w_r = A.in[15]; const float* g_moe = A.in[14];
        { const float* g_cross = A.in[9]; bf16* wcqn = (bf16*)(F.ws + WS_WCQ);
          for (int i = gt; i < DM * DM / 4; i += NGT) { const int k = i >> 9; const f32x4 v = *((const f32x4*)w_cq + i) * g_cross[k]; st_bf16x4(wcqn + (size_t)i * 4, v); } }
        for (int i = gt; i < 16 * KD; i += NGT) { const int k = i >> 4, r = i & 15; wlow[r * KD + k] = f2bf(w_in[(size_t)k * INC + NPROJ + r]); }
        for (int i = gt; i < 32 * KD; i += NGT) { const int k = i >> 5, e = i & 31; const float w = w_r[k * 32 + e] * g_moe[k]; const bf16 h = f2bf(w); wrh[e * KD + k] = h; wrl[e * KD + k] = f2bf(w - bf2f(h)); }
    }
    for (int m = gw; m < NT + NMEM; m += NGW) {
        if (m < NT) rms_row_bf16(A.in[0] + (size_t)m * DM, A.in[2], (bf16*)(F.ws + WS_H1) + (size_t)m * DM, F.lane);
        else rms_row_bf16(A.in[1] + (size_t)(m - NT) * DM, A.in[10], (bf16*)(F.ws + WS_MEMN) + (size_t)(m - NT) * DM, F.lane);
    }
}

__device__ __forceinline__ void conv_step(const Frame& F, const Args& A, int seq) {
    LAS unsigned* scr = (LAS unsigned*)(F.lds + F.wave * 16384);
    const int cw = F.bid - NCOMP;
    if (seq < 32) moe_items_stream<true, true>(F, A, seq * 1024 + (cw * NWAVES + F.wave) * 2, 1, 2, scr);
    else moe_item_fp8<true>(F, A, 32768 + (seq - 32) * 512 + cw * NWAVES + F.wave, scr);
    VM_WAIT(); __syncthreads();
    if (F.tid == 0) __hip_atomic_fetch_add((unsigned*)(F.ws + WS_CTL) + CW_EXP + 64 * seq, 1u, __ATOMIC_RELAXED, __HIP_MEMORY_SCOPE_AGENT);
}

#define EPI_LOOP(...) _Pragma("unroll") for (int ai = 0; ai < 2; ++ai) _Pragma("unroll") for (int m = 0; m < 4; ++m) { const int rl = ai * 128 + wr * 64 + m * 16 + fr; \
        _Pragma("unroll") for (int bj = 0; bj < 2; ++bj) _Pragma("unroll") for (int n = 0; n < 2; ++n) { const int cl = bj * 128 + wc * 32 + n * 16 + 4 * fq; const f32x4 v = acc[ai][bj][m][n]; __VA_ARGS__ } }
#define EPI_LOOP_P(...) _Pragma("unroll") for (int ai = 0; ai < 2; ++ai) _Pragma("unroll") for (int m = 0; m < 4; ++m) { const int rl = ai * 128 + wr * 64 + m * 16 + fr; \
        _Pragma("unroll") for (int bj = 0; bj < 2; ++bj) { const int cl = bj * 128 + wc * 32 + 8 * fq; const f32x4 v0 = acc[ai][bj][m][0], v1 = acc[ai][bj][m][1]; __VA_ARGS__ } }
__device__ __forceinline__ void st_bf16x8(bf16* p, f32x4 a, f32x4 b) { u32x4 w; w.x = cvt_pk_bf16(a.x, a.y); w.y = cvt_pk_bf16(a.z, a.w); w.z = cvt_pk_bf16(b.x, b.y); w.w = cvt_pk_bf16(b.z, b.w); *(u32x4*)p = w; }

struct EpiInProj {
    static constexpr bool PERM = true;
    unsigned char* ws;
    __device__ __forceinline__ void operator()(f32x4 (&acc)[2][2][4][2], const Unit& u, int wr, int wc, int fr, int fq) const {
        const int c0 = u.c0;
        if (c0 < 2048 || (c0 >= 3072 && c0 < 4096) || c0 >= 5120) {
            bf16* base; int ld, cc;
            if (c0 < 1024) { base = (bf16*)(ws + WS_SBQ); ld = 1024; cc = c0; }
            else if (c0 < 2048) { base = (bf16*)(ws + WS_SBK); ld = 1024; cc = c0 - 1024; }
            else if (c0 < 3584) { base = (bf16*)(ws + WS_GQ); ld = 512; cc = c0 - 3072; }
            else if (c0 < 4096) { base = (bf16*)(ws + WS_GK); ld = 512; cc = c0 - 3584; }
            else { base = (bf16*)(ws + WS_GR); ld = 1024; cc = c0 - 5120; }
            EPI_LOOP_P( st_bf16x8(base + (size_t)(u.r0 + rl) * ld + cc + cl, v0, v1); )
        } else {
            bf16* base = (bf16*)(ws + (c0 < 3072 ? WS_SBVT : WS_GVT)); const int cc = c0 - (c0 < 3072 ? 2048 : 4096);
            EPI_LOOP_P( const int r = u.r0 + rl, b = r >> 11, sq = r & 2047; const int c = cc + cl;
                _Pragma("unroll") for (int j = 0; j < 4; ++j) { base[((size_t)(b * 1024 + c + j)) * SEQ + sq] = f2bf(v0[j]); base[((size_t)(b * 1024 + c + 4 + j)) * SEQ + sq] = f2bf(v1[j]); } )
        }
    }
};
struct EpiKV {
    static constexpr bool PERM = true;
    unsigned char* ws;
    __device__ __forceinline__ void operator()(f32x4 (&acc)[2][2][4][2], const Unit& u, int wr, int wc, int fr, int fq) const {
        bf16* base = (bf16*)(ws + (u.c0 < 2048 ? WS_KVK : WS_KVVT)); const int cc = u.c0 < 2048 ? u.c0 : u.c0 - 2048;
        EPI_LOOP_P( st_bf16x8(base + (size_t)(u.r0 + rl) * DM + cc + cl, v0, v1); )
    }
};
struct EpiRes1 {
    static constexpr bool PERM = true;
    const float* x; float* x1; bf16* x1b; float* ssq;
    __device__ __forceinline__ void operator()(f32x4 (&acc)[2][2][4][2], const Unit& u, int wr, int wc, int fr, int fq) const {
#pragma unroll
        for (int ai = 0; ai < 2; ++ai)
#pragma unroll
            for (int m = 0; m < 4; ++m) { const int r = u.r0 + ai * 128 + wr * 64 + m * 16 + fr; float s = 0.f;
#pragma unroll
                for (int bj = 0; bj < 2; ++bj) { const int c = u.c0 + bj * 128 + wc * 32 + 8 * fq; const size_t o = (size_t)r * DM + c;
                    const f32x4 a = acc[ai][bj][m][0] + *(const f32x4*)(x + o), b = acc[ai][bj][m][1] + *(const f32x4*)(x + o + 4);
                    *(f32x4*)(x1 + o) = a; *(f32x4*)(x1 + o + 4) = b; st_bf16x8(x1b + o, a, b);
                    s += ((a.x * a.x + a.y * a.y) + (a.z * a.z + a.w * a.w)) + ((b.x * b.x + b.y * b.y) + (b.z * b.z + b.w * b.w)); }
                s += __shfl_xor(s, 16); s += __shfl_xor(s, 32);
                if (fq == 0) ssq[(size_t)((u.c0 >> 8) * 4 + wc) * NT + r] = s; }
    }
};
struct EpiRes2 {
    static constexpr bool PERM = false;
    const float* x1; float* x2;
    __device__ __forceinline__ void operator()(f32x4 (&acc)[2][2][4][2], const Unit& u, int wr, int wc, int fr, int fq) const {
        EPI_LOOP( const size_t o = (size_t)(u.r0 + rl) * DM + u.c0 + cl; *(f32x4*)(x2 + o) = v + *(const f32x4*)(x1 + o); )
    }
};
constexpr float WUNSC = (MOE_FP8 && MX_UNSCALED) ? (1.0f / 64.0f) : 1.0f;
struct EpiAct {
    static constexpr bool PERM = true;
    const float* bgu; bf16* act;
    __device__ __forceinline__ void operator()(f32x4 (&acc)[2][2][4][2], const Unit& u, int wr, int wc, int fr, int fq) const {
        const float* bg = bgu + (size_t)u.e * 2 * DFF; const int j0 = u.c0 + wc * 32 + 8 * fq;
        f32x4 b0[2], b1[2];
#pragma unroll
        for (int n = 0; n < 2; ++n) { b0[n] = *(const f32x4*)(bg + j0 + 4 * n); b1[n] = *(const f32x4*)(bg + DFF + j0 + 4 * n); }
#pragma unroll
        for (int ai = 0; ai < 2; ++ai)
#pragma unroll
            for (int m = 0; m < 4; ++m) { const int rl = ai * 128 + wr * 64 + m * 16 + fr; if (rl < u.rows) { f32x4 a[2];
#pragma unroll
                for (int n = 0; n < 2; ++n) { const f32x4 g = acc[ai][0][m][n] * WUNSC + b0[n], l = acc[ai][1][m][n] * WUNSC + b1[n];
#pragma unroll
                    for (int j = 0; j < 4; ++j) { const float gg = fminf(g[j], 7.0f), ll = fminf(fmaxf(l[j], -7.0f), 7.0f); a[n][j] = gg * frcp(1.0f + fexp2(-1.702f * LOG2E * gg)) * (ll + 1.0f); } }
#if MOE_FP8
                u32x2 w; w.x = pk_fp8x4(a[0].x, a[0].y, a[0].z, a[0].w); w.y = pk_fp8x4(a[1].x, a[1].y, a[1].z, a[1].w);
                *(u32x2*)((unsigned char*)act + (size_t)(u.r0 + rl) * DFF + j0) = w;
#else
                st_bf16x8(act + (size_t)(u.r0 + rl) * DFF + j0, a[0], a[1]);
#endif
                } }
    }
};
struct EpiY {
    static constexpr bool PERM = true;
    const float* bd; const float* sw; bf16* y;
    __device__ __forceinline__ void operator()(f32x4 (&acc)[2][2][4][2], const Unit& u, int wr, int wc, int fr, int fq) const {
        const float* bb = bd + (size_t)u.e * DM;
        f32x4 bv[2][2];
#pragma unroll
        for (int bj = 0; bj < 2; ++bj)
#pragma unroll
            for (int n = 0; n < 2; ++n) bv[bj][n] = *(const f32x4*)(bb + u.c0 + bj * 128 + wc * 32 + 8 * fq + 4 * n);
#pragma unroll
        for (int ai = 0; ai < 2; ++ai)
#pragma unroll
            for (int m = 0; m < 4; ++m) { const int rl = ai * 128 + wr * 64 + m * 16 + fr; if (rl < u.rows) { const float w = sw[u.r0 + rl];
#pragma unroll
                for (int bj = 0; bj < 2; ++bj) { const int c = u.c0 + bj * 128 + wc * 32 + 8 * fq; const f32x4 y0 = (acc[ai][bj][m][0] * WUNSC + bv[bj][0]) * w, y1 = (acc[ai][bj][m][1] * WUNSC + bv[bj][1]) * w;
#if Y_FP8
                    u32x2 yw; yw.x = pk_fp8x4(y0.x * 16.0f, y0.y * 16.0f, y0.z * 16.0f, y0.w * 16.0f); yw.y = pk_fp8x4(y1.x * 16.0f, y1.y * 16.0f, y1.z * 16.0f, y1.w * 16.0f);
                    *(u32x2*)((unsigned char*)y + (size_t)(u.r0 + rl) * DM + c) = yw;
#else
                    st_bf16x8(y + (size_t)(u.r0 + rl) * DM + c, y0, y1);
#endif
                    } } }
    }
};

constexpr int RSC_OFF = RED2_OFF + 4096;
__device__ __forceinline__ void xattn_row_scales(LAS unsigned char* lds, const float* __restrict__ ssq, int r0) {
    const int t = threadIdx.x, row = t >> 1, hf = t & 1; float q = 0.f;
#pragma unroll
    for (int pp = 0; pp < 16; ++pp) q += ssq[(size_t)(16 * hf + pp) * NT + r0 + row];
    q += __shfl_xor(q, 1);
    if (hf == 0) ((LAS float*)(lds + RSC_OFF))[row] = (0.04419417382415922f * LOG2E) / sqrtf(q * (1.f / DM) + EPS);
    __syncthreads();
}
struct EpiSoftmax {
    static constexpr bool PERM = true;
    LAS unsigned char* lds; bf16* P;
    __device__ __forceinline__ void operator()(f32x4 (&acc)[2][2][4][2], const Unit& u, int wr, int wc, int fr, int fq) const {
        LAS float* red1 = (LAS float*)(lds + RED1_OFF); LAS float* red2 = (LAS float*)(lds + RED2_OFF);
        float rs[2][4];
#pragma unroll
        for (int ai = 0; ai < 2; ++ai)
#pragma unroll
            for (int m = 0; m < 4; ++m) rs[ai][m] = ((const LAS float*)(lds + RSC_OFF))[ai * 128 + wr * 64 + m * 16 + fr];
#pragma unroll
        for (int ai = 0; ai < 2; ++ai)
#pragma unroll
            for (int m = 0; m < 4; ++m) { const int rl = ai * 128 + wr * 64 + m * 16 + fr; float mx = -3.0e38f;
#pragma unroll
                for (int bj = 0; bj < 2; ++bj)
#pragma unroll
                    for (int n = 0; n < 2; ++n) { const f32x4 v = acc[ai][bj][m][n]; mx = fmaxf(fmaxf(mx, fmaxf(v.x, v.y)), fmaxf(v.z, v.w)); }
                mx = fmaxf(mx, __shfl_xor(mx, 16)); mx = fmaxf(mx, __shfl_xor(mx, 32));
                if (fq == 0) red1[rl * 4 + wc] = mx; }
        asm volatile("s_waitcnt lgkmcnt(0)" ::: "memory"); __builtin_amdgcn_s_barrier(); asm volatile("" ::: "memory");
#pragma unroll
        for (int ai = 0; ai < 2; ++ai)
#pragma unroll
            for (int m = 0; m < 4; ++m) { const int rl = ai * 128 + wr * 64 + m * 16 + fr; const f32x4 mv = *(const LAS f32x4*)(red1 + rl * 4);
                const float mx = fmaxf(fmaxf(mv.x, mv.y), fmaxf(mv.z, mv.w)); float sum = 0.f;
#pragma unroll
                for (int bj = 0; bj < 2; ++bj)
#pragma unroll
                    for (int n = 0; n < 2; ++n) { f32x4 v = acc[ai][bj][m][n];
#pragma unroll
                        for (int j = 0; j < 4; ++j) { v[j] = fexp2((v[j] - mx) * rs[ai][m]); sum += v[j]; }
                        acc[ai][bj][m][n] = v; }
                sum += __shfl_xor(sum, 16); sum += __shfl_xor(sum, 32);
                if (fq == 0) red2[rl * 4 + wc] = sum; }
        asm volatile("s_waitcnt lgkmcnt(0)" ::: "memory"); __builtin_amdgcn_s_barrier(); asm volatile("" ::: "memory");
#pragma unroll
        for (int ai = 0; ai < 2; ++ai)
#pragma unroll
            for (int m = 0; m < 4; ++m) { const int rl = ai * 128 + wr * 64 + m * 16 + fr; const f32x4 sv = *(const LAS f32x4*)(red2 + rl * 4);
                const float inv = 1.0f / ((sv.x + sv.y) + (sv.z + sv.w));
#pragma unroll
                for (int bj = 0; bj < 2; ++bj) st_bf16x8(P + (size_t)(u.r0 + rl) * 1024 + u.c0 + bj * 128 + wc * 32 + 8 * fq, acc[ai][bj][m][0] * inv, acc[ai][bj][m][1] * inv); }
        asm volatile("s_waitcnt lgkmcnt(0)" ::: "memory"); __builtin_amdgcn_s_barrier(); asm volatile("" ::: "memory");
    }
};
struct XpreOrder {
    const char* Kk; const char* Wcqn; const char* Wcot; const char* Vv; int c;
    __device__ bool next(int i, Unit& u) const { if (i > 0 || c >= 256) return false; u.rows = 256; u.e = 0;
        if (c < 128) { const int bh = c >> 3, nt = c & 7, b = bh >> 2, h = bh & 3;
            u.a = Kk + ((size_t)(b * MEMLEN) * DM + h * 512) * 2; u.b = Wcqn + ((size_t)(nt * 256) * DM + h * 512) * 2; u.r0 = bh * 256; u.c0 = nt * 256; u.e = 0; }
        else { const int q = c - 128, bh = q >> 3, nt = q & 7, b = bh >> 2, h = bh & 3;
            u.a = Wcot + ((size_t)(nt * 256) * DM + h * 512) * 2; u.b = Vv + ((size_t)(b * MEMLEN) * DM + h * 512) * 2; u.r0 = b * DM + nt * 256; u.c0 = h * 256; u.e = 1; }
        return true; }
    __device__ __forceinline__ void a_ready(const Unit&) const {}
};
struct EpiXpre {
    static constexpr bool PERM = true;
    bf16* MT; bf16* VWT;
    __device__ __forceinline__ void operator()(f32x4 (&acc)[2][2][4][2], const Unit& u, int wr, int wc, int fr, int fq) const {
        bf16* O = u.e ? VWT : MT; const int ld = u.e ? 1024 : DM;
        EPI_LOOP_P( st_bf16x8(O + (size_t)(u.r0 + rl) * ld + u.c0 + cl, v0, v1); )
    }
};
struct MixOrder {
    pg8::DenseOrder D; XpreOrder X; int c;
    __device__ bool next(int i, Unit& u) const { if (i > 1) return false; const bool first_dense = true;
        if ((i == 0) == first_dense) { const bool ok = D.next(0, u); u.e = 0; u.nt = 32; return ok; }
        const bool ok = X.next(0, u); u.e = u.e + 1; u.nt = 8; return ok; }
    __device__ __forceinline__ void a_ready(const Unit&) const {}
};
struct EpiMix {
    static constexpr bool PERM = true;
    EpiRes1 R; EpiXpre Xp;
    __device__ __forceinline__ void operator()(f32x4 (&acc)[2][2][4][2], const Unit& u, int wr, int wc, int fr, int fq) const {
        if (u.e == 0) R(acc, u, wr, wc, fr, fq); else { Unit v = u; v.e = u.e - 1; Xp(acc, v, wr, wc, fr, fq); }
    }
};
struct XsOrder {
    const char* X; const char* MT; int c;
    __device__ bool next(int i, Unit& u) const { if (i > 0 || c >= 128) return false; const int bh = c >> 3, qt = c & 7, b = bh >> 2, h = bh & 3;
        u.a = X + ((size_t)(b * SEQ + 256 * qt) * DM) * 2; u.b = MT + ((size_t)(bh * 256) * DM) * 2; u.r0 = b * SEQ + 256 * qt; u.c0 = h * 256; u.rows = 256; u.e = 0; return true; }
    __device__ __forceinline__ void a_ready(const Unit&) const {}
};
struct XoutOrder {
    const char* P; const char* VWT; int c;
    __device__ bool next(int i, Unit& u) const { if (i > 0 || c >= 256) return false; const int b = c >> 6, pm = (c >> 3) & 7, pn = c & 7;
        u.a = P + ((size_t)(b * SEQ + 256 * pm) * 1024) * 2; u.b = VWT + ((size_t)(b * DM + 256 * pn) * 1024) * 2; u.r0 = b * SEQ + 256 * pm; u.c0 = 256 * pn; u.rows = 256; u.e = 0; return true; }
    __device__ __forceinline__ void a_ready(const Unit&) const {}
};
struct KvOrder {
    const char* A; const char* Bt; int c;
    __device__ bool next(int i, Unit& u) const { if (i > 0 || c >= 64) return false; const int pm = c >> 4, pn = c & 15;
        u.a = A + (size_t)pm * 256 * KD * 2; u.b = Bt + (size_t)pn * 256 * KD * 2; u.r0 = pm * 256; u.c0 = pn * 256; u.rows = 256; u.e = 0; return true; }
    __device__ __forceinline__ void a_ready(const Unit&) const {}
};
struct MoeOrder {
    const LAS int* tab; const char* A; const char* Bt; int ntn, G, c; size_t bstride; int ocol; int pitchb;
    __device__ bool next(int i, Unit& u) const {
        const int idx = i * G + c; const int total = __builtin_amdgcn_readfirstlane(tab[32]);
        if (idx >= total) return false;
        int e = 0;
        for (int q = 1; q < 32; ++q) { const int p = __builtin_amdgcn_readfirstlane(tab[q]); if (idx >= p) e = q; }
        const int ue = __builtin_amdgcn_readfirstlane(tab[e]), st = __builtin_amdgcn_readfirstlane(tab[64 + e]), cn = __builtin_amdgcn_readfirstlane(tab[128 + e]);
        const int local = idx - ue, mt = local / ntn, nt = local - mt * ntn;
        u.a = A + (size_t)(st + 256 * mt) * pitchb; u.b = Bt + (size_t)e * bstride + (size_t)nt * 256 * pitchb;
        u.r0 = st + 256 * mt; u.c0 = nt * ocol; u.rows = (cn - 256 * mt) < 256 ? (cn - 256 * mt) : 256; u.e = e; return true;
    }
    const unsigned* ecnt; int* ready; int hi_ready;
    __device__ __forceinline__ void a_ready(const Unit& u) const {
        if (ecnt == nullptr || u.e <= *ready || u.e >= hi_ready) return;
        if (threadIdx.x < 64) { unsigned sp = 0;
            while ((unsigned)__builtin_amdgcn_readfirstlane(__hip_atomic_load(ecnt + 64 * u.e, __ATOMIC_RELAXED, __HIP_MEMORY_SCOPE_AGENT)) < (unsigned)CONV_WGS) { __builtin_amdgcn_s_sleep(4); if (++sp > (1u << 22)) break; }
            __builtin_amdgcn_fence(__ATOMIC_ACQUIRE, "agent");
            asm volatile("s_waitcnt vmcnt(0)" ::: "memory"); }
        asm volatile("" ::: "memory"); __builtin_amdgcn_s_barrier(); asm volatile("" ::: "memory");
        *ready = u.e;
    }
};
__device__ __forceinline__ void moe_table(const Frame& F, int ntn) {
    LAS int* tab = (LAS int*)(F.lds + TAB_OFF); const int* cs = (const int*)(F.ws + WS_CNT);
    if (F.tid < 32) { tab[64 + F.tid] = cs[32 + F.tid]; tab[128 + F.tid] = cs[F.tid]; }
    __syncthreads();
    if (F.tid == 0) { int p = 0; for (int e = 0; e < 32; ++e) { tab[e] = p; p += ((tab[128 + e] + 255) >> 8) * ntn; } tab[32] = p; }
    __syncthreads();
}

__device__ __forceinline__ void gla_low_job(const Frame& F) {
    const bf16* h1 = (const bf16*)(F.ws + WS_H1); const bf16* wl = (const bf16*)(F.ws + WS_WLOW); float* glow = (float*)(F.ws + WS_GLOW);
    LAS float* red = (LAS float*)F.lds;
    const int l = F.lane, r16 = l & 15, quad = l >> 4;
    for (int rb = F.bid; rb < NT / 32; rb += F.G) {
        f32x4 acc[2] = {{0.f, 0.f, 0.f, 0.f}, {0.f, 0.f, 0.f, 0.f}};
#pragma unroll
        for (int st = 0; st < 8; ++st) { const int k0 = 256 * F.wave + 32 * st + 8 * quad;
            const bf16x8 bfr = *(const bf16x8*)(wl + (size_t)r16 * KD + k0);
#pragma unroll
            for (int tb = 0; tb < 2; ++tb) { const bf16x8 afr = *(const bf16x8*)(h1 + (size_t)(rb * 32 + tb * 16 + r16) * KD + k0);
                acc[tb] = __builtin_amdgcn_mfma_f32_16x16x32_bf16(afr, bfr, acc[tb], 0, 0, 0); } }
#pragma unroll
        for (int tb = 0; tb < 2; ++tb)
#pragma unroll
            for (int j = 0; j < 4; ++j) red[(F.wave * 32 + tb * 16 + 4 * quad + j) * 16 + r16] = acc[tb][j];
        __syncthreads();
        { const int tok = F.tid >> 4, r = F.tid & 15; float s = 0.f;
#pragma unroll
          for (int w = 0; w < 8; ++w) s += red[(w * 32 + tok) * 16 + r];
          glow[(size_t)(rb * 32 + tok) * 16 + r] = s; }
        __syncthreads();
    }
}

__device__ __forceinline__ void sb_attn_wave(const Frame& F, const float* __restrict__ sb_g, int wu) {
    const bf16* Q = (const bf16*)(F.ws + WS_SBQ); const bf16* Kp = (const bf16*)(F.ws + WS_SBK); const bf16* VT = (const bf16*)(F.ws + WS_SBVT); bf16* O = (bf16*)(F.ws + WS_MIXO);
    const int l = F.lane, r = l & 31, hh = l >> 5;
    const int qb = 63 - (wu & 63), bh = wu >> 6, b = bh >> 3, h = bh & 7;
    const int t0 = qb * 32;
    bf16x8 qf[8];
#pragma unroll
    for (int st = 0; st < 8; ++st) qf[st] = *(const bf16x8*)(Q + (size_t)(b * SEQ + t0 + r) * 1024 + h * 128 + 16 * st + 8 * hh);
    f32x16 o[4];
#pragma unroll
    for (int d = 0; d < 4; ++d)
#pragma unroll
        for (int i = 0; i < 16; ++i) o[d][i] = 0.f;
    float R = 0.f;
    const float zs = 0.08838834764831845f * LOG2E;
    const int qpos = t0 + r;
    for (int kt = qb; kt >= 0; --kt) {
        f32x16 s;
#pragma unroll
        for (int i = 0; i < 16; ++i) s[i] = 0.f;
#pragma unroll
        for (int st = 0; st < 8; ++st) { const bf16x8 kf = *(const bf16x8*)(Kp + (size_t)(b * SEQ + kt * 32 + r) * 1024 + h * 128 + 16 * st + 8 * hh);
            s = __builtin_amdgcn_mfma_f32_32x32x16_bf16(kf, qf[st], s, 0, 0, 0); }
        float lm[16], lb[16];
#pragma unroll
        for (int i = 0; i < 16; ++i) { const int key = kt * 32 + (i & 3) + 8 * (i >> 2) + 4 * hh; const float z2 = s[i] * zs; const bool valid = key < qpos;
            const float sp = fmaxf(z2, 0.f) + flog2(1.f + fexp2(-fabsf(z2)));
            lm[i] = valid ? -sp : 0.f; lb[i] = z2 - sp; }
        float Gown[4], Gpar[4];
#pragma unroll
        for (int c = 0; c < 4; ++c) { Gown[c] = (lm[4 * c] + lm[4 * c + 1]) + (lm[4 * c + 2] + lm[4 * c + 3]); Gpar[c] = __shfl_xor(Gown[c], 32); }
        float sufT[4]; sufT[3] = 0.f;
#pragma unroll
        for (int c = 2; c >= 0; --c) sufT[c] = sufT[c + 1] + (Gown[c + 1] + Gpar[c + 1]);
        float p[16];
#pragma unroll
        for (int c = 0; c < 4; ++c) { float run = R + sufT[c] + (hh == 0 ? Gpar[c] : 0.f);
#pragma unroll
            for (int e = 3; e >= 0; --e) { const int i = 4 * c + e; const int key = kt * 32 + e + 8 * c + 4 * hh;
                p[i] = (key < qpos) ? fexp2(lb[i] + run) : 0.f; run += lm[i]; } }
        R += (Gown[0] + Gpar[0]) + (Gown[1] + Gpar[1]) + (Gown[2] + Gpar[2]) + (Gown[3] + Gpar[3]);
#pragma unroll
        for (int s2 = 0; s2 < 2; ++s2) {
            u32x4 pw; pw.x = cvt_pk_bf16(p[8 * s2 + 0], p[8 * s2 + 1]); pw.y = cvt_pk_bf16(p[8 * s2 + 2], p[8 * s2 + 3]); pw.z = cvt_pk_bf16(p[8 * s2 + 4], p[8 * s2 + 5]); pw.w = cvt_pk_bf16(p[8 * s2 + 6], p[8 * s2 + 7]);
            const bf16x8 pb = __builtin_bit_cast(bf16x8, pw);
#pragma unroll
            for (int d = 0; d < 4; ++d) { const bf16* vp = VT + ((size_t)(bh * 128 + d * 32 + r)) * SEQ + kt * 32 + 16 * s2 + 4 * hh;
                u32x4 vw; const u32x2 v0 = *(const u32x2*)vp, v1 = *(const u32x2*)(vp + 8); vw.x = v0.x; vw.y = v0.y; vw.z = v1.x; vw.w = v1.y;
                o[d] = __builtin_amdgcn_mfma_f32_32x32x16_bf16(__builtin_bit_cast(bf16x8, vw), pb, o[d], 0, 0, 0); } }
        if (__all(R < -40.f)) break;
    }
    float ss = 0.f;
#pragma unroll
    for (int d = 0; d < 4; ++d)
#pragma unroll
        for (int i = 0; i < 16; ++i) ss += o[d][i] * o[d][i];
    ss += __shfl_xor(ss, 32);
    const float rstd = 1.0f / sqrtf(ss * (1.f / 128.f) + EPS);
#pragma unroll
    for (int d = 0; d < 4; ++d)
#pragma unroll
        for (int c = 0; c < 4; ++c) { const int dim = 32 * d + 8 * c + 4 * hh; const f32x4 g = *(const f32x4*)(sb_g + h * 128 + dim);
            f32x4 v; v.x = o[d][4 * c] * rstd * g.x; v.y = o[d][4 * c + 1] * rstd * g.y; v.z = o[d][4 * c + 2] * rstd * g.z; v.w = o[d][4 * c + 3] * rstd * g.w;
            st_bf16x4(O + (size_t)(b * SEQ + qpos) * DM + h * 128 + dim, v); }
}

constexpr int G1_QIN = 0, G1_KIN = 64 * 136 * 2, G1_KDT = 2 * 64 * 136 * 2, G1_LOW = G1_KDT + 128 * 72 * 2, G1_SEG = G1_LOW + 64 * 16 * 4, G1_QRAW = G1_SEG + 4 * 128 * 4, G1_KRAW = G1_QRAW + 64 * 128 * 2, G1_END = G1_KRAW + 64 * 128 * 2;
constexpr int G1_KVT = G1_QRAW;
static_assert(G1_END <= RING_BYTES && G1_KVT + 65536 <= RING_BYTES && (G1_KVT & 15) == 0, "g1 lds");
__device__ __forceinline__ void gla_g1_unit(const Frame& F, const float* __restrict__ w2, const float* __restrict__ b2, int unit) {
    const int n = unit & 31, bh = unit >> 5, b = bh >> 2, h = bh & 3;
    const int t0 = b * SEQ + 64 * n;
    const bf16* GQ = (const bf16*)(F.ws + WS_GQ); const bf16* GK = (const bf16*)(F.ws + WS_GK); const bf16* GVT = (const bf16*)(F.ws + WS_GVT); const float* GLOW = (const float*)(F.ws + WS_GLOW);
    LAS bf16* qin = (LAS bf16*)(F.lds + G1_QIN); LAS bf16* kin = (LAS bf16*)(F.lds + G1_KIN); LAS bf16* kdt = (LAS bf16*)(F.lds + G1_KDT);
    LAS float* lowl = (LAS float*)(F.lds + G1_LOW); LAS float* seg = (LAS float*)(F.lds + G1_SEG);
    for (int i = F.tid; i < 64 * 16; i += NTHR) lowl[i] = GLOW[(size_t)t0 * 16 + i];
    LAS bf16* qraw = (LAS bf16*)(F.lds + G1_QRAW); LAS bf16* kraw = (LAS bf16*)(F.lds + G1_KRAW);
#pragma unroll
    for (int q2 = 0; q2 < 2; ++q2) { const int id = F.tid + 512 * q2, row = id >> 4, ch = id & 15;
        *(LAS u32x4*)(qraw + row * 128 + ch * 8) = *(const u32x4*)(GQ + (size_t)(t0 + row) * 512 + h * 128 + ch * 8);
        *(LAS u32x4*)(kraw + row * 128 + ch * 8) = *(const u32x4*)(GK + (size_t)(t0 + row) * 512 + h * 128 + ch * 8); }
    __syncthreads();
    const int d = F.tid & 127, sg = F.tid >> 7, dd = h * 128 + d;
    float wcol[16];
#pragma unroll
    for (int r = 0; r < 16; ++r) wcol[r] = w2[r * 512 + dd];
    const float bias = b2[dd];
    float pre[16]; float run = 0.f;
#pragma unroll
    for (int i = 0; i < 16; ++i) { const int c = 16 * sg + i; float z = bias;
#pragma unroll
        for (int r4 = 0; r4 < 4; ++r4) { const f32x4 lv = *(const LAS f32x4*)(lowl + c * 16 + 4 * r4); z += lv.x * wcol[4 * r4] + lv.y * wcol[4 * r4 + 1] + lv.z * wcol[4 * r4 + 2] + lv.w * wcol[4 * r4 + 3]; }
        run += log2_sigmoid2(z * LOG2E) * (1.0f / 16.0f);
        pre[i] = run; }
    seg[sg * 128 + d] = run;
    __syncthreads();
    float off = 0.f, tot = 0.f;
#pragma unroll
    for (int s = 0; s < 4; ++s) { const float v = seg[s * 128 + d]; tot += v; if (s < sg) off += v; }
    bf16* QIN = (bf16*)(F.ws + WS_QIN);
#pragma unroll
    for (int i = 0; i < 16; ++i) { const int c = 16 * sg + i; const float g = off + pre[i];
        const float qv = bf2f(qraw[c * 128 + d]), kv = bf2f(kraw[c * 128 + d]);
        const bf16 qi = f2bf(qv * 0.08838834764831845f * fexp2(g));
        qin[c * 136 + d] = qi;
        kin[c * 136 + d] = f2bf(kv * fexp2(-g));
        kdt[d * 72 + c] = f2bf(kv * fexp2(tot - g)); }
    if (sg == 0) ((float*)(F.ws + WS_DECAY))[(size_t)unit * 128 + d] = fexp2(tot);
    __syncthreads();
#pragma unroll
    for (int q2 = 0; q2 < 2; ++q2) { const int id = F.tid + 512 * q2, row = id >> 4, ch = id & 15;
        *(u32x4*)(QIN + (size_t)(t0 + row) * 512 + h * 128 + ch * 8) = *(const LAS u32x4*)(qin + row * 136 + ch * 8); }
    const int w = F.wave, l = F.lane, r = l & 31, hh = l >> 5, cb = w & 1, dvp = w >> 1;
    f32x16 X[2];
#pragma unroll
    for (int sb = 0; sb < 2; ++sb) {
#pragma unroll
        for (int i = 0; i < 16; ++i) X[sb][i] = 0.f;
#pragma unroll
        for (int st = 0; st < 8; ++st) { const bf16x8 af = *(const LAS bf16x8*)(kin + (32 * sb + r) * 136 + 16 * st + 8 * hh), bfq = *(const LAS bf16x8*)(qin + (32 * cb + r) * 136 + 16 * st + 8 * hh);
            X[sb] = __builtin_amdgcn_mfma_f32_32x32x16_bf16(af, bfq, X[sb], 0, 0, 0); }
#pragma unroll
        for (int i = 0; i < 16; ++i) { const int s = 32 * sb + (i & 3) + 8 * (i >> 2) + 4 * hh; if (32 * cb + r < s) X[sb][i] = 0.f; }
    }
    u32x4* OI = (u32x4*)(F.ws + WS_OINTRA) + ((size_t)unit * 8 + w) * 256;
#pragma unroll
    for (int dbi = 0; dbi < 2; ++dbi) { const int db = 2 * dvp + dbi; f32x16 oacc;
#pragma unroll
        for (int i = 0; i < 16; ++i) oacc[i] = 0.f;
#pragma unroll
        for (int sb = 0; sb < 2; ++sb)
#pragma unroll
            for (int s2 = 0; s2 < 2; ++s2) {
                u32x4 pw; pw.x = cvt_pk_bf16(X[sb][8 * s2 + 0], X[sb][8 * s2 + 1]); pw.y = cvt_pk_bf16(X[sb][8 * s2 + 2], X[sb][8 * s2 + 3]); pw.z = cvt_pk_bf16(X[sb][8 * s2 + 4], X[sb][8 * s2 + 5]); pw.w = cvt_pk_bf16(X[sb][8 * s2 + 6], X[sb][8 * s2 + 7]);
                const bf16* vp = GVT + ((size_t)(bh * 256 + db * 32 + r)) * SEQ + 64 * n + 32 * sb + 16 * s2 + 4 * hh;
                u32x4 vw; const u32x2 v0 = *(const u32x2*)vp, v1 = *(const u32x2*)(vp + 8); vw.x = v0.x; vw.y = v0.y; vw.z = v1.x; vw.w = v1.y;
                oacc = __builtin_amdgcn_mfma_f32_32x32x16_bf16(__builtin_bit_cast(bf16x8, vw), __builtin_bit_cast(bf16x8, pw), oacc, 0, 0, 0); }
#pragma unroll
        for (int q4 = 0; q4 < 2; ++q4) { u32x4 ow; ow.x = cvt_pk_bf16(oacc[8 * q4], oacc[8 * q4 + 1]); ow.y = cvt_pk_bf16(oacc[8 * q4 + 2], oacc[8 * q4 + 3]); ow.z = cvt_pk_bf16(oacc[8 * q4 + 4], oacc[8 * q4 + 5]); ow.w = cvt_pk_bf16(oacc[8 * q4 + 6], oacc[8 * q4 + 7]);
            OI[(dbi * 2 + q4) * 64 + l] = ow; } }
    bf16* KVN = (bf16*)(F.ws + WS_KVN) + (size_t)unit * 32768; LAS bf16* kvt = (LAS bf16*)(F.lds + G1_KVT);
    bf16x8 vf[4];
#pragma unroll
    for (int st = 0; st < 4; ++st) vf[st] = *(const bf16x8*)(GVT + ((size_t)(bh * 256 + w * 32 + r)) * SEQ + 64 * n + 16 * st + 8 * hh);
#pragma unroll
    for (int dkb = 0; dkb < 4; ++dkb) { f32x16 kacc;
#pragma unroll
        for (int i = 0; i < 16; ++i) kacc[i] = 0.f;
#pragma unroll
        for (int st = 0; st < 4; ++st) { const bf16x8 bk = *(const LAS bf16x8*)(kdt + (32 * dkb + r) * 72 + 16 * st + 8 * hh);
            kacc = __builtin_amdgcn_mfma_f32_32x32x16_bf16(vf[st], bk, kacc, 0, 0, 0); }
#pragma unroll
        for (int i = 0; i < 16; ++i) kvt[(32 * w + (i & 3) + 8 * (i >> 2) + 4 * hh) * 128 + 32 * dkb + r] = f2bf(kacc[i]); }
    LDS_WAIT();
#pragma unroll
    for (int q8 = 0; q8 < 8; ++q8) { const int row = 32 * w + 4 * q8 + (l >> 4), ch = l & 15;
        *(u32x4*)(KVN + (size_t)row * 128 + ch * 8) = *(const LAS u32x4*)(kvt + row * 128 + ch * 8); }
    __syncthreads();
}

__device__ __forceinline__ void gla_scan(const Frame& F) {
    const bf16* KVN = (const bf16*)(F.ws + WS_KVN); const float* DEC = (const float*)(F.ws + WS_DECAY); bf16* ST = (bf16*)(F.ws + WS_STATE);
    for (int g = F.bid * NTHR + F.tid; g < 16 * 8192; g += F.G * NTHR) {
        const int bh = g >> 13, e4 = (g & 8191) * 4, dk = e4 & 127;
        f32x4 S = {0.f, 0.f, 0.f, 0.f};
#pragma unroll 8
        for (int n = 0; n < 32; ++n) { const size_t u = (size_t)(bh * 32 + n);
            st_bf16x4(ST + u * 32768 + e4, S);
            const u32x2 kw = *(const u32x2*)(KVN + u * 32768 + e4); const f32x4 kv = {bflo(kw.x), bfhi(kw.x), bflo(kw.y), bfhi(kw.y)}, dc = *(const f32x4*)(DEC + u * 128 + dk);
            S = S * dc + kv; }
    }
}

__device__ __forceinline__ void gla_g3_unit(const Frame& F, const float* __restrict__ gn, int unit) {
    const int n = unit & 31, bh = unit >> 5, b = bh >> 2, h = bh & 3; const int t0 = b * SEQ + 64 * n;
    const int w = F.wave, l = F.lane, r = l & 31, hh = l >> 5, cb = w & 1, dvp = w >> 1;
    const bf16* QIN = (const bf16*)(F.ws + WS_QIN); const bf16* ST = (const bf16*)(F.ws + WS_STATE) + (size_t)unit * 32768; const bf16* GR = (const bf16*)(F.ws + WS_GR); bf16* O = (bf16*)(F.ws + WS_MIXO);
    const u32x4* OI = (const u32x4*)(F.ws + WS_OINTRA) + ((size_t)unit * 8 + w) * 256;
    LAS float* part = (LAS float*)F.lds;
    bf16x8 qf[8];
#pragma unroll
    for (int st = 0; st < 8; ++st) qf[st] = *(const bf16x8*)(QIN + (size_t)(t0 + 32 * cb + r) * 512 + h * 128 + 16 * st + 8 * hh);
    f32x16 o[2]; float ss = 0.f;
#pragma unroll
    for (int dbi = 0; dbi < 2; ++dbi) { const int db = 2 * dvp + dbi;
#pragma unroll
        for (int q4 = 0; q4 < 2; ++q4) { const u32x4 ow = OI[(dbi * 2 + q4) * 64 + l];
            o[dbi][8 * q4] = bflo(ow.x); o[dbi][8 * q4 + 1] = bfhi(ow.x); o[dbi][8 * q4 + 2] = bflo(ow.y); o[dbi][8 * q4 + 3] = bfhi(ow.y); o[dbi][8 * q4 + 4] = bflo(ow.z); o[dbi][8 * q4 + 5] = bfhi(ow.z); o[dbi][8 * q4 + 6] = bflo(ow.w); o[dbi][8 * q4 + 7] = bfhi(ow.w); }
#pragma unroll
        for (int st = 0; st < 8; ++st) { const bf16x8 sf = *(const bf16x8*)(ST + (size_t)(32 * db + r) * 128 + 16 * st + 8 * hh);
            o[dbi] = __builtin_amdgcn_mfma_f32_32x32x16_bf16(sf, qf[st], o[dbi], 0, 0, 0); }
#pragma unroll
        for (int i = 0; i < 16; ++i) ss += o[dbi][i] * o[dbi][i]; }
    ss += __shfl_xor(ss, 32);
    if (hh == 0) part[w * 32 + r] = ss;
    __syncthreads();
    float tot = 0.f;
#pragma unroll
    for (int q = 0; q < 4; ++q) tot += part[(2 * q + cb) * 32 + r];
    const float rstd = 1.0f / sqrtf(tot * (1.f / 256.f) + EPS);
    const int tok = t0 + 32 * cb + r;
#pragma unroll
    for (int dbi = 0; dbi < 2; ++dbi)
#pragma unroll
        for (int c = 0; c < 4; ++c) { const int dv = 32 * (2 * dvp + dbi) + 8 * c + 4 * hh; const f32x4 g = *(const f32x4*)(gn + h * 256 + dv);
            const u32x2 rw = *(const u32x2*)(GR + (size_t)tok * 1024 + h * 256 + dv);
            const float r0 = bflo(rw.x), r1 = bfhi(rw.x), r2 = bflo(rw.y), r3 = bfhi(rw.y);
            f32x4 v; v.x = o[dbi][4 * c] * rstd * g.x * (r0 * frcp(1.f + fexp2(-r0 * LOG2E))); v.y = o[dbi][4 * c + 1] * rstd * g.y * (r1 * frcp(1.f + fexp2(-r1 * LOG2E)));
            v.z = o[dbi][4 * c + 2] * rstd * g.z * (r2 * frcp(1.f + fexp2(-r2 * LOG2E))); v.w = o[dbi][4 * c + 3] * rstd * g.w * (r3 * frcp(1.f + fexp2(-r3 * LOG2E)));
            st_bf16x4(O + (size_t)tok * DM + 1024 + h * 256 + dv, v); }
    __syncthreads();
}
__device__ __forceinline__ void gla_g3_pair(const Frame& F, const float* __restrict__ gn, int uA, int uB) {
    const int w = F.wave, l = F.lane, r = l & 31, hh = l >> 5, w4 = w & 3, cb = w4 & 1, dvh = w4 >> 1;
    const int unit = (w < 4) ? uA : uB; const bool act = unit >= 0;
    const int uu = act ? unit : 0, n = uu & 31, bh = uu >> 5, b = bh >> 2, h = bh & 3; const int t0 = b * SEQ + 64 * n;
    const bf16* QIN = (const bf16*)(F.ws + WS_QIN); const bf16* ST = (const bf16*)(F.ws + WS_STATE) + (size_t)uu * 32768; const bf16* GR = (const bf16*)(F.ws + WS_GR); bf16* O = (bf16*)(F.ws + WS_MIXO);
    LAS float* part = (LAS float*)F.lds;
    f32x16 o[4]; float ss = 0.f;
    if (act) {
        bf16x8 qf[8];
#pragma unroll
        for (int st = 0; st < 8; ++st) qf[st] = *(const bf16x8*)(QIN + (size_t)(t0 + 32 * cb + r) * 512 + h * 128 + 16 * st + 8 * hh);
#pragma unroll
        for (int dbi = 0; dbi < 4; ++dbi) { const int db = 4 * dvh + dbi;
            const u32x4* OI = (const u32x4*)(F.ws + WS_OINTRA) + ((size_t)uu * 8 + (2 * (db >> 1) + cb)) * 256 + ((db & 1) * 2) * 64 + l;
#pragma unroll
            for (int q4 = 0; q4 < 2; ++q4) { const u32x4 ow = OI[q4 * 64];
                o[dbi][8 * q4] = bflo(ow.x); o[dbi][8 * q4 + 1] = bfhi(ow.x); o[dbi][8 * q4 + 2] = bflo(ow.y); o[dbi][8 * q4 + 3] = bfhi(ow.y); o[dbi][8 * q4 + 4] = bflo(ow.z); o[dbi][8 * q4 + 5] = bfhi(ow.z); o[dbi][8 * q4 + 6] = bflo(ow.w); o[dbi][8 * q4 + 7] = bfhi(ow.w); }
#pragma unroll
            for (int st = 0; st < 8; ++st) { const bf16x8 sf = *(const bf16x8*)(ST + (size_t)(32 * db + r) * 128 + 16 * st + 8 * hh);
                o[dbi] = __builtin_amdgcn_mfma_f32_32x32x16_bf16(sf, qf[st], o[dbi], 0, 0, 0); }
#pragma unroll
            for (int i = 0; i < 16; ++i) ss += o[dbi][i] * o[dbi][i]; }
        ss += __shfl_xor(ss, 32);
        if (hh == 0) part[w * 32 + r] = ss;
    }
    __syncthreads();
    if (act) {
        const float tot = part[((w & 4) + cb) * 32 + r] + part[((w & 4) + cb + 2) * 32 + r];
        const float rstd = 1.0f / sqrtf(tot * (1.f / 256.f) + EPS);
        const int tok = t0 + 32 * cb + r;
#pragma unroll
        for (int dbi = 0; dbi < 4; ++dbi)
#pragma unroll
            for (int c = 0; c < 4; ++c) { const int dv = 32 * (4 * dvh + dbi) + 8 * c + 4 * hh; const f32x4 g = *(const f32x4*)(gn + h * 256 + dv);
                const u32x2 rw = *(const u32x2*)(GR + (size_t)tok * 1024 + h * 256 + dv);
                const float r0 = bflo(rw.x), r1 = bfhi(rw.x), r2 = bflo(rw.y), r3 = bfhi(rw.y);
                f32x4 v; v.x = o[dbi][4 * c] * rstd * g.x * (r0 * frcp(1.f + fexp2(-r0 * LOG2E))); v.y = o[dbi][4 * c + 1] * rstd * g.y * (r1 * frcp(1.f + fexp2(-r1 * LOG2E)));
                v.z = o[dbi][4 * c + 2] * rstd * g.z * (r2 * frcp(1.f + fexp2(-r2 * LOG2E))); v.w = o[dbi][4 * c + 3] * rstd * g.w * (r3 * frcp(1.f + fexp2(-r3 * LOG2E)));
                st_bf16x4(O + (size_t)tok * DM + 1024 + h * 256 + dv, v); }
    }
    __syncthreads();
}

__device__ __forceinline__ void router_phase(const Frame& F, const float* __restrict__ b_router) {
    const float* X2 = (const float*)(F.ws + WS_X2); const bf16* WH = (const bf16*)(F.ws + WS_WRH); const bf16* WL = (const bf16*)(F.ws + WS_WRL);
    int* TOPE = (int*)(F.ws + WS_TOPE); float* TOPW = (float*)(F.ws + WS_TOPW); float* RSTD = (float*)(F.ws + WS_RSTD3); int* HIST = (int*)(F.ws + WS_HIST);
    LAS float* part = (LAS float*)F.lds;
    LAS float* sq = (LAS float*)(F.lds + 32768);
    LAS int* hist = (LAS int*)(F.lds + 33792);
    const int w = F.wave, l = F.lane, r16 = l & 15, quad = l >> 4;
    for (int rb = F.bid; rb < NT / 32; rb += F.G) {
        if (F.tid < 32) hist[F.tid] = 0;
        f32x4 acc[2][2] = {{{0.f, 0.f, 0.f, 0.f}, {0.f, 0.f, 0.f, 0.f}}, {{0.f, 0.f, 0.f, 0.f}, {0.f, 0.f, 0.f, 0.f}}}; float ssq[2] = {0.f, 0.f};
#pragma unroll 4
        for (int st = 0; st < 8; ++st) { const int k0 = 256 * w + 32 * st + 8 * quad;
            bf16x8 bh[2], bl[2];
#pragma unroll
            for (int eb = 0; eb < 2; ++eb) { bh[eb] = *(const bf16x8*)(WH + (size_t)(16 * eb + r16) * KD + k0); bl[eb] = *(const bf16x8*)(WL + (size_t)(16 * eb + r16) * KD + k0); }
#pragma unroll
            for (int tg = 0; tg < 2; ++tg) { const int row = rb * 32 + 16 * tg + r16;
                const f32x4 xa = *(const f32x4*)(X2 + (size_t)row * DM + k0), xb = *(const f32x4*)(X2 + (size_t)row * DM + k0 + 4);
                ssq[tg] += (xa.x * xa.x + xa.y * xa.y) + (xa.z * xa.z + xa.w * xa.w) + (xb.x * xb.x + xb.y * xb.y) + (xb.z * xb.z + xb.w * xb.w);
                u32x4 hw; hw.x = cvt_pk_bf16(xa.x, xa.y); hw.y = cvt_pk_bf16(xa.z, xa.w); hw.z = cvt_pk_bf16(xb.x, xb.y); hw.w = cvt_pk_bf16(xb.z, xb.w);
                u32x4 lw; lw.x = cvt_pk_bf16(xa.x - bflo(hw.x), xa.y - bfhi(hw.x)); lw.y = cvt_pk_bf16(xa.z - bflo(hw.y), xa.w - bfhi(hw.y));
                lw.z = cvt_pk_bf16(xb.x - bflo(hw.z), xb.y - bfhi(hw.z)); lw.w = cvt_pk_bf16(xb.z - bflo(hw.w), xb.w - bfhi(hw.w));
                const bf16x8 ah = __builtin_bit_cast(bf16x8, hw), alo = __builtin_bit_cast(bf16x8, lw);
#pragma unroll
                for (int eb = 0; eb < 2; ++eb) {
                    acc[tg][eb] = __builtin_amdgcn_mfma_f32_16x16x32_bf16(ah, bh[eb], acc[tg][eb], 0, 0, 0);
                    acc[tg][eb] = __builtin_amdgcn_mfma_f32_16x16x32_bf16(ah, bl[eb], acc[tg][eb], 0, 0, 0);
                    acc[tg][eb] = __builtin_amdgcn_mfma_f32_16x16x32_bf16(alo, bh[eb], acc[tg][eb], 0, 0, 0); } } }
#pragma unroll
        for (int tg = 0; tg < 2; ++tg) { float q = ssq[tg]; q += __shfl_xor(q, 16); q += __shfl_xor(q, 32);
            if (quad == 0) sq[w * 32 + 16 * tg + r16] = q;
#pragma unroll
            for (int eb = 0; eb < 2; ++eb)
#pragma unroll
                for (int j = 0; j < 4; ++j) part[(w * 32 + 16 * tg + 4 * quad + j) * 32 + 16 * eb + r16] = acc[tg][eb][j]; }
        __syncthreads();
        for (int q2 = 0; q2 < 2; ++q2) { const int hf = l >> 5, e = l & 31; const int ti = 4 * w + 2 * q2 + hf; const int tok = rb * 32 + ti;
            LAS float* lg = (LAS float*)(F.lds + 36864) + (w * 2 + hf) * 32; LAS float* tvr = (LAS float*)(F.lds + 40960) + (w * 2 + hf) * 4;
            float s2 = 0.f, a = 0.f;
#pragma unroll
            for (int k = 0; k < 8; ++k) { s2 += sq[k * 32 + ti]; a += part[(k * 32 + ti) * 32 + e]; }
            const float rstd = 1.0f / sqrtf(s2 * (1.f / DM) + EPS);
            float v = a * rstd + b_router[e]; v = (v == v) ? v : -3.0e38f;
            lg[e] = v;
            LDS_WAIT();
            int rank = 0;
#pragma unroll
            for (int j4 = 0; j4 < 8; ++j4) { const f32x4 o = *(const LAS f32x4*)(lg + 4 * j4);
                rank += (o.x > v || (o.x == v && 4 * j4 + 0 < e)) ? 1 : 0; rank += (o.y > v || (o.y == v && 4 * j4 + 1 < e)) ? 1 : 0;
                rank += (o.z > v || (o.z == v && 4 * j4 + 2 < e)) ? 1 : 0; rank += (o.w > v || (o.w == v && 4 * j4 + 3 < e)) ? 1 : 0; }
            if (rank < 4) tvr[rank] = v;
            LDS_WAIT();
            const f32x4 t = *(const LAS f32x4*)tvr;
            const float e1 = fexp2((t.y - t.x) * LOG2E), e2 = fexp2((t.z - t.x) * LOG2E), e3 = fexp2((t.w - t.x) * LOG2E); const float inv = 1.0f / (1.0f + e1 + e2 + e3);
            if (rank < 4) { TOPE[tok * 4 + rank] = e; TOPW[tok * 4 + rank] = fexp2((v - t.x) * LOG2E) * inv; atomicAdd((int*)&hist[e], 1); }
            if (e == 0) RSTD[tok] = rstd;
            LDS_WAIT(); }
        __syncthreads();
        if (F.tid < 32) HIST[rb * 32 + F.tid] = hist[F.tid];
        __syncthreads();
    }
}

__device__ __forceinline__ void slots_phase(const Frame& F, const float* __restrict__ g_moe) {
    const float* X2 = (const float*)(F.ws + WS_X2); const int* TOPE = (const int*)(F.ws + WS_TOPE); const float* TOPW = (const float*)(F.ws + WS_TOPW); const float* RSTD = (const float*)(F.ws + WS_RSTD3);
    const int* HIST = (const int*)(F.ws + WS_HIST); float* SLOTW = (float*)(F.ws + WS_SLOTW); int* TOKSLOT = (int*)(F.ws + WS_TOKSLOT); int* CNT = (int*)(F.ws + WS_CNT); bf16* XS = (bf16*)(F.ws + WS_XS);
    LAS int* ptot = (LAS int*)F.lds;
    LAS int* pbel = ptot + 512;
    LAS int* base = pbel + 512;
    LAS int* asg = base + 32;
    LAS int* aslot = asg + 128;
    for (int rb = F.bid; rb < NT / 32; rb += F.G) {
        { const int e = F.tid & 31, p = F.tid >> 5; int t = 0, bl = 0;
          for (int q = 0; q < 16; ++q) { const int bb = 16 * p + q; const int hv = HIST[bb * 32 + e]; t += hv; if (bb < rb) bl += hv; }
          ptot[p * 32 + e] = t; pbel[p * 32 + e] = bl; }
        if (F.tid < 128) asg[F.tid] = TOPE[rb * 128 + F.tid];
        __syncthreads();
        if (F.tid < 32) { int t = 0, bl = 0; for (int p = 0; p < 16; ++p) { t += ptot[p * 32 + F.tid]; bl += pbel[p * 32 + F.tid]; }
            ptot[F.tid] = t; pbel[F.tid] = bl; }
        __syncthreads();
        if (F.tid < 32) { int st = 0; for (int e = 0; e < F.tid; ++e) st += ptot[e]; base[F.tid] = st + pbel[F.tid];
            if (rb == 0) { CNT[F.tid] = ptot[F.tid]; CNT[32 + F.tid] = st; }
            int run = base[F.tid]; for (int i = 0; i < 128; ++i) if (asg[i] == F.tid) { aslot[i] = run; ++run; } }
        __syncthreads();
        if (F.tid < 128) { const int sl = aslot[F.tid]; TOKSLOT[rb * 128 + F.tid] = sl; SLOTW[sl] = TOPW[rb * 128 + F.tid]; }
        for (int q = 0; q < 4; ++q) { const int ti = 4 * F.wave + q, tok = rb * 32 + ti; const float rstd = RSTD[tok];
            const f32x4* xr = (const f32x4*)(X2 + (size_t)tok * DM) + F.lane; const f32x4* gr = (const f32x4*)g_moe + F.lane;
#if MOE_FP8
            unsigned hw[8];
#pragma unroll
            for (int j = 0; j < 8; ++j) { const f32x4 v = xr[64 * j], g = gr[64 * j]; hw[j] = pk_fp8x4(v.x * rstd * g.x, v.y * rstd * g.y, v.z * rstd * g.z, v.w * rstd * g.w); }
            LAS unsigned* rowb = (LAS unsigned*)(F.lds + 16384 + F.wave * 2048);
#pragma unroll
            for (int j = 0; j < 8; ++j) rowb[64 * j + F.lane] = hw[j];
            LDS_WAIT();
            const u32x4 w0 = *(const LAS u32x4*)(rowb + 4 * F.lane), w1 = *(const LAS u32x4*)(rowb + 256 + 4 * F.lane);
#pragma unroll
            for (int k = 0; k < 4; ++k) { const int sl = aslot[ti * 4 + k]; u32x4* o16 = (u32x4*)((unsigned char*)XS + (size_t)sl * DM) + F.lane;
                o16[0] = w0; o16[64] = w1; }
            LDS_WAIT();
#else
            u32x2 hw[8];
#pragma unroll
            for (int j = 0; j < 8; ++j) { const f32x4 v = xr[64 * j], g = gr[64 * j]; hw[j].x = cvt_pk_bf16(v.x * rstd * g.x, v.y * rstd * g.y); hw[j].y = cvt_pk_bf16(v.z * rstd * g.z, v.w * rstd * g.w); }
#pragma unroll
            for (int k = 0; k < 4; ++k) { const int sl = aslot[ti * 4 + k]; u32x2* o8 = (u32x2*)(XS + (size_t)sl * DM) + F.lane;
#pragma unroll
                for (int j = 0; j < 8; ++j) o8[64 * j] = hw[j]; }
#endif
            }
        __syncthreads();
    }
}

__device__ __forceinline__ void final_phase(const Frame& F, const float* __restrict__ g_fin, float* __restrict__ out) {
    const float* X2 = (const float*)(F.ws + WS_X2); const bf16* Y = (const bf16*)(F.ws + WS_Y); const int* TOKSLOT = (const int*)(F.ws + WS_TOKSLOT);
    const int gw = F.bid * NWAVES + F.wave, NGW = F.G * NWAVES;
    for (int tok = gw; tok < NT; tok += NGW) {
        const f32x4* xr = (const f32x4*)(X2 + (size_t)tok * DM) + F.lane;
        f32x4 v[8];
#pragma unroll
        for (int j = 0; j < 8; ++j) v[j] = xr[64 * j];
#pragma unroll
#if Y_FP8
        for (int k = 0; k < 4; ++k) { const int sl = TOKSLOT[tok * 4 + k]; const unsigned* yr = (const unsigned*)((const unsigned char*)Y + (size_t)sl * DM) + F.lane;
#pragma unroll
            for (int j = 0; j < 8; ++j) { const int yw = (int)yr[64 * j]; const f32x2 lo = __builtin_amdgcn_cvt_pk_f32_fp8(yw, false), hi = __builtin_amdgcn_cvt_pk_f32_fp8(yw, true);
                v[j].x += lo.x * 0.0625f; v[j].y += lo.y * 0.0625f; v[j].z += hi.x * 0.0625f; v[j].w += hi.y * 0.0625f; } }
#else
        for (int k = 0; k < 4; ++k) { const int sl = TOKSLOT[tok * 4 + k]; const u32x2* yr = (const u32x2*)(Y + (size_t)sl * DM) + F.lane;
#pragma unroll
            for (int j = 0; j < 8; ++j) { const u32x2 yw = yr[64 * j]; v[j].x += bflo(yw.x); v[j].y += bfhi(yw.x); v[j].z += bflo(yw.y); v[j].w += bfhi(yw.y); } }
#endif
        float s = 0.f;
#pragma unroll
        for (int j = 0; j < 8; ++j) s += (v[j].x * v[j].x + v[j].y * v[j].y) + (v[j].z * v[j].z + v[j].w * v[j].w);
        const float rstd = 1.0f / sqrtf(wave_sum(s) * (1.f / DM) + EPS);
        f32x4* orow = (f32x4*)(out + (size_t)tok * DM) + F.lane; const f32x4* gr = (const f32x4*)g_fin + F.lane;
#pragma unroll
        for (int j = 0; j < 8; ++j) orow[64 * j] = v[j] * rstd * gr[64 * j];
    }
}

constexpr int N_PHASES = 14;
__global__ void __launch_bounds__(NTHR, 2) fwd_kernel(Args args) {
    extern __shared__ __attribute__((aligned(16))) unsigned char lds[];
    Frame F;
    F.lds = (LAS unsigned char*)lds;
    F.tid = threadIdx.x; F.lane = F.tid & 63; F.wave = __builtin_amdgcn_readfirstlane(F.tid >> 6);
    F.G = gridDim.x; F.bid = blockIdx.x; F.ws = args.ws;
    for (int u = F.tid; u < (LDS_BYTES - LDSCTL_OFF) / 4; u += NTHR) ((LAS unsigned*)(F.lds + LDSCTL_OFF))[u] = 0u;
    __syncthreads();
    unsigned* ctl = (unsigned*)(args.ws + WS_CTL);
    XcdBarrier bar; bar.bar = ctl + CW_BAR; bar.x = 0; bar.st = nullptr;
    const bool fused = (args.ph_hi - args.ph_lo) > 1;
    if (fused) bar = xcd_barrier_post(ctl + CW_BAR, (volatile LAS unsigned*)(F.lds + MISC_OFF));
    const int lo = args.ph_lo, hi = args.ph_hi;
    const bool conv_on = fused && CONV_WGS > 0 && F.G == 256;
    const bool conv_wg = conv_on && F.bid >= NCOMP;
    Frame FC = F; if (conv_on) FC.G = NCOMP;
#define IN(k) (lo <= (k) && (k) < hi)
#define REP(k) _Pragma("unroll") for (int _r = 0; _r < 1 + ((DUP_MASK >> (k)) & 1); ++_r)
#define SEAM(k) do { if (IN(k) && IN((k) + 1)) xcd_barrier(bar); } while (0)

    if (IN(0)) REP(0) { p0_prologue(F, args);
        if (!conv_on) { LAS unsigned* scr = (LAS unsigned*)(F.lds + F.wave * 16384);
            for (int it = F.bid * NWAVES + F.wave; it < MOE_ITEMS; it += F.G * NWAVES) if (!CONV_WGS || !((it >= (32 - E_P0) * 1024 && it < 32768) || it >= 32768 + (32 - D_P0) * 512)) moe_item_fp8<false>(F, args, it, scr); }
    } SEAM(0);

    if (IN(1)) REP(1) {
        if (conv_wg) {
            { KvOrder S{(const char*)(F.ws + WS_MEMN), (const char*)(F.ws + WS_WCKV), F.bid - NCOMP}; EpiKV E{F.ws}; pg8::gemm_phase<4096, 32, false>(F.lds, S, E); }
            LAS unsigned* scr = (LAS unsigned*)(F.lds + F.wave * 16384); const int w2 = (F.bid - NCOMP) * NWAVES + F.wave;
            moe_items_stream<false, true>(F, args, w2, CONV_WGS * NWAVES, CONV_NA / (CONV_WGS * NWAVES), scr); }
        else {
        pg8::DenseOrder S; S.init(F.ws + WS_H1, F.ws + WS_WIN, NT, NPROJ, FC.G, F.bid);
        EpiInProj E{F.ws};
        pg8::gemm_phase<4096, 32, false>(F.lds, S, E);
        gla_low_job(FC);
        }
    } SEAM(1);

    if (IN(2)) REP(2) {
        {
        const bool kv_here = !(conv_on && CONV_WGS == 64);
        if (kv_here && F.bid < 64) { KvOrder S{(const char*)(F.ws + WS_MEMN), (const char*)(F.ws + WS_WCKV), F.bid}; EpiKV E{F.ws}; pg8::gemm_phase<4096, 32, false>(F.lds, S, E); }
        REP(14) { if (kv_here && F.G > 64) { if (F.bid >= 64) for (int u = F.bid - 64; u < 512; u += F.G - 64) gla_g1_unit(F, args.in[4], args.in[5], u); }
        else { for (int u = F.bid; u < 512; u += F.G) gla_g1_unit(F, args.in[4], args.in[5], u); } }
        REP(15) { for (int wu = F.bid * NWAVES + F.wave; wu < 2048; wu += F.G * NWAVES) sb_attn_wave(F, args.in[6], wu); }
        }
    } SEAM(2);

    if (IN(3)) REP(3) { gla_scan(F); } SEAM(3);

    if (IN(4)) REP(4) { for (int u = F.bid; u < 512; u += 2 * F.G) gla_g3_pair(F, args.in[7], u, (u + F.G < 512) ? u + F.G : -1); } SEAM(4);

    if (IN(5)) REP(5) {
        if (F.G == 256) {
            MixOrder S; S.D.init(F.ws + WS_MIXO, F.ws + WS_WOUT, NT, DM, F.G, F.bid); S.X = XpreOrder{(const char*)(F.ws + WS_KVK), (const char*)(F.ws + WS_WCQ), (const char*)(F.ws + WS_WCO), (const char*)(F.ws + WS_KVVT), F.bid}; S.c = F.bid;
            EpiMix E{EpiRes1{args.in[0], (float*)(F.ws + WS_X1), (bf16*)(F.ws + WS_X1B), (float*)(F.ws + WS_SSQ)}, EpiXpre{(bf16*)(F.ws + WS_MT), (bf16*)(F.ws + WS_VWT)}};
            pg8::gemm_phase<4096, 0, false>(F.lds, S, E);
        } else {
            { pg8::DenseOrder S; S.init(F.ws + WS_MIXO, F.ws + WS_WOUT, NT, DM, F.G, F.bid); EpiRes1 E{args.in[0], (float*)(F.ws + WS_X1), (bf16*)(F.ws + WS_X1B), (float*)(F.ws + WS_SSQ)}; pg8::gemm_phase<4096, 32, false>(F.lds, S, E); }
            for (int c = F.bid; c < 256; c += F.G) { XpreOrder S{(const char*)(F.ws + WS_KVK), (const char*)(F.ws + WS_WCQ), (const char*)(F.ws + WS_WCO), (const char*)(F.ws + WS_KVVT), c}; EpiXpre E{(bf16*)(F.ws + WS_MT), (bf16*)(F.ws + WS_VWT)}; pg8::gemm_phase<4096, 8, false>(F.lds, S, E); }
        }
    } SEAM(5);

    if (IN(7)) REP(7) {
        if (F.bid < 128) { const int bh = F.bid >> 3, qt = F.bid & 7; xattn_row_scales(F.lds, (const float*)(F.ws + WS_SSQ), (bh >> 2) * SEQ + 256 * qt); }
        { XsOrder S{(const char*)(F.ws + WS_X1B), (const char*)(F.ws + WS_MT), F.bid}; EpiSoftmax E{F.lds, (bf16*)(F.ws + WS_P)};
          pg8::gemm_phase<4096, 32, false>(F.lds, S, E); }
        if (conv_on && F.bid >= 128) {
            LAS unsigned* scr = (LAS unsigned*)(F.lds + F.wave * 16384); const int w2 = (F.bid - 128) * NWAVES + F.wave;
            moe_items_stream<false, true>(F, args, CONV_NA + w2, 1024, CONV_NB / 1024, scr); }
    } SEAM(7);

    if (IN(8)) REP(8) {
        XoutOrder S{(const char*)(F.ws + WS_P), (const char*)(F.ws + WS_VWT), F.bid};
        EpiRes2 E{(const float*)(F.ws + WS_X1), (float*)(F.ws + WS_X2)};
        pg8::gemm_phase<2048, 16, false>(F.lds, S, E);
    } SEAM(8);

    if (IN(9)) REP(9) { router_phase(F, args.in[16]); } SEAM(9);

    if (IN(10)) REP(10) { slots_phase(F, args.in[14]); } SEAM(10);

    if (IN(11)) REP(11) {
        moe_table(F, 16);
        constexpr int PB = MOE_FP8 ? 2048 : 4096;
        if (conv_wg) { for (int seq = E_PRE; seq < 32 - E_P0; ++seq) conv_step(F, args, seq); for (int seq = 32; seq < 32 + DN_IN_P11; ++seq) conv_step(F, args, seq); }
        else {
        int ready = conv_on ? E_PRE - 1 : 31;
        MoeOrder S{(const LAS int*)(F.lds + TAB_OFF), (const char*)(F.ws + WS_XS), (const char*)(F.ws + WS_WGU), 16, FC.G, F.bid, (size_t)2 * DFF * PB, 128, PB, conv_on ? (const unsigned*)(F.ws + WS_CTL) + CW_EXP : nullptr, &ready, 32 - E_P0};
        EpiAct E{args.in[18], (bf16*)(F.ws + WS_ACT)};
        pg8::gemm_phase<PB, MOE_FP8 ? 16 : 32, MOE_FP8 != 0>(F.lds, S, E);
        }
    } SEAM(11);

    if (IN(12)) REP(12) {
        moe_table(F, 8);
        constexpr int PB = MOE_FP8 ? 2048 : 4096;
        if (conv_wg) { for (int seq = 32 + DN_IN_P11; seq < 64 - D_P0; ++seq) conv_step(F, args, seq); }
        else {
        int ready = conv_on ? DN_IN_P11 - 1 : 31;
        MoeOrder S{(const LAS int*)(F.lds + TAB_OFF), (const char*)(F.ws + WS_ACT), (const char*)(F.ws + WS_WD), 8, FC.G, F.bid, (size_t)DM * PB, 256, PB, conv_on ? (const unsigned*)(F.ws + WS_CTL) + CW_EXP + 64 * 32 : nullptr, &ready, 32 - D_P0};
        EpiY E{args.in[20], (const float*)(F.ws + WS_SLOTW), (bf16*)(F.ws + WS_Y)};
        pg8::gemm_phase<PB, MOE_FP8 ? 16 : 32, MOE_FP8 != 0>(F.lds, S, E);
        }
    } SEAM(12);

#ifdef EXTRA_BARS
    if (fused) { for (int i = 0; i < EXTRA_BARS; ++i) xcd_barrier(bar); }
#endif
    if (IN(13)) REP(13) { final_phase(F, args.in[21], args.out); }
#undef IN
#undef SEAM
}

extern "C" void kernel_launch(void* const* d_in, const int* in_sizes, int n_in, void* d_out, int out_size, void* d_ws, size_t ws_size, hipStream_t stream) {
    static int grid = 0;
    if (grid == 0) {
        if (n_in != 22 || out_size != NT * DM || ws_size < WS_END) { fprintf(stderr, "kernel_launch: unexpected problem (n_in %d out %d ws %zu need %zu)\n", n_in, out_size, ws_size, (size_t)WS_END); grid = -1; return; }
        int dev = 0, cus = 0, per_cu = 0;
        if (hipGetDevice(&dev) != hipSuccess || hipDeviceGetAttribute(&cus, hipDeviceAttributeMultiprocessorCount, dev) != hipSuccess) { grid = -1; return; }
        if (hipFuncSetAttribute((const void*)fwd_kernel, hipFuncAttributeMaxDynamicSharedMemorySize, LDS_BYTES) != hipSuccess) { fprintf(stderr, "kernel_launch: hipFuncSetAttribute failed\n"); grid = -1; return; }
        if (hipOccupancyMaxActiveBlocksPerMultiprocessor(&per_cu, (const void*)fwd_kernel, NTHR, LDS_BYTES) != hipSuccess || per_cu < 1) fprintf(stderr, "kernel_launch: occupancy query reports %d\n", per_cu);
        (void)hipGetLastError();
        grid = cus;
    }
    if (grid < 0) return;
    (void)hipMemsetAsync((char*)d_ws + WS_CTL, 0, CTL_ZERO_BYTES, stream);
    Args a{};
    for (int i = 0; i < 22; ++i) a.in[i] = (const float*)d_in[i];
    a.out = (float*)d_out; a.ws = (unsigned char*)d_ws;
#if MK_N_LAUNCHES == 1
    a.ph_lo = 0; a.ph_hi = N_PHASES;
    hipLaunchKernelGGL(fwd_kernel, dim3(grid), dim3(NTHR), LDS_BYTES, stream, a);
#else
    for (int p = 0; p < N_PHASES; ++p) { a.ph_lo = p; a.ph_hi = p + 1; hipLaunchKernelGGL(fwd_kernel, dim3(grid), dim3(NTHR), LDS_BYTES, stream, a); }
#endif
}
```

```cpp
#include <hip/hip_runtime.h>
#include <cstdio>
#include <cstdint>

#ifndef MK_N_LAUNCHES
#define MK_N_LAUNCHES 1
#endif
#ifndef MOE_FP8
#define MOE_FP8 1
#endif
#ifndef CONV_LD_AUX
#define CONV_LD_AUX 18
#endif
#ifndef Y_FP8
#define Y_FP8 1
#endif
#ifndef MX_UNSCALED
#define MX_UNSCALED 1
#endif
#ifndef WCVT_SCALE
#define WCVT_SCALE 0.015625f
#endif
#ifndef DUP_MASK
#define DUP_MASK 0
#endif

#define GAS __attribute__((address_space(1)))
#define LAS __attribute__((address_space(3)))
typedef unsigned short bf16;
typedef short bf16x8 __attribute__((ext_vector_type(8)));
typedef float f32x2 __attribute__((ext_vector_type(2)));
typedef float f32x4 __attribute__((ext_vector_type(4)));
typedef float f32x16 __attribute__((ext_vector_type(16)));
typedef unsigned u32x2 __attribute__((ext_vector_type(2)));
typedef unsigned u32x4 __attribute__((ext_vector_type(4)));
typedef GAS unsigned gu32;

#define LDS_WAIT() asm volatile("s_waitcnt lgkmcnt(0)" ::: "memory")
#define VM_WAIT() asm volatile("s_waitcnt vmcnt(0)" ::: "memory")

constexpr int DM = 2048, NB = 4, SEQ = 2048, NT = NB * SEQ;
constexpr int INC = 6160, NPROJ = 6144;
constexpr int MEMLEN = 256, NMEM = NB * MEMLEN;
constexpr int NEXP = 32, TOPK = 4, NASSIGN = NT * TOPK, DFF = 2048;
constexpr float EPS = 1e-6f;
constexpr float LOG2E = 1.4426950408889634f, LN2 = 0.6931471805599453f;
constexpr int KD = 2048;

typedef __bf16 bf16x2_t __attribute__((ext_vector_type(2)));
__device__ __forceinline__ unsigned cvt_pk_bf16(float lo, float hi) { const f32x2 v = {lo, hi}; const bf16x2_t b = __builtin_convertvector(v, bf16x2_t); return __builtin_bit_cast(unsigned, b); }
__device__ __forceinline__ bf16 f2bf(float f) { return (bf16)(cvt_pk_bf16(f, 0.f) & 0xffffu); }
__device__ __forceinline__ float bf2f(unsigned b) { return __uint_as_float(b << 16); }
__device__ __forceinline__ float bflo(unsigned w) { return __uint_as_float(w << 16); }
__device__ __forceinline__ float bfhi(unsigned w) { return __uint_as_float(w & 0xffff0000u); }
__device__ __forceinline__ void st_bf16x4(bf16* p, f32x4 v) { u32x2 w; w.x = cvt_pk_bf16(v.x, v.y); w.y = cvt_pk_bf16(v.z, v.w); *(u32x2*)p = w; }
__device__ __forceinline__ float wave_sum(float v) {
#pragma unroll
    for (int o = 1; o < 64; o <<= 1) v += __shfl_xor(v, o);
    return v;
}
__device__ __forceinline__ float fexp2(float x) { return __builtin_amdgcn_exp2f(x); }
__device__ __forceinline__ float flog2(float x) { return __builtin_amdgcn_logf(x); }
__device__ __forceinline__ float frcp(float x) { return __builtin_amdgcn_rcpf(x); }
__device__ __forceinline__ float log2_sigmoid2(float z2) { return -(fmaxf(-z2, 0.f) + flog2(1.f + fexp2(-fabsf(z2)))); }

namespace pg8 {
constexpr int BM = 256, BK = 64, HALF = 128, HTB = HALF * BK * 2, STAGE_BYTES = 8 * HTB, NXCD = 8, WGM = 8;
__host__ __device__ __forceinline__ int lds_byte(int r, int c) { const int st = (r >> 4) * 2 + (c >> 5), rr = r & 15, cc = c & 31, ob = rr * 64 + cc * 2; return st * 1024 + (ob ^ (((ob >> 9) & 1) << 5)); }
__host__ __device__ __forceinline__ void stage_rc(int b, int& R, int& C) { const int st = b / 1024, sb = b % 1024, swz = sb ^ (((sb >> 9) & 1) << 5); R = (st >> 1) * 16 + swz / 64; C = (st & 1) * 32 + (swz % 64) / 2; }

typedef int v8i __attribute__((ext_vector_type(8)));
typedef int v4i __attribute__((ext_vector_type(4)));
__device__ __forceinline__ v8i cat8(bf16x8 lo, bf16x8 hi) { const v4i a = __builtin_bit_cast(v4i, lo), b = __builtin_bit_cast(v4i, hi); return (v8i){a.x, a.y, a.z, a.w, b.x, b.y, b.z, b.w}; }
__host__ __device__ __forceinline__ int perm32(int rho) { const int n = rho >> 4, i = rho & 15; return 8 * (i >> 2) + 4 * n + (i & 3); }
struct Unit { const char* a; const char* b; int r0, c0, rows, e, nt; };

struct DenseOrder {
    const char* A; const char* Bt; int nM, nN, nwg, G, c;
    __device__ void init(const void* A_, const void* Bt_, int M, int N, int G_, int c_) { A = (const char*)A_; Bt = (const char*)Bt_; nM = M / BM; nN = N / BM; nwg = nM * nN; G = G_; c = c_; }
    __device__ bool next(int i, Unit& u) const {
        const long L = (long)i * G + c; if (L >= nwg) return false;
        int wgid = (int)L; { const int q = nwg / NXCD, r = nwg % NXCD, xcd = wgid % NXCD, off = wgid / NXCD; wgid = (xcd < r ? xcd * (q + 1) : r * (q + 1) + (xcd - r) * q) + off; }
        const int nig = WGM * nN, gid = wgid / nig, fm = gid * WGM, gsz = (nM - fm) < WGM ? (nM - fm) : WGM;
        const int pm = fm + ((wgid % nig) % gsz), pn = (wgid % nig) / gsz;
        u.a = A + (size_t)pm * BM * KD * 2; u.b = Bt + (size_t)pn * BM * KD * 2; u.r0 = pm * BM; u.c0 = pn * BM; u.rows = BM; u.e = 0; return true;
    }
    __device__ __forceinline__ void a_ready(const Unit&) const {}
};

template <int PITCHB, int NTILES, bool FP8, class Epi, class Sched>
__device__ __forceinline__ void gemm_phase(LAS unsigned char* lds, const Sched& S, const Epi& E) {
    const int tid = threadIdx.x, wid = __builtin_amdgcn_readfirstlane(tid >> 6), lane = tid & 63, wr = wid >> 2, wc = wid & 3, fr = lane & 15, fq = lane >> 4;
    unsigned voffA[2], voffB[2];
#pragma unroll
    for (int i = 0; i < 2; ++i) { int R, C; stage_rc(tid * 16 + i * 8192, R, C); const int Rb = Epi::PERM ? ((R & ~31) + perm32(R & 31)) : R;
        voffA[i] = (unsigned)(R * PITCHB + C * 2); voffB[i] = (unsigned)(Rb * PITCHB + C * 2); }
    const size_t kstep = (size_t)(BK * 2);
    const size_t hstep = (size_t)HALF * PITCHB;
    const unsigned ldsw = (unsigned)wid * 1024u;
    const int aoff = lds_byte(wr * 64 + fr, fq * 8), boff = lds_byte(wc * 32 + fr, fq * 8);
#define PG8_SA(b, h) (((b) * 2 + (h)) * HTB)
#define PG8_SB(b, h) ((4 + (b) * 2 + (h)) * HTB)
#define PG8_STAGE_X(bufoff, gbase, voff) do { _Pragma("unroll") for (int _i = 0; _i < 2; ++_i) \
        __builtin_amdgcn_global_load_lds((const unsigned*)((const char*)(gbase) + (voff)[_i]), (LAS unsigned*)(lds + (bufoff) + ldsw + _i * 8192), 16, 0, 0); } while (0)
#define PG8_STAGE_A(bufoff, gbase) PG8_STAGE_X(bufoff, gbase, voffA)
#define PG8_STAGE_B(bufoff, gbase) PG8_STAGE_X(bufoff, gbase, voffB)
#define PG8_LDA(dst, b, h) do { _Pragma("unroll") for (int m = 0; m < 4; ++m) { if constexpr (FP8) { const v4i _lo = *(const LAS v4i*)(lds + PG8_SA(b, h) + aoff + m * 2048), _hi = *(const LAS v4i*)(lds + PG8_SA(b, h) + aoff + m * 2048 + 1024); \
            dst##8[m] = (v8i){_lo.x, _lo.y, _lo.z, _lo.w, _hi.x, _hi.y, _hi.z, _hi.w}; } \
        else { _Pragma("unroll") for (int k = 0; k < 2; ++k) dst[m][k] = *(const LAS bf16x8*)(lds + PG8_SA(b, h) + aoff + m * 2048 + k * 1024); } } } while (0)
#define PG8_LDB(dst, b, h) do { _Pragma("unroll") for (int n = 0; n < 2; ++n) { if constexpr (FP8) { const v4i _lo = *(const LAS v4i*)(lds + PG8_SB(b, h) + boff + n * 2048), _hi = *(const LAS v4i*)(lds + PG8_SB(b, h) + boff + n * 2048 + 1024); \
            dst##8[n] = (v8i){_lo.x, _lo.y, _lo.z, _lo.w, _hi.x, _hi.y, _hi.z, _hi.w}; } \
        else { _Pragma("unroll") for (int k = 0; k < 2; ++k) dst[n][k] = *(const LAS bf16x8*)(lds + PG8_SB(b, h) + boff + n * 2048 + k * 1024); } } } while (0)
#define PG8_MMA(ai, bj, At, Bt) do { __builtin_amdgcn_s_setprio(1); _Pragma("unroll") for (int m = 0; m < 4; ++m) _Pragma("unroll") for (int n = 0; n < 2; ++n) { \
        if constexpr (FP8) { if constexpr (MX_UNSCALED != 0) asm volatile("v_mfma_f32_16x16x128_f8f6f4 %0, %1, %2, %0" : "+v"(acc[ai][bj][m][n]) : "v"(Bt##8[n]), "v"(At##8[m])); \
            else asm volatile("v_mfma_scale_f32_16x16x128_f8f6f4 %0, %1, %2, %0, %3, %4 op_sel_hi:[0,0,0]" : "+v"(acc[ai][bj][m][n]) : "v"(Bt##8[n]), "v"(At##8[m]), "v"(sclW), "v"(sclA)); } \
        else { _Pragma("unroll") for (int k = 0; k < 2; ++k) acc[ai][bj][m][n] = __builtin_amdgcn_mfma_f32_16x16x32_bf16(Bt[n][k], At[m][k], acc[ai][bj][m][n], 0, 0, 0); } } \
        __builtin_amdgcn_s_setprio(0); } while (0)
#define PG8_WAIT_V(n) asm volatile("s_waitcnt vmcnt(" #n ")" ::: "memory")
#define PG8_WAIT_L(n) asm volatile("s_waitcnt lgkmcnt(" #n ")" ::: "memory")
#define PG8_BAR __builtin_amdgcn_s_barrier()
#define PG8_SCHED __builtin_amdgcn_sched_barrier(0)
    Unit cur, nxt; int ui = 0;
    if (!S.next(0, cur)) return;
    f32x4 acc[2][2][4][2];
#pragma unroll
    for (int a = 0; a < 2; ++a)
#pragma unroll
        for (int b = 0; b < 2; ++b)
#pragma unroll
            for (int m = 0; m < 4; ++m)
#pragma unroll
                for (int n = 0; n < 2; ++n) acc[a][b][m][n] = (f32x4){0.f, 0.f, 0.f, 0.f};
    const int sclW = 0x79797979, sclA = 0x7f7f7f7f;
    bf16x8 At[4][2], B0[2][2], B1[2][2]; v8i At8[4], B08[2], B18[2];
    const char* cA = cur.a; const char* cB = cur.b;
    S.a_ready(cur);
    PG8_STAGE_B(PG8_SB(0, 0), cB); PG8_STAGE_B(PG8_SB(0, 1), cB + hstep); PG8_STAGE_A(PG8_SA(0, 0), cA); PG8_STAGE_A(PG8_SA(0, 1), cA + hstep);
    if (wr == 1) PG8_BAR;
    PG8_WAIT_V(2); PG8_BAR;
    PG8_STAGE_B(PG8_SB(1, 0), cB + kstep); PG8_STAGE_A(PG8_SA(1, 0), cA + kstep); PG8_STAGE_B(PG8_SB(1, 1), cB + hstep + kstep);
    PG8_WAIT_V(6); PG8_BAR;
    for (;;) {
        const bool has_next = S.next(ui + 1, nxt);
        const char* nA = has_next ? nxt.a : cA; const char* nB = has_next ? nxt.b : cB;
        const int nt = NTILES > 0 ? NTILES : cur.nt;
#pragma nounroll
        for (int t = 0; t < nt; t += 2) {
            const bool last = (t == nt - 2);
            const char* a1 = cA + (size_t)(t + 1) * kstep;
            const char* a2 = last ? nA : cA + (size_t)(t + 2) * kstep; const char* b2 = last ? nB : cB + (size_t)(t + 2) * kstep;
            const char* a3 = a2 + kstep; const char* b3 = b2 + kstep;
            if (last && has_next) S.a_ready(nxt);
            PG8_LDB(B0, 0, 0); PG8_LDB(B1, 0, 1); PG8_SCHED; PG8_LDA(At, 0, 0); PG8_STAGE_A(PG8_SA(1, 1), a1 + hstep);
            PG8_WAIT_V(8); PG8_WAIT_L(0); PG8_BAR; PG8_MMA(0, 0, At, B0); PG8_MMA(0, 1, At, B1); PG8_BAR; PG8_SCHED;
            PG8_LDA(At, 0, 1); PG8_STAGE_B(PG8_SB(0, 0), b2); PG8_STAGE_B(PG8_SB(0, 1), b2 + hstep); PG8_STAGE_A(PG8_SA(0, 0), a2);
            PG8_WAIT_V(8); PG8_WAIT_L(0); PG8_BAR; PG8_MMA(1, 0, At, B0); PG8_MMA(1, 1, At, B1); PG8_BAR; PG8_SCHED;
            PG8_LDB(B0, 1, 0); PG8_LDB(B1, 1, 1); PG8_SCHED; PG8_LDA(At, 1, 0); PG8_STAGE_A(PG8_SA(0, 1), a2 + hstep);
            PG8_WAIT_V(8); PG8_WAIT_L(0); PG8_BAR; PG8_MMA(0, 0, At, B0); PG8_MMA(0, 1, At, B1); PG8_BAR; PG8_SCHED;
            PG8_LDA(At, 1, 1); PG8_STAGE_B(PG8_SB(1, 0), b3); PG8_STAGE_B(PG8_SB(1, 1), b3 + hstep); PG8_STAGE_A(PG8_SA(1, 0), a3);
            PG8_WAIT_V(8); PG8_WAIT_L(0); PG8_BAR; PG8_MMA(1, 0, At, B0); PG8_MMA(1, 1, At, B1); PG8_BAR; PG8_SCHED;
        }
        if constexpr (FP8) {
            asm volatile("s_nop 15\n\ts_nop 15" : "+v"(acc[0][0][0][0]), "+v"(acc[0][0][0][1]), "+v"(acc[0][0][1][0]), "+v"(acc[0][0][1][1]), "+v"(acc[0][0][2][0]), "+v"(acc[0][0][2][1]), "+v"(acc[0][0][3][0]), "+v"(acc[0][0][3][1]) :: "memory");
            asm volatile("" : "+v"(acc[0][1][0][0]), "+v"(acc[0][1][0][1]), "+v"(acc[0][1][1][0]), "+v"(acc[0][1][1][1]), "+v"(acc[0][1][2][0]), "+v"(acc[0][1][2][1]), "+v"(acc[0][1][3][0]), "+v"(acc[0][1][3][1]));
            asm volatile("" : "+v"(acc[1][0][0][0]), "+v"(acc[1][0][0][1]), "+v"(acc[1][0][1][0]), "+v"(acc[1][0][1][1]), "+v"(acc[1][0][2][0]), "+v"(acc[1][0][2][1]), "+v"(acc[1][0][3][0]), "+v"(acc[1][0][3][1]));
            asm volatile("" : "+v"(acc[1][1][0][0]), "+v"(acc[1][1][0][1]), "+v"(acc[1][1][1][0]), "+v"(acc[1][1][1][1]), "+v"(acc[1][1][2][0]), "+v"(acc[1][1][2][1]), "+v"(acc[1][1][3][0]), "+v"(acc[1][1][3][1]));
        }
        if (wr == 0) PG8_BAR;
        E(acc, cur, wr, wc, fr, fq);
        if (!has_next) break;
#pragma unroll
        for (int a = 0; a < 2; ++a)
#pragma unroll
            for (int b = 0; b < 2; ++b)
#pragma unroll
                for (int m = 0; m < 4; ++m)
#pragma unroll
                    for (int n = 0; n < 2; ++n) acc[a][b][m][n] = (f32x4){0.f, 0.f, 0.f, 0.f};
        cur = nxt; cA = nA; cB = nB; ++ui;
        if (wr == 1) PG8_BAR;
    }
    PG8_WAIT_V(0);
    PG8_BAR;
#undef PG8_SA
#undef PG8_SB
#undef PG8_STAGE_X
#undef PG8_STAGE_A
#undef PG8_STAGE_B
#undef PG8_LDA
#undef PG8_LDB
#undef PG8_MMA
#undef PG8_WAIT_V
#undef PG8_WAIT_L
#undef PG8_BAR
#undef PG8_SCHED
}
}
using pg8::Unit;

#define XB_TMO      128
#define XB_XCNT(j)  (256  + 64 * (j))
#define XB_XSUB(j)  (1280 + 64 * (j))
#define XB_XGEN(j)  (2304 + 64 * (j))
#define XB_TOP      3328
#define XB_TOPGEN   3392
#define XCD_BAR_WORDS 3456
#define XB_SPIN_CAP (1u << 22)
__device__ __forceinline__ unsigned xb_ld(unsigned* p)              { return __hip_atomic_load(p, __ATOMIC_RELAXED, __HIP_MEMORY_SCOPE_AGENT); }
__device__ __forceinline__ unsigned xb_add(unsigned* p, unsigned v) { return __hip_atomic_fetch_add(p, v, __ATOMIC_RELAXED, __HIP_MEMORY_SCOPE_AGENT); }
__device__ __forceinline__ unsigned xb_xcc_id() { return (unsigned)__builtin_amdgcn_s_getreg((3 << 11) | 20) & 0xFu; }
#define XB_SPIN(cond, bar) do { unsigned _sp = 0; while (cond) { __builtin_amdgcn_s_sleep(1); \
    if ((++_sp & 255u) == 0u) { if (xb_ld(&(bar)[XB_TMO])) break; if (_sp > XB_SPIN_CAP) { atomicAdd(&(bar)[XB_TMO], 1u); break; } } } } while (0)
struct XcdBarrier { unsigned* bar; unsigned x; volatile LAS unsigned* st; };
__device__ __forceinline__ XcdBarrier xcd_barrier_post(unsigned* bar, volatile LAS unsigned* st) {
    XcdBarrier b; b.bar = bar; b.x = xb_xcc_id(); b.st = st;
    if (threadIdx.x == 0) (void)xb_add(&bar[XB_XCNT(b.x)], 1u);
    return b;
}
__device__ __forceinline__ void xcd_barrier_complete(unsigned* bar, unsigned x, unsigned& nloc, unsigned& nx) {
    const unsigned G = gridDim.x * gridDim.y * gridDim.z;
    unsigned sum, cnt, mine, sp = 0u;
    for (;;) {
        sum = 0u; cnt = 0u; mine = 0u;
#pragma unroll
        for (unsigned j = 0; j < 16; ++j) { const unsigned c = xb_ld(&bar[XB_XCNT(j)]); sum += c; cnt += (c > 0u) ? 1u : 0u; mine = (j == x) ? c : mine; }
        if (sum == G) break;
        __builtin_amdgcn_s_sleep(1);
        if ((++sp & 255u) == 0u) { if (xb_ld(&bar[XB_TMO])) break; if (sp > XB_SPIN_CAP) { atomicAdd(&bar[XB_TMO], 1u); break; } }
    }
    nloc = mine > 0u ? mine : 1u; nx = cnt > 0u ? cnt : 1u;
}
__device__ __forceinline__ void xcd_barrier(const XcdBarrier& b) {
    asm volatile("s_waitcnt vmcnt(0)" ::: "memory");
    __syncthreads();
    if (threadIdx.x == 0) {
        unsigned* bar = b.bar;
        __builtin_amdgcn_s_waitcnt(0);
        unsigned nloc = b.st[0], nx = b.st[1];
        if (nloc == 0u) { xcd_barrier_complete(bar, b.x, nloc, nx); b.st[0] = nloc; b.st[1] = nx; }
        const unsigned old = xb_add(&bar[XB_XSUB(b.x)], 1u);
        const unsigned gen = old / nloc;
        if (old + 1u == (gen + 1u) * nloc) {
            __builtin_amdgcn_fence(__ATOMIC_RELEASE, "agent");
            asm volatile("s_waitcnt vmcnt(0)" ::: "memory");
            const unsigned og = xb_add(&bar[XB_TOP], 1u);
            const unsigned tg = og / nx;
            if (og + 1u == (tg + 1u) * nx) xb_add(&bar[XB_TOPGEN], 1u);
            else XB_SPIN(xb_ld(&bar[XB_TOPGEN]) == tg, bar);
            __builtin_amdgcn_fence(__ATOMIC_ACQUIRE, "agent");
            xb_add(&bar[XB_XGEN(b.x)], 1u);
            asm volatile("s_waitcnt vmcnt(0)" ::: "memory");
        } else {
            XB_SPIN(xb_ld(&bar[XB_XGEN(b.x)]) == gen, bar);
            __builtin_amdgcn_fence(__ATOMIC_ACQUIRE, "agent");
            asm volatile("s_waitcnt vmcnt(0)" ::: "memory");
        }
    }
    __syncthreads();
}

constexpr size_t MiB = 1u << 20;
constexpr size_t al(size_t x) { return (x + 255) & ~(size_t)255; }
constexpr size_t WS_CTL = 0, CTL_ZERO_BYTES = 1 * MiB;
constexpr size_t WS_WIN = 1 * MiB;
constexpr size_t WS_WLOW = WS_WIN + (size_t)NPROJ * KD * 2;
constexpr size_t WS_WRH = WS_WLOW + 16 * KD * 2;
constexpr size_t WS_WRL = WS_WRH + 32 * KD * 2;
constexpr size_t WS_WOUT = WS_WRL + 32 * KD * 2;
constexpr size_t WS_WCQ = WS_WOUT + (size_t)DM * KD * 2;
constexpr size_t WS_WCKV = WS_WCQ + (size_t)DM * KD * 2;
constexpr size_t WS_WCO = WS_WCKV + (size_t)2 * DM * KD * 2;
constexpr size_t WS_WGU = WS_WCO + (size_t)DM * KD * 2;
constexpr size_t WS_WD = WS_WGU + (size_t)NEXP * 2 * DFF * KD * 2;
constexpr size_t WS_H1 = WS_WD + (size_t)NEXP * DM * KD * 2;
constexpr size_t WS_MEMN = WS_H1 + (size_t)NT * DM * 2;
constexpr size_t WS_SBQ = WS_MEMN + (size_t)NMEM * DM * 2;
constexpr size_t WS_SBK = WS_SBQ + (size_t)NT * 1024 * 2;
constexpr size_t WS_SBVT = WS_SBK + (size_t)NT * 1024 * 2;
constexpr size_t WS_GQ = WS_SBVT + (size_t)NT * 1024 * 2;
constexpr size_t WS_GK = WS_GQ + (size_t)NT * 512 * 2;
constexpr size_t WS_GVT = WS_GK + (size_t)NT * 512 * 2;
constexpr size_t WS_GR = WS_GVT + (size_t)NT * 1024 * 2;
constexpr size_t WS_GLOW = WS_GR + (size_t)NT * 1024 * 2;
constexpr size_t WS_KVK = WS_GLOW + (size_t)NT * 16 * 4;
constexpr size_t WS_KVVT = WS_KVK + (size_t)NMEM * DM * 2;
constexpr size_t WS_QIN = WS_KVVT + (size_t)NMEM * DM * 2;
constexpr size_t WS_OINTRA = WS_QIN + (size_t)NT * 512 * 2;
constexpr size_t WS_KVN = WS_OINTRA + (size_t)512 * 16384 * 4;
constexpr size_t WS_DECAY = WS_KVN + (size_t)512 * 32768 * 4;
constexpr size_t WS_STATE = WS_DECAY + (size_t)512 * 128 * 4;
constexpr size_t WS_MIXO = WS_STATE + (size_t)512 * 32768 * 2;
constexpr size_t WS_X1 = WS_MIXO + (size_t)NT * DM * 2;
constexpr size_t WS_X1B = WS_X1 + (size_t)NT * DM * 4;
constexpr size_t WS_SSQ = WS_X1B + (size_t)NT * DM * 2;
constexpr size_t WS_CQ = WS_SSQ + (size_t)32 * NT * 4;
constexpr size_t WS_ATTO = WS_CQ + (size_t)NT * DM * 2;
constexpr size_t WS_X2 = WS_ATTO + (size_t)NT * DM * 2;
constexpr size_t WS_TOPE = WS_X2 + (size_t)NT * DM * 4;
constexpr size_t WS_TOPW = WS_TOPE + (size_t)NT * 4 * 4;
constexpr size_t WS_RSTD3 = WS_TOPW + (size_t)NT * 4 * 4;
constexpr size_t WS_HIST = WS_RSTD3 + (size_t)NT * 4;
constexpr size_t WS_SLOTW = WS_HIST + (size_t)256 * 32 * 4;
constexpr size_t WS_TOKSLOT = WS_SLOTW + (size_t)(NASSIGN + 256) * 4;
constexpr size_t WS_CNT = WS_TOKSLOT + (size_t)NT * 4 * 4;
constexpr size_t WS_XS = al(WS_CNT + 256);
constexpr size_t WS_ACT = WS_XS + (size_t)(NASSIGN + 256) * DM * 2;
constexpr size_t WS_Y = WS_ACT + (size_t)(NASSIGN + 256) * DM * 2;
constexpr size_t WS_P = WS_Y + (size_t)(NASSIGN + 256) * DM * 2;
constexpr size_t WS_MT = WS_P + (size_t)16 * SEQ * MEMLEN * 2;
constexpr size_t WS_VWT = WS_MT + (size_t)16 * MEMLEN * DM * 2;
constexpr size_t WS_END = WS_VWT + (size_t)NB * DM * 1024 * 2;

constexpr int CW_BAR = 4096;
static_assert((CW_BAR + XCD_BAR_WORDS) * 4 <= (int)CTL_ZERO_BYTES, "ctl");

constexpr int RING_BYTES = 131072, LDSCTL_OFF = RING_BYTES, MISC_OFF = LDSCTL_OFF + 64, TAB_OFF = LDSCTL_OFF + 256;
constexpr int RED1_OFF = LDSCTL_OFF + 2048, RED2_OFF = RED1_OFF + 4096;
constexpr int LDS_BYTES = 147456;

constexpr int NWAVES = 8, NTHR = 512;

struct Args { const float* in[22]; float* out; unsigned char* ws; int ph_lo, ph_hi; };

struct Frame {
    LAS unsigned char* lds;
    int tid, lane, wave, G, bid;
    unsigned char* ws;
};

__device__ __forceinline__ void cvt_tile(const float* __restrict__ W, int ldn, int k0, int n0, bf16* __restrict__ dst, int dst_row0, const float* __restrict__ gk, LAS unsigned* scr, int lane) {
    const int q = lane >> 4, c4 = lane & 15;
    f32x4 v[16];
#pragma unroll
    for (int i = 0; i < 16; ++i) { const int k = k0 + 8 * (i >> 1) + 2 * q + (i & 1); v[i] = *(const f32x4*)(W + (size_t)k * ldn + n0 + 4 * c4); if (gk) v[i] = v[i] * gk[k]; }
#pragma unroll
    for (int p = 0; p < 8; ++p)
#pragma unroll
        for (int j = 0; j < 4; ++j) { const int n = 4 * c4 + j, kd = 4 * p + q; scr[n * 32 + (kd ^ ((c4 & 7) << 2))] = cvt_pk_bf16(v[2 * p][j], v[2 * p + 1][j]); }
    LDS_WAIT();
#pragma unroll
    for (int jj = 0; jj < 8; ++jj) { const int n = 8 * jj + (lane >> 3), ch = lane & 7; const u32x4 w = *(const LAS u32x4*)(scr + n * 32 + ((ch ^ ((n >> 2) & 7)) << 2));
        *(u32x4*)(dst + (size_t)(dst_row0 + n) * KD + k0 + 8 * ch) = w; }
    LDS_WAIT();
}
__device__ __forceinline__ unsigned pk_fp8x4(float a, float b, float c, float d) { int r = __builtin_amdgcn_cvt_pk_fp8_f32(a, b, 0, false); r = __builtin_amdgcn_cvt_pk_fp8_f32(c, d, r, true); return (unsigned)r; }
__device__ __forceinline__ void rms_row_bf16(const float* __restrict__ xrow, const float* __restrict__ g, bf16* __restrict__ orow, int lane) {
    const f32x4* xr = (const f32x4*)xrow + lane; const f32x4* gr = (const f32x4*)g + lane;
    f32x4 v[8]; float s = 0.f;
#pragma unroll
    for (int j = 0; j < 8; ++j) { v[j] = xr[64 * j]; s += (v[j].x * v[j].x + v[j].y * v[j].y) + (v[j].z * v[j].z + v[j].w * v[j].w); }
    const float rstd = 1.0f / sqrtf(wave_sum(s) * (1.f / DM) + EPS);
    u32x2* o8 = (u32x2*)orow + lane;
#pragma unroll
    for (int j = 0; j < 8; ++j) { const f32x4 gg = gr[64 * j]; u32x2 w; w.x = cvt_pk_bf16(v[j].x * rstd * gg.x, v[j].y * rstd * gg.y); w.y = cvt_pk_bf16(v[j].z * rstd * gg.z, v[j].w * rstd * gg.w); o8[64 * j] = w; }
}

constexpr int MOE_ITEMS = NEXP * 64 * 16 + NEXP * 32 * 16;
#ifndef CONV_WGS
#define CONV_WGS 64
#endif
#ifndef E_P1
#define E_P1 9
#endif
constexpr int E_P7 = 7, E_PRE = E_P1 + E_P7;
#ifndef DN_IN_P11
#define DN_IN_P11 16
#endif
#ifndef E_P0
#define E_P0 0
#endif
#ifndef D_P0
#define D_P0 0
#endif
constexpr int NCOMP = 256 - CONV_WGS, CONV_NA = E_P1 * 1024, CONV_NB = E_P7 * 1024;
constexpr int CW_EXP = 8192;
static_assert(E_PRE + E_P0 <= 32 && DN_IN_P11 + D_P0 <= 32, "expert conversion ranges");
struct MoeItem { const float* W; int ldn, k0, n0; unsigned char* dst; int drow; };
__device__ __forceinline__ MoeItem moe_item_desc(const Frame& F, const Args& A, int it) {
    constexpr int J5 = NEXP * 64 * 16; MoeItem m;
    if (it < J5) { const int e = it >> 10, r = it & 1023, kt = r >> 6, n0 = (r & 63) * 64;
        m.W = A.in[17] + (size_t)e * DM * 2 * DFF; m.ldn = 2 * DFF; m.k0 = kt * 128; m.n0 = n0; m.dst = F.ws + WS_WGU + (size_t)e * 2 * DFF * KD;
        m.drow = (n0 < DFF) ? ((n0 >> 7) * 256 + (n0 & 127)) : (((n0 - DFF) >> 7) * 256 + 128 + ((n0 - DFF) & 127)); }
    else { const int q2 = it - J5, e = q2 >> 9, r = q2 & 511, kt = r >> 5, n0 = (r & 31) * 64;
        m.W = A.in[19] + (size_t)e * DFF * DM; m.ldn = DM; m.k0 = kt * 128; m.n0 = n0; m.dst = F.ws + WS_WD + (size_t)e * DM * KD; m.drow = n0; }
    return m;
}
template <bool SLD> __device__ __forceinline__ void moe_ld_half(f32x4 (&v)[16], const MoeItem& m, int half, int lane) {
    const int q = lane >> 4, c4 = lane & 15;
    if constexpr (SLD) { const __amdgpu_buffer_rsrc_t rw = __builtin_amdgcn_make_buffer_rsrc((void*)m.W, 0, 0x7fffffff, 0x00020000);
        const int vo = ((m.k0 + 64 * half + 4 * q) * m.ldn + m.n0 + 4 * c4) * 4;
#pragma unroll
        for (int i = 0; i < 16; ++i) v[i] = __builtin_bit_cast(f32x4, __builtin_amdgcn_raw_buffer_load_b128(rw, vo, (16 * (i >> 2) + (i & 3)) * m.ldn * 4, CONV_LD_AUX)); }
    else {
#pragma unroll
        for (int i = 0; i < 16; ++i) { const int k = m.k0 + 64 * half + 16 * (i >> 2) + 4 * q + (i & 3); v[i] = __builtin_nontemporal_load((const f32x4*)(m.W + (size_t)k * m.ldn + m.n0 + 4 * c4)); } }
}
typedef short v2s16 __attribute__((ext_vector_type(2)));
__device__ __forceinline__ unsigned pk_fp8x4_scaled(float a, float b, float c, float d, float scale) { v2s16 r; asm volatile("" : "=v"(r));
    r = __builtin_amdgcn_cvt_scalef32_pk_fp8_f32(r, a, b, scale, false); r = __builtin_amdgcn_cvt_scalef32_pk_fp8_f32(r, c, d, scale, true); return __builtin_bit_cast(unsigned, r); }
__device__ __forceinline__ void moe_cv_half(const f32x4 (&v)[16], LAS unsigned* scr, int half, int lane) {
    const int q = lane >> 4, c4 = lane & 15;
#pragma unroll
    for (int pp = 0; pp < 4; ++pp)
#pragma unroll
        for (int j = 0; j < 4; ++j) scr[(4 * c4 + j) * 33 + 16 * half + 4 * pp + q] = pk_fp8x4_scaled(v[4 * pp][j], v[4 * pp + 1][j], v[4 * pp + 2][j], v[4 * pp + 3][j], WCVT_SCALE);
}
template <bool SC1> __device__ __forceinline__ void moe_flush(const MoeItem& m, LAS unsigned* scr, int lane) {
#pragma unroll
    for (int jj = 0; jj < 8; ++jj) { const int n = 8 * jj + (lane >> 3), ch = lane & 7; u32x4 w; const LAS unsigned* sp = scr + n * 33 + 4 * ch; w.x = sp[0]; w.y = sp[1]; w.z = sp[2]; w.w = sp[3];
        if constexpr (SC1) { const __amdgpu_buffer_rsrc_t rs = __builtin_amdgcn_make_buffer_rsrc(m.dst, 0, 0x7fffffff, 0x00020000);
            __builtin_amdgcn_raw_buffer_store_b128(w, rs, (m.drow + n) * KD + m.k0 + 16 * ch, 0, 16); }
        else __builtin_nontemporal_store(w, (u32x4*)(m.dst + (size_t)(m.drow + n) * KD + m.k0 + 16 * ch)); }
}
template <bool SC1, bool SLD> __device__ __forceinline__ void moe_items_stream(const Frame& F, const Args& A, int it0, int stride, int count, LAS unsigned* scr) {
    if (count <= 0) return;
    f32x4 va[16], vb[16];
    MoeItem cur = moe_item_desc(F, A, it0);
    moe_ld_half<SLD>(va, cur, 0, F.lane);
    for (int i = 0; i < count; ++i) {
        moe_ld_half<SLD>(vb, cur, 1, F.lane);
        moe_cv_half(va, scr, 0, F.lane);
        MoeItem nxt = cur;
        if (i + 1 < count) { nxt = moe_item_desc(F, A, it0 + (i + 1) * stride); moe_ld_half<SLD>(va, nxt, 0, F.lane); }
        moe_cv_half(vb, scr, 1, F.lane);
        LDS_WAIT();
        moe_flush<SC1>(cur, scr, F.lane);
        LDS_WAIT();
        cur = nxt;
    }
}
template <bool SC1, bool SLD = SC1> __device__ __forceinline__ void moe_item_fp8(const Frame& F, const Args& A, int it, LAS unsigned* scr) { moe_items_stream<SC1, SLD>(F, A, it, 0, 1, scr); }
__device__ __forceinline__ void p0_prologue(const Frame& F, const Args& A) {
    LAS unsigned* scr = (LAS unsigned*)(F.lds + F.wave * 16384);
    const int gw = F.bid * NWAVES + F.wave, NGW = F.G * NWAVES;
    const float* w_in = A.in[3]; const float* w_out = A.in[8]; const float* w_cq = A.in[11]; const float* w_ckv = A.in[12]; const float* w_co = A.in[13];
    const float* w_gu = A.in[17]; const float* w_dn = A.in[19]; (void)w_gu; (void)w_dn;
    constexpr int I0 = 96 * 32, I1 = 32 * 32, I2 = 0, I3 = 64 * 32, I4 = 32 * 32, I5 = MOE_FP8 ? 0 : NEXP * 64 * 32, I6 = MOE_FP8 ? 0 : NEXP * 32 * 32;
    constexpr int NITEMS = I0 + I1 + I2 + I3 + I4 + I5 + I6;
    for (int it = gw; it < NITEMS; it += NGW) {
        int r = it; const float* W; int ldn, nct; bf16* dst; const float* gk = nullptr; int mode = 0;
        if (r < I0) { W = w_in; ldn = INC; nct = 96; dst = (bf16*)(F.ws + WS_WIN); }
        else if ((r -= I0) < I1) { W = w_out; ldn = DM; nct = 32; dst = (bf16*)(F.ws + WS_WOUT); }
        else if ((r -= I1) < I3) { W = w_ckv; ldn = 2 * DM; nct = 64; dst = (bf16*)(F.ws + WS_WCKV); }
        else if ((r -= I3) < I4) { W = w_co; ldn = DM; nct = 32; dst = (bf16*)(F.ws + WS_WCO); }
        else if ((r -= I4) < I5) { const int e = r / (64 * 32); r -= e * (64 * 32); W = w_gu + (size_t)e * DM * 2 * DFF; ldn = 2 * DFF; nct = 64; dst = (bf16*)(F.ws + WS_WGU) + (size_t)e * 2 * DFF * KD; mode = 1; }
        else { r -= I5; const int e = r / (32 * 32); r -= e * (32 * 32); W = w_dn + (size_t)e * DFF * DM; ldn = DM; nct = 32; dst = (bf16*)(F.ws + WS_WD) + (size_t)e * DM * KD; }
        const int kt = r / nct, ct = r - kt * nct; const int n0 = ct * 64;
        int drow = n0;
        if (mode == 1) drow = (n0 < DFF) ? ((n0 >> 7) * 256 + (n0 & 127)) : (((n0 - DFF) >> 7) * 256 + 128 + ((n0 - DFF) & 127));
        cvt_tile(W, ldn, kt * 64, n0, dst, drow, gk, scr, F.lane);
    }
#if MOE_FP8
    if (CONV_WGS) {
        for (int it = (32 - E_P0) * 1024 + gw; it < 32768; it += NGW) moe_item_fp8<false>(F, A, it, scr);
        for (int it = 32768 + (32 - D_P0) * 512 + gw; it < MOE_ITEMS; it += NGW) moe_item_fp8<false>(F, A, it, scr);
    }
#endif
    {
        const int gt = F.bid * NTHR + F.tid, NGT = F.G * NTHR;
        bf16* wlow = (bf16*)(F.ws + WS_WLOW); bf16* wrh = (bf16*)(F.ws + WS_WRH); bf16* wrl = (bf16*)(F.ws + WS_WRL);
        const float* w_r = A.in[15]; const float* g_moe = A.in[14];
        { const float* g_cross = A.in[9]; bf16* wcqn = (bf16*)(F.ws + WS_WCQ);
          for (int i = gt; i < DM * DM / 4; i += NGT) { const int k = i >> 9; const f32x4 v = *((const f32x4*)w_cq + i) * g_cross[k]; st_bf16x4(wcqn + (size_t)i * 4, v); } }
        for (int i = gt; i < 16 * KD; i += NGT) { const int k = i >> 4, r = i & 15; wlow[r * KD + k] = f2bf(w_in[(size_t)k * INC + NPROJ + r]); }
        for (int i = gt; i < 32 * KD; i += NGT) { const int k = i >> 5, e = i & 31; const float w = w_r[k * 32 + e] * g_moe[k]; const bf16 h = f2bf(w); wrh[e * KD + k] = h; wrl[e * KD + k] = f2bf(w - bf2f(h)); }
    }
    for (int m = gw; m < NT + NMEM; m += NGW) {
        if (m < NT) rms_row_bf16(A.in[0] + (size_t)m * DM, A.in[2], (bf16*)(F.ws + WS_H1) + (size_t)m * DM, F.lane);
        else rms_row_bf16(A.in[1] + (size_t)(m - NT) * DM, A.in[10], (bf16*)(F.ws + WS_MEMN) + (size_t)(m - NT) * DM, F.lane);
    }
}

__device__ __forceinline__ void conv_step(const Frame& F, const Args& A, int seq) {
    LAS unsigned* scr = (LAS unsigned*)(F.lds + F.wave * 16384);
    const int cw = F.bid - NCOMP;
    if (seq < 32) moe_items_stream<true, true>(F, A, seq * 1024 + (cw * NWAVES + F.wave) * 2, 1, 2, scr);
    else moe_item_fp8<true>(F, A, 32768 + (seq - 32) * 512 + cw * NWAVES + F.wave, scr);
    VM_WAIT(); __syncthreads();
    if (F.tid == 0) __hip_atomic_fetch_add((unsigned*)(F.ws + WS_CTL) + CW_EXP + 64 * seq, 1u, __ATOMIC_RELAXED, __HIP_MEMORY_SCOPE_AGENT);
}

#define EPI_LOOP(...) _Pragma("unroll") for (int ai = 0; ai < 2; ++ai) _Pragma("unroll") for (int m = 0; m < 4; ++m) { const int rl = ai * 128 + wr * 64 + m * 16 + fr; \
        _Pragma("unroll") for (int bj = 0; bj < 2; ++bj) _Pragma("unroll") for (int n = 0; n < 2; ++n) { const int cl = bj * 128 + wc * 32 + n * 16 + 4 * fq; const f32x4 v = acc[ai][bj][m][n]; __VA_ARGS__ } }
#define EPI_LOOP_P(...) _Pragma("unroll") for (int ai = 0; ai < 2; ++ai) _Pragma("unroll") for (int m = 0; m < 4; ++m) { const int rl = ai * 128 + wr * 64 + m * 16 + fr; \
        _Pragma("unroll") for (int bj = 0; bj < 2; ++bj) { const int cl = bj * 128 + wc * 32 + 8 * fq; const f32x4 v0 = acc[ai][bj][m][0], v1 = acc[ai][bj][m][1]; __VA_ARGS__ } }
__device__ __forceinline__ void st_bf16x8(bf16* p, f32x4 a, f32x4 b) { u32x4 w; w.x = cvt_pk_bf16(a.x, a.y); w.y = cvt_pk_bf16(a.z, a.w); w.z = cvt_pk_bf16(b.x, b.y); w.w = cvt_pk_bf16(b.z, b.w); *(u32x4*)p = w; }

struct EpiInProj {
    static constexpr bool PERM = true;
    unsigned char* ws;
    __device__ __forceinline__ void operator()(f32x4 (&acc)[2][2][4][2], const Unit& u, int wr, int wc, int fr, int fq) const {
        const int c0 = u.c0;
        if (c0 < 2048 || (c0 >= 3072 && c0 < 4096) || c0 >= 5120) {
            bf16* base; int ld, cc;
            if (c0 < 1024) { base = (bf16*)(ws + WS_SBQ); ld = 1024; cc = c0; }
            else if (c0 < 2048) { base = (bf16*)(ws + WS_SBK); ld = 1024; cc = c0 - 1024; }
            else if (c0 < 3584) { base = (bf16*)(ws + WS_GQ); ld = 512; cc = c0 - 3072; }
            else if (c0 < 4096) { base = (bf16*)(ws + WS_GK); ld = 512; cc = c0 - 3584; }
            else { base = (bf16*)(ws + WS_GR); ld = 1024; cc = c0 - 5120; }
            EPI_LOOP_P( st_bf16x8(base + (size_t)(u.r0 + rl) * ld + cc + cl, v0, v1); )
        } else {
            bf16* base = (bf16*)(ws + (c0 < 3072 ? WS_SBVT : WS_GVT)); const int cc = c0 - (c0 < 3072 ? 2048 : 4096);
            EPI_LOOP_P( const int r = u.r0 + rl, b = r >> 11, sq = r & 2047; const int c = cc + cl;
                _Pragma("unroll") for (int j = 0; j < 4; ++j) { base[((size_t)(b * 1024 + c + j)) * SEQ + sq] = f2bf(v0[j]); base[((size_t)(b * 1024 + c + 4 + j)) * SEQ + sq] = f2bf(v1[j]); } )
        }
    }
};
struct EpiKV {
    static constexpr bool PERM = true;
    unsigned char* ws;
    __device__ __forceinline__ void operator()(f32x4 (&acc)[2][2][4][2], const Unit& u, int wr, int wc, int fr, int fq) const {
        bf16* base = (bf16*)(ws + (u.c0 < 2048 ? WS_KVK : WS_KVVT)); const int cc = u.c0 < 2048 ? u.c0 : u.c0 - 2048;
        EPI_LOOP_P( st_bf16x8(base + (size_t)(u.r0 + rl) * DM + cc + cl, v0, v1); )
    }
};
struct EpiRes1 {
    static constexpr bool PERM = true;
    const float* x; float* x1; bf16* x1b; float* ssq;
    __device__ __forceinline__ void operator()(f32x4 (&acc)[2][2][4][2], const Unit& u, int wr, int wc, int fr, int fq) const {
#pragma unroll
        for (int ai = 0; ai < 2; ++ai)
#pragma unroll
            for (int m = 0; m < 4; ++m) { const int r = u.r0 + ai * 128 + wr * 64 + m * 16 + fr; float s = 0.f;
#pragma unroll
                for (int bj = 0; bj < 2; ++bj) { const int c = u.c0 + bj * 128 + wc * 32 + 8 * fq; const size_t o = (size_t)r * DM + c;
                    const f32x4 a = acc[ai][bj][m][0] + *(const f32x4*)(x + o), b = acc[ai][bj][m][1] + *(const f32x4*)(x + o + 4);
                    *(f32x4*)(x1 + o) = a; *(f32x4*)(x1 + o + 4) = b; st_bf16x8(x1b + o, a, b);
                    s += ((a.x * a.x + a.y * a.y) + (a.z * a.z + a.w * a.w)) + ((b.x * b.x + b.y * b.y) + (b.z * b.z + b.w * b.w)); }
                s += __shfl_xor(s, 16); s += __shfl_xor(s, 32);
                if (fq == 0) ssq[(size_t)((u.c0 >> 8) * 4 + wc) * NT + r] = s; }
    }
};
struct EpiRes2 {
    static constexpr bool PERM = false;
    const float* x1; float* x2;
    __device__ __forceinline__ void operator()(f32x4 (&acc)[2][2][4][2], const Unit& u, int wr, int wc, int fr, int fq) const {
        EPI_LOOP( const size_t o = (size_t)(u.r0 + rl) * DM + u.c0 + cl; *(f32x4*)(x2 + o) = v + *(const f32x4*)(x1 + o); )
    }
};
constexpr float WUNSC = (MOE_FP8 && MX_UNSCALED) ? (1.0f / 64.0f) : 1.0f;
struct EpiAct {
    static constexpr bool PERM = true;
    const float* bgu; bf16* act;
    __device__ __forceinline__ void operator()(f32x4 (&acc)[2][2][4][2], const Unit& u, int wr, int wc, int fr, int fq) const {
        const float* bg = bgu + (size_t)u.e * 2 * DFF; const int j0 = u.c0 + wc * 32 + 8 * fq;
        f32x4 b0[2], b1[2];
#pragma unroll
        for (int n = 0; n < 2; ++n) { b0[n] = *(const f32x4*)(bg + j0 + 4 * n); b1[n] = *(const f32x4*)(bg + DFF + j0 + 4 * n); }
#pragma unroll
        for (int ai = 0; ai < 2; ++ai)
#pragma unroll
            for (int m = 0; m < 4; ++m) { const int rl = ai * 128 + wr * 64 + m * 16 + fr; if (rl < u.rows) { f32x4 a[2];
#pragma unroll
                for (int n = 0; n < 2; ++n) { const f32x4 g = acc[ai][0][m][n] * WUNSC + b0[n], l = acc[ai][1][m][n] * WUNSC + b1[n];
#pragma unroll
                    for (int j = 0; j < 4; ++j) { const float gg = fminf(g[j], 7.0f), ll = fminf(fmaxf(l[j], -7.0f), 7.0f); a[n][j] = gg * frcp(1.0f + fexp2(-1.702f * LOG2E * gg)) * (ll + 1.0f); } }
#if MOE_FP8
                u32x2 w; w.x = pk_fp8x4(a[0].x, a[0].y, a[0].z, a[0].w); w.y = pk_fp8x4(a[1].x, a[1].y, a[1].z, a[1].w);
                *(u32x2*)((unsigned char*)act + (size_t)(u.r0 + rl) * DFF + j0) = w;
#else
                st_bf16x8(act + (size_t)(u.r0 + rl) * DFF + j0, a[0], a[1]);
#endif
                } }
    }
};
struct EpiY {
    static constexpr bool PERM = true;
    const float* bd; const float* sw; bf16* y;
    __device__ __forceinline__ void operator()(f32x4 (&acc)[2][2][4][2], const Unit& u, int wr, int wc, int fr, int fq) const {
        const float* bb = bd + (size_t)u.e * DM;
        f32x4 bv[2][2];
#pragma unroll
        for (int bj = 0; bj < 2; ++bj)
#pragma unroll
            for (int n = 0; n < 2; ++n) bv[bj][n] = *(const f32x4*)(bb + u.c0 + bj * 128 + wc * 32 + 8 * fq + 4 * n);
#pragma unroll
        for (int ai = 0; ai < 2; ++ai)
#pragma unroll
            for (int m = 0; m < 4; ++m) { const int rl = ai * 128 + wr * 64 + m * 16 + fr; if (rl < u.rows) { const float w = sw[u.r0 + rl];
#pragma unroll
                for (int bj = 0; bj < 2; ++bj) { const int c = u.c0 + bj * 128 + wc * 32 + 8 * fq; const f32x4 y0 = (acc[ai][bj][m][0] * WUNSC + bv[bj][0]) * w, y1 = (acc[ai][bj][m][1] * WUNSC + bv[bj][1]) * w;
#if Y_FP8
                    u32x2 yw; yw.x = pk_fp8x4(y0.x * 16.0f, y0.y * 16.0f, y0.z * 16.0f, y0.w * 16.0f); yw.y = pk_fp8x4(y1.x * 16.0f, y1.y * 16.0f, y1.z * 16.0f, y1.w * 16.0f);
                    *(u32x2*)((unsigned char*)y + (size_t)(u.r0 + rl) * DM + c) = yw;
#else
                    st_bf16x8(y + (size_t)(u.r0 + rl) * DM + c, y0, y1);
#endif
                    } } }
    }
};

constexpr int RSC_OFF = RED2_OFF + 4096;
__device__ __forceinline__ void xattn_row_scales(LAS unsigned char* lds, const float* __restrict__ ssq, int r0) {
    const int t = threadIdx.x, row = t >> 1, hf = t & 1; float q = 0.f;
#pragma unroll
    for (int pp = 0; pp < 16; ++pp) q += ssq[(size_t)(16 * hf + pp) * NT + r0 + row];
    q += __shfl_xor(q, 1);
    if (hf == 0) ((LAS float*)(lds + RSC_OFF))[row] = (0.04419417382415922f * LOG2E) / sqrtf(q * (1.f / DM) + EPS);
    __syncthreads();
}
struct EpiSoftmax {
    static constexpr bool PERM = true;
    LAS unsigned char* lds; bf16* P;
    __device__ __forceinline__ void operator()(f32x4 (&acc)[2][2][4][2], const Unit& u, int wr, int wc, int fr, int fq) const {
        LAS float* red1 = (LAS float*)(lds + RED1_OFF); LAS float* red2 = (LAS float*)(lds + RED2_OFF);
        float rs[2][4];
#pragma unroll
        for (int ai = 0; ai < 2; ++ai)
#pragma unroll
            for (int m = 0; m < 4; ++m) rs[ai][m] = ((const LAS float*)(lds + RSC_OFF))[ai * 128 + wr * 64 + m * 16 + fr];
#pragma unroll
        for (int ai = 0; ai < 2; ++ai)
#pragma unroll
            for (int m = 0; m < 4; ++m) { const int rl = ai * 128 + wr * 64 + m * 16 + fr; float mx = -3.0e38f;
#pragma unroll
                for (int bj = 0; bj < 2; ++bj)
#pragma unroll
                    for (int n = 0; n < 2; ++n) { const f32x4 v = acc[ai][bj][m][n]; mx = fmaxf(fmaxf(mx, fmaxf(v.x, v.y)), fmaxf(v.z, v.w)); }
                mx = fmaxf(mx, __shfl_xor(mx, 16)); mx = fmaxf(mx, __shfl_xor(mx, 32));
                if (fq == 0) red1[rl * 4 + wc] = mx; }
        asm volatile("s_waitcnt lgkmcnt(0)" ::: "memory"); __builtin_amdgcn_s_barrier(); asm volatile("" ::: "memory");
#pragma unroll
        for (int ai = 0; ai < 2; ++ai)
#pragma unroll
            for (int m = 0; m < 4; ++m) { const int rl = ai * 128 + wr * 64 + m * 16 + fr; const f32x4 mv = *(const LAS f32x4*)(red1 + rl * 4);
                const float mx = fmaxf(fmaxf(mv.x, mv.y), fmaxf(mv.z, mv.w)); float sum = 0.f;
#pragma unroll
                for (int bj = 0; bj < 2; ++bj)
#pragma unroll
                    for (int n = 0; n < 2; ++n) { f32x4 v = acc[ai][bj][m][n];
#pragma unroll
                        for (int j = 0; j < 4; ++j) { v[j] = fexp2((v[j] - mx) * rs[ai][m]); sum += v[j]; }
                        acc[ai][bj][m][n] = v; }
                sum += __shfl_xor(sum, 16); sum += __shfl_xor(sum, 32);
                if (fq == 0) red2[rl * 4 + wc] = sum; }
        asm volatile("s_waitcnt lgkmcnt(0)" ::: "memory"); __builtin_amdgcn_s_barrier(); asm volatile("" ::: "memory");
#pragma unroll
        for (int ai = 0; ai < 2; ++ai)
#pragma unroll
            for (int m = 0; m < 4; ++m) { const int rl = ai * 128 + wr * 64 + m * 16 + fr; const f32x4 sv = *(const LAS f32x4*)(red2 + rl * 4);
                const float inv = 1.0f / ((sv.x + sv.y) + (sv.z + sv.w));
#pragma unroll
                for (int bj = 0; bj < 2; ++bj) st_bf16x8(P + (size_t)(u.r0 + rl) * 1024 + u.c0 + bj * 128 + wc * 32 + 8 * fq, acc[ai][bj][m][0] * inv, acc[ai][bj][m][1] * inv); }
        asm volatile("s_waitcnt lgkmcnt(0)" ::: "memory"); __builtin_amdgcn_s_barrier(); asm volatile("" ::: "memory");
    }
};
struct XpreOrder {
    const char* Kk; const char* Wcqn; const char* Wcot; const char* Vv; int c;
    __device__ bool next(int i, Unit& u) const { if (i > 0 || c >= 256) return false; u.rows = 256; u.e = 0;
        if (c < 128) { const int bh = c >> 3, nt = c & 7, b = bh >> 2, h = bh & 3;
            u.a = Kk + ((size_t)(b * MEMLEN) * DM + h * 512) * 2; u.b = Wcqn + ((size_t)(nt * 256) * DM + h * 512) * 2; u.r0 = bh * 256; u.c0 = nt * 256; u.e = 0; }
        else { const int q = c - 128, bh = q >> 3, nt = q & 7, b = bh >> 2, h = bh & 3;
            u.a = Wcot + ((size_t)(nt * 256) * DM + h * 512) * 2; u.b = Vv + ((size_t)(b * MEMLEN) * DM + h * 512) * 2; u.r0 = b * DM + nt * 256; u.c0 = h * 256; u.e = 1; }
        return true; }
    __device__ __forceinline__ void a_ready(const Unit&) const {}
};
struct EpiXpre {
    static constexpr bool PERM = true;
    bf16* MT; bf16* VWT;
    __device__ __forceinline__ void operator()(f32x4 (&acc)[2][2][4][2], const Unit& u, int wr, int wc, int fr, int fq) const {
        bf16* O = u.e ? VWT : MT; const int ld = u.e ? 1024 : DM;
        EPI_LOOP_P( st_bf16x8(O + (size_t)(u.r0 + rl) * ld + u.c0 + cl, v0, v1); )
    }
};
struct MixOrder {
    pg8::DenseOrder D; XpreOrder X; int c;
    __device__ bool next(int i, Unit& u) const { if (i > 1) return false; const bool first_dense = true;
        if ((i == 0) == first_dense) { const bool ok = D.next(0, u); u.e = 0; u.nt = 32; return ok; }
        const bool ok = X.next(0, u); u.e = u.e + 1; u.nt = 8; return ok; }
    __device__ __forceinline__ void a_ready(const Unit&) const {}
};
struct EpiMix {
    static constexpr bool PERM = true;
    EpiRes1 R; EpiXpre Xp;
    __device__ __forceinline__ void operator()(f32x4 (&acc)[2][2][4][2], const Unit& u, int wr, int wc, int fr, int fq) const {
        if (u.e == 0) R(acc, u, wr, wc, fr, fq); else { Unit v = u; v.e = u.e - 1; Xp(acc, v, wr, wc, fr, fq); }
    }
};
struct XsOrder {
    const char* X; const char* MT; int c;
    __device__ bool next(int i, Unit& u) const { if (i > 0 || c >= 128) return false; const int bh = c >> 3, qt = c & 7, b = bh >> 2, h = bh & 3;
        u.a = X + ((size_t)(b * SEQ + 256 * qt) * DM) * 2; u.b = MT + ((size_t)(bh * 256) * DM) * 2; u.r0 = b * SEQ + 256 * qt; u.c0 = h * 256; u.rows = 256; u.e = 0; return true; }
    __device__ __forceinline__ void a_ready(const Unit&) const {}
};
struct XoutOrder {
    const char* P; const char* VWT; int c;
    __device__ bool next(int i, Unit& u) const { if (i > 0 || c >= 256) return false; const int b = c >> 6, pm = (c >> 3) & 7, pn = c & 7;
        u.a = P + ((size_t)(b * SEQ + 256 * pm) * 1024) * 2; u.b = VWT + ((size_t)(b * DM + 256 * pn) * 1024) * 2; u.r0 = b * SEQ + 256 * pm; u.c0 = 256 * pn; u.rows = 256; u.e = 0; return true; }
    __device__ __forceinline__ void a_ready(const Unit&) const {}
};
struct KvOrder {
    const char* A; const char* Bt; int c;
    __device__ bool next(int i, Unit& u) const { if (i > 0 || c >= 64) return false; const int pm = c >> 4, pn = c & 15;
        u.a = A + (size_t)pm * 256 * KD * 2; u.b = Bt + (size_t)pn * 256 * KD * 2; u.r0 = pm * 256; u.c0 = pn * 256; u.rows = 256; u.e = 0; return true; }
    __device__ __forceinline__ void a_ready(const Unit&) const {}
};
struct MoeOrder {
    const LAS int* tab; const char* A; const char* Bt; int ntn, G, c; size_t bstride; int ocol; int pitchb;
    __device__ bool next(int i, Unit& u) const {
        const int idx = i * G + c; const int total = __builtin_amdgcn_readfirstlane(tab[32]);
        if (idx >= total) return false;
        int e = 0;
        for (int q = 1; q < 32; ++q) { const int p = __builtin_amdgcn_readfirstlane(tab[q]); if (idx >= p) e = q; }
        const int ue = __builtin_amdgcn_readfirstlane(tab[e]), st = __builtin_amdgcn_readfirstlane(tab[64 + e]), cn = __builtin_amdgcn_readfirstlane(tab[128 + e]);
        const int local = idx - ue, mt = local / ntn, nt = local - mt * ntn;
        u.a = A + (size_t)(st + 256 * mt) * pitchb; u.b = Bt + (size_t)e * bstride + (size_t)nt * 256 * pitchb;
        u.r0 = st + 256 * mt; u.c0 = nt * ocol; u.rows = (cn - 256 * mt) < 256 ? (cn - 256 * mt) : 256; u.e = e; return true;
    }
    const unsigned* ecnt; int* ready; int hi_ready;
    __device__ __forceinline__ void a_ready(const Unit& u) const {
        if (ecnt == nullptr || u.e <= *ready || u.e >= hi_ready) return;
        if (threadIdx.x < 64) { unsigned sp = 0;
            while ((unsigned)__builtin_amdgcn_readfirstlane(__hip_atomic_load(ecnt + 64 * u.e, __ATOMIC_RELAXED, __HIP_MEMORY_SCOPE_AGENT)) < (unsigned)CONV_WGS) { __builtin_amdgcn_s_sleep(4); if (++sp > (1u << 22)) break; }
            __builtin_amdgcn_fence(__ATOMIC_ACQUIRE, "agent");
            asm volatile("s_waitcnt vmcnt(0)" ::: "memory"); }
        asm volatile("" ::: "memory"); __builtin_amdgcn_s_barrier(); asm volatile("" ::: "memory");
        *ready = u.e;
    }
};
__device__ __forceinline__ void moe_table(const Frame& F, int ntn) {
    LAS int* tab = (LAS int*)(F.lds + TAB_OFF); const int* cs = (const int*)(F.ws + WS_CNT);
    if (F.tid < 32) { tab[64 + F.tid] = cs[32 + F.tid]; tab[128 + F.tid] = cs[F.tid]; }
    __syncthreads();
    if (F.tid == 0) { int p = 0; for (int e = 0; e < 32; ++e) { tab[e] = p; p += ((tab[128 + e] + 255) >> 8) * ntn; } tab[32] = p; }
    __syncthreads();
}

__device__ __forceinline__ void gla_low_job(const Frame& F) {
    const bf16* h1 = (const bf16*)(F.ws + WS_H1); const bf16* wl = (const bf16*)(F.ws + WS_WLOW); float* glow = (float*)(F.ws + WS_GLOW);
    LAS float* red = (LAS float*)F.lds;
    const int l = F.lane, r16 = l & 15, quad = l >> 4;
    for (int rb = F.bid; rb < NT / 32; rb += F.G) {
        f32x4 acc[2] = {{0.f, 0.f, 0.f, 0.f}, {0.f, 0.f, 0.f, 0.f}};
#pragma unroll
        for (int st = 0; st < 8; ++st) { const int k0 = 256 * F.wave + 32 * st + 8 * quad;
            const bf16x8 bfr = *(const bf16x8*)(wl + (size_t)r16 * KD + k0);
#pragma unroll
            for (int tb = 0; tb < 2; ++tb) { const bf16x8 afr = *(const bf16x8*)(h1 + (size_t)(rb * 32 + tb * 16 + r16) * KD + k0);
                acc[tb] = __builtin_amdgcn_mfma_f32_16x16x32_bf16(afr, bfr, acc[tb], 0, 0, 0); } }
#pragma unroll
        for (int tb = 0; tb < 2; ++tb)
#pragma unroll
            for (int j = 0; j < 4; ++j) red[(F.wave * 32 + tb * 16 + 4 * quad + j) * 16 + r16] = acc[tb][j];
        __syncthreads();
        { const int tok = F.tid >> 4, r = F.tid & 15; float s = 0.f;
#pragma unroll
          for (int w = 0; w < 8; ++w) s += red[(w * 32 + tok) * 16 + r];
          glow[(size_t)(rb * 32 + tok) * 16 + r] = s; }
        __syncthreads();
    }
}

__device__ __forceinline__ void sb_attn_wave(const Frame& F, const float* __restrict__ sb_g, int wu) {
    const bf16* Q = (const bf16*)(F.ws + WS_SBQ); const bf16* Kp = (const bf16*)(F.ws + WS_SBK); const bf16* VT = (const bf16*)(F.ws + WS_SBVT); bf16* O = (bf16*)(F.ws + WS_MIXO);
    const int l = F.lane, r = l & 31, hh = l >> 5;
    const int qb = 63 - (wu & 63), bh = wu >> 6, b = bh >> 3, h = bh & 7;
    const int t0 = qb * 32;
    bf16x8 qf[8];
#pragma unroll
    for (int st = 0; st < 8; ++st) qf[st] = *(const bf16x8*)(Q + (size_t)(b * SEQ + t0 + r) * 1024 + h * 128 + 16 * st + 8 * hh);
    f32x16 o[4];
#pragma unroll
    for (int d = 0; d < 4; ++d)
#pragma unroll
        for (int i = 0; i < 16; ++i) o[d][i] = 0.f;
    float R = 0.f;
    const float zs = 0.08838834764831845f * LOG2E;
    const int qpos = t0 + r;
    for (int kt = qb; kt >= 0; --kt) {
        f32x16 s;
#pragma unroll
        for (int i = 0; i < 16; ++i) s[i] = 0.f;
#pragma unroll
        for (int st = 0; st < 8; ++st) { const bf16x8 kf = *(const bf16x8*)(Kp + (size_t)(b * SEQ + kt * 32 + r) * 1024 + h * 128 + 16 * st + 8 * hh);
            s = __builtin_amdgcn_mfma_f32_32x32x16_bf16(kf, qf[st], s, 0, 0, 0); }
        float lm[16], lb[16];
#pragma unroll
        for (int i = 0; i < 16; ++i) { const int key = kt * 32 + (i & 3) + 8 * (i >> 2) + 4 * hh; const float z2 = s[i] * zs; const bool valid = key < qpos;
            const float sp = fmaxf(z2, 0.f) + flog2(1.f + fexp2(-fabsf(z2)));
            lm[i] = valid ? -sp : 0.f; lb[i] = z2 - sp; }
        float Gown[4], Gpar[4];
#pragma unroll
        for (int c = 0; c < 4; ++c) { Gown[c] = (lm[4 * c] + lm[4 * c + 1]) + (lm[4 * c + 2] + lm[4 * c + 3]); Gpar[c] = __shfl_xor(Gown[c], 32); }
        float sufT[4]; sufT[3] = 0.f;
#pragma unroll
        for (int c = 2; c >= 0; --c) sufT[c] = sufT[c + 1] + (Gown[c + 1] + Gpar[c + 1]);
        float p[16];
#pragma unroll
        for (int c = 0; c < 4; ++c) { float run = R + sufT[c] + (hh == 0 ? Gpar[c] : 0.f);
#pragma unroll
            for (int e = 3; e >= 0; --e) { const int i = 4 * c + e; const int key = kt * 32 + e + 8 * c + 4 * hh;
                p[i] = (key < qpos) ? fexp2(lb[i] + run) : 0.f; run += lm[i]; } }
        R += (Gown[0] + Gpar[0]) + (Gown[1] + Gpar[1]) + (Gown[2] + Gpar[2]) + (Gown[3] + Gpar[3]);
#pragma unroll
        for (int s2 = 0; s2 < 2; ++s2) {
            u32x4 pw; pw.x = cvt_pk_bf16(p[8 * s2 + 0], p[8 * s2 + 1]); pw.y = cvt_pk_bf16(p[8 * s2 + 2], p[8 * s2 + 3]); pw.z = cvt_pk_bf16(p[8 * s2 + 4], p[8 * s2 + 5]); pw.w = cvt_pk_bf16(p[8 * s2 + 6], p[8 * s2 + 7]);
            const bf16x8 pb = __builtin_bit_cast(bf16x8, pw);
#pragma unroll
            for (int d = 0; d < 4; ++d) { const bf16* vp = VT + ((size_t)(bh * 128 + d * 32 + r)) * SEQ + kt * 32 + 16 * s2 + 4 * hh;
                u32x4 vw; const u32x2 v0 = *(const u32x2*)vp, v1 = *(const u32x2*)(vp + 8); vw.x = v0.x; vw.y = v0.y; vw.z = v1.x; vw.w = v1.y;
                o[d] = __builtin_amdgcn_mfma_f32_32x32x16_bf16(__builtin_bit_cast(bf16x8, vw), pb, o[d], 0, 0, 0); } }
        if (__all(R < -40.f)) break;
    }
    float ss = 0.f;
#pragma unroll
    for (int d = 0; d < 4; ++d)
#pragma unroll
        for (int i = 0; i < 16; ++i) ss += o[d][i] * o[d][i];
    ss += __shfl_xor(ss, 32);
    const float rstd = 1.0f / sqrtf(ss * (1.f / 128.f) + EPS);
#pragma unroll
    for (int d = 0; d < 4; ++d)
#pragma unroll
        for (int c = 0; c < 4; ++c) { const int dim = 32 * d + 8 * c + 4 * hh; const f32x4 g = *(const f32x4*)(sb_g + h * 128 + dim);
            f32x4 v; v.x = o[d][4 * c] * rstd * g.x; v.y = o[d][4 * c + 1] * rstd * g.y; v.z = o[d][4 * c + 2] * rstd * g.z; v.w = o[d][4 * c + 3] * rstd * g.w;
            st_bf16x4(O + (size_t)(b * SEQ + qpos) * DM + h * 128 + dim, v); }
}

constexpr int G1_QIN = 0, G1_KIN = 64 * 136 * 2, G1_KDT = 2 * 64 * 136 * 2, G1_LOW = G1_KDT + 128 * 72 * 2, G1_SEG = G1_LOW + 64 * 16 * 4, G1_QRAW = G1_SEG + 4 * 128 * 4, G1_KRAW = G1_QRAW + 64 * 128 * 2, G1_END = G1_KRAW + 64 * 128 * 2;
constexpr int G1_KVT = G1_QRAW;
static_assert(G1_END <= RING_BYTES && G1_KVT + 65536 <= RING_BYTES && (G1_KVT & 15) == 0, "g1 lds");
__device__ __forceinline__ void gla_g1_unit(const Frame& F, const float* __restrict__ w2, const float* __restrict__ b2, int unit) {
    const int n = unit & 31, bh = unit >> 5, b = bh >> 2, h = bh & 3;
    const int t0 = b * SEQ + 64 * n;
    const bf16* GQ = (const bf16*)(F.ws + WS_GQ); const bf16* GK = (const bf16*)(F.ws + WS_GK); const bf16* GVT = (const bf16*)(F.ws + WS_GVT); const float* GLOW = (const float*)(F.ws + WS_GLOW);
    LAS bf16* qin = (LAS bf16*)(F.lds + G1_QIN); LAS bf16* kin = (LAS bf16*)(F.lds + G1_KIN); LAS bf16* kdt = (LAS bf16*)(F.lds + G1_KDT);
    LAS float* lowl = (LAS float*)(F.lds + G1_LOW); LAS float* seg = (LAS float*)(F.lds + G1_SEG);
    for (int i = F.tid; i < 64 * 16; i += NTHR) lowl[i] = GLOW[(size_t)t0 * 16 + i];
    LAS bf16* qraw = (LAS bf16*)(F.lds + G1_QRAW); LAS bf16* kraw = (LAS bf16*)(F.lds + G1_KRAW);
#pragma unroll
    for (int q2 = 0; q2 < 2; ++q2) { const int id = F.tid + 512 * q2, row = id >> 4, ch = id & 15;
        *(LAS u32x4*)(qraw + row * 128 + ch * 8) = *(const u32x4*)(GQ + (size_t)(t0 + row) * 512 + h * 128 + ch * 8);
        *(LAS u32x4*)(kraw + row * 128 + ch * 8) = *(const u32x4*)(GK + (size_t)(t0 + row) * 512 + h * 128 + ch * 8); }
    __syncthreads();
    const int d = F.tid & 127, sg = F.tid >> 7, dd = h * 128 + d;
    float wcol[16];
#pragma unroll
    for (int r = 0; r < 16; ++r) wcol[r] = w2[r * 512 + dd];
    const float bias = b2[dd];
    float pre[16]; float run = 0.f;
#pragma unroll
    for (int i = 0; i < 16; ++i) { const int c = 16 * sg + i; float z = bias;
#pragma unroll
        for (int r4 = 0; r4 < 4; ++r4) { const f32x4 lv = *(const LAS f32x4*)(lowl + c * 16 + 4 * r4); z += lv.x * wcol[4 * r4] + lv.y * wcol[4 * r4 + 1] + lv.z * wcol[4 * r4 + 2] + lv.w * wcol[4 * r4 + 3]; }
        run += log2_sigmoid2(z * LOG2E) * (1.0f / 16.0f);
        pre[i] = run; }
    seg[sg * 128 + d] = run;
    __syncthreads();
    float off = 0.f, tot = 0.f;
#pragma unroll
    for (int s = 0; s < 4; ++s) { const float v = seg[s * 128 + d]; tot += v; if (s < sg) off += v; }
    bf16* QIN = (bf16*)(F.ws + WS_QIN);
#pragma unroll
    for (int i = 0; i < 16; ++i) { const int c = 16 * sg + i; const float g = off + pre[i];
        const float qv = bf2f(qraw[c * 128 + d]), kv = bf2f(kraw[c * 128 + d]);
        const bf16 qi = f2bf(qv * 0.08838834764831845f * fexp2(g));
        qin[c * 136 + d] = qi;
        kin[c * 136 + d] = f2bf(kv * fexp2(-g));
        kdt[d * 72 + c] = f2bf(kv * fexp2(tot - g)); }
    if (sg == 0) ((float*)(F.ws + WS_DECAY))[(size_t)unit * 128 + d] = fexp2(tot);
    __syncthreads();
#pragma unroll
    for (int q2 = 0; q2 < 2; ++q2) { const int id = F.tid + 512 * q2, row = id >> 4, ch = id & 15;
        *(u32x4*)(QIN + (size_t)(t0 + row) * 512 + h * 128 + ch * 8) = *(const LAS u32x4*)(qin + row * 136 + ch * 8); }
    const int w = F.wave, l = F.lane, r = l & 31, hh = l >> 5, cb = w & 1, dvp = w >> 1;
    f32x16 X[2];
#pragma unroll
    for (int sb = 0; sb < 2; ++sb) {
#pragma unroll
        for (int i = 0; i < 16; ++i) X[sb][i] = 0.f;
#pragma unroll
        for (int st = 0; st < 8; ++st) { const bf16x8 af = *(const LAS bf16x8*)(kin + (32 * sb + r) * 136 + 16 * st + 8 * hh), bfq = *(const LAS bf16x8*)(qin + (32 * cb + r) * 136 + 16 * st + 8 * hh);
            X[sb] = __builtin_amdgcn_mfma_f32_32x32x16_bf16(af, bfq, X[sb], 0, 0, 0); }
#pragma unroll
        for (int i = 0; i < 16; ++i) { const int s = 32 * sb + (i & 3) + 8 * (i >> 2) + 4 * hh; if (32 * cb + r < s) X[sb][i] = 0.f; }
    }
    u32x4* OI = (u32x4*)(F.ws + WS_OINTRA) + ((size_t)unit * 8 + w) * 256;
#pragma unroll
    for (int dbi = 0; dbi < 2; ++dbi) { const int db = 2 * dvp + dbi; f32x16 oacc;
#pragma unroll
        for (int i = 0; i < 16; ++i) oacc[i] = 0.f;
#pragma unroll
        for (int sb = 0; sb < 2; ++sb)
#pragma unroll
            for (int s2 = 0; s2 < 2; ++s2) {
                u32x4 pw; pw.x = cvt_pk_bf16(X[sb][8 * s2 + 0], X[sb][8 * s2 + 1]); pw.y = cvt_pk_bf16(X[sb][8 * s2 + 2], X[sb][8 * s2 + 3]); pw.z = cvt_pk_bf16(X[sb][8 * s2 + 4], X[sb][8 * s2 + 5]); pw.w = cvt_pk_bf16(X[sb][8 * s2 + 6], X[sb][8 * s2 + 7]);
                const bf16* vp = GVT + ((size_t)(bh * 256 + db * 32 + r)) * SEQ + 64 * n + 32 * sb + 16 * s2 + 4 * hh;
                u32x4 vw; const u32x2 v0 = *(const u32x2*)vp, v1 = *(const u32x2*)(vp + 8); vw.x = v0.x; vw.y = v0.y; vw.z = v1.x; vw.w = v1.y;
                oacc = __builtin_amdgcn_mfma_f32_32x32x16_bf16(__builtin_bit_cast(bf16x8, vw), __builtin_bit_cast(bf16x8, pw), oacc, 0, 0, 0); }
#pragma unroll
        for (int q4 = 0; q4 < 2; ++q4) { u32x4 ow; ow.x = cvt_pk_bf16(oacc[8 * q4], oacc[8 * q4 + 1]); ow.y = cvt_pk_bf16(oacc[8 * q4 + 2], oacc[8 * q4 + 3]); ow.z = cvt_pk_bf16(oacc[8 * q4 + 4], oacc[8 * q4 + 5]); ow.w = cvt_pk_bf16(oacc[8 * q4 + 6], oacc[8 * q4 + 7]);
            OI[(dbi * 2 + q4) * 64 + l] = ow; } }
    bf16* KVN = (bf16*)(F.ws + WS_KVN) + (size_t)unit * 32768; LAS bf16* kvt = (LAS bf16*)(F.lds + G1_KVT);
    bf16x8 vf[4];
#pragma unroll
    for (int st = 0; st < 4; ++st) vf[st] = *(const bf16x8*)(GVT + ((size_t)(bh * 256 + w * 32 + r)) * SEQ + 64 * n + 16 * st + 8 * hh);
#pragma unroll
    for (int dkb = 0; dkb < 4; ++dkb) { f32x16 kacc;
#pragma unroll
        for (int i = 0; i < 16; ++i) kacc[i] = 0.f;
#pragma unroll
        for (int st = 0; st < 4; ++st) { const bf16x8 bk = *(const LAS bf16x8*)(kdt + (32 * dkb + r) * 72 + 16 * st + 8 * hh);
            kacc = __builtin_amdgcn_mfma_f32_32x32x16_bf16(vf[st], bk, kacc, 0, 0, 0); }
#pragma unroll
        for (int i = 0; i < 16; ++i) kvt[(32 * w + (i & 3) + 8 * (i >> 2) + 4 * hh) * 128 + 32 * dkb + r] = f2bf(kacc[i]); }
    LDS_WAIT();
#pragma unroll
    for (int q8 = 0; q8 < 8; ++q8) { const int row = 32 * w + 4 * q8 + (l >> 4), ch = l & 15;
        *(u32x4*)(KVN + (size_t)row * 128 + ch * 8) = *(const LAS u32x4*)(kvt + row * 128 + ch * 8); }
    __syncthreads();
}

__device__ __forceinline__ void gla_scan(const Frame& F) {
    const bf16* KVN = (const bf16*)(F.ws + WS_KVN); const float* DEC = (const float*)(F.ws + WS_DECAY); bf16* ST = (bf16*)(F.ws + WS_STATE);
    for (int g = F.bid * NTHR + F.tid; g < 16 * 8192; g += F.G * NTHR) {
        const int bh = g >> 13, e4 = (g & 8191) * 4, dk = e4 & 127;
        f32x4 S = {0.f, 0.f, 0.f, 0.f};
#pragma unroll 8
        for (int n = 0; n < 32; ++n) { const size_t u = (size_t)(bh * 32 + n);
            st_bf16x4(ST + u * 32768 + e4, S);
            const u32x2 kw = *(const u32x2*)(KVN + u * 32768 + e4); const f32x4 kv = {bflo(kw.x), bfhi(kw.x), bflo(kw.y), bfhi(kw.y)}, dc = *(const f32x4*)(DEC + u * 128 + dk);
            S = S * dc + kv; }
    }
}

__device__ __forceinline__ void gla_g3_unit(const Frame& F, const float* __restrict__ gn, int unit) {
    const int n = unit & 31, bh = unit >> 5, b = bh >> 2, h = bh & 3; const int t0 = b * SEQ + 64 * n;
    const int w = F.wave, l = F.lane, r = l & 31, hh = l >> 5, cb = w & 1, dvp = w >> 1;
    const bf16* QIN = (const bf16*)(F.ws + WS_QIN); const bf16* ST = (const bf16*)(F.ws + WS_STATE) + (size_t)unit * 32768; const bf16* GR = (const bf16*)(F.ws + WS_GR); bf16* O = (bf16*)(F.ws + WS_MIXO);
    const u32x4* OI = (const u32x4*)(F.ws + WS_OINTRA) + ((size_t)unit * 8 + w) * 256;
    LAS float* part = (LAS float*)F.lds;
    bf16x8 qf[8];
#pragma unroll
    for (int st = 0; st < 8; ++st) qf[st] = *(const bf16x8*)(QIN + (size_t)(t0 + 32 * cb + r) * 512 + h * 128 + 16 * st + 8 * hh);
    f32x16 o[2]; float ss = 0.f;
#pragma unroll
    for (int dbi = 0; dbi < 2; ++dbi) { const int db = 2 * dvp + dbi;
#pragma unroll
        for (int q4 = 0; q4 < 2; ++q4) { const u32x4 ow = OI[(dbi * 2 + q4) * 64 + l];
            o[dbi][8 * q4] = bflo(ow.x); o[dbi][8 * q4 + 1] = bfhi(ow.x); o[dbi][8 * q4 + 2] = bflo(ow.y); o[dbi][8 * q4 + 3] = bfhi(ow.y); o[dbi][8 * q4 + 4] = bflo(ow.z); o[dbi][8 * q4 + 5] = bfhi(ow.z); o[dbi][8 * q4 + 6] = bflo(ow.w); o[dbi][8 * q4 + 7] = bfhi(ow.w); }
#pragma unroll
        for (int st = 0; st < 8; ++st) { const bf16x8 sf = *(const bf16x8*)(ST + (size_t)(32 * db + r) * 128 + 16 * st + 8 * hh);
            o[dbi] = __builtin_amdgcn_mfma_f32_32x32x16_bf16(sf, qf[st], o[dbi], 0, 0, 0); }
#pragma unroll
        for (int i = 0; i < 16; ++i) ss += o[dbi][i] * o[dbi][i]; }
    ss += __shfl_xor(ss, 32);
    if (hh == 0) part[w * 32 + r] = ss;
    __syncthreads();
    float tot = 0.f;
#pragma unroll
    for (int q = 0; q < 4; ++q) tot += part[(2 * q + cb) * 32 + r];
    const float rstd = 1.0f / sqrtf(tot * (1.f / 256.f) + EPS);
    const int tok = t0 + 32 * cb + r;
#pragma unroll
    for (int dbi = 0; dbi < 2; ++dbi)
#pragma unroll
        for (int c = 0; c < 4; ++c) { const int dv = 32 * (2 * dvp + dbi) + 8 * c + 4 * hh; const f32x4 g = *(const f32x4*)(gn + h * 256 + dv);
            const u32x2 rw = *(const u32x2*)(GR + (size_t)tok * 1024 + h * 256 + dv);
            const float r0 = bflo(rw.x), r1 = bfhi(rw.x), r2 = bflo(rw.y), r3 = bfhi(rw.y);
            f32x4 v; v.x = o[dbi][4 * c] * rstd * g.x * (r0 * frcp(1.f + fexp2(-r0 * LOG2E))); v.y = o[dbi][4 * c + 1] * rstd * g.y * (r1 * frcp(1.f + fexp2(-r1 * LOG2E)));
            v.z = o[dbi][4 * c + 2] * rstd * g.z * (r2 * frcp(1.f + fexp2(-r2 * LOG2E))); v.w = o[dbi][4 * c + 3] * rstd * g.w * (r3 * frcp(1.f + fexp2(-r3 * LOG2E)));
            st_bf16x4(O + (size_t)tok * DM + 1024 + h * 256 + dv, v); }
    __syncthreads();
}
__device__ __forceinline__ void gla_g3_pair(const Frame& F, const float* __restrict__ gn, int uA, int uB) {
    const int w = F.wave, l = F.lane, r = l & 31, hh = l >> 5, w4 = w & 3, cb = w4 & 1, dvh = w4 >> 1;
    const int unit = (w < 4) ? uA : uB; const bool act = unit >= 0;
    const int uu = act ? unit : 0, n = uu & 31, bh = uu >> 5, b = bh >> 2, h = bh & 3; const int t0 = b * SEQ + 64 * n;
    const bf16* QIN = (const bf16*)(F.ws + WS_QIN); const bf16* ST = (const bf16*)(F.ws + WS_STATE) + (size_t)uu * 32768; const bf16* GR = (const bf16*)(F.ws + WS_GR); bf16* O = (bf16*)(F.ws + WS_MIXO);
    LAS float* part = (LAS float*)F.lds;
    f32x16 o[4]; float ss = 0.f;
    if (act) {
        bf16x8 qf[8];
#pragma unroll
        for (int st = 0; st < 8; ++st) qf[st] = *(const bf16x8*)(QIN + (size_t)(t0 + 32 * cb + r) * 512 + h * 128 + 16 * st + 8 * hh);
#pragma unroll
        for (int dbi = 0; dbi < 4; ++dbi) { const int db = 4 * dvh + dbi;
            const u32x4* OI = (const u32x4*)(F.ws + WS_OINTRA) + ((size_t)uu * 8 + (2 * (db >> 1) + cb)) * 256 + ((db & 1) * 2) * 64 + l;
#pragma unroll
            for (int q4 = 0; q4 < 2; ++q4) { const u32x4 ow = OI[q4 * 64];
                o[dbi][8 * q4] = bflo(ow.x); o[dbi][8 * q4 + 1] = bfhi(ow.x); o[dbi][8 * q4 + 2] = bflo(ow.y); o[dbi][8 * q4 + 3] = bfhi(ow.y); o[dbi][8 * q4 + 4] = bflo(ow.z); o[dbi][8 * q4 + 5] = bfhi(ow.z); o[dbi][8 * q4 + 6] = bflo(ow.w); o[dbi][8 * q4 + 7] = bfhi(ow.w); }
#pragma unroll
            for (int st = 0; st < 8; ++st) { const bf16x8 sf = *(const bf16x8*)(ST + (size_t)(32 * db + r) * 128 + 16 * st + 8 * hh);
                o[dbi] = __builtin_amdgcn_mfma_f32_32x32x16_bf16(sf, qf[st], o[dbi], 0, 0, 0); }
#pragma unroll
            for (int i = 0; i < 16; ++i) ss += o[dbi][i] * o[dbi][i]; }
        ss += __shfl_xor(ss, 32);
        if (hh == 0) part[w * 32 + r] = ss;
    }
    __syncthreads();
    if (act) {
        const float tot = part[((w & 4) + cb) * 32 + r] + part[((w & 4) + cb + 2) * 32 + r];
        const float rstd = 1.0f / sqrtf(tot * (1.f / 256.f) + EPS);
        const int tok = t0 + 32 * cb + r;
#pragma unroll
        for (int dbi = 0; dbi < 4; ++dbi)
#pragma unroll
            for (int c = 0; c < 4; ++c) { const int dv = 32 * (4 * dvh + dbi) + 8 * c + 4 * hh; const f32x4 g = *(const f32x4*)(gn + h * 256 + dv);
                const u32x2 rw = *(const u32x2*)(GR + (size_t)tok * 1024 + h * 256 + dv);
                const float r0 = bflo(rw.x), r1 = bfhi(rw.x), r2 = bflo(rw.y), r3 = bfhi(rw.y);
                f32x4 v; v.x = o[dbi][4 * c] * rstd * g.x * (r0 * frcp(1.f + fexp2(-r0 * LOG2E))); v.y = o[dbi][4 * c + 1] * rstd * g.y * (r1 * frcp(1.f + fexp2(-r1 * LOG2E)));
                v.z = o[dbi][4 * c + 2] * rstd * g.z * (r2 * frcp(1.f + fexp2(-r2 * LOG2E))); v.w = o[dbi][4 * c + 3] * rstd * g.w * (r3 * frcp(1.f + fexp2(-r3 * LOG2E)));
                st_bf16x4(O + (size_t)tok * DM + 1024 + h * 256 + dv, v); }
    }
    __syncthreads();
}

__device__ __forceinline__ void router_phase(const Frame& F, const float* __restrict__ b_router) {
    const float* X2 = (const float*)(F.ws + WS_X2); const bf16* WH = (const bf16*)(F.ws + WS_WRH); const bf16* WL = (const bf16*)(F.ws + WS_WRL);
    int* TOPE = (int*)(F.ws + WS_TOPE); float* TOPW = (float*)(F.ws + WS_TOPW); float* RSTD = (float*)(F.ws + WS_RSTD3); int* HIST = (int*)(F.ws + WS_HIST);
    LAS float* part = (LAS float*)F.lds;
    LAS float* sq = (LAS float*)(F.lds + 32768);
    LAS int* hist = (LAS int*)(F.lds + 33792);
    const int w = F.wave, l = F.lane, r16 = l & 15, quad = l >> 4;
    for (int rb = F.bid; rb < NT / 32; rb += F.G) {
        if (F.tid < 32) hist[F.tid] = 0;
        f32x4 acc[2][2] = {{{0.f, 0.f, 0.f, 0.f}, {0.f, 0.f, 0.f, 0.f}}, {{0.f, 0.f, 0.f, 0.f}, {0.f, 0.f, 0.f, 0.f}}}; float ssq[2] = {0.f, 0.f};
#pragma unroll 4
        for (int st = 0; st < 8; ++st) { const int k0 = 256 * w + 32 * st + 8 * quad;
            bf16x8 bh[2], bl[2];
#pragma unroll
            for (int eb = 0; eb < 2; ++eb) { bh[eb] = *(const bf16x8*)(WH + (size_t)(16 * eb + r16) * KD + k0); bl[eb] = *(const bf16x8*)(WL + (size_t)(16 * eb + r16) * KD + k0); }
#pragma unroll
            for (int tg = 0; tg < 2; ++tg) { const int row = rb * 32 + 16 * tg + r16;
                const f32x4 xa = *(const f32x4*)(X2 + (size_t)row * DM + k0), xb = *(const f32x4*)(X2 + (size_t)row * DM + k0 + 4);
                ssq[tg] += (xa.x * xa.x + xa.y * xa.y) + (xa.z * xa.z + xa.w * xa.w) + (xb.x * xb.x + xb.y * xb.y) + (xb.z * xb.z + xb.w * xb.w);
                u32x4 hw; hw.x = cvt_pk_bf16(xa.x, xa.y); hw.y = cvt_pk_bf16(xa.z, xa.w); hw.z = cvt_pk_bf16(xb.x, xb.y); hw.w = cvt_pk_bf16(xb.z, xb.w);
                u32x4 lw; lw.x = cvt_pk_bf16(xa.x - bflo(hw.x), xa.y - bfhi(hw.x)); lw.y = cvt_pk_bf16(xa.z - bflo(hw.y), xa.w - bfhi(hw.y));
                lw.z = cvt_pk_bf16(xb.x - bflo(hw.z), xb.y - bfhi(hw.z)); lw.w = cvt_pk_bf16(xb.z - bflo(hw.w), xb.w - bfhi(hw.w));
                const bf16x8 ah = __builtin_bit_cast(bf16x8, hw), alo = __builtin_bit_cast(bf16x8, lw);
#pragma unroll
                for (int eb = 0; eb < 2; ++eb) {
                    acc[tg][eb] = __builtin_amdgcn_mfma_f32_16x16x32_bf16(ah, bh[eb], acc[tg][eb], 0, 0, 0);
                    acc[tg][eb] = __builtin_amdgcn_mfma_f32_16x16x32_bf16(ah, bl[eb], acc[tg][eb], 0, 0, 0);
                    acc[tg][eb] = __builtin_amdgcn_mfma_f32_16x16x32_bf16(alo, bh[eb], acc[tg][eb], 0, 0, 0); } } }
#pragma unroll
        for (int tg = 0; tg < 2; ++tg) { float q = ssq[tg]; q += __shfl_xor(q, 16); q += __shfl_xor(q, 32);
            if (quad == 0) sq[w * 32 + 16 * tg + r16] = q;
#pragma unroll
            for (int eb = 0; eb < 2; ++eb)
#pragma unroll
                for (int j = 0; j < 4; ++j) part[(w * 32 + 16 * tg + 4 * quad + j) * 32 + 16 * eb + r16] = acc[tg][eb][j]; }
        __syncthreads();
        for (int q2 = 0; q2 < 2; ++q2) { const int hf = l >> 5, e = l & 31; const int ti = 4 * w + 2 * q2 + hf; const int tok = rb * 32 + ti;
            LAS float* lg = (LAS float*)(F.lds + 36864) + (w * 2 + hf) * 32; LAS float* tvr = (LAS float*)(F.lds + 40960) + (w * 2 + hf) * 4;
            float s2 = 0.f, a = 0.f;
#pragma unroll
            for (int k = 0; k < 8; ++k) { s2 += sq[k * 32 + ti]; a += part[(k * 32 + ti) * 32 + e]; }
            const float rstd = 1.0f / sqrtf(s2 * (1.f / DM) + EPS);
            float v = a * rstd + b_router[e]; v = (v == v) ? v : -3.0e38f;
            lg[e] = v;
            LDS_WAIT();
            int rank = 0;
#pragma unroll
            for (int j4 = 0; j4 < 8; ++j4) { const f32x4 o = *(const LAS f32x4*)(lg + 4 * j4);
                rank += (o.x > v || (o.x == v && 4 * j4 + 0 < e)) ? 1 : 0; rank += (o.y > v || (o.y == v && 4 * j4 + 1 < e)) ? 1 : 0;
                rank += (o.z > v || (o.z == v && 4 * j4 + 2 < e)) ? 1 : 0; rank += (o.w > v || (o.w == v && 4 * j4 + 3 < e)) ? 1 : 0; }
            if (rank < 4) tvr[rank] = v;
            LDS_WAIT();
            const f32x4 t = *(const LAS f32x4*)tvr;
            const float e1 = fexp2((t.y - t.x) * LOG2E), e2 = fexp2((t.z - t.x) * LOG2E), e3 = fexp2((t.w - t.x) * LOG2E); const float inv = 1.0f / (1.0f + e1 + e2 + e3);
            if (rank < 4) { TOPE[tok * 4 + rank] = e; TOPW[tok * 4 + rank] = fexp2((v - t.x) * LOG2E) * inv; atomicAdd((int*)&hist[e], 1); }
            if (e == 0) RSTD[tok] = rstd;
            LDS_WAIT(); }
        __syncthreads();
        if (F.tid < 32) HIST[rb * 32 + F.tid] = hist[F.tid];
        __syncthreads();
    }
}

__device__ __forceinline__ void slots_phase(const Frame& F, const float* __restrict__ g_moe) {
    const float* X2 = (const float*)(F.ws + WS_X2); const int* TOPE = (const int*)(F.ws + WS_TOPE); const float* TOPW = (const float*)(F.ws + WS_TOPW); const float* RSTD = (const float*)(F.ws + WS_RSTD3);
    const int* HIST = (const int*)(F.ws + WS_HIST); float* SLOTW = (float*)(F.ws + WS_SLOTW); int* TOKSLOT = (int*)(F.ws + WS_TOKSLOT); int* CNT = (int*)(F.ws + WS_CNT); bf16* XS = (bf16*)(F.ws + WS_XS);
    LAS int* ptot = (LAS int*)F.lds;
    LAS int* pbel = ptot + 512;
    LAS int* base = pbel + 512;
    LAS int* asg = base + 32;
    LAS int* aslot = asg + 128;
    for (int rb = F.bid; rb < NT / 32; rb += F.G) {
        { const int e = F.tid & 31, p = F.tid >> 5; int t = 0, bl = 0;
          for (int q = 0; q < 16; ++q) { const int bb = 16 * p + q; const int hv = HIST[bb * 32 + e]; t += hv; if (bb < rb) bl += hv; }
          ptot[p * 32 + e] = t; pbel[p * 32 + e] = bl; }
        if (F.tid < 128) asg[F.tid] = TOPE[rb * 128 + F.tid];
        __syncthreads();
        if (F.tid < 32) { int t = 0, bl = 0; for (int p = 0; p < 16; ++p) { t += ptot[p * 32 + F.tid]; bl += pbel[p * 32 + F.tid]; }
            ptot[F.tid] = t; pbel[F.tid] = bl; }
        __syncthreads();
        if (F.tid < 32) { int st = 0; for (int e = 0; e < F.tid; ++e) st += ptot[e]; base[F.tid] = st + pbel[F.tid];
            if (rb == 0) { CNT[F.tid] = ptot[F.tid]; CNT[32 + F.tid] = st; }
            int run = base[F.tid]; for (int i = 0; i < 128; ++i) if (asg[i] == F.tid) { aslot[i] = run; ++run; } }
        __syncthreads();
        if (F.tid < 128) { const int sl = aslot[F.tid]; TOKSLOT[rb * 128 + F.tid] = sl; SLOTW[sl] = TOPW[rb * 128 + F.tid]; }
        for (int q = 0; q < 4; ++q) { const int ti = 4 * F.wave + q, tok = rb * 32 + ti; const float rstd = RSTD[tok];
            const f32x4* xr = (const f32x4*)(X2 + (size_t)tok * DM) + F.lane; const f32x4* gr = (const f32x4*)g_moe + F.lane;
#if MOE_FP8
            unsigned hw[8];
#pragma unroll
            for (int j = 0; j < 8; ++j) { const f32x4 v = xr[64 * j], g = gr[64 * j]; hw[j] = pk_fp8x4(v.x * rstd * g.x, v.y * rstd * g.y, v.z * rstd * g.z, v.w * rstd * g.w); }
            LAS unsigned* rowb = (LAS unsigned*)(F.lds + 16384 + F.wave * 2048);
#pragma unroll
            for (int j = 0; j < 8; ++j) rowb[64 * j + F.lane] = hw[j];
            LDS_WAIT();
            const u32x4 w0 = *(const LAS u32x4*)(rowb + 4 * F.lane), w1 = *(const LAS u32x4*)(rowb + 256 + 4 * F.lane);
#pragma unroll
            for (int k = 0; k < 4; ++k) { const int sl = aslot[ti * 4 + k]; u32x4* o16 = (u32x4*)((unsigned char*)XS + (size_t)sl * DM) + F.lane;
                o16[0] = w0; o16[64] = w1; }
            LDS_WAIT();
#else
            u32x2 hw[8];
#pragma unroll
            for (int j = 0; j < 8; ++j) { const f32x4 v = xr[64 * j], g = gr[64 * j]; hw[j].x = cvt_pk_bf16(v.x * rstd * g.x, v.y * rstd * g.y); hw[j].y = cvt_pk_bf16(v.z * rstd * g.z, v.w * rstd * g.w); }
#pragma unroll
            for (int k = 0; k < 4; ++k) { const int sl = aslot[ti * 4 + k]; u32x2* o8 = (u32x2*)(XS + (size_t)sl * DM) + F.lane;
#pragma unroll
                for (int j = 0; j < 8; ++j) o8[64 * j] = hw[j]; }
#endif
            }
        __syncthreads();
    }
}

__device__ __forceinline__ void final_phase(const Frame& F, const float* __restrict__ g_fin, float* __restrict__ out) {
    const float* X2 = (const float*)(F.ws + WS_X2); const bf16* Y = (const bf16*)(F.ws + WS_Y); const int* TOKSLOT = (const int*)(F.ws + WS_TOKSLOT);
    const int gw = F.bid * NWAVES + F.wave, NGW = F.G * NWAVES;
    for (int tok = gw; tok < NT; tok += NGW) {
        const f32x4* xr = (const f32x4*)(X2 + (size_t)tok * DM) + F.lane;
        f32x4 v[8];
#pragma unroll
        for (int j = 0; j < 8; ++j) v[j] = xr[64 * j];
#pragma unroll
#if Y_FP8
        for (int k = 0; k < 4; ++k) { const int sl = TOKSLOT[tok * 4 + k]; const unsigned* yr = (const unsigned*)((const unsigned char*)Y + (size_t)sl * DM) + F.lane;
#pragma unroll
            for (int j = 0; j < 8; ++j) { const int yw = (int)yr[64 * j]; const f32x2 lo = __builtin_amdgcn_cvt_pk_f32_fp8(yw, false), hi = __builtin_amdgcn_cvt_pk_f32_fp8(yw, true);
                v[j].x += lo.x * 0.0625f; v[j].y += lo.y * 0.0625f; v[j].z += hi.x * 0.0625f; v[j].w += hi.y * 0.0625f; } }
#else
        for (int k = 0; k < 4; ++k) { const int sl = TOKSLOT[tok * 4 + k]; const u32x2* yr = (const u32x2*)(Y + (size_t)sl * DM) + F.lane;
#pragma unroll
            for (int j = 0; j < 8; ++j) { const u32x2 yw = yr[64 * j]; v[j].x += bflo(yw.x); v[j].y += bfhi(yw.x); v[j].z += bflo(yw.y); v[j].w += bfhi(yw.y); } }
#endif
        float s = 0.f;
#pragma unroll
        for (int j = 0; j < 8; ++j) s += (v[j].x * v[j].x + v[j].y * v[j].y) + (v[j].z * v[j].z + v[j].w * v[j].w);
        const float rstd = 1.0f / sqrtf(wave_sum(s) * (1.f / DM) + EPS);
        f32x4* orow = (f32x4*)(out + (size_t)tok * DM) + F.lane; const f32x4* gr = (const f32x4*)g_fin + F.lane;
#pragma unroll
        for (int j = 0; j < 8; ++j) orow[64 * j] = v[j] * rstd * gr[64 * j];
    }
}

constexpr int N_PHASES = 14;
__global__ void __launch_bounds__(NTHR, 2) fwd_kernel(Args args) {
    extern __shared__ __attribute__((aligned(16))) unsigned char lds[];
    Frame F;
    F.lds = (LAS unsigned char*)lds;
    F.tid = threadIdx.x; F.lane = F.tid & 63; F.wave = __builtin_amdgcn_readfirstlane(F.tid >> 6);
    F.G = gridDim.x; F.bid = blockIdx.x; F.ws = args.ws;
    for (int u = F.tid; u < (LDS_BYTES - LDSCTL_OFF) / 4; u += NTHR) ((LAS unsigned*)(F.lds + LDSCTL_OFF))[u] = 0u;
    __syncthreads();
    unsigned* ctl = (unsigned*)(args.ws + WS_CTL);
    XcdBarrier bar; bar.bar = ctl + CW_BAR; bar.x = 0; bar.st = nullptr;
    const bool fused = (args.ph_hi - args.ph_lo) > 1;
    if (fused) bar = xcd_barrier_post(ctl + CW_BAR, (volatile LAS unsigned*)(F.lds + MISC_OFF));
    const int lo = args.ph_lo, hi = args.ph_hi;
    const bool conv_on = fused && CONV_WGS > 0 && F.G == 256;
    const bool conv_wg = conv_on && F.bid >= NCOMP;
    Frame FC = F; if (conv_on) FC.G = NCOMP;
#define IN(k) (lo <= (k) && (k) < hi)
#define REP(k) _Pragma("unroll") for (int _r = 0; _r < 1 + ((DUP_MASK >> (k)) & 1); ++_r)
#define SEAM(k) do { if (IN(k) && IN((k) + 1)) xcd_barrier(bar); } while (0)

    if (IN(0)) REP(0) { p0_prologue(F, args);
        if (!conv_on) { LAS unsigned* scr = (LAS unsigned*)(F.lds + F.wave * 16384);
            for (int it = F.bid * NWAVES + F.wave; it < MOE_ITEMS; it += F.G * NWAVES) if (!CONV_WGS || !((it >= (32 - E_P0) * 1024 && it < 32768) || it >= 32768 + (32 - D_P0) * 512)) moe_item_fp8<false>(F, args, it, scr); }
    } SEAM(0);

    if (IN(1)) REP(1) {
        if (conv_wg) {
            { KvOrder S{(const char*)(F.ws + WS_MEMN), (const char*)(F.ws + WS_WCKV), F.bid - NCOMP}; EpiKV E{F.ws}; pg8::gemm_phase<4096, 32, false>(F.lds, S, E); }
            LAS unsigned* scr = (LAS unsigned*)(F.lds + F.wave * 16384); const int w2 = (F.bid - NCOMP) * NWAVES + F.wave;
            moe_items_stream<false, true>(F, args, w2, CONV_WGS * NWAVES, CONV_NA / (CONV_WGS * NWAVES), scr); }
        else {
        pg8::DenseOrder S; S.init(F.ws + WS_H1, F.ws + WS_WIN, NT, NPROJ, FC.G, F.bid);
        EpiInProj E{F.ws};
        pg8::gemm_phase<4096, 32, false>(F.lds, S, E);
        gla_low_job(FC);
        }
    } SEAM(1);

    if (IN(2)) REP(2) {
        {
        const bool kv_here = !(conv_on && CONV_WGS == 64);
        if (kv_here && F.bid < 64) { KvOrder S{(const char*)(F.ws + WS_MEMN), (const char*)(F.ws + WS_WCKV), F.bid}; EpiKV E{F.ws}; pg8::gemm_phase<4096, 32, false>(F.lds, S, E); }
        REP(14) { if (kv_here && F.G > 64) { if (F.bid >= 64) for (int u = F.bid - 64; u < 512; u += F.G - 64) gla_g1_unit(F, args.in[4], args.in[5], u); }
        else { for (int u = F.bid; u < 512; u += F.G) gla_g1_unit(F, args.in[4], args.in[5], u); } }
        REP(15) { for (int wu = F.bid * NWAVES + F.wave; wu < 2048; wu += F.G * NWAVES) sb_attn_wave(F, args.in[6], wu); }
        }
    } SEAM(2);

    if (IN(3)) REP(3) { gla_scan(F); } SEAM(3);

    if (IN(4)) REP(4) { for (int u = F.bid; u < 512; u += 2 * F.G) gla_g3_pair(F, args.in[7], u, (u + F.G < 512) ? u + F.G : -1); } SEAM(4);

    if (IN(5)) REP(5) {
        if (F.G == 256) {
            MixOrder S; S.D.init(F.ws + WS_MIXO, F.ws + WS_WOUT, NT, DM, F.G, F.bid); S.X = XpreOrder{(const char*)(F.ws + WS_KVK), (const char*)(F.ws + WS_WCQ), (const char*)(F.ws + WS_WCO), (const char*)(F.ws + WS_KVVT), F.bid}; S.c = F.bid;
            EpiMix E{EpiRes1{args.in[0], (float*)(F.ws + WS_X1), (bf16*)(F.ws + WS_X1B), (float*)(F.ws + WS_SSQ)}, EpiXpre{(bf16*)(F.ws + WS_MT), (bf16*)(F.ws + WS_VWT)}};
            pg8::gemm_phase<4096, 0, false>(F.lds, S, E);
        } else {
            { pg8::DenseOrder S; S.init(F.ws + WS_MIXO, F.ws + WS_WOUT, NT, DM, F.G, F.bid); EpiRes1 E{args.in[0], (float*)(F.ws + WS_X1), (bf16*)(F.ws + WS_X1B), (float*)(F.ws + WS_SSQ)}; pg8::gemm_phase<4096, 32, false>(F.lds, S, E); }
            for (int c = F.bid; c < 256; c += F.G) { XpreOrder S{(const char*)(F.ws + WS_KVK), (const char*)(F.ws + WS_WCQ), (const char*)(F.ws + WS_WCO), (const char*)(F.ws + WS_KVVT), c}; EpiXpre E{(bf16*)(F.ws + WS_MT), (bf16*)(F.ws + WS_VWT)}; pg8::gemm_phase<4096, 8, false>(F.lds, S, E); }
        }
    } SEAM(5);

    if (IN(7)) REP(7) {
        if (F.bid < 128) { const int bh = F.bid >> 3, qt = F.bid & 7; xattn_row_scales(F.lds, (const float*)(F.ws + WS_SSQ), (bh >> 2) * SEQ + 256 * qt); }
        { XsOrder S{(const char*)(F.ws + WS_X1B), (const char*)(F.ws + WS_MT), F.bid}; EpiSoftmax E{F.lds, (bf16*)(F.ws + WS_P)};
          pg8::gemm_phase<4096, 32, false>(F.lds, S, E); }
        if (conv_on && F.bid >= 128) {
            LAS unsigned* scr = (LAS unsigned*)(F.lds + F.wave * 16384); const int w2 = (F.bid - 128) * NWAVES + F.wave;
            moe_items_stream<false, true>(F, args, CONV_NA + w2, 1024, CONV_NB / 1024, scr); }
    } SEAM(7);

    if (IN(8)) REP(8) {
        XoutOrder S{(const char*)(F.ws + WS_P), (const char*)(F.ws + WS_VWT), F.bid};
        EpiRes2 E{(const float*)(F.ws + WS_X1), (float*)(F.ws + WS_X2)};
        pg8::gemm_phase<2048, 16, false>(F.lds, S, E);
    } SEAM(8);

    if (IN(9)) REP(9) { router_phase(F, args.in[16]); } SEAM(9);

    if (IN(10)) REP(10) { slots_phase(F, args.in[14]); } SEAM(10);

    if (IN(11)) REP(11) {
        moe_table(F, 16);
        constexpr int PB = MOE_FP8 ? 2048 : 4096;
        if (conv_wg) { for (int seq = E_PRE; seq < 32 - E_P0; ++seq) conv_step(F, args, seq); for (int seq = 32; seq < 32 + DN_IN_P11; ++seq) conv_step(F, args, seq); }
        else {
        int ready = conv_on ? E_PRE - 1 : 31;
        MoeOrder S{(const LAS int*)(F.lds + TAB_OFF), (const char*)(F.ws + WS_XS), (const char*)(F.ws + WS_WGU), 16, FC.G, F.bid, (size_t)2 * DFF * PB, 128, PB, conv_on ? (const unsigned*)(F.ws + WS_CTL) + CW_EXP : nullptr, &ready, 32 - E_P0};
        EpiAct E{args.in[18], (bf16*)(F.ws + WS_ACT)};
        pg8::gemm_phase<PB, MOE_FP8 ? 16 : 32, MOE_FP8 != 0>(F.lds, S, E);
        }
    } SEAM(11);

    if (IN(12)) REP(12) {
        moe_table(F, 8);
        constexpr int PB = MOE_FP8 ? 2048 : 4096;
        if (conv_wg) { for (int seq = 32 + DN_IN_P11; seq < 64 - D_P0; ++seq) conv_step(F, args, seq); }
        else {
        int ready = conv_on ? DN_IN_P11 - 1 : 31;
        MoeOrder S{(const LAS int*)(F.lds + TAB_OFF), (const char*)(F.ws + WS_ACT), (const char*)(F.ws + WS_WD), 8, FC.G, F.bid, (size_t)DM * PB, 256, PB, conv_on ? (const unsigned*)(F.ws + WS_CTL) + CW_EXP + 64 * 32 : nullptr, &ready, 32 - D_P0};
        EpiY E{args.in[20], (const float*)(F.ws + WS_SLOTW), (bf16*)(F.ws + WS_Y)};
        pg8::gemm_phase<PB, MOE_FP8 ? 16 : 32, MOE_FP8 != 0>(F.lds, S, E);
        }
    } SEAM(12);

#ifdef EXTRA_BARS
    if (fused) { for (int i = 0; i < EXTRA_BARS; ++i) xcd_barrier(bar); }
#endif
    if (IN(13)) REP(13) { final_phase(F, args.in[21], args.out); }
#undef IN
#undef SEAM
}

extern "C" void kernel_launch(void* const* d_in, const int* in_sizes, int n_in, void* d_out, int out_size, void* d_ws, size_t ws_size, hipStream_t stream) {
    static int grid = 0;
    if (grid == 0) {
        if (n_in != 22 || out_size != NT * DM || ws_size < WS_END) { fprintf(stderr, "kernel_launch: unexpected problem (n_in %d out %d ws %zu need %zu)\n", n_in, out_size, ws_size, (size_t)WS_END); grid = -1; return; }
        int dev = 0, cus = 0, per_cu = 0;
        if (hipGetDevice(&dev) != hipSuccess || hipDeviceGetAttribute(&cus, hipDeviceAttributeMultiprocessorCount, dev) != hipSuccess) { grid = -1; return; }
        if (hipFuncSetAttribute((const void*)fwd_kernel, hipFuncAttributeMaxDynamicSharedMemorySize, LDS_BYTES) != hipSuccess) { fprintf(stderr, "kernel_launch: hipFuncSetAttribute failed\n"); grid = -1; return; }
        if (hipOccupancyMaxActiveBlocksPerMultiprocessor(&per_cu, (const void*)fwd_kernel, NTHR, LDS_BYTES) != hipSuccess || per_cu < 1) fprintf(stderr, "kernel_launch: occupancy query reports %d\n", per_cu);
        (void)hipGetLastError();
        grid = cus;
    }
    if (grid < 0) return;
    (void)hipMemsetAsync((char*)d_ws + WS_CTL, 0, CTL_ZERO_BYTES, stream);
    Args a{};
    for (int i = 0; i < 22; ++i) a.in[i] = (const float*)d_in[i];
    a.out = (float*)d_out; a.ws = (unsigned char*)d_ws;
#if MK_N_LAUNCHES == 1
    a.ph_lo = 0; a.ph_hi = N_PHASES;
    hipLaunchKernelGGL(fwd_kernel, dim3(grid), dim3(NTHR), LDS_BYTES, stream, a);
#else
    for (int p = 0; p < N_PHASES; ++p) { a.ph_lo = p; a.ph_hi = p + 1; hipLaunchKernelGGL(fwd_kernel, dim3(grid), dim3(NTHR), LDS_BYTES, stream, a); }
#endif
}
```

```cpp
#include <hip/hip_runtime.h>
#include <cstdio>
#include <cstdint>

#ifndef MK_N_LAUNCHES
#define MK_N_LAUNCHES 1
#endif
#ifndef MOE_FP8
#define MOE_FP8 1
#endif
#ifndef CONV_LD_AUX
#define CONV_LD_AUX 18
#endif
#ifndef Y_FP8
#define Y_FP8 1
#endif
#ifndef MX_UNSCALED
#define MX_UNSCALED 1
#endif
#ifndef WCVT_SCALE
#define WCVT_SCALE 0.015625f
#endif
#ifndef DUP_MASK
#define DUP_MASK 0
#endif

#define GAS __attribute__((address_space(1)))
#define LAS __attribute__((address_space(3)))
typedef unsigned short bf16;
typedef short bf16x8 __attribute__((ext_vector_type(8)));
typedef float f32x2 __attribute__((ext_vector_type(2)));
typedef float f32x4 __attribute__((ext_vector_type(4)));
typedef float f32x16 __attribute__((ext_vector_type(16)));
typedef unsigned u32x2 __attribute__((ext_vector_type(2)));
typedef unsigned u32x4 __attribute__((ext_vector_type(4)));
typedef GAS unsigned gu32;

#define LDS_WAIT() asm volatile("s_waitcnt lgkmcnt(0)" ::: "memory")
#define VM_WAIT() asm volatile("s_waitcnt vmcnt(0)" ::: "memory")

constexpr int DM = 2048, NB = 4, SEQ = 2048, NT = NB * SEQ;
constexpr int INC = 6160, NPROJ = 6144;
constexpr int MEMLEN = 256, NMEM = NB * MEMLEN;
constexpr int NEXP = 32, TOPK = 4, NASSIGN = NT * TOPK, DFF = 2048;
constexpr float EPS = 1e-6f;
constexpr float LOG2E = 1.4426950408889634f, LN2 = 0.6931471805599453f;
constexpr int KD = 2048;

typedef __bf16 bf16x2_t __attribute__((ext_vector_type(2)));
__device__ __forceinline__ unsigned cvt_pk_bf16(float lo, float hi) { const f32x2 v = {lo, hi}; const bf16x2_t b = __builtin_convertvector(v, bf16x2_t); return __builtin_bit_cast(unsigned, b); }
__device__ __forceinline__ bf16 f2bf(float f) { return (bf16)(cvt_pk_bf16(f, 0.f) & 0xffffu); }
__device__ __forceinline__ float bf2f(unsigned b) { return __uint_as_float(b << 16); }
__device__ __forceinline__ float bflo(unsigned w) { return __uint_as_float(w << 16); }
__device__ __forceinline__ float bfhi(unsigned w) { return __uint_as_float(w & 0xffff0000u); }
__device__ __forceinline__ void st_bf16x4(bf16* p, f32x4 v) { u32x2 w; w.x = cvt_pk_bf16(v.x, v.y); w.y = cvt_pk_bf16(v.z, v.w); *(u32x2*)p = w; }
__device__ __forceinline__ float wave_sum(float v) {
#pragma unroll
    for (int o = 1; o < 64; o <<= 1) v += __shfl_xor(v, o);
    return v;
}
__device__ __forceinline__ float fexp2(float x) { return __builtin_amdgcn_exp2f(x); }
__device__ __forceinline__ float flog2(float x) { return __builtin_amdgcn_logf(x); }
__device__ __forceinline__ float frcp(float x) { return __builtin_amdgcn_rcpf(x); }
__device__ __forceinline__ float log2_sigmoid2(float z2) { return -(fmaxf(-z2, 0.f) + flog2(1.f + fexp2(-fabsf(z2)))); }

namespace pg8 {
constexpr int BM = 256, BK = 64, HALF = 128, HTB = HALF * BK * 2, STAGE_BYTES = 8 * HTB, NXCD = 8, WGM = 8;
__host__ __device__ __forceinline__ int lds_byte(int r, int c) { const int st = (r >> 4) * 2 + (c >> 5), rr = r & 15, cc = c & 31, ob = rr * 64 + cc * 2; return st * 1024 + (ob ^ (((ob >> 9) & 1) << 5)); }
__host__ __device__ __forceinline__ void stage_rc(int b, int& R, int& C) { const int st = b / 1024, sb = b % 1024, swz = sb ^ (((sb >> 9) & 1) << 5); R = (st >> 1) * 16 + swz / 64; C = (st & 1) * 32 + (swz % 64) / 2; }

typedef int v8i __attribute__((ext_vector_type(8)));
typedef int v4i __attribute__((ext_vector_type(4)));
__device__ __forceinline__ v8i cat8(bf16x8 lo, bf16x8 hi) { const v4i a = __builtin_bit_cast(v4i, lo), b = __builtin_bit_cast(v4i, hi); return (v8i){a.x, a.y, a.z, a.w, b.x, b.y, b.z, b.w}; }
__host__ __device__ __forceinline__ int perm32(int rho) { const int n = rho >> 4, i = rho & 15; return 8 * (i >> 2) + 4 * n + (i & 3); }
struct Unit { const char* a; const char* b; int r0, c0, rows, e, nt; };

struct DenseOrder {
    const char* A; const char* Bt; int nM, nN, nwg, G, c;
    __device__ void init(const void* A_, const void* Bt_, int M, int N, int G_, int c_) { A = (const char*)A_; Bt = (const char*)Bt_; nM = M / BM; nN = N / BM; nwg = nM * nN; G = G_; c = c_; }
    __device__ bool next(int i, Unit& u) const {
        const long L = (long)i * G + c; if (L >= nwg) return false;
        int wgid = (int)L; { const int q = nwg / NXCD, r = nwg % NXCD, xcd = wgid % NXCD, off = wgid / NXCD; wgid = (xcd < r ? xcd * (q + 1) : r * (q + 1) + (xcd - r) * q) + off; }
        const int nig = WGM * nN, gid = wgid / nig, fm = gid * WGM, gsz = (nM - fm) < WGM ? (nM - fm) : WGM;
        const int pm = fm + ((wgid % nig) % gsz), pn = (wgid % nig) / gsz;
        u.a = A + (size_t)pm * BM * KD * 2; u.b = Bt + (size_t)pn * BM * KD * 2; u.r0 = pm * BM; u.c0 = pn * BM; u.rows = BM; u.e = 0; return true;
    }
    __device__ __forceinline__ void a_ready(const Unit&) const {}
};

template <int PITCHB, int NTILES, bool FP8, class Epi, class Sched>
__device__ __forceinline__ void gemm_phase(LAS unsigned char* lds, const Sched& S, const Epi& E) {
    const int tid = threadIdx.x, wid = __builtin_amdgcn_readfirstlane(tid >> 6), lane = tid & 63, wr = wid >> 2, wc = wid & 3, fr = lane & 15, fq = lane >> 4;
    unsigned voffA[2], voffB[2];
#pragma unroll
    for (int i = 0; i < 2; ++i) { int R, C; stage_rc(tid * 16 + i * 8192, R, C); const int Rb = Epi::PERM ? ((R & ~31) + perm32(R & 31)) : R;
        voffA[i] = (unsigned)(R * PITCHB + C * 2); voffB[i] = (unsigned)(Rb * PITCHB + C * 2); }
    const size_t kstep = (size_t)(BK * 2);
    const size_t hstep = (size_t)HALF * PITCHB;
    const unsigned ldsw = (unsigned)wid * 1024u;
    const int aoff = lds_byte(wr * 64 + fr, fq * 8), boff = lds_byte(wc * 32 + fr, fq * 8);
#define PG8_SA(b, h) (((b) * 2 + (h)) * HTB)
#define PG8_SB(b, h) ((4 + (b) * 2 + (h)) * HTB)
#define PG8_STAGE_X(bufoff, gbase, voff) do { _Pragma("unroll") for (int _i = 0; _i < 2; ++_i) \
        __builtin_amdgcn_global_load_lds((const unsigned*)((const char*)(gbase) + (voff)[_i]), (LAS unsigned*)(lds + (bufoff) + ldsw + _i * 8192), 16, 0, 0); } while (0)
#define PG8_STAGE_A(bufoff, gbase) PG8_STAGE_X(bufoff, gbase, voffA)
#define PG8_STAGE_B(bufoff, gbase) PG8_STAGE_X(bufoff, gbase, voffB)
#define PG8_LDA(dst, b, h) do { _Pragma("unroll") for (int m = 0; m < 4; ++m) { if constexpr (FP8) { const v4i _lo = *(const LAS v4i*)(lds + PG8_SA(b, h) + aoff + m * 2048), _hi = *(const LAS v4i*)(lds + PG8_SA(b, h) + aoff + m * 2048 + 1024); \
            dst##8[m] = (v8i){_lo.x, _lo.y, _lo.z, _lo.w, _hi.x, _hi.y, _hi.z, _hi.w}; } \
        else { _Pragma("unroll") for (int k = 0; k < 2; ++k) dst[m][k] = *(const LAS bf16x8*)(lds + PG8_SA(b, h) + aoff + m * 2048 + k * 1024); } } } while (0)
#define PG8_LDB(dst, b, h) do { _Pragma("unroll") for (int n = 0; n < 2; ++n) { if constexpr (FP8) { const v4i _lo = *(const LAS v4i*)(lds + PG8_SB(b, h) + boff + n * 2048), _hi = *(const LAS v4i*)(lds + PG8_SB(b, h) + boff + n * 2048 + 1024); \
            dst##8[n] = (v8i){_lo.x, _lo.y, _lo.z, _lo.w, _hi.x, _hi.y, _hi.z, _hi.w}; } \
        else { _Pragma("unroll") for (int k = 0; k < 2; ++k) dst[n][k] = *(const LAS bf16x8*)(lds + PG8_SB(b, h) + boff + n * 2048 + k * 1024); } } } while (0)
#define PG8_MMA(ai, bj, At, Bt) do { __builtin_amdgcn_s_setprio(1); _Pragma("unroll") for (int m = 0; m < 4; ++m) _Pragma("unroll") for (int n = 0; n < 2; ++n) { \
        if constexpr (FP8) { if constexpr (MX_UNSCALED != 0) asm volatile("v_mfma_f32_16x16x128_f8f6f4 %0, %1, %2, %0" : "+v"(acc[ai][bj][m][n]) : "v"(Bt##8[n]), "v"(At##8[m])); \
            else asm volatile("v_mfma_scale_f32_16x16x128_f8f6f4 %0, %1, %2, %0, %3, %4 op_sel_hi:[0,0,0]" : "+v"(acc[ai][bj][m][n]) : "v"(Bt##8[n]), "v"(At##8[m]), "v"(sclW), "v"(sclA)); } \
        else { _Pragma("unroll") for (int k = 0; k < 2; ++k) acc[ai][bj][m][n] = __builtin_amdgcn_mfma_f32_16x16x32_bf16(Bt[n][k], At[m][k], acc[ai][bj][m][n], 0, 0, 0); } } \
        __builtin_amdgcn_s_setprio(0); } while (0)
#define PG8_WAIT_V(n) asm volatile("s_waitcnt vmcnt(" #n ")" ::: "memory")
#define PG8_WAIT_L(n) asm volatile("s_waitcnt lgkmcnt(" #n ")" ::: "memory")
#define PG8_BAR __builtin_amdgcn_s_barrier()
#define PG8_SCHED __builtin_amdgcn_sched_barrier(0)
    Unit cur, nxt; int ui = 0;
    if (!S.next(0, cur)) return;
    f32x4 acc[2][2][4][2];
#pragma unroll
    for (int a = 0; a < 2; ++a)
#pragma unroll
        for (int b = 0; b < 2; ++b)
#pragma unroll
            for (int m = 0; m < 4; ++m)
#pragma unroll
                for (int n = 0; n < 2; ++n) acc[a][b][m][n] = (f32x4){0.f, 0.f, 0.f, 0.f};
    const int sclW = 0x79797979, sclA = 0x7f7f7f7f;
    bf16x8 At[4][2], B0[2][2], B1[2][2]; v8i At8[4], B08[2], B18[2];
    const char* cA = cur.a; const char* cB = cur.b;
    S.a_ready(cur);
    PG8_STAGE_B(PG8_SB(0, 0), cB); PG8_STAGE_B(PG8_SB(0, 1), cB + hstep); PG8_STAGE_A(PG8_SA(0, 0), cA); PG8_STAGE_A(PG8_SA(0, 1), cA + hstep);
    if (wr == 1) PG8_BAR;
    PG8_WAIT_V(2); PG8_BAR;
    PG8_STAGE_B(PG8_SB(1, 0), cB + kstep); PG8_STAGE_A(PG8_SA(1, 0), cA + kstep); PG8_STAGE_B(PG8_SB(1, 1), cB + hstep + kstep);
    PG8_WAIT_V(6); PG8_BAR;
    for (;;) {
        const bool has_next = S.next(ui + 1, nxt);
        const char* nA = has_next ? nxt.a : cA; const char* nB = has_next ? nxt.b : cB;
        const int nt = NTILES > 0 ? NTILES : cur.nt;
#pragma nounroll
        for (int t = 0; t < nt; t += 2) {
            const bool last = (t == nt - 2);
            const char* a1 = cA + (size_t)(t + 1) * kstep;
            const char* a2 = last ? nA : cA + (size_t)(t + 2) * kstep; const char* b2 = last ? nB : cB + (size_t)(t + 2) * kstep;
            const char* a3 = a2 + kstep; const char* b3 = b2 + kstep;
            if (last && has_next) S.a_ready(nxt);
            PG8_LDB(B0, 0, 0); PG8_LDB(B1, 0, 1); PG8_SCHED; PG8_LDA(At, 0, 0); PG8_STAGE_A(PG8_SA(1, 1), a1 + hstep);
            PG8_WAIT_V(8); PG8_WAIT_L(0); PG8_BAR; PG8_MMA(0, 0, At, B0); PG8_MMA(0, 1, At, B1); PG8_BAR; PG8_SCHED;
            PG8_LDA(At, 0, 1); PG8_STAGE_B(PG8_SB(0, 0), b2); PG8_STAGE_B(PG8_SB(0, 1), b2 + hstep); PG8_STAGE_A(PG8_SA(0, 0), a2);
            PG8_WAIT_V(8); PG8_WAIT_L(0); PG8_BAR; PG8_MMA(1, 0, At, B0); PG8_MMA(1, 1, At, B1); PG8_BAR; PG8_SCHED;
            PG8_LDB(B0, 1, 0); PG8_LDB(B1, 1, 1); PG8_SCHED; PG8_LDA(At, 1, 0); PG8_STAGE_A(PG8_SA(0, 1), a2 + hstep);
            PG8_WAIT_V(8); PG8_WAIT_L(0); PG8_BAR; PG8_MMA(0, 0, At, B0); PG8_MMA(0, 1, At, B1); PG8_BAR; PG8_SCHED;
            PG8_LDA(At, 1, 1); PG8_STAGE_B(PG8_SB(1, 0), b3); PG8_STAGE_B(PG8_SB(1, 1), b3 + hstep); PG8_STAGE_A(PG8_SA(1, 0), a3);
            PG8_WAIT_V(8); PG8_WAIT_L(0); PG8_BAR; PG8_MMA(1, 0, At, B0); PG8_MMA(1, 1, At, B1); PG8_BAR; PG8_SCHED;
        }
        if constexpr (FP8) {
            asm volatile("s_nop 15\n\ts_nop 15" : "+v"(acc[0][0][0][0]), "+v"(acc[0][0][0][1]), "+v"(acc[0][0][1][0]), "+v"(acc[0][0][1][1]), "+v"(acc[0][0][2][0]), "+v"(acc[0][0][2][1]), "+v"(acc[0][0][3][0]), "+v"(acc[0][0][3][1]) :: "memory");
            asm volatile("" : "+v"(acc[0][1][0][0]), "+v"(acc[0][1][0][1]), "+v"(acc[0][1][1][0]), "+v"(acc[0][1][1][1]), "+v"(acc[0][1][2][0]), "+v"(acc[0][1][2][1]), "+v"(acc[0][1][3][0]), "+v"(acc[0][1][3][1]));
            asm volatile("" : "+v"(acc[1][0][0][0]), "+v"(acc[1][0][0][1]), "+v"(acc[1][0][1][0]), "+v"(acc[1][0][1][1]), "+v"(acc[1][0][2][0]), "+v"(acc[1][0][2][1]), "+v"(acc[1][0][3][0]), "+v"(acc[1][0][3][1]));
            asm volatile("" : "+v"(acc[1][1][0][0]), "+v"(acc[1][1][0][1]), "+v"(acc[1][1][1][0]), "+v"(acc[1][1][1][1]), "+v"(acc[1][1][2][0]), "+v"(acc[1][1][2][1]), "+v"(acc[1][1][3][0]), "+v"(acc[1][1][3][1]));
        }
        if (wr == 0) PG8_BAR;
        E(acc, cur, wr, wc, fr, fq);
        if (!has_next) break;
#pragma unroll
        for (int a = 0; a < 2; ++a)
#pragma unroll
            for (int b = 0; b < 2; ++b)
#pragma unroll
                for (int m = 0; m < 4; ++m)
#pragma unroll
                    for (int n = 0; n < 2; ++n) acc[a][b][m][n] = (f32x4){0.f, 0.f, 0.f, 0.f};
        cur = nxt; cA = nA; cB = nB; ++ui;
        if (wr == 1) PG8_BAR;
    }
    PG8_WAIT_V(0);
    PG8_BAR;
#undef PG8_SA
#undef PG8_SB
#undef PG8_STAGE_X
#undef PG8_STAGE_A
#undef PG8_STAGE_B
#undef PG8_LDA
#undef PG8_LDB
#undef PG8_MMA
#undef PG8_WAIT_V
#undef PG8_WAIT_L
#undef PG8_BAR
#undef PG8_SCHED
}
}
using pg8::Unit;

#define XB_TMO      128
#define XB_XCNT(j)  (256  + 64 * (j))
#define XB_XSUB(j)  (1280 + 64 * (j))
#define XB_XGEN(j)  (2304 + 64 * (j))
#define XB_TOP      3328
#define XB_TOPGEN   3392
#define XCD_BAR_WORDS 3456
#define XB_SPIN_CAP (1u << 22)
__device__ __forceinline__ unsigned xb_ld(unsigned* p)              { return __hip_atomic_load(p, __ATOMIC_RELAXED, __HIP_MEMORY_SCOPE_AGENT); }
__device__ __forceinline__ unsigned xb_add(unsigned* p, unsigned v) { return __hip_atomic_fetch_add(p, v, __ATOMIC_RELAXED, __HIP_MEMORY_SCOPE_AGENT); }
__device__ __forceinline__ unsigned xb_xcc_id() { return (unsigned)__builtin_amdgcn_s_getreg((3 << 11) | 20) & 0xFu; }
#define XB_SPIN(cond, bar) do { unsigned _sp = 0; while (cond) { __builtin_amdgcn_s_sleep(1); \
    if ((++_sp & 255u) == 0u) { if (xb_ld(&(bar)[XB_TMO])) break; if (_sp > XB_SPIN_CAP) { atomicAdd(&(bar)[XB_TMO], 1u); break; } } } } while (0)
struct XcdBarrier { unsigned* bar; unsigned x; volatile LAS unsigned* st; };
__device__ __forceinline__ XcdBarrier xcd_barrier_post(unsigned* bar, volatile LAS unsigned* st) {
    XcdBarrier b; b.bar = bar; b.x = xb_xcc_id(); b.st = st;
    if (threadIdx.x == 0) (void)xb_add(&bar[XB_XCNT(b.x)], 1u);
    return b;
}
__device__ __forceinline__ void xcd_barrier_complete(unsigned* bar, unsigned x, unsigned& nloc, unsigned& nx) {
    const unsigned G = gridDim.x * gridDim.y * gridDim.z;
    unsigned sum, cnt, mine, sp = 0u;
    for (;;) {
        sum = 0u; cnt = 0u; mine = 0u;
#pragma unroll
        for (unsigned j = 0; j < 16; ++j) { const unsigned c = xb_ld(&bar[XB_XCNT(j)]); sum += c; cnt += (c > 0u) ? 1u : 0u; mine = (j == x) ? c : mine; }
        if (sum == G) break;
        __builtin_amdgcn_s_sleep(1);
        if ((++sp & 255u) == 0u) { if (xb_ld(&bar[XB_TMO])) break; if (sp > XB_SPIN_CAP) { atomicAdd(&bar[XB_TMO], 1u); break; } }
    }
    nloc = mine > 0u ? mine : 1u; nx = cnt > 0u ? cnt : 1u;
}
__device__ __forceinline__ void xcd_barrier(const XcdBarrier& b) {
    asm volatile("s_waitcnt vmcnt(0)" ::: "memory");
    __syncthreads();
    if (threadIdx.x == 0) {
        unsigned* bar = b.bar;
        __builtin_amdgcn_s_waitcnt(0);
        unsigned nloc = b.st[0], nx = b.st[1];
        if (nloc == 0u) { xcd_barrier_complete(bar, b.x, nloc, nx); b.st[0] = nloc; b.st[1] = nx; }
        const unsigned old = xb_add(&bar[XB_XSUB(b.x)], 1u);
        const unsigned gen = old / nloc;
        if (old + 1u == (gen + 1u) * nloc) {
            __builtin_amdgcn_fence(__ATOMIC_RELEASE, "agent");
            asm volatile("s_waitcnt vmcnt(0)" ::: "memory");
            const unsigned og = xb_add(&bar[XB_TOP], 1u);
            const unsigned tg = og / nx;
            if (og + 1u == (tg + 1u) * nx) xb_add(&bar[XB_TOPGEN], 1u);
            else XB_SPIN(xb_ld(&bar[XB_TOPGEN]) == tg, bar);
            __builtin_amdgcn_fence(__ATOMIC_ACQUIRE, "agent");
            xb_add(&bar[XB_XGEN(b.x)], 1u);
            asm volatile("s_waitcnt vmcnt(0)" ::: "memory");
        } else {
            XB_SPIN(xb_ld(&bar[XB_XGEN(b.x)]) == gen, bar);
            __builtin_amdgcn_fence(__ATOMIC_ACQUIRE, "agent");
            asm volatile("s_waitcnt vmcnt(0)" ::: "memory");
        }
    }
    __syncthreads();
}

constexpr size_t MiB = 1u << 20;
constexpr size_t al(size_t x) { return (x + 255) & ~(size_t)255; }
constexpr size_t WS_CTL = 0, CTL_ZERO_BYTES = 1 * MiB;
constexpr size_t WS_WIN = 1 * MiB;
constexpr size_t WS_WLOW = WS_WIN + (size_t)NPROJ * KD * 2;
constexpr size_t WS_WRH = WS_WLOW + 16 * KD * 2;
constexpr size_t WS_WRL = WS_WRH + 32 * KD * 2;
constexpr size_t WS_WOUT = WS_WRL + 32 * KD * 2;
constexpr size_t WS_WCQ = WS_WOUT + (size_t)DM * KD * 2;
constexpr size_t WS_WCKV = WS_WCQ + (size_t)DM * KD * 2;
constexpr size_t WS_WCO = WS_WCKV + (size_t)2 * DM * KD * 2;
constexpr size_t WS_WGU = WS_WCO + (size_t)DM * KD * 2;
constexpr size_t WS_WD = WS_WGU + (size_t)NEXP * 2 * DFF * KD * 2;
constexpr size_t WS_H1 = WS_WD + (size_t)NEXP * DM * KD * 2;
constexpr size_t WS_MEMN = WS_H1 + (size_t)NT * DM * 2;
constexpr size_t WS_SBQ = WS_MEMN + (size_t)NMEM * DM * 2;
constexpr size_t WS_SBK = WS_SBQ + (size_t)NT * 1024 * 2;
constexpr size_t WS_SBVT = WS_SBK + (size_t)NT * 1024 * 2;
constexpr size_t WS_GQ = WS_SBVT + (size_t)NT * 1024 * 2;
constexpr size_t WS_GK = WS_GQ + (size_t)NT * 512 * 2;
constexpr size_t WS_GVT = WS_GK + (size_t)NT * 512 * 2;
constexpr size_t WS_GR = WS_GVT + (size_t)NT * 1024 * 2;
constexpr size_t WS_GLOW = WS_GR + (size_t)NT * 1024 * 2;
constexpr size_t WS_KVK = WS_GLOW + (size_t)NT * 16 * 4;
constexpr size_t WS_KVVT = WS_KVK + (size_t)NMEM * DM * 2;
constexpr size_t WS_QIN = WS_KVVT + (size_t)NMEM * DM * 2;
constexpr size_t WS_OINTRA = WS_QIN + (size_t)NT * 512 * 2;
constexpr size_t WS_KVN = WS_OINTRA + (size_t)512 * 16384 * 4;
constexpr size_t WS_DECAY = WS_KVN + (size_t)512 * 32768 * 4;
constexpr size_t WS_STATE = WS_DECAY + (size_t)512 * 128 * 4;
constexpr size_t WS_MIXO = WS_STATE + (size_t)512 * 32768 * 2;
constexpr size_t WS_X1 = WS_MIXO + (size_t)NT * DM * 2;
constexpr size_t WS_X1B = WS_X1 + (size_t)NT * DM * 4;
constexpr size_t WS_SSQ = WS_X1B + (size_t)NT * DM * 2;
constexpr size_t WS_CQ = WS_SSQ + (size_t)32 * NT * 4;
constexpr size_t WS_ATTO = WS_CQ + (size_t)NT * DM * 2;
constexpr size_t WS_X2 = WS_ATTO + (size_t)NT * DM * 2;
constexpr size_t WS_TOPE = WS_X2 + (size_t)NT * DM * 4;
constexpr size_t WS_TOPW = WS_TOPE + (size_t)NT * 4 * 4;
constexpr size_t WS_RSTD3 = WS_TOPW + (size_t)NT * 4 * 4;
constexpr size_t WS_HIST = WS_RSTD3 + (size_t)NT * 4;
constexpr size_t WS_SLOTW = WS_HIST + (size_t)256 * 32 * 4;
constexpr size_t WS_TOKSLOT = WS_SLOTW + (size_t)(NASSIGN + 256) * 4;
constexpr size_t WS_CNT = WS_TOKSLOT + (size_t)NT * 4 * 4;
constexpr size_t WS_XS = al(WS_CNT + 256);
constexpr size_t WS_ACT = WS_XS + (size_t)(NASSIGN + 256) * DM * 2;
constexpr size_t WS_Y = WS_ACT + (size_t)(NASSIGN + 256) * DM * 2;
constexpr size_t WS_P = WS_Y + (size_t)(NASSIGN + 256) * DM * 2;
constexpr size_t WS_MT = WS_P + (size_t)16 * SEQ * MEMLEN * 2;
constexpr size_t WS_VWT = WS_MT + (size_t)16 * MEMLEN * DM * 2;
constexpr size_t WS_END = WS_VWT + (size_t)NB * DM * 1024 * 2;

constexpr int CW_BAR = 4096;
static_assert((CW_BAR + XCD_BAR_WORDS) * 4 <= (int)CTL_ZERO_BYTES, "ctl");

constexpr int RING_BYTES = 131072, LDSCTL_OFF = RING_BYTES, MISC_OFF = LDSCTL_OFF + 64, TAB_OFF = LDSCTL_OFF + 256;
constexpr int RED1_OFF = LDSCTL_OFF + 2048, RED2_OFF = RED1_OFF + 4096;
constexpr int LDS_BYTES = 147456;

constexpr int NWAVES = 8, NTHR = 512;

struct Args { const float* in[22]; float* out; unsigned char* ws; int ph_lo, ph_hi; };

struct Frame {
    LAS unsigned char* lds;
    int tid, lane, wave, G, bid;
    unsigned char* ws;
};

__device__ __forceinline__ void cvt_tile(const float* __restrict__ W, int ldn, int k0, int n0, bf16* __restrict__ dst, int dst_row0, const float* __restrict__ gk, LAS unsigned* scr, int lane) {
    const int q = lane >> 4, c4 = lane & 15;
    f32x4 v[16];
#pragma unroll
    for (int i = 0; i < 16; ++i) { const int k = k0 + 8 * (i >> 1) + 2 * q + (i & 1); v[i] = *(const f32x4*)(W + (size_t)k * ldn + n0 + 4 * c4); if (gk) v[i] = v[i] * gk[k]; }
#pragma unroll
    for (int p = 0; p < 8; ++p)
#pragma unroll
        for (int j = 0; j < 4; ++j) { const int n = 4 * c4 + j, kd = 4 * p + q; scr[n * 32 + (kd ^ ((c4 & 7) << 2))] = cvt_pk_bf16(v[2 * p][j], v[2 * p + 1][j]); }
    LDS_WAIT();
#pragma unroll
    for (int jj = 0; jj < 8; ++jj) { const int n = 8 * jj + (lane >> 3), ch = lane & 7; const u32x4 w = *(const LAS u32x4*)(scr + n * 32 + ((ch ^ ((n >> 2) & 7)) << 2));
        *(u32x4*)(dst + (size_t)(dst_row0 + n) * KD + k0 + 8 * ch) = w; }
    LDS_WAIT();
}
__device__ __forceinline__ unsigned pk_fp8x4(float a, float b, float c, float d) { int r = __builtin_amdgcn_cvt_pk_fp8_f32(a, b, 0, false); r = __builtin_amdgcn_cvt_pk_fp8_f32(c, d, r, true); return (unsigned)r; }
__device__ __forceinline__ void rms_row_bf16(const float* __restrict__ xrow, const float* __restrict__ g, bf16* __restrict__ orow, int lane) {
    const f32x4* xr = (const f32x4*)xrow + lane; const f32x4* gr = (const f32x4*)g + lane;
    f32x4 v[8]; float s = 0.f;
#pragma unroll
    for (int j = 0; j < 8; ++j) { v[j] = xr[64 * j]; s += (v[j].x * v[j].x + v[j].y * v[j].y) + (v[j].z * v[j].z + v[j].w * v[j].w); }
    const float rstd = 1.0f / sqrtf(wave_sum(s) * (1.f / DM) + EPS);
    u32x2* o8 = (u32x2*)orow + lane;
#pragma unroll
    for (int j = 0; j < 8; ++j) { const f32x4 gg = gr[64 * j]; u32x2 w; w.x = cvt_pk_bf16(v[j].x * rstd * gg.x, v[j].y * rstd * gg.y); w.y = cvt_pk_bf16(v[j].z * rstd * gg.z, v[j].w * rstd * gg.w); o8[64 * j] = w; }
}

constexpr int MOE_ITEMS = NEXP * 64 * 16 + NEXP * 32 * 16;
#ifndef X1_F32
#define X1_F32 0
#endif
#ifndef CONV_WGS
#define CONV_WGS 64
#endif
#ifndef E_P1
#define E_P1 9
#endif
constexpr int E_P7 = 7, E_PRE = E_P1 + E_P7;
#ifndef DN_IN_P11
#define DN_IN_P11 16
#endif
#ifndef E_P0
#define E_P0 0
#endif
#ifndef D_P0
#define D_P0 0
#endif
constexpr int NCOMP = 256 - CONV_WGS, CONV_NA = E_P1 * 1024, CONV_NB = E_P7 * 1024;
constexpr int CW_EXP = 8192;
static_assert(E_PRE + E_P0 <= 32 && DN_IN_P11 + D_P0 <= 32, "expert conversion ranges");
struct MoeItem { const float* W; int ldn, k0, n0; unsigned char* dst; int drow; };
__device__ __forceinline__ MoeItem moe_item_desc(const Frame& F, const Args& A, int it) {
    constexpr int J5 = NEXP * 64 * 16; MoeItem m;
    if (it < J5) { const int e = it >> 10, r = it & 1023, kt = r >> 6, n0 = (r & 63) * 64;
        m.W = A.in[17] + (size_t)e * DM * 2 * DFF; m.ldn = 2 * DFF; m.k0 = kt * 128; m.n0 = n0; m.dst = F.ws + WS_WGU + (size_t)e * 2 * DFF * KD;
        m.drow = (n0 < DFF) ? ((n0 >> 7) * 256 + (n0 & 127)) : (((n0 - DFF) >> 7) * 256 + 128 + ((n0 - DFF) & 127)); }
    else { const int q2 = it - J5, e = q2 >> 9, r = q2 & 511, kt = r >> 5, n0 = (r & 31) * 64;
        m.W = A.in[19] + (size_t)e * DFF * DM; m.ldn = DM; m.k0 = kt * 128; m.n0 = n0; m.dst = F.ws + WS_WD + (size_t)e * DM * KD; m.drow = n0; }
    return m;
}
template <bool SLD> __device__ __forceinline__ void moe_ld_half(f32x4 (&v)[16], const MoeItem& m, int half, int lane) {
    const int q = lane >> 4, c4 = lane & 15;
    if constexpr (SLD) { const __amdgpu_buffer_rsrc_t rw = __builtin_amdgcn_make_buffer_rsrc((void*)m.W, 0, 0x7fffffff, 0x00020000);
        const int vo = ((m.k0 + 64 * half + 4 * q) * m.ldn + m.n0 + 4 * c4) * 4;
#pragma unroll
        for (int i = 0; i < 16; ++i) v[i] = __builtin_bit_cast(f32x4, __builtin_amdgcn_raw_buffer_load_b128(rw, vo, (16 * (i >> 2) + (i & 3)) * m.ldn * 4, CONV_LD_AUX)); }
    else {
#pragma unroll
        for (int i = 0; i < 16; ++i) { const int k = m.k0 + 64 * half + 16 * (i >> 2) + 4 * q + (i & 3); v[i] = __builtin_nontemporal_load((const f32x4*)(m.W + (size_t)k * m.ldn + m.n0 + 4 * c4)); } }
}
typedef short v2s16 __attribute__((ext_vector_type(2)));
__device__ __forceinline__ unsigned pk_fp8x4_scaled(float a, float b, float c, float d, float scale) { v2s16 r; asm volatile("" : "=v"(r));
    r = __builtin_amdgcn_cvt_scalef32_pk_fp8_f32(r, a, b, scale, false); r = __builtin_amdgcn_cvt_scalef32_pk_fp8_f32(r, c, d, scale, true); return __builtin_bit_cast(unsigned, r); }
__device__ __forceinline__ void moe_cv_half(const f32x4 (&v)[16], LAS unsigned* scr, int half, int lane) {
    const int q = lane >> 4, c4 = lane & 15;
#pragma unroll
    for (int pp = 0; pp < 4; ++pp)
#pragma unroll
        for (int j = 0; j < 4; ++j) scr[(4 * c4 + j) * 33 + 16 * half + 4 * pp + q] = pk_fp8x4_scaled(v[4 * pp][j], v[4 * pp + 1][j], v[4 * pp + 2][j], v[4 * pp + 3][j], WCVT_SCALE);
}
template <bool SC1> __device__ __forceinline__ void moe_flush(const MoeItem& m, LAS unsigned* scr, int lane) {
#pragma unroll
    for (int jj = 0; jj < 8; ++jj) { const int n = 8 * jj + (lane >> 3), ch = lane & 7; u32x4 w; const LAS unsigned* sp = scr + n * 33 + 4 * ch; w.x = sp[0]; w.y = sp[1]; w.z = sp[2]; w.w = sp[3];
        if constexpr (SC1) { const __amdgpu_buffer_rsrc_t rs = __builtin_amdgcn_make_buffer_rsrc(m.dst, 0, 0x7fffffff, 0x00020000);
            __builtin_amdgcn_raw_buffer_store_b128(w, rs, (m.drow + n) * KD + m.k0 + 16 * ch, 0, 16); }
        else __builtin_nontemporal_store(w, (u32x4*)(m.dst + (size_t)(m.drow + n) * KD + m.k0 + 16 * ch)); }
}
template <bool SC1, bool SLD> __device__ __forceinline__ void moe_items_stream(const Frame& F, const Args& A, int it0, int stride, int count, LAS unsigned* scr) {
    if (count <= 0) return;
    f32x4 va[16], vb[16];
    MoeItem cur = moe_item_desc(F, A, it0);
    moe_ld_half<SLD>(va, cur, 0, F.lane);
    for (int i = 0; i < count; ++i) {
        moe_ld_half<SLD>(vb, cur, 1, F.lane);
        moe_cv_half(va, scr, 0, F.lane);
        MoeItem nxt = cur;
        if (i + 1 < count) { nxt = moe_item_desc(F, A, it0 + (i + 1) * stride); moe_ld_half<SLD>(va, nxt, 0, F.lane); }
        moe_cv_half(vb, scr, 1, F.lane);
        LDS_WAIT();
        moe_flush<SC1>(cur, scr, F.lane);
        LDS_WAIT();
        cur = nxt;
    }
}
template <bool SC1, bool SLD = SC1> __device__ __forceinline__ void moe_item_fp8(const Frame& F, const Args& A, int it, LAS unsigned* scr) { moe_items_stream<SC1, SLD>(F, A, it, 0, 1, scr); }
__device__ __forceinline__ void p0_prologue(const Frame& F, const Args& A) {
    LAS unsigned* scr = (LAS unsigned*)(F.lds + F.wave * 16384);
    const int gw = F.bid * NWAVES + F.wave, NGW = F.G * NWAVES;
    const float* w_in = A.in[3]; const float* w_out = A.in[8]; const float* w_cq = A.in[11]; const float* w_ckv = A.in[12]; const float* w_co = A.in[13];
    const float* w_gu = A.in[17]; const float* w_dn = A.in[19]; (void)w_gu; (void)w_dn;
    constexpr int I0 = 96 * 32, I1 = 32 * 32, I2 = 0, I3 = 64 * 32, I4 = 32 * 32, I5 = MOE_FP8 ? 0 : NEXP * 64 * 32, I6 = MOE_FP8 ? 0 : NEXP * 32 * 32;
    constexpr int NITEMS = I0 + I1 + I2 + I3 + I4 + I5 + I6;
    for (int it = gw; it < NITEMS; it += NGW) {
        int r = it; const float* W; int ldn, nct; bf16* dst; const float* gk = nullptr; int mode = 0;
        if (r < I0) { W = w_in; ldn = INC; nct = 96; dst = (bf16*)(F.ws + WS_WIN); }
        else if ((r -= I0) < I1) { W = w_out; ldn = DM; nct = 32; dst = (bf16*)(F.ws + WS_WOUT); }
        else if ((r -= I1) < I3) { W = w_ckv; ldn = 2 * DM; nct = 64; dst = (bf16*)(F.ws + WS_WCKV); }
        else if ((r -= I3) < I4) { W = w_co; ldn = DM; nct = 32; dst = (bf16*)(F.ws + WS_WCO); }
        else if ((r -= I4) < I5) { const int e = r / (64 * 32); r -= e * (64 * 32); W = w_gu + (size_t)e * DM * 2 * DFF; ldn = 2 * DFF; nct = 64; dst = (bf16*)(F.ws + WS_WGU) + (size_t)e * 2 * DFF * KD; mode = 1; }
        else { r -= I5; const int e = r / (32 * 32); r -= e * (32 * 32); W = w_dn + (size_t)e * DFF * DM; ldn = DM; nct = 32; dst = (bf16*)(F.ws + WS_WD) + (size_t)e * DM * KD; }
        const int kt = r / nct, ct = r - kt * nct; const int n0 = ct * 64;
        int drow = n0;
        if (mode == 1) drow = (n0 < DFF) ? ((n0 >> 7) * 256 + (n0 & 127)) : (((n0 - DFF) >> 7) * 256 + 128 + ((n0 - DFF) & 127));
        cvt_tile(W, ldn, kt * 64, n0, dst, drow, gk, scr, F.lane);
    }
#if MOE_FP8
    if (CONV_WGS) {
        for (int it = (32 - E_P0) * 1024 + gw; it < 32768; it += NGW) moe_item_fp8<false>(F, A, it, scr);
        for (int it = 32768 + (32 - D_P0) * 512 + gw; it < MOE_ITEMS; it += NGW) moe_item_fp8<false>(F, A, it, scr);
    }
#endif
    {
        const int gt = F.bid * NTHR + F.tid, NGT = F.G * NTHR;
        bf16* wlow = (bf16*)(F.ws + WS_WLOW); bf16* wrh = (bf16*)(F.ws + WS_WRH); bf16* wrl = (bf16*)(F.ws + WS_WRL);
        const float* w_r = A.in[15]; const float* g_moe = A.in[14];
        { const float* g_cross = A.in[9]; bf16* wcqn = (bf16*)(F.ws + WS_WCQ);
          for (int i = gt; i < DM * DM / 4; i += NGT) { const int k = i >> 9; const f32x4 v = *((const f32x4*)w_cq + i) * g_cross[k]; st_bf16x4(wcqn + (size_t)i * 4, v); } }
        for (int i = gt; i < 16 * KD; i += NGT) { const int k = i >> 4, r = i & 15; wlow[r * KD + k] = f2bf(w_in[(size_t)k * INC + NPROJ + r]); }
        for (int i = gt; i < 32 * KD; i += NGT) { const int k = i >> 5, e = i & 31; const float w = w_r[k * 32 + e] * g_moe[k]; const bf16 h = f2bf(w); wrh[e * KD + k] = h; wrl[e * KD + k] = f2bf(w - bf2f(h)); }
    }
    for (int m = gw; m < NT + NMEM; m += NGW) {
        if (m < NT) rms_row_bf16(A.in[0] + (size_t)m * DM, A.in[2], (bf16*)(F.ws + WS_H1) + (size_t)m * DM, F.lane);
        else rms_row_bf16(A.in[1] + (size_t)(m - NT) * DM, A.in[10], (bf16*)(F.ws + WS_MEMN) + (size_t)(m - NT) * DM, F.lane);
    }
}

__device__ __forceinline__ void conv_step(const Frame& F, const Args& A, int seq) {
    LAS unsigned* scr = (LAS unsigned*)(F.lds + F.wave * 16384);
    const int cw = F.bid - NCOMP;
    if (seq < 32) moe_items_stream<true, true>(F, A, seq * 1024 + (cw * NWAVES + F.wave) * 2, 1, 2, scr);
    else moe_item_fp8<true>(F, A, 32768 + (seq - 32) * 512 + cw * NWAVES + F.wave, scr);
    VM_WAIT(); __syncthreads();
    if (F.tid == 0) __hip_atomic_fetch_add((unsigned*)(F.ws + WS_CTL) + CW_EXP + 64 * seq, 1u, __ATOMIC_RELAXED, __HIP_MEMORY_SCOPE_AGENT);
}

#define EPI_LOOP(...) _Pragma("unroll") for (int ai = 0; ai < 2; ++ai) _Pragma("unroll") for (int m = 0; m < 4; ++m) { const int rl = ai * 128 + wr * 64 + m * 16 + fr; \
        _Pragma("unroll") for (int bj = 0; bj < 2; ++bj) _Pragma("unroll") for (int n = 0; n < 2; ++n) { const int cl = bj * 128 + wc * 32 + n * 16 + 4 * fq; const f32x4 v = acc[ai][bj][m][n]; __VA_ARGS__ } }
#define EPI_LOOP_P(...) _Pragma("unroll") for (int ai = 0; ai < 2; ++ai) _Pragma("unroll") for (int m = 0; m < 4; ++m) { const int rl = ai * 128 + wr * 64 + m * 16 + fr; \
        _Pragma("unroll") for (int bj = 0; bj < 2; ++bj) { const int cl = bj * 128 + wc * 32 + 8 * fq; const f32x4 v0 = acc[ai][bj][m][0], v1 = acc[ai][bj][m][1]; __VA_ARGS__ } }
__device__ __forceinline__ void st_bf16x8(bf16* p, f32x4 a, f32x4 b) { u32x4 w; w.x = cvt_pk_bf16(a.x, a.y); w.y = cvt_pk_bf16(a.z, a.w); w.z = cvt_pk_bf16(b.x, b.y); w.w = cvt_pk_bf16(b.z, b.w); *(u32x4*)p = w; }

struct EpiInProj {
    static constexpr bool PERM = true;
    unsigned char* ws;
    __device__ __forceinline__ void operator()(f32x4 (&acc)[2][2][4][2], const Unit& u, int wr, int wc, int fr, int fq) const {
        const int c0 = u.c0;
        if (c0 < 2048 || (c0 >= 3072 && c0 < 4096) || c0 >= 5120) {
            bf16* base; int ld, cc;
            if (c0 < 1024) { base = (bf16*)(ws + WS_SBQ); ld = 1024; cc = c0; }
            else if (c0 < 2048) { base = (bf16*)(ws + WS_SBK); ld = 1024; cc = c0 - 1024; }
            else if (c0 < 3584) { base = (bf16*)(ws + WS_GQ); ld = 512; cc = c0 - 3072; }
            else if (c0 < 4096) { base = (bf16*)(ws + WS_GK); ld = 512; cc = c0 - 3584; }
            else { base = (bf16*)(ws + WS_GR); ld = 1024; cc = c0 - 5120; }
            EPI_LOOP_P( st_bf16x8(base + (size_t)(u.r0 + rl) * ld + cc + cl, v0, v1); )
        } else {
            bf16* base = (bf16*)(ws + (c0 < 3072 ? WS_SBVT : WS_GVT)); const int cc = c0 - (c0 < 3072 ? 2048 : 4096);
            EPI_LOOP_P( const int r = u.r0 + rl, b = r >> 11, sq = r & 2047; const int c = cc + cl;
                _Pragma("unroll") for (int j = 0; j < 4; ++j) { base[((size_t)(b * 1024 + c + j)) * SEQ + sq] = f2bf(v0[j]); base[((size_t)(b * 1024 + c + 4 + j)) * SEQ + sq] = f2bf(v1[j]); } )
        }
    }
};
struct EpiKV {
    static constexpr bool PERM = true;
    unsigned char* ws;
    __device__ __forceinline__ void operator()(f32x4 (&acc)[2][2][4][2], const Unit& u, int wr, int wc, int fr, int fq) const {
        bf16* base = (bf16*)(ws + (u.c0 < 2048 ? WS_KVK : WS_KVVT)); const int cc = u.c0 < 2048 ? u.c0 : u.c0 - 2048;
        EPI_LOOP_P( st_bf16x8(base + (size_t)(u.r0 + rl) * DM + cc + cl, v0, v1); )
    }
};
struct EpiRes1 {
    static constexpr bool PERM = true;
    const float* x; float* x1; bf16* x1b; float* ssq;
    __device__ __forceinline__ void operator()(f32x4 (&acc)[2][2][4][2], const Unit& u, int wr, int wc, int fr, int fq) const {
#pragma unroll
        for (int ai = 0; ai < 2; ++ai)
#pragma unroll
            for (int m = 0; m < 4; ++m) { const int r = u.r0 + ai * 128 + wr * 64 + m * 16 + fr; float s = 0.f;
#pragma unroll
                for (int bj = 0; bj < 2; ++bj) { const int c = u.c0 + bj * 128 + wc * 32 + 8 * fq; const size_t o = (size_t)r * DM + c;
                    const f32x4 a = acc[ai][bj][m][0] + *(const f32x4*)(x + o), b = acc[ai][bj][m][1] + *(const f32x4*)(x + o + 4);
                    if constexpr (X1_F32) { *(f32x4*)(x1 + o) = a; *(f32x4*)(x1 + o + 4) = b; } st_bf16x8(x1b + o, a, b);
                    s += ((a.x * a.x + a.y * a.y) + (a.z * a.z + a.w * a.w)) + ((b.x * b.x + b.y * b.y) + (b.z * b.z + b.w * b.w)); }
                s += __shfl_xor(s, 16); s += __shfl_xor(s, 32);
                if (fq == 0) ssq[(size_t)((u.c0 >> 8) * 4 + wc) * NT + r] = s; }
    }
};
#if X1_F32
struct EpiRes2 {
    static constexpr bool PERM = false;
    const float* x1; const bf16* x1b; float* x2;
    __device__ __forceinline__ void operator()(f32x4 (&acc)[2][2][4][2], const Unit& u, int wr, int wc, int fr, int fq) const {
        EPI_LOOP( const size_t o = (size_t)(u.r0 + rl) * DM + u.c0 + cl; *(f32x4*)(x2 + o) = v + *(const f32x4*)(x1 + o); )
    }
};
#else
struct EpiRes2 {
    static constexpr bool PERM = true;
    const float* x1; const bf16* x1b; float* x2;
    __device__ __forceinline__ void operator()(f32x4 (&acc)[2][2][4][2], const Unit& u, int wr, int wc, int fr, int fq) const {
        EPI_LOOP_P( const size_t o = (size_t)(u.r0 + rl) * DM + u.c0 + cl; const u32x4 w = *(const u32x4*)(x1b + o);
            *(f32x4*)(x2 + o) = v0 + (f32x4){bflo(w.x), bfhi(w.x), bflo(w.y), bfhi(w.y)}; *(f32x4*)(x2 + o + 4) = v1 + (f32x4){bflo(w.z), bfhi(w.z), bflo(w.w), bfhi(w.w)}; )
    }
};
#endif
constexpr float WUNSC = (MOE_FP8 && MX_UNSCALED) ? (1.0f / 64.0f) : 1.0f;
struct EpiAct {
    static constexpr bool PERM = true;
    const float* bgu; bf16* act;
    __device__ __forceinline__ void operator()(f32x4 (&acc)[2][2][4][2], const Unit& u, int wr, int wc, int fr, int fq) const {
        const float* bg = bgu + (size_t)u.e * 2 * DFF; const int j0 = u.c0 + wc * 32 + 8 * fq;
        f32x4 b0[2], b1[2];
#pragma unroll
        for (int n = 0; n < 2; ++n) { b0[n] = *(const f32x4*)(bg + j0 + 4 * n); b1[n] = *(const f32x4*)(bg + DFF + j0 + 4 * n); }
#pragma unroll
        for (int ai = 0; ai < 2; ++ai)
#pragma unroll
            for (int m = 0; m < 4; ++m) { const int rl = ai * 128 + wr * 64 + m * 16 + fr; if (rl < u.rows) { f32x4 a[2];
#pragma unroll
                for (int n = 0; n < 2; ++n) { const f32x4 g = acc[ai][0][m][n] * WUNSC + b0[n], l = acc[ai][1][m][n] * WUNSC + b1[n];
#pragma unroll
                    for (int j = 0; j < 4; ++j) { const float gg = fminf(g[j], 7.0f), ll = fminf(fmaxf(l[j], -7.0f), 7.0f); a[n][j] = gg * frcp(1.0f + fexp2(-1.702f * LOG2E * gg)) * (ll + 1.0f); } }
#if MOE_FP8
                u32x2 w; w.x = pk_fp8x4(a[0].x, a[0].y, a[0].z, a[0].w); w.y = pk_fp8x4(a[1].x, a[1].y, a[1].z, a[1].w);
                *(u32x2*)((unsigned char*)act + (size_t)(u.r0 + rl) * DFF + j0) = w;
#else
                st_bf16x8(act + (size_t)(u.r0 + rl) * DFF + j0, a[0], a[1]);
#endif
                } }
    }
};
struct EpiY {
    static constexpr bool PERM = true;
    const float* bd; const float* sw; bf16* y;
    __device__ __forceinline__ void operator()(f32x4 (&acc)[2][2][4][2], const Unit& u, int wr, int wc, int fr, int fq) const {
        const float* bb = bd + (size_t)u.e * DM;
        f32x4 bv[2][2];
#pragma unroll
        for (int bj = 0; bj < 2; ++bj)
#pragma unroll
            for (int n = 0; n < 2; ++n) bv[bj][n] = *(const f32x4*)(bb + u.c0 + bj * 128 + wc * 32 + 8 * fq + 4 * n);
#pragma unroll
        for (int ai = 0; ai < 2; ++ai)
#pragma unroll
            for (int m = 0; m < 4; ++m) { const int rl = ai * 128 + wr * 64 + m * 16 + fr; if (rl < u.rows) { const float w = sw[u.r0 + rl];
#pragma unroll
                for (int bj = 0; bj < 2; ++bj) { const int c = u.c0 + bj * 128 + wc * 32 + 8 * fq; const f32x4 y0 = (acc[ai][bj][m][0] * WUNSC + bv[bj][0]) * w, y1 = (acc[ai][bj][m][1] * WUNSC + bv[bj][1]) * w;
#if Y_FP8
                    u32x2 yw; yw.x = pk_fp8x4(y0.x * 16.0f, y0.y * 16.0f, y0.z * 16.0f, y0.w * 16.0f); yw.y = pk_fp8x4(y1.x * 16.0f, y1.y * 16.0f, y1.z * 16.0f, y1.w * 16.0f);
                    *(u32x2*)((unsigned char*)y + (size_t)(u.r0 + rl) * DM + c) = yw;
#else
                    st_bf16x8(y + (size_t)(u.r0 + rl) * DM + c, y0, y1);
#endif
                    } } }
    }
};

constexpr int RSC_OFF = RED2_OFF + 4096;
__device__ __forceinline__ void xattn_row_scales(LAS unsigned char* lds, const float* __restrict__ ssq, int r0) {
    const int t = threadIdx.x, row = t >> 1, hf = t & 1; float q = 0.f;
#pragma unroll
    for (int pp = 0; pp < 16; ++pp) q += ssq[(size_t)(16 * hf + pp) * NT + r0 + row];
    q += __shfl_xor(q, 1);
    if (hf == 0) ((LAS float*)(lds + RSC_OFF))[row] = (0.04419417382415922f * LOG2E) / sqrtf(q * (1.f / DM) + EPS);
    __syncthreads();
}
struct EpiSoftmax {
    static constexpr bool PERM = true;
    LAS unsigned char* lds; bf16* P;
    __device__ __forceinline__ void operator()(f32x4 (&acc)[2][2][4][2], const Unit& u, int wr, int wc, int fr, int fq) const {
        LAS float* red1 = (LAS float*)(lds + RED1_OFF); LAS float* red2 = (LAS float*)(lds + RED2_OFF);
        float rs[2][4];
#pragma unroll
        for (int ai = 0; ai < 2; ++ai)
#pragma unroll
            for (int m = 0; m < 4; ++m) rs[ai][m] = ((const LAS float*)(lds + RSC_OFF))[ai * 128 + wr * 64 + m * 16 + fr];
#pragma unroll
        for (int ai = 0; ai < 2; ++ai)
#pragma unroll
            for (int m = 0; m < 4; ++m) { const int rl = ai * 128 + wr * 64 + m * 16 + fr; float mx = -3.0e38f;
#pragma unroll
                for (int bj = 0; bj < 2; ++bj)
#pragma unroll
                    for (int n = 0; n < 2; ++n) { const f32x4 v = acc[ai][bj][m][n]; mx = fmaxf(fmaxf(mx, fmaxf(v.x, v.y)), fmaxf(v.z, v.w)); }
                mx = fmaxf(mx, __shfl_xor(mx, 16)); mx = fmaxf(mx, __shfl_xor(mx, 32));
                if (fq == 0) red1[rl * 4 + wc] = mx; }
        asm volatile("s_waitcnt lgkmcnt(0)" ::: "memory"); __builtin_amdgcn_s_barrier(); asm volatile("" ::: "memory");
#pragma unroll
        for (int ai = 0; ai < 2; ++ai)
#pragma unroll
            for (int m = 0; m < 4; ++m) { const int rl = ai * 128 + wr * 64 + m * 16 + fr; const f32x4 mv = *(const LAS f32x4*)(red1 + rl * 4);
                const float mx = fmaxf(fmaxf(mv.x, mv.y), fmaxf(mv.z, mv.w)); float sum = 0.f;
#pragma unroll
                for (int bj = 0; bj < 2; ++bj)
#pragma unroll
                    for (int n = 0; n < 2; ++n) { f32x4 v = acc[ai][bj][m][n];
#pragma unroll
                        for (int j = 0; j < 4; ++j) { v[j] = fexp2((v[j] - mx) * rs[ai][m]); sum += v[j]; }
                        acc[ai][bj][m][n] = v; }
                sum += __shfl_xor(sum, 16); sum += __shfl_xor(sum, 32);
                if (fq == 0) red2[rl * 4 + wc] = sum; }
        asm volatile("s_waitcnt lgkmcnt(0)" ::: "memory"); __builtin_amdgcn_s_barrier(); asm volatile("" ::: "memory");
#pragma unroll
        for (int ai = 0; ai < 2; ++ai)
#pragma unroll
            for (int m = 0; m < 4; ++m) { const int rl = ai * 128 + wr * 64 + m * 16 + fr; const f32x4 sv = *(const LAS f32x4*)(red2 + rl * 4);
                const float inv = 1.0f / ((sv.x + sv.y) + (sv.z + sv.w));
#pragma unroll
                for (int bj = 0; bj < 2; ++bj) st_bf16x8(P + (size_t)(u.r0 + rl) * 1024 + u.c0 + bj * 128 + wc * 32 + 8 * fq, acc[ai][bj][m][0] * inv, acc[ai][bj][m][1] * inv); }
        asm volatile("s_waitcnt lgkmcnt(0)" ::: "memory"); __builtin_amdgcn_s_barrier(); asm volatile("" ::: "memory");
    }
};
struct XpreOrder {
    const char* Kk; const char* Wcqn; const char* Wcot; const char* Vv; int c;
    __device__ bool next(int i, Unit& u) const { if (i > 0 || c >= 256) return false; u.rows = 256; u.e = 0;
        if (c < 128) { const int bh = c >> 3, nt = c & 7, b = bh >> 2, h = bh & 3;
            u.a = Kk + ((size_t)(b * MEMLEN) * DM + h * 512) * 2; u.b = Wcqn + ((size_t)(nt * 256) * DM + h * 512) * 2; u.r0 = bh * 256; u.c0 = nt * 256; u.e = 0; }
        else { const int q = c - 128, bh = q >> 3, nt = q & 7, b = bh >> 2, h = bh & 3;
            u.a = Wcot + ((size_t)(nt * 256) * DM + h * 512) * 2; u.b = Vv + ((size_t)(b * MEMLEN) * DM + h * 512) * 2; u.r0 = b * DM + nt * 256; u.c0 = h * 256; u.e = 1; }
        return true; }
    __device__ __forceinline__ void a_ready(const Unit&) const {}
};
struct EpiXpre {
    static constexpr bool PERM = true;
    bf16* MT; bf16* VWT;
    __device__ __forceinline__ void operator()(f32x4 (&acc)[2][2][4][2], const Unit& u, int wr, int wc, int fr, int fq) const {
        bf16* O = u.e ? VWT : MT; const int ld = u.e ? 1024 : DM;
        EPI_LOOP_P( st_bf16x8(O + (size_t)(u.r0 + rl) * ld + u.c0 + cl, v0, v1); )
    }
};
struct MixOrder {
    pg8::DenseOrder D; XpreOrder X; int c;
    __device__ bool next(int i, Unit& u) const { if (i > 1) return false; const bool first_dense = true;
        if ((i == 0) == first_dense) { const bool ok = D.next(0, u); u.e = 0; u.nt = 32; return ok; }
        const bool ok = X.next(0, u); u.e = u.e + 1; u.nt = 8; return ok; }
    __device__ __forceinline__ void a_ready(const Unit&) const {}
};
struct EpiMix {
    static constexpr bool PERM = true;
    EpiRes1 R; EpiXpre Xp;
    __device__ __forceinline__ void operator()(f32x4 (&acc)[2][2][4][2], const Unit& u, int wr, int wc, int fr, int fq) const {
        if (u.e == 0) R(acc, u, wr, wc, fr, fq); else { Unit v = u; v.e = u.e - 1; Xp(acc, v, wr, wc, fr, fq); }
    }
};
struct XsOrder {
    const char* X; const char* MT; int c;
    __device__ bool next(int i, Unit& u) const { if (i > 0 || c >= 128) return false; const int bh = c >> 3, qt = c & 7, b = bh >> 2, h = bh & 3;
        u.a = X + ((size_t)(b * SEQ + 256 * qt) * DM) * 2; u.b = MT + ((size_t)(bh * 256) * DM) * 2; u.r0 = b * SEQ + 256 * qt; u.c0 = h * 256; u.rows = 256; u.e = 0; return true; }
    __device__ __forceinline__ void a_ready(const Unit&) const {}
};
struct XoutOrder {
    const char* P; const char* VWT; int c;
    __device__ bool next(int i, Unit& u) const { if (i > 0 || c >= 256) return false; const int b = c >> 6, pm = (c >> 3) & 7, pn = c & 7;
        u.a = P + ((size_t)(b * SEQ + 256 * pm) * 1024) * 2; u.b = VWT + ((size_t)(b * DM + 256 * pn) * 1024) * 2; u.r0 = b * SEQ + 256 * pm; u.c0 = 256 * pn; u.rows = 256; u.e = 0; return true; }
    __device__ __forceinline__ void a_ready(const Unit&) const {}
};
struct KvOrder {
    const char* A; const char* Bt; int c;
    __device__ bool next(int i, Unit& u) const { if (i > 0 || c >= 64) return false; const int pm = c >> 4, pn = c & 15;
        u.a = A + (size_t)pm * 256 * KD * 2; u.b = Bt + (size_t)pn * 256 * KD * 2; u.r0 = pm * 256; u.c0 = pn * 256; u.rows = 256; u.e = 0; return true; }
    __device__ __forceinline__ void a_ready(const Unit&) const {}
};
struct MoeOrder {
    const LAS int* tab; const char* A; const char* Bt; int ntn, G, c; size_t bstride; int ocol; int pitchb;
    __device__ bool next(int i, Unit& u) const {
        const int idx = i * G + c; const int total = __builtin_amdgcn_readfirstlane(tab[32]);
        if (idx >= total) return false;
        int e = 0;
        for (int q = 1; q < 32; ++q) { const int p = __builtin_amdgcn_readfirstlane(tab[q]); if (idx >= p) e = q; }
        const int ue = __builtin_amdgcn_readfirstlane(tab[e]), st = __builtin_amdgcn_readfirstlane(tab[64 + e]), cn = __builtin_amdgcn_readfirstlane(tab[128 + e]);
        const int local = idx - ue, mt = local / ntn, nt = local - mt * ntn;
        u.a = A + (size_t)(st + 256 * mt) * pitchb; u.b = Bt + (size_t)e * bstride + (size_t)nt * 256 * pitchb;
        u.r0 = st + 256 * mt; u.c0 = nt * ocol; u.rows = (cn - 256 * mt) < 256 ? (cn - 256 * mt) : 256; u.e = e; return true;
    }
    const unsigned* ecnt; int* ready; int hi_ready;
    __device__ __forceinline__ void a_ready(const Unit& u) const {
        if (ecnt == nullptr || u.e <= *ready || u.e >= hi_ready) return;
        if (threadIdx.x < 64) { unsigned sp = 0;
            while ((unsigned)__builtin_amdgcn_readfirstlane(__hip_atomic_load(ecnt + 64 * u.e, __ATOMIC_RELAXED, __HIP_MEMORY_SCOPE_AGENT)) < (unsigned)CONV_WGS) { __builtin_amdgcn_s_sleep(4); if (++sp > (1u << 22)) break; }
            __builtin_amdgcn_fence(__ATOMIC_ACQUIRE, "agent");
            asm volatile("s_waitcnt vmcnt(0)" ::: "memory"); }
        asm volatile("" ::: "memory"); __builtin_amdgcn_s_barrier(); asm volatile("" ::: "memory");
        *ready = u.e;
    }
};
__device__ __forceinline__ void moe_table(const Frame& F, int ntn) {
    LAS int* tab = (LAS int*)(F.lds + TAB_OFF); const int* cs = (const int*)(F.ws + WS_CNT);
    if (F.tid < 32) { tab[64 + F.tid] = cs[32 + F.tid]; tab[128 + F.tid] = cs[F.tid]; }
    __syncthreads();
    if (F.tid == 0) { int p = 0; for (int e = 0; e < 32; ++e) { tab[e] = p; p += ((tab[128 + e] + 255) >> 8) * ntn; } tab[32] = p; }
    __syncthreads();
}

__device__ __forceinline__ void gla_low_job(const Frame& F) {
    const bf16* h1 = (const bf16*)(F.ws + WS_H1); const bf16* wl = (const bf16*)(F.ws + WS_WLOW); float* glow = (float*)(F.ws + WS_GLOW);
    LAS float* red = (LAS float*)F.lds;
    const int l = F.lane, r16 = l & 15, quad = l >> 4;
    for (int rb = F.bid; rb < NT / 32; rb += F.G) {
        f32x4 acc[2] = {{0.f, 0.f, 0.f, 0.f}, {0.f, 0.f, 0.f, 0.f}};
#pragma unroll
        for (int st = 0; st < 8; ++st) { const int k0 = 256 * F.wave + 32 * st + 8 * quad;
            const bf16x8 bfr = *(const bf16x8*)(wl + (size_t)r16 * KD + k0);
#pragma unroll
            for (int tb = 0; tb < 2; ++tb) { const bf16x8 afr = *(const bf16x8*)(h1 + (size_t)(rb * 32 + tb * 16 + r16) * KD + k0);
                acc[tb] = __builtin_amdgcn_mfma_f32_16x16x32_bf16(afr, bfr, acc[tb], 0, 0, 0); } }
#pragma unroll
        for (int tb = 0; tb < 2; ++tb)
#pragma unroll
            for (int j = 0; j < 4; ++j) red[(F.wave * 32 + tb * 16 + 4 * quad + j) * 16 + r16] = acc[tb][j];
        __syncthreads();
        { const int tok = F.tid >> 4, r = F.tid & 15; float s = 0.f;
#pragma unroll
          for (int w = 0; w < 8; ++w) s += red[(w * 32 + tok) * 16 + r];
          glow[(size_t)(rb * 32 + tok) * 16 + r] = s; }
        __syncthreads();
    }
}

__device__ __forceinline__ void sb_attn_wave(const Frame& F, const float* __restrict__ sb_g, int wu) {
    const bf16* Q = (const bf16*)(F.ws + WS_SBQ); const bf16* Kp = (const bf16*)(F.ws + WS_SBK); const bf16* VT = (const bf16*)(F.ws + WS_SBVT); bf16* O = (bf16*)(F.ws + WS_MIXO);
    const int l = F.lane, r = l & 31, hh = l >> 5;
    const int qb = 63 - (wu & 63), bh = wu >> 6, b = bh >> 3, h = bh & 7;
    const int t0 = qb * 32;
    bf16x8 qf[8];
#pragma unroll
    for (int st = 0; st < 8; ++st) qf[st] = *(const bf16x8*)(Q + (size_t)(b * SEQ + t0 + r) * 1024 + h * 128 + 16 * st + 8 * hh);
    f32x16 o[4];
#pragma unroll
    for (int d = 0; d < 4; ++d)
#pragma unroll
        for (int i = 0; i < 16; ++i) o[d][i] = 0.f;
    float R = 0.f;
    const float zs = 0.08838834764831845f * LOG2E;
    const int qpos = t0 + r;
    for (int kt = qb; kt >= 0; --kt) {
        f32x16 s;
#pragma unroll
        for (int i = 0; i < 16; ++i) s[i] = 0.f;
#pragma unroll
        for (int st = 0; st < 8; ++st) { const bf16x8 kf = *(const bf16x8*)(Kp + (size_t)(b * SEQ + kt * 32 + r) * 1024 + h * 128 + 16 * st + 8 * hh);
            s = __builtin_amdgcn_mfma_f32_32x32x16_bf16(kf, qf[st], s, 0, 0, 0); }
        float lm[16], lb[16];
#pragma unroll
        for (int i = 0; i < 16; ++i) { const int key = kt * 32 + (i & 3) + 8 * (i >> 2) + 4 * hh; const float z2 = s[i] * zs; const bool valid = key < qpos;
            const float sp = fmaxf(z2, 0.f) + flog2(1.f + fexp2(-fabsf(z2)));
            lm[i] = valid ? -sp : 0.f; lb[i] = z2 - sp; }
        float Gown[4], Gpar[4];
#pragma unroll
        for (int c = 0; c < 4; ++c) { Gown[c] = (lm[4 * c] + lm[4 * c + 1]) + (lm[4 * c + 2] + lm[4 * c + 3]); Gpar[c] = __shfl_xor(Gown[c], 32); }
        float sufT[4]; sufT[3] = 0.f;
#pragma unroll
        for (int c = 2; c >= 0; --c) sufT[c] = sufT[c + 1] + (Gown[c + 1] + Gpar[c + 1]);
        float p[16];
#pragma unroll
        for (int c = 0; c < 4; ++c) { float run = R + sufT[c] + (hh == 0 ? Gpar[c] : 0.f);
#pragma unroll
            for (int e = 3; e >= 0; --e) { const int i = 4 * c + e; const int key = kt * 32 + e + 8 * c + 4 * hh;
                p[i] = (key < qpos) ? fexp2(lb[i] + run) : 0.f; run += lm[i]; } }
        R += (Gown[0] + Gpar[0]) + (Gown[1] + Gpar[1]) + (Gown[2] + Gpar[2]) + (Gown[3] + Gpar[3]);
#pragma unroll
        for (int s2 = 0; s2 < 2; ++s2) {
            u32x4 pw; pw.x = cvt_pk_bf16(p[8 * s2 + 0], p[8 * s2 + 1]); pw.y = cvt_pk_bf16(p[8 * s2 + 2], p[8 * s2 + 3]); pw.z = cvt_pk_bf16(p[8 * s2 + 4], p[8 * s2 + 5]); pw.w = cvt_pk_bf16(p[8 * s2 + 6], p[8 * s2 + 7]);
            const bf16x8 pb = __builtin_bit_cast(bf16x8, pw);
#pragma unroll
            for (int d = 0; d < 4; ++d) { const bf16* vp = VT + ((size_t)(bh * 128 + d * 32 + r)) * SEQ + kt * 32 + 16 * s2 + 4 * hh;
                u32x4 vw; const u32x2 v0 = *(const u32x2*)vp, v1 = *(const u32x2*)(vp + 8); vw.x = v0.x; vw.y = v0.y; vw.z = v1.x; vw.w = v1.y;
                o[d] = __builtin_amdgcn_mfma_f32_32x32x16_bf16(__builtin_bit_cast(bf16x8, vw), pb, o[d], 0, 0, 0); } }
        if (__all(R < -40.f)) break;
    }
    float ss = 0.f;
#pragma unroll
    for (int d = 0; d < 4; ++d)
#pragma unroll
        for (int i = 0; i < 16; ++i) ss += o[d][i] * o[d][i];
    ss += __shfl_xor(ss, 32);
    const float rstd = 1.0f / sqrtf(ss * (1.f / 128.f) + EPS);
#pragma unroll
    for (int d = 0; d < 4; ++d)
#pragma unroll
        for (int c = 0; c < 4; ++c) { const int dim = 32 * d + 8 * c + 4 * hh; const f32x4 g = *(const f32x4*)(sb_g + h * 128 + dim);
            f32x4 v; v.x = o[d][4 * c] * rstd * g.x; v.y = o[d][4 * c + 1] * rstd * g.y; v.z = o[d][4 * c + 2] * rstd * g.z; v.w = o[d][4 * c + 3] * rstd * g.w;
            st_bf16x4(O + (size_t)(b * SEQ + qpos) * DM + h * 128 + dim, v); }
}

constexpr int G1_QIN = 0, G1_KIN = 64 * 136 * 2, G1_KDT = 2 * 64 * 136 * 2, G1_LOW = G1_KDT + 128 * 72 * 2, G1_SEG = G1_LOW + 64 * 16 * 4, G1_QRAW = G1_SEG + 4 * 128 * 4, G1_KRAW = G1_QRAW + 64 * 128 * 2, G1_END = G1_KRAW + 64 * 128 * 2;
constexpr int G1_KVT = G1_QRAW;
static_assert(G1_END <= RING_BYTES && G1_KVT + 65536 <= RING_BYTES && (G1_KVT & 15) == 0, "g1 lds");
__device__ __forceinline__ void gla_g1_unit(const Frame& F, const float* __restrict__ w2, const float* __restrict__ b2, int unit) {
    const int n = unit & 31, bh = unit >> 5, b = bh >> 2, h = bh & 3;
    const int t0 = b * SEQ + 64 * n;
    const bf16* GQ = (const bf16*)(F.ws + WS_GQ); const bf16* GK = (const bf16*)(F.ws + WS_GK); const bf16* GVT = (const bf16*)(F.ws + WS_GVT); const float* GLOW = (const float*)(F.ws + WS_GLOW);
    LAS bf16* qin = (LAS bf16*)(F.lds + G1_QIN); LAS bf16* kin = (LAS bf16*)(F.lds + G1_KIN); LAS bf16* kdt = (LAS bf16*)(F.lds + G1_KDT);
    LAS float* lowl = (LAS float*)(F.lds + G1_LOW); LAS float* seg = (LAS float*)(F.lds + G1_SEG);
    for (int i = F.tid; i < 64 * 16; i += NTHR) lowl[i] = GLOW[(size_t)t0 * 16 + i];
    LAS bf16* qraw = (LAS bf16*)(F.lds + G1_QRAW); LAS bf16* kraw = (LAS bf16*)(F.lds + G1_KRAW);
#pragma unroll
    for (int q2 = 0; q2 < 2; ++q2) { const int id = F.tid + 512 * q2, row = id >> 4, ch = id & 15;
        *(LAS u32x4*)(qraw + row * 128 + ch * 8) = *(const u32x4*)(GQ + (size_t)(t0 + row) * 512 + h * 128 + ch * 8);
        *(LAS u32x4*)(kraw + row * 128 + ch * 8) = *(const u32x4*)(GK + (size_t)(t0 + row) * 512 + h * 128 + ch * 8); }
    __syncthreads();
    const int d = F.tid & 127, sg = F.tid >> 7, dd = h * 128 + d;
    float wcol[16];
#pragma unroll
    for (int r = 0; r < 16; ++r) wcol[r] = w2[r * 512 + dd];
    const float bias = b2[dd];
    float pre[16]; float run = 0.f;
#pragma unroll
    for (int i = 0; i < 16; ++i) { const int c = 16 * sg + i; float z = bias;
#pragma unroll
        for (int r4 = 0; r4 < 4; ++r4) { const f32x4 lv = *(const LAS f32x4*)(lowl + c * 16 + 4 * r4); z += lv.x * wcol[4 * r4] + lv.y * wcol[4 * r4 + 1] + lv.z * wcol[4 * r4 + 2] + lv.w * wcol[4 * r4 + 3]; }
        run += log2_sigmoid2(z * LOG2E) * (1.0f / 16.0f);
        pre[i] = run; }
    seg[sg * 128 + d] = run;
    __syncthreads();
    float off = 0.f, tot = 0.f;
#pragma unroll
    for (int s = 0; s < 4; ++s) { const float v = seg[s * 128 + d]; tot += v; if (s < sg) off += v; }
    bf16* QIN = (bf16*)(F.ws + WS_QIN);
#pragma unroll
    for (int i = 0; i < 16; ++i) { const int c = 16 * sg + i; const float g = off + pre[i];
        const float qv = bf2f(qraw[c * 128 + d]), kv = bf2f(kraw[c * 128 + d]);
        const bf16 qi = f2bf(qv * 0.08838834764831845f * fexp2(g));
        qin[c * 136 + d] = qi;
        kin[c * 136 + d] = f2bf(kv * fexp2(-g));
        kdt[d * 72 + c] = f2bf(kv * fexp2(tot - g)); }
    if (sg == 0) ((float*)(F.ws + WS_DECAY))[(size_t)unit * 128 + d] = fexp2(tot);
    __syncthreads();
#pragma unroll
    for (int q2 = 0; q2 < 2; ++q2) { const int id = F.tid + 512 * q2, row = id >> 4, ch = id & 15;
        *(u32x4*)(QIN + (size_t)(t0 + row) * 512 + h * 128 + ch * 8) = *(const LAS u32x4*)(qin + row * 136 + ch * 8); }
    const int w = F.wave, l = F.lane, r = l & 31, hh = l >> 5, cb = w & 1, dvp = w >> 1;
    f32x16 X[2];
#pragma unroll
    for (int sb = 0; sb < 2; ++sb) {
#pragma unroll
        for (int i = 0; i < 16; ++i) X[sb][i] = 0.f;
#pragma unroll
        for (int st = 0; st < 8; ++st) { const bf16x8 af = *(const LAS bf16x8*)(kin + (32 * sb + r) * 136 + 16 * st + 8 * hh), bfq = *(const LAS bf16x8*)(qin + (32 * cb + r) * 136 + 16 * st + 8 * hh);
            X[sb] = __builtin_amdgcn_mfma_f32_32x32x16_bf16(af, bfq, X[sb], 0, 0, 0); }
#pragma unroll
        for (int i = 0; i < 16; ++i) { const int s = 32 * sb + (i & 3) + 8 * (i >> 2) + 4 * hh; if (32 * cb + r < s) X[sb][i] = 0.f; }
    }
    u32x4* OI = (u32x4*)(F.ws + WS_OINTRA) + ((size_t)unit * 8 + w) * 256;
#pragma unroll
    for (int dbi = 0; dbi < 2; ++dbi) { const int db = 2 * dvp + dbi; f32x16 oacc;
#pragma unroll
        for (int i = 0; i < 16; ++i) oacc[i] = 0.f;
#pragma unroll
        for (int sb = 0; sb < 2; ++sb)
#pragma unroll
            for (int s2 = 0; s2 < 2; ++s2) {
                u32x4 pw; pw.x = cvt_pk_bf16(X[sb][8 * s2 + 0], X[sb][8 * s2 + 1]); pw.y = cvt_pk_bf16(X[sb][8 * s2 + 2], X[sb][8 * s2 + 3]); pw.z = cvt_pk_bf16(X[sb][8 * s2 + 4], X[sb][8 * s2 + 5]); pw.w = cvt_pk_bf16(X[sb][8 * s2 + 6], X[sb][8 * s2 + 7]);
                const bf16* vp = GVT + ((size_t)(bh * 256 + db * 32 + r)) * SEQ + 64 * n + 32 * sb + 16 * s2 + 4 * hh;
                u32x4 vw; const u32x2 v0 = *(const u32x2*)vp, v1 = *(const u32x2*)(vp + 8); vw.x = v0.x; vw.y = v0.y; vw.z = v1.x; vw.w = v1.y;
                oacc = __builtin_amdgcn_mfma_f32_32x32x16_bf16(__builtin_bit_cast(bf16x8, vw), __builtin_bit_cast(bf16x8, pw), oacc, 0, 0, 0); }
#pragma unroll
        for (int q4 = 0; q4 < 2; ++q4) { u32x4 ow; ow.x = cvt_pk_bf16(oacc[8 * q4], oacc[8 * q4 + 1]); ow.y = cvt_pk_bf16(oacc[8 * q4 + 2], oacc[8 * q4 + 3]); ow.z = cvt_pk_bf16(oacc[8 * q4 + 4], oacc[8 * q4 + 5]); ow.w = cvt_pk_bf16(oacc[8 * q4 + 6], oacc[8 * q4 + 7]);
            OI[(dbi * 2 + q4) * 64 + l] = ow; } }
    bf16* KVN = (bf16*)(F.ws + WS_KVN) + (size_t)unit * 32768; LAS bf16* kvt = (LAS bf16*)(F.lds + G1_KVT);
    bf16x8 vf[4];
#pragma unroll
    for (int st = 0; st < 4; ++st) vf[st] = *(const bf16x8*)(GVT + ((size_t)(bh * 256 + w * 32 + r)) * SEQ + 64 * n + 16 * st + 8 * hh);
#pragma unroll
    for (int dkb = 0; dkb < 4; ++dkb) { f32x16 kacc;
#pragma unroll
        for (int i = 0; i < 16; ++i) kacc[i] = 0.f;
#pragma unroll
        for (int st = 0; st < 4; ++st) { const bf16x8 bk = *(const LAS bf16x8*)(kdt + (32 * dkb + r) * 72 + 16 * st + 8 * hh);
            kacc = __builtin_amdgcn_mfma_f32_32x32x16_bf16(vf[st], bk, kacc, 0, 0, 0); }
#pragma unroll
        for (int i = 0; i < 16; ++i) kvt[(32 * w + (i & 3) + 8 * (i >> 2) + 4 * hh) * 128 + 32 * dkb + r] = f2bf(kacc[i]); }
    LDS_WAIT();
#pragma unroll
    for (int q8 = 0; q8 < 8; ++q8) { const int row = 32 * w + 4 * q8 + (l >> 4), ch = l & 15;
        *(u32x4*)(KVN + (size_t)row * 128 + ch * 8) = *(const LAS u32x4*)(kvt + row * 128 + ch * 8); }
    __syncthreads();
}

__device__ __forceinline__ void gla_scan(const Frame& F) {
    const bf16* KVN = (const bf16*)(F.ws + WS_KVN); const float* DEC = (const float*)(F.ws + WS_DECAY); bf16* ST = (bf16*)(F.ws + WS_STATE);
    for (int g = F.bid * NTHR + F.tid; g < 16 * 8192; g += F.G * NTHR) {
        const int bh = g >> 13, e4 = (g & 8191) * 4, dk = e4 & 127;
        f32x4 S = {0.f, 0.f, 0.f, 0.f};
#pragma unroll 8
        for (int n = 0; n < 32; ++n) { const size_t u = (size_t)(bh * 32 + n);
            st_bf16x4(ST + u * 32768 + e4, S);
            const u32x2 kw = *(const u32x2*)(KVN + u * 32768 + e4); const f32x4 kv = {bflo(kw.x), bfhi(kw.x), bflo(kw.y), bfhi(kw.y)}, dc = *(const f32x4*)(DEC + u * 128 + dk);
            S = S * dc + kv; }
    }
}

__device__ __forceinline__ void gla_g3_unit(const Frame& F, const float* __restrict__ gn, int unit) {
    const int n = unit & 31, bh = unit >> 5, b = bh >> 2, h = bh & 3; const int t0 = b * SEQ + 64 * n;
    const int w = F.wave, l = F.lane, r = l & 31, hh = l >> 5, cb = w & 1, dvp = w >> 1;
    const bf16* QIN = (const bf16*)(F.ws + WS_QIN); const bf16* ST = (const bf16*)(F.ws + WS_STATE) + (size_t)unit * 32768; const bf16* GR = (const bf16*)(F.ws + WS_GR); bf16* O = (bf16*)(F.ws + WS_MIXO);
    const u32x4* OI = (const u32x4*)(F.ws + WS_OINTRA) + ((size_t)unit * 8 + w) * 256;
    LAS float* part = (LAS float*)F.lds;
    bf16x8 qf[8];
#pragma unroll
    for (int st = 0; st < 8; ++st) qf[st] = *(const bf16x8*)(QIN + (size_t)(t0 + 32 * cb + r) * 512 + h * 128 + 16 * st + 8 * hh);
    f32x16 o[2]; float ss = 0.f;
#pragma unroll
    for (int dbi = 0; dbi < 2; ++dbi) { const int db = 2 * dvp + dbi;
#pragma unroll
        for (int q4 = 0; q4 < 2; ++q4) { const u32x4 ow = OI[(dbi * 2 + q4) * 64 + l];
            o[dbi][8 * q4] = bflo(ow.x); o[dbi][8 * q4 + 1] = bfhi(ow.x); o[dbi][8 * q4 + 2] = bflo(ow.y); o[dbi][8 * q4 + 3] = bfhi(ow.y); o[dbi][8 * q4 + 4] = bflo(ow.z); o[dbi][8 * q4 + 5] = bfhi(ow.z); o[dbi][8 * q4 + 6] = bflo(ow.w); o[dbi][8 * q4 + 7] = bfhi(ow.w); }
#pragma unroll
        for (int st = 0; st < 8; ++st) { const bf16x8 sf = *(const bf16x8*)(ST + (size_t)(32 * db + r) * 128 + 16 * st + 8 * hh);
            o[dbi] = __builtin_amdgcn_mfma_f32_32x32x16_bf16(sf, qf[st], o[dbi], 0, 0, 0); }
#pragma unroll
        for (int i = 0; i < 16; ++i) ss += o[dbi][i] * o[dbi][i]; }
    ss += __shfl_xor(ss, 32);
    if (hh == 0) part[w * 32 + r] = ss;
    __syncthreads();
    float tot = 0.f;
#pragma unroll
    for (int q = 0; q < 4; ++q) tot += part[(2 * q + cb) * 32 + r];
    const float rstd = 1.0f / sqrtf(tot * (1.f / 256.f) + EPS);
    const int tok = t0 + 32 * cb + r;
#pragma unroll
    for (int dbi = 0; dbi < 2; ++dbi)
#pragma unroll
        for (int c = 0; c < 4; ++c) { const int dv = 32 * (2 * dvp + dbi) + 8 * c + 4 * hh; const f32x4 g = *(const f32x4*)(gn + h * 256 + dv);
            const u32x2 rw = *(const u32x2*)(GR + (size_t)tok * 1024 + h * 256 + dv);
            const float r0 = bflo(rw.x), r1 = bfhi(rw.x), r2 = bflo(rw.y), r3 = bfhi(rw.y);
            f32x4 v; v.x = o[dbi][4 * c] * rstd * g.x * (r0 * frcp(1.f + fexp2(-r0 * LOG2E))); v.y = o[dbi][4 * c + 1] * rstd * g.y * (r1 * frcp(1.f + fexp2(-r1 * LOG2E)));
            v.z = o[dbi][4 * c + 2] * rstd * g.z * (r2 * frcp(1.f + fexp2(-r2 * LOG2E))); v.w = o[dbi][4 * c + 3] * rstd * g.w * (r3 * frcp(1.f + fexp2(-r3 * LOG2E)));
            st_bf16x4(O + (size_t)tok * DM + 1024 + h * 256 + dv, v); }
    __syncthreads();
}
__device__ __forceinline__ void gla_g3_pair(const Frame& F, const float* __restrict__ gn, int uA, int uB) {
    const int w = F.wave, l = F.lane, r = l & 31, hh = l >> 5, w4 = w & 3, cb = w4 & 1, dvh = w4 >> 1;
    const int unit = (w < 4) ? uA : uB; const bool act = unit >= 0;
    const int uu = act ? unit : 0, n = uu & 31, bh = uu >> 5, b = bh >> 2, h = bh & 3; const int t0 = b * SEQ + 64 * n;
    const bf16* QIN = (const bf16*)(F.ws + WS_QIN); const bf16* ST = (const bf16*)(F.ws + WS_STATE) + (size_t)uu * 32768; const bf16* GR = (const bf16*)(F.ws + WS_GR); bf16* O = (bf16*)(F.ws + WS_MIXO);
    LAS float* part = (LAS float*)F.lds;
    f32x16 o[4]; float ss = 0.f;
    if (act) {
        bf16x8 qf[8];
#pragma unroll
        for (int st = 0; st < 8; ++st) qf[st] = *(const bf16x8*)(QIN + (size_t)(t0 + 32 * cb + r) * 512 + h * 128 + 16 * st + 8 * hh);
#pragma unroll
        for (int dbi = 0; dbi < 4; ++dbi) { const int db = 4 * dvh + dbi;
            const u32x4* OI = (const u32x4*)(F.ws + WS_OINTRA) + ((size_t)uu * 8 + (2 * (db >> 1) + cb)) * 256 + ((db & 1) * 2) * 64 + l;
#pragma unroll
            for (int q4 = 0; q4 < 2; ++q4) { const u32x4 ow = OI[q4 * 64];
                o[dbi][8 * q4] = bflo(ow.x); o[dbi][8 * q4 + 1] = bfhi(ow.x); o[dbi][8 * q4 + 2] = bflo(ow.y); o[dbi][8 * q4 + 3] = bfhi(ow.y); o[dbi][8 * q4 + 4] = bflo(ow.z); o[dbi][8 * q4 + 5] = bfhi(ow.z); o[dbi][8 * q4 + 6] = bflo(ow.w); o[dbi][8 * q4 + 7] = bfhi(ow.w); }
#pragma unroll
            for (int st = 0; st < 8; ++st) { const bf16x8 sf = *(const bf16x8*)(ST + (size_t)(32 * db + r) * 128 + 16 * st + 8 * hh);
                o[dbi] = __builtin_amdgcn_mfma_f32_32x32x16_bf16(sf, qf[st], o[dbi], 0, 0, 0); }
#pragma unroll
            for (int i = 0; i < 16; ++i) ss += o[dbi][i] * o[dbi][i]; }
        ss += __shfl_xor(ss, 32);
        if (hh == 0) part[w * 32 + r] = ss;
    }
    __syncthreads();
    if (act) {
        const float tot = part[((w & 4) + cb) * 32 + r] + part[((w & 4) + cb + 2) * 32 + r];
        const float rstd = 1.0f / sqrtf(tot * (1.f / 256.f) + EPS);
        const int tok = t0 + 32 * cb + r;
#pragma unroll
        for (int dbi = 0; dbi < 4; ++dbi)
#pragma unroll
            for (int c = 0; c < 4; ++c) { const int dv = 32 * (4 * dvh + dbi) + 8 * c + 4 * hh; const f32x4 g = *(const f32x4*)(gn + h * 256 + dv);
                const u32x2 rw = *(const u32x2*)(GR + (size_t)tok * 1024 + h * 256 + dv);
                const float r0 = bflo(rw.x), r1 = bfhi(rw.x), r2 = bflo(rw.y), r3 = bfhi(rw.y);
                f32x4 v; v.x = o[dbi][4 * c] * rstd * g.x * (r0 * frcp(1.f + fexp2(-r0 * LOG2E))); v.y = o[dbi][4 * c + 1] * rstd * g.y * (r1 * frcp(1.f + fexp2(-r1 * LOG2E)));
                v.z = o[dbi][4 * c + 2] * rstd * g.z * (r2 * frcp(1.f + fexp2(-r2 * LOG2E))); v.w = o[dbi][4 * c + 3] * rstd * g.w * (r3 * frcp(1.f + fexp2(-r3 * LOG2E)));
                st_bf16x4(O + (size_t)tok * DM + 1024 + h * 256 + dv, v); }
    }
    __syncthreads();
}

__device__ __forceinline__ void router_phase(const Frame& F, const float* __restrict__ b_router) {
    const float* X2 = (const float*)(F.ws + WS_X2); const bf16* WH = (const bf16*)(F.ws + WS_WRH); const bf16* WL = (const bf16*)(F.ws + WS_WRL);
    int* TOPE = (int*)(F.ws + WS_TOPE); float* TOPW = (float*)(F.ws + WS_TOPW); float* RSTD = (float*)(F.ws + WS_RSTD3); int* HIST = (int*)(F.ws + WS_HIST);
    LAS float* part = (LAS float*)F.lds;
    LAS float* sq = (LAS float*)(F.lds + 32768);
    LAS int* hist = (LAS int*)(F.lds + 33792);
    const int w = F.wave, l = F.lane, r16 = l & 15, quad = l >> 4;
    for (int rb = F.bid; rb < NT / 32; rb += F.G) {
        if (F.tid < 32) hist[F.tid] = 0;
        f32x4 acc[2][2] = {{{0.f, 0.f, 0.f, 0.f}, {0.f, 0.f, 0.f, 0.f}}, {{0.f, 0.f, 0.f, 0.f}, {0.f, 0.f, 0.f, 0.f}}}; float ssq[2] = {0.f, 0.f};
#pragma unroll 4
        for (int st = 0; st < 8; ++st) { const int k0 = 256 * w + 32 * st + 8 * quad;
            bf16x8 bh[2], bl[2];
#pragma unroll
            for (int eb = 0; eb < 2; ++eb) { bh[eb] = *(const bf16x8*)(WH + (size_t)(16 * eb + r16) * KD + k0); bl[eb] = *(const bf16x8*)(WL + (size_t)(16 * eb + r16) * KD + k0); }
#pragma unroll
            for (int tg = 0; tg < 2; ++tg) { const int row = rb * 32 + 16 * tg + r16;
                const f32x4 xa = *(const f32x4*)(X2 + (size_t)row * DM + k0), xb = *(const f32x4*)(X2 + (size_t)row * DM + k0 + 4);
                ssq[tg] += (xa.x * xa.x + xa.y * xa.y) + (xa.z * xa.z + xa.w * xa.w) + (xb.x * xb.x + xb.y * xb.y) + (xb.z * xb.z + xb.w * xb.w);
                u32x4 hw; hw.x = cvt_pk_bf16(xa.x, xa.y); hw.y = cvt_pk_bf16(xa.z, xa.w); hw.z = cvt_pk_bf16(xb.x, xb.y); hw.w = cvt_pk_bf16(xb.z, xb.w);
                u32x4 lw; lw.x = cvt_pk_bf16(xa.x - bflo(hw.x), xa.y - bfhi(hw.x)); lw.y = cvt_pk_bf16(xa.z - bflo(hw.y), xa.w - bfhi(hw.y));
                lw.z = cvt_pk_bf16(xb.x - bflo(hw.z), xb.y - bfhi(hw.z)); lw.w = cvt_pk_bf16(xb.z - bflo(hw.w), xb.w - bfhi(hw.w));
                const bf16x8 ah = __builtin_bit_cast(bf16x8, hw), alo = __builtin_bit_cast(bf16x8, lw);
#pragma unroll
                for (int eb = 0; eb < 2; ++eb) {
                    acc[tg][eb] = __builtin_amdgcn_mfma_f32_16x16x32_bf16(ah, bh[eb], acc[tg][eb], 0, 0, 0);
                    acc[tg][eb] = __builtin_amdgcn_mfma_f32_16x16x32_bf16(ah, bl[eb], acc[tg][eb], 0, 0, 0);
                    acc[tg][eb] = __builtin_amdgcn_mfma_f32_16x16x32_bf16(alo, bh[eb], acc[tg][eb], 0, 0, 0); } } }
#pragma unroll
        for (int tg = 0; tg < 2; ++tg) { float q = ssq[tg]; q += __shfl_xor(q, 16); q += __shfl_xor(q, 32);
            if (quad == 0) sq[w * 32 + 16 * tg + r16] = q;
#pragma unroll
            for (int eb = 0; eb < 2; ++eb)
#pragma unroll
                for (int j = 0; j < 4; ++j) part[(w * 32 + 16 * tg + 4 * quad + j) * 32 + 16 * eb + r16] = acc[tg][eb][j]; }
        __syncthreads();
        for (int q2 = 0; q2 < 2; ++q2) { const int hf = l >> 5, e = l & 31; const int ti = 4 * w + 2 * q2 + hf; const int tok = rb * 32 + ti;
            LAS float* lg = (LAS float*)(F.lds + 36864) + (w * 2 + hf) * 32; LAS float* tvr = (LAS float*)(F.lds + 40960) + (w * 2 + hf) * 4;
            float s2 = 0.f, a = 0.f;
#pragma unroll
            for (int k = 0; k < 8; ++k) { s2 += sq[k * 32 + ti]; a += part[(k * 32 + ti) * 32 + e]; }
            const float rstd = 1.0f / sqrtf(s2 * (1.f / DM) + EPS);
            float v = a * rstd + b_router[e]; v = (v == v) ? v : -3.0e38f;
            lg[e] = v;
            LDS_WAIT();
            int rank = 0;
#pragma unroll
            for (int j4 = 0; j4 < 8; ++j4) { const f32x4 o = *(const LAS f32x4*)(lg + 4 * j4);
                rank += (o.x > v || (o.x == v && 4 * j4 + 0 < e)) ? 1 : 0; rank += (o.y > v || (o.y == v && 4 * j4 + 1 < e)) ? 1 : 0;
                rank += (o.z > v || (o.z == v && 4 * j4 + 2 < e)) ? 1 : 0; rank += (o.w > v || (o.w == v && 4 * j4 + 3 < e)) ? 1 : 0; }
            if (rank < 4) tvr[rank] = v;
            LDS_WAIT();
            const f32x4 t = *(const LAS f32x4*)tvr;
            const float e1 = fexp2((t.y - t.x) * LOG2E), e2 = fexp2((t.z - t.x) * LOG2E), e3 = fexp2((t.w - t.x) * LOG2E); const float inv = 1.0f / (1.0f + e1 + e2 + e3);
            if (rank < 4) { TOPE[tok * 4 + rank] = e; TOPW[tok * 4 + rank] = fexp2((v - t.x) * LOG2E) * inv; atomicAdd((int*)&hist[e], 1); }
            if (e == 0) RSTD[tok] = rstd;
            LDS_WAIT(); }
        __syncthreads();
        if (F.tid < 32) HIST[rb * 32 + F.tid] = hist[F.tid];
        __syncthreads();
    }
}

__device__ __forceinline__ void slots_phase(const Frame& F, const float* __restrict__ g_moe) {
    const float* X2 = (const float*)(F.ws + WS_X2); const int* TOPE = (const int*)(F.ws + WS_TOPE); const float* TOPW = (const float*)(F.ws + WS_TOPW); const float* RSTD = (const float*)(F.ws + WS_RSTD3);
    const int* HIST = (const int*)(F.ws + WS_HIST); float* SLOTW = (float*)(F.ws + WS_SLOTW); int* TOKSLOT = (int*)(F.ws + WS_TOKSLOT); int* CNT = (int*)(F.ws + WS_CNT); bf16* XS = (bf16*)(F.ws + WS_XS);
    LAS int* ptot = (LAS int*)F.lds;
    LAS int* pbel = ptot + 512;
    LAS int* base = pbel + 512;
    LAS int* asg = base + 32;
    LAS int* aslot = asg + 128;
    for (int rb = F.bid; rb < NT / 32; rb += F.G) {
        { const int e = F.tid & 31, p = F.tid >> 5; int t = 0, bl = 0;
          for (int q = 0; q < 16; ++q) { const int bb = 16 * p + q; const int hv = HIST[bb * 32 + e]; t += hv; if (bb < rb) bl += hv; }
          ptot[p * 32 + e] = t; pbel[p * 32 + e] = bl; }
        if (F.tid < 128) asg[F.tid] = TOPE[rb * 128 + F.tid];
        __syncthreads();
        if (F.tid < 32) { int t = 0, bl = 0; for (int p = 0; p < 16; ++p) { t += ptot[p * 32 + F.tid]; bl += pbel[p * 32 + F.tid]; }
            ptot[F.tid] = t; pbel[F.tid] = bl; }
        __syncthreads();
        if (F.tid < 32) { int st = 0; for (int e = 0; e < F.tid; ++e) st += ptot[e]; base[F.tid] = st + pbel[F.tid];
            if (rb == 0) { CNT[F.tid] = ptot[F.tid]; CNT[32 + F.tid] = st; }
            int run = base[F.tid]; for (int i = 0; i < 128; ++i) if (asg[i] == F.tid) { aslot[i] = run; ++run; } }
        __syncthreads();
        if (F.tid < 128) { const int sl = aslot[F.tid]; TOKSLOT[rb * 128 + F.tid] = sl; SLOTW[sl] = TOPW[rb * 128 + F.tid]; }
        for (int q = 0; q < 4; ++q) { const int ti = 4 * F.wave + q, tok = rb * 32 + ti; const float rstd = RSTD[tok];
            const f32x4* xr = (const f32x4*)(X2 + (size_t)tok * DM) + F.lane; const f32x4* gr = (const f32x4*)g_moe + F.lane;
#if MOE_FP8
            unsigned hw[8];
#pragma unroll
            for (int j = 0; j < 8; ++j) { const f32x4 v = xr[64 * j], g = gr[64 * j]; hw[j] = pk_fp8x4(v.x * rstd * g.x, v.y * rstd * g.y, v.z * rstd * g.z, v.w * rstd * g.w); }
            LAS unsigned* rowb = (LAS unsigned*)(F.lds + 16384 + F.wave * 2048);
#pragma unroll
            for (int j = 0; j < 8; ++j) rowb[64 * j + F.lane] = hw[j];
            LDS_WAIT();
            const u32x4 w0 = *(const LAS u32x4*)(rowb + 4 * F.lane), w1 = *(const LAS u32x4*)(rowb + 256 + 4 * F.lane);
#pragma unroll
            for (int k = 0; k < 4; ++k) { const int sl = aslot[ti * 4 + k]; u32x4* o16 = (u32x4*)((unsigned char*)XS + (size_t)sl * DM) + F.lane;
                o16[0] = w0; o16[64] = w1; }
            LDS_WAIT();
#else
            u32x2 hw[8];
#pragma unroll
            for (int j = 0; j < 8; ++j) { const f32x4 v = xr[64 * j], g = gr[64 * j]; hw[j].x = cvt_pk_bf16(v.x * rstd * g.x, v.y * rstd * g.y); hw[j].y = cvt_pk_bf16(v.z * rstd * g.z, v.w * rstd * g.w); }
#pragma unroll
            for (int k = 0; k < 4; ++k) { const int sl = aslot[ti * 4 + k]; u32x2* o8 = (u32x2*)(XS + (size_t)sl * DM) + F.lane;
#pragma unroll
                for (int j = 0; j < 8; ++j) o8[64 * j] = hw[j]; }
#endif
            }
        __syncthreads();
    }
}

__device__ __forceinline__ void final_phase(const Frame& F, const float* __restrict__ g_fin, float* __restrict__ out) {
    const float* X2 = (const float*)(F.ws + WS_X2); const bf16* Y = (const bf16*)(F.ws + WS_Y); const int* TOKSLOT = (const int*)(F.ws + WS_TOKSLOT);
    const int gw = F.bid * NWAVES + F.wave, NGW = F.G * NWAVES;
    for (int tok = gw; tok < NT; tok += NGW) {
        const f32x4* xr = (const f32x4*)(X2 + (size_t)tok * DM) + F.lane;
        f32x4 v[8];
#pragma unroll
        for (int j = 0; j < 8; ++j) v[j] = xr[64 * j];
#pragma unroll
#if Y_FP8
        for (int k = 0; k < 4; ++k) { const int sl = TOKSLOT[tok * 4 + k]; const unsigned* yr = (const unsigned*)((const unsigned char*)Y + (size_t)sl * DM) + F.lane;
#pragma unroll
            for (int j = 0; j < 8; ++j) { const int yw = (int)yr[64 * j]; const f32x2 lo = __builtin_amdgcn_cvt_pk_f32_fp8(yw, false), hi = __builtin_amdgcn_cvt_pk_f32_fp8(yw, true);
                v[j].x += lo.x * 0.0625f; v[j].y += lo.y * 0.0625f; v[j].z += hi.x * 0.0625f; v[j].w += hi.y * 0.0625f; } }
#else
        for (int k = 0; k < 4; ++k) { const int sl = TOKSLOT[tok * 4 + k]; const u32x2* yr = (const u32x2*)(Y + (size_t)sl * DM) + F.lane;
#pragma unroll
            for (int j = 0; j < 8; ++j) { const u32x2 yw = yr[64 * j]; v[j].x += bflo(yw.x); v[j].y += bfhi(yw.x); v[j].z += bflo(yw.y); v[j].w += bfhi(yw.y); } }
#endif
        float s = 0.f;
#pragma unroll
        for (int j = 0; j < 8; ++j) s += (v[j].x * v[j].x + v[j].y * v[j].y) + (v[j].z * v[j].z + v[j].w * v[j].w);
        const float rstd = 1.0f / sqrtf(wave_sum(s) * (1.f / DM) + EPS);
        f32x4* orow = (f32x4*)(out + (size_t)tok * DM) + F.lane; const f32x4* gr = (const f32x4*)g_fin + F.lane;
#pragma unroll
        for (int j = 0; j < 8; ++j) orow[64 * j] = v[j] * rstd * gr[64 * j];
    }
}

constexpr int N_PHASES = 14;
__global__ void __launch_bounds__(NTHR, 2) fwd_kernel(Args args) {
    extern __shared__ __attribute__((aligned(16))) unsigned char lds[];
    Frame F;
    F.lds = (LAS unsigned char*)lds;
    F.tid = threadIdx.x; F.lane = F.tid & 63; F.wave = __builtin_amdgcn_readfirstlane(F.tid >> 6);
    F.G = gridDim.x; F.bid = blockIdx.x; F.ws = args.ws;
    for (int u = F.tid; u < (LDS_BYTES - LDSCTL_OFF) / 4; u += NTHR) ((LAS unsigned*)(F.lds + LDSCTL_OFF))[u] = 0u;
    __syncthreads();
    unsigned* ctl = (unsigned*)(args.ws + WS_CTL);
    XcdBarrier bar; bar.bar = ctl + CW_BAR; bar.x = 0; bar.st = nullptr;
    const bool fused = (args.ph_hi - args.ph_lo) > 1;
    if (fused) bar = xcd_barrier_post(ctl + CW_BAR, (volatile LAS unsigned*)(F.lds + MISC_OFF));
    const int lo = args.ph_lo, hi = args.ph_hi;
    const bool conv_on = fused && CONV_WGS > 0 && F.G == 256;
    const bool conv_wg = conv_on && F.bid >= NCOMP;
    Frame FC = F; if (conv_on) FC.G = NCOMP;
#define IN(k) (lo <= (k) && (k) < hi)
#define REP(k) _Pragma("unroll") for (int _r = 0; _r < 1 + ((DUP_MASK >> (k)) & 1); ++_r)
#define SEAM(k) do { if (IN(k) && IN((k) + 1)) xcd_barrier(bar); } while (0)

    if (IN(0)) REP(0) { p0_prologue(F, args);
        if (!conv_on) { LAS unsigned* scr = (LAS unsigned*)(F.lds + F.wave * 16384);
            for (int it = F.bid * NWAVES + F.wave; it < MOE_ITEMS; it += F.G * NWAVES) if (!CONV_WGS || !((it >= (32 - E_P0) * 1024 && it < 32768) || it >= 32768 + (32 - D_P0) * 512)) moe_item_fp8<false>(F, args, it, scr); }
    } SEAM(0);

    if (IN(1)) REP(1) {
        if (conv_wg) {
            { KvOrder S{(const char*)(F.ws + WS_MEMN), (const char*)(F.ws + WS_WCKV), F.bid - NCOMP}; EpiKV E{F.ws}; pg8::gemm_phase<4096, 32, false>(F.lds, S, E); }
            LAS unsigned* scr = (LAS unsigned*)(F.lds + F.wave * 16384); const int w2 = (F.bid - NCOMP) * NWAVES + F.wave;
            moe_items_stream<false, true>(F, args, w2, CONV_WGS * NWAVES, CONV_NA / (CONV_WGS * NWAVES), scr); }
        else {
        pg8::DenseOrder S; S.init(F.ws + WS_H1, F.ws + WS_WIN, NT, NPROJ, FC.G, F.bid);
        EpiInProj E{F.ws};
        pg8::gemm_phase<4096, 32, false>(F.lds, S, E);
        gla_low_job(FC);
        }
    } SEAM(1);

    if (IN(2)) REP(2) {
        {
        const bool kv_here = !(conv_on && CONV_WGS == 64);
        if (kv_here && F.bid < 64) { KvOrder S{(const char*)(F.ws + WS_MEMN), (const char*)(F.ws + WS_WCKV), F.bid}; EpiKV E{F.ws}; pg8::gemm_phase<4096, 32, false>(F.lds, S, E); }
        REP(14) { if (kv_here && F.G > 64) { if (F.bid >= 64) for (int u = F.bid - 64; u < 512; u += F.G - 64) gla_g1_unit(F, args.in[4], args.in[5], u); }
        else { for (int u = F.bid; u < 512; u += F.G) gla_g1_unit(F, args.in[4], args.in[5], u); } }
        REP(15) { for (int wu = F.bid * NWAVES + F.wave; wu < 2048; wu += F.G * NWAVES) sb_attn_wave(F, args.in[6], wu); }
        }
    } SEAM(2);

    if (IN(3)) REP(3) { gla_scan(F); } SEAM(3);

    if (IN(4)) REP(4) { for (int u = F.bid; u < 512; u += 2 * F.G) gla_g3_pair(F, args.in[7], u, (u + F.G < 512) ? u + F.G : -1); } SEAM(4);

    if (IN(5)) REP(5) {
        if (F.G == 256) {
            MixOrder S; S.D.init(F.ws + WS_MIXO, F.ws + WS_WOUT, NT, DM, F.G, F.bid); S.X = XpreOrder{(const char*)(F.ws + WS_KVK), (const char*)(F.ws + WS_WCQ), (const char*)(F.ws + WS_WCO), (const char*)(F.ws + WS_KVVT), F.bid}; S.c = F.bid;
            EpiMix E{EpiRes1{args.in[0], (float*)(F.ws + WS_X1), (bf16*)(F.ws + WS_X1B), (float*)(F.ws + WS_SSQ)}, EpiXpre{(bf16*)(F.ws + WS_MT), (bf16*)(F.ws + WS_VWT)}};
            pg8::gemm_phase<4096, 0, false>(F.lds, S, E);
        } else {
            { pg8::DenseOrder S; S.init(F.ws + WS_MIXO, F.ws + WS_WOUT, NT, DM, F.G, F.bid); EpiRes1 E{args.in[0], (float*)(F.ws + WS_X1), (bf16*)(F.ws + WS_X1B), (float*)(F.ws + WS_SSQ)}; pg8::gemm_phase<4096, 32, false>(F.lds, S, E); }
            for (int c = F.bid; c < 256; c += F.G) { XpreOrder S{(const char*)(F.ws + WS_KVK), (const char*)(F.ws + WS_WCQ), (const char*)(F.ws + WS_WCO), (const char*)(F.ws + WS_KVVT), c}; EpiXpre E{(bf16*)(F.ws + WS_MT), (bf16*)(F.ws + WS_VWT)}; pg8::gemm_phase<4096, 8, false>(F.lds, S, E); }
        }
    } SEAM(5);

    if (IN(7)) REP(7) {
        if (F.bid < 128) { const int bh = F.bid >> 3, qt = F.bid & 7; xattn_row_scales(F.lds, (const float*)(F.ws + WS_SSQ), (bh >> 2) * SEQ + 256 * qt); }
        { XsOrder S{(const char*)(F.ws + WS_X1B), (const char*)(F.ws + WS_MT), F.bid}; EpiSoftmax E{F.lds, (bf16*)(F.ws + WS_P)};
          pg8::gemm_phase<4096, 32, false>(F.lds, S, E); }
        if (conv_on && F.bid >= 128) {
            LAS unsigned* scr = (LAS unsigned*)(F.lds + F.wave * 16384); const int w2 = (F.bid - 128) * NWAVES + F.wave;
            moe_items_stream<false, true>(F, args, CONV_NA + w2, 1024, CONV_NB / 1024, scr); }
    } SEAM(7);

    if (IN(8)) REP(8) {
        XoutOrder S{(const char*)(F.ws + WS_P), (const char*)(F.ws + WS_VWT), F.bid};
        EpiRes2 E{(const float*)(F.ws + WS_X1), (const bf16*)(F.ws + WS_X1B), (float*)(F.ws + WS_X2)};
        pg8::gemm_phase<2048, 16, false>(F.lds, S, E);
    } SEAM(8);

    if (IN(9)) REP(9) { router_phase(F, args.in[16]); } SEAM(9);

    if (IN(10)) REP(10) { slots_phase(F, args.in[14]); } SEAM(10);

    if (IN(11)) REP(11) {
        moe_table(F, 16);
        constexpr int PB = MOE_FP8 ? 2048 : 4096;
        if (conv_wg) { for (int seq = E_PRE; seq < 32 - E_P0; ++seq) conv_step(F, args, seq); for (int seq = 32; seq < 32 + DN_IN_P11; ++seq) conv_step(F, args, seq); }
        else {
        int ready = conv_on ? E_PRE - 1 : 31;
        MoeOrder S{(const LAS int*)(F.lds + TAB_OFF), (const char*)(F.ws + WS_XS), (const char*)(F.ws + WS_WGU), 16, FC.G, F.bid, (size_t)2 * DFF * PB, 128, PB, conv_on ? (const unsigned*)(F.ws + WS_CTL) + CW_EXP : nullptr, &ready, 32 - E_P0};
        EpiAct E{args.in[18], (bf16*)(F.ws + WS_ACT)};
        pg8::gemm_phase<PB, MOE_FP8 ? 16 : 32, MOE_FP8 != 0>(F.lds, S, E);
        }
    } SEAM(11);

    if (IN(12)) REP(12) {
        moe_table(F, 8);
        constexpr int PB = MOE_FP8 ? 2048 : 4096;
        if (conv_wg) { for (int seq = 32 + DN_IN_P11; seq < 64 - D_P0; ++seq) conv_step(F, args, seq); }
        else {
        int ready = conv_on ? DN_IN_P11 - 1 : 31;
        MoeOrder S{(const LAS int*)(F.lds + TAB_OFF), (const char*)(F.ws + WS_ACT), (const char*)(F.ws + WS_WD), 8, FC.G, F.bid, (size_t)DM * PB, 256, PB, conv_on ? (const unsigned*)(F.ws + WS_CTL) + CW_EXP + 64 * 32 : nullptr, &ready, 32 - D_P0};
        EpiY E{args.in[20], (const float*)(F.ws + WS_SLOTW), (bf16*)(F.ws + WS_Y)};
        pg8::gemm_phase<PB, MOE_FP8 ? 16 : 32, MOE_FP8 != 0>(F.lds, S, E);
        }
    } SEAM(12);

#ifdef EXTRA_BARS
    if (fused) { for (int i = 0; i < EXTRA_BARS; ++i) xcd_barrier(bar); }
#endif
    if (IN(13)) REP(13) { final_phase(F, args.in[21], args.out); }
#undef IN
#undef SEAM
}

extern "C" void kernel_launch(void* const* d_in, const int* in_sizes, int n_in, void* d_out, int out_size, void* d_ws, size_t ws_size, hipStream_t stream) {
    static int grid = 0;
    if (grid == 0) {
        if (n_in != 22 || out_size != NT * DM || ws_size < WS_END) { fprintf(stderr, "kernel_launch: unexpected problem (n_in %d out %d ws %zu need %zu)\n", n_in, out_size, ws_size, (size_t)WS_END); grid = -1; return; }
        int dev = 0, cus = 0, per_cu = 0;
        if (hipGetDevice(&dev) != hipSuccess || hipDeviceGetAttribute(&cus, hipDeviceAttributeMultiprocessorCount, dev) != hipSuccess) { grid = -1; return; }
        if (hipFuncSetAttribute((const void*)fwd_kernel, hipFuncAttributeMaxDynamicSharedMemorySize, LDS_BYTES) != hipSuccess) { fprintf(stderr, "kernel_launch: hipFuncSetAttribute failed\n"); grid = -1; return; }
        if (hipOccupancyMaxActiveBlocksPerMultiprocessor(&per_cu, (const void*)fwd_kernel, NTHR, LDS_BYTES) != hipSuccess || per_cu < 1) fprintf(stderr, "kernel_launch: occupancy query reports %d\n", per_cu);
        (void)hipGetLastError();
        grid = cus;
    }
    if (grid < 0) return;
    (void)hipMemsetAsync((char*)d_ws + WS_CTL, 0, CTL_ZERO_BYTES, stream);
    Args a{};
    for (int i = 0; i < 22; ++i) a.in[i] = (const float*)d_in[i];
    a.out = (float*)d_out; a.ws = (unsigned char*)d_ws;
#if MK_N_LAUNCHES == 1
    a.ph_lo = 0; a.ph_hi = N_PHASES;
    hipLaunchKernelGGL(fwd_kernel, dim3(grid), dim3(NTHR), LDS_BYTES, stream, a);
#else
    for (int p = 0; p < N_PHASES; ++p) { a.ph_lo = p; a.ph_hi = p + 1; hipLaunchKernelGGL(fwd_kernel, dim3(grid), dim3(NTHR), LDS_BYTES, stream, a); }
#endif
}
```

```cpp
#include <hip/hip_runtime.h>
#include <cstdio>
#include <cstdint>

#ifndef MK_N_LAUNCHES
#define MK_N_LAUNCHES 1
#endif
#ifndef MOE_FP8
#define MOE_FP8 1
#endif
#ifndef CONV_LD_AUX
#define CONV_LD_AUX 18
#endif
#ifndef Y_FP8
#define Y_FP8 1
#endif
#ifndef MX_UNSCALED
#define MX_UNSCALED 1
#endif
#ifndef WCVT_SCALE
#define WCVT_SCALE 0.015625f
#endif
#ifndef DUP_MASK
#define DUP_MASK 0
#endif

#define GAS __attribute__((address_space(1)))
#define LAS __attribute__((address_space(3)))
typedef unsigned short bf16;
typedef short bf16x8 __attribute__((ext_vector_type(8)));
typedef float f32x2 __attribute__((ext_vector_type(2)));
typedef float f32x4 __attribute__((ext_vector_type(4)));
typedef float f32x16 __attribute__((ext_vector_type(16)));
typedef unsigned u32x2 __attribute__((ext_vector_type(2)));
typedef unsigned u32x4 __attribute__((ext_vector_type(4)));
typedef GAS unsigned gu32;

#define LDS_WAIT() asm volatile("s_waitcnt lgkmcnt(0)" ::: "memory")
#define VM_WAIT() asm volatile("s_waitcnt vmcnt(0)" ::: "memory")

constexpr int DM = 2048, NB = 4, SEQ = 2048, NT = NB * SEQ;
constexpr int INC = 6160, NPROJ = 6144;
constexpr int MEMLEN = 256, NMEM = NB * MEMLEN;
constexpr int NEXP = 32, TOPK = 4, NASSIGN = NT * TOPK, DFF = 2048;
constexpr float EPS = 1e-6f;
constexpr float LOG2E = 1.4426950408889634f, LN2 = 0.6931471805599453f;
constexpr int KD = 2048;

typedef __bf16 bf16x2_t __attribute__((ext_vector_type(2)));
__device__ __forceinline__ unsigned cvt_pk_bf16(float lo, float hi) { const f32x2 v = {lo, hi}; const bf16x2_t b = __builtin_convertvector(v, bf16x2_t); return __builtin_bit_cast(unsigned, b); }
__device__ __forceinline__ bf16 f2bf(float f) { return (bf16)(cvt_pk_bf16(f, 0.f) & 0xffffu); }
__device__ __forceinline__ float bf2f(unsigned b) { return __uint_as_float(b << 16); }
__device__ __forceinline__ float bflo(unsigned w) { return __uint_as_float(w << 16); }
__device__ __forceinline__ float bfhi(unsigned w) { return __uint_as_float(w & 0xffff0000u); }
__device__ __forceinline__ void st_bf16x4(bf16* p, f32x4 v) { u32x2 w; w.x = cvt_pk_bf16(v.x, v.y); w.y = cvt_pk_bf16(v.z, v.w); *(u32x2*)p = w; }
__device__ __forceinline__ float wave_sum(float v) {
#pragma unroll
    for (int o = 1; o < 64; o <<= 1) v += __shfl_xor(v, o);
    return v;
}
__device__ __forceinline__ float fexp2(float x) { return __builtin_amdgcn_exp2f(x); }
__device__ __forceinline__ float flog2(float x) { return __builtin_amdgcn_logf(x); }
__device__ __forceinline__ float frcp(float x) { return __builtin_amdgcn_rcpf(x); }
__device__ __forceinline__ float log2_sigmoid2(float z2) { return -(fmaxf(-z2, 0.f) + flog2(1.f + fexp2(-fabsf(z2)))); }

namespace pg8 {
constexpr int BM = 256, BK = 64, HALF = 128, HTB = HALF * BK * 2, STAGE_BYTES = 8 * HTB, NXCD = 8, WGM = 8;
__host__ __device__ __forceinline__ int lds_byte(int r, int c) { const int st = (r >> 4) * 2 + (c >> 5), rr = r & 15, cc = c & 31, ob = rr * 64 + cc * 2; return st * 1024 + (ob ^ (((ob >> 9) & 1) << 5)); }
__host__ __device__ __forceinline__ void stage_rc(int b, int& R, int& C) { const int st = b / 1024, sb = b % 1024, swz = sb ^ (((sb >> 9) & 1) << 5); R = (st >> 1) * 16 + swz / 64; C = (st & 1) * 32 + (swz % 64) / 2; }

typedef int v8i __attribute__((ext_vector_type(8)));
typedef int v4i __attribute__((ext_vector_type(4)));
__device__ __forceinline__ v8i cat8(bf16x8 lo, bf16x8 hi) { const v4i a = __builtin_bit_cast(v4i, lo), b = __builtin_bit_cast(v4i, hi); return (v8i){a.x, a.y, a.z, a.w, b.x, b.y, b.z, b.w}; }
__host__ __device__ __forceinline__ int perm32(int rho) { const int n = rho >> 4, i = rho & 15; return 8 * (i >> 2) + 4 * n + (i & 3); }
struct Unit { const char* a; const char* b; int r0, c0, rows, e, nt; };

struct DenseOrder {
    const char* A; const char* Bt; int nM, nN, nwg, G, c;
    __device__ void init(const void* A_, const void* Bt_, int M, int N, int G_, int c_) { A = (const char*)A_; Bt = (const char*)Bt_; nM = M / BM; nN = N / BM; nwg = nM * nN; G = G_; c = c_; }
    __device__ bool next(int i, Unit& u) const {
        const long L = (long)i * G + c; if (L >= nwg) return false;
        int wgid = (int)L; { const int q = nwg / NXCD, r = nwg % NXCD, xcd = wgid % NXCD, off = wgid / NXCD; wgid = (xcd < r ? xcd * (q + 1) : r * (q + 1) + (xcd - r) * q) + off; }
        const int nig = WGM * nN, gid = wgid / nig, fm = gid * WGM, gsz = (nM - fm) < WGM ? (nM - fm) : WGM;
        const int pm = fm + ((wgid % nig) % gsz), pn = (wgid % nig) / gsz;
        u.a = A + (size_t)pm * BM * KD * 2; u.b = Bt + (size_t)pn * BM * KD * 2; u.r0 = pm * BM; u.c0 = pn * BM; u.rows = BM; u.e = 0; return true;
    }
    __device__ __forceinline__ void a_ready(const Unit&) const {}
};

template <int PITCHB, int NTILES, bool FP8, class Epi, class Sched>
__device__ __forceinline__ void gemm_phase(LAS unsigned char* lds, const Sched& S, const Epi& E) {
    const int tid = threadIdx.x, wid = __builtin_amdgcn_readfirstlane(tid >> 6), lane = tid & 63, wr = wid >> 2, wc = wid & 3, fr = lane & 15, fq = lane >> 4;
    unsigned voffA[2], voffB[2];
#pragma unroll
    for (int i = 0; i < 2; ++i) { int R, C; stage_rc(tid * 16 + i * 8192, R, C); const int Rb = Epi::PERM ? ((R & ~31) + perm32(R & 31)) : R;
        voffA[i] = (unsigned)(R * PITCHB + C * 2); voffB[i] = (unsigned)(Rb * PITCHB + C * 2); }
    const size_t kstep = (size_t)(BK * 2);
    const size_t hstep = (size_t)HALF * PITCHB;
    const unsigned ldsw = (unsigned)wid * 1024u;
    const int aoff = lds_byte(wr * 64 + fr, fq * 8), boff = lds_byte(wc * 32 + fr, fq * 8);
#define PG8_SA(b, h) (((b) * 2 + (h)) * HTB)
#define PG8_SB(b, h) ((4 + (b) * 2 + (h)) * HTB)
#define PG8_STAGE_X(bufoff, gbase, voff) do { _Pragma("unroll") for (int _i = 0; _i < 2; ++_i) \
        __builtin_amdgcn_global_load_lds((const unsigned*)((const char*)(gbase) + (voff)[_i]), (LAS unsigned*)(lds + (bufoff) + ldsw + _i * 8192), 16, 0, 0); } while (0)
#define PG8_STAGE_A(bufoff, gbase) PG8_STAGE_X(bufoff, gbase, voffA)
#define PG8_STAGE_B(bufoff, gbase) PG8_STAGE_X(bufoff, gbase, voffB)
#define PG8_LDA(dst, b, h) do { _Pragma("unroll") for (int m = 0; m < 4; ++m) { if constexpr (FP8) { const v4i _lo = *(const LAS v4i*)(lds + PG8_SA(b, h) + aoff + m * 2048), _hi = *(const LAS v4i*)(lds + PG8_SA(b, h) + aoff + m * 2048 + 1024); \
            dst##8[m] = (v8i){_lo.x, _lo.y, _lo.z, _lo.w, _hi.x, _hi.y, _hi.z, _hi.w}; } \
        else { _Pragma("unroll") for (int k = 0; k < 2; ++k) dst[m][k] = *(const LAS bf16x8*)(lds + PG8_SA(b, h) + aoff + m * 2048 + k * 1024); } } } while (0)
#define PG8_LDB(dst, b, h) do { _Pragma("unroll") for (int n = 0; n < 2; ++n) { if constexpr (FP8) { const v4i _lo = *(const LAS v4i*)(lds + PG8_SB(b, h) + boff + n * 2048), _hi = *(const LAS v4i*)(lds + PG8_SB(b, h) + boff + n * 2048 + 1024); \
            dst##8[n] = (v8i){_lo.x, _lo.y, _lo.z, _lo.w, _hi.x, _hi.y, _hi.z, _hi.w}; } \
        else { _Pragma("unroll") for (int k = 0; k < 2; ++k) dst[n][k] = *(const LAS bf16x8*)(lds + PG8_SB(b, h) + boff + n * 2048 + k * 1024); } } } while (0)
#define PG8_MMA(ai, bj, At, Bt) do { __builtin_amdgcn_s_setprio(1); _Pragma("unroll") for (int m = 0; m < 4; ++m) _Pragma("unroll") for (int n = 0; n < 2; ++n) { \
        if constexpr (FP8) { if constexpr (MX_UNSCALED != 0) asm volatile("v_mfma_f32_16x16x128_f8f6f4 %0, %1, %2, %0" : "+v"(acc[ai][bj][m][n]) : "v"(Bt##8[n]), "v"(At##8[m])); \
            else asm volatile("v_mfma_scale_f32_16x16x128_f8f6f4 %0, %1, %2, %0, %3, %4 op_sel_hi:[0,0,0]" : "+v"(acc[ai][bj][m][n]) : "v"(Bt##8[n]), "v"(At##8[m]), "v"(sclW), "v"(sclA)); } \
        else { _Pragma("unroll") for (int k = 0; k < 2; ++k) acc[ai][bj][m][n] = __builtin_amdgcn_mfma_f32_16x16x32_bf16(Bt[n][k], At[m][k], acc[ai][bj][m][n], 0, 0, 0); } } \
        __builtin_amdgcn_s_setprio(0); } while (0)
#define PG8_WAIT_V(n) asm volatile("s_waitcnt vmcnt(" #n ")" ::: "memory")
#define PG8_WAIT_L(n) asm volatile("s_waitcnt lgkmcnt(" #n ")" ::: "memory")
#define PG8_BAR __builtin_amdgcn_s_barrier()
#define PG8_SCHED __builtin_amdgcn_sched_barrier(0)
    Unit cur, nxt; int ui = 0;
    if (!S.next(0, cur)) return;
    f32x4 acc[2][2][4][2];
#pragma unroll
    for (int a = 0; a < 2; ++a)
#pragma unroll
        for (int b = 0; b < 2; ++b)
#pragma unroll
            for (int m = 0; m < 4; ++m)
#pragma unroll
                for (int n = 0; n < 2; ++n) acc[a][b][m][n] = (f32x4){0.f, 0.f, 0.f, 0.f};
    const int sclW = 0x79797979, sclA = 0x7f7f7f7f;
    bf16x8 At[4][2], B0[2][2], B1[2][2]; v8i At8[4], B08[2], B18[2];
    const char* cA = cur.a; const char* cB = cur.b;
    S.a_ready(cur);
    PG8_STAGE_B(PG8_SB(0, 0), cB); PG8_STAGE_B(PG8_SB(0, 1), cB + hstep); PG8_STAGE_A(PG8_SA(0, 0), cA); PG8_STAGE_A(PG8_SA(0, 1), cA + hstep);
    if (wr == 1) PG8_BAR;
    PG8_WAIT_V(2); PG8_BAR;
    PG8_STAGE_B(PG8_SB(1, 0), cB + kstep); PG8_STAGE_A(PG8_SA(1, 0), cA + kstep); PG8_STAGE_B(PG8_SB(1, 1), cB + hstep + kstep);
    PG8_WAIT_V(6); PG8_BAR;
    for (;;) {
        const bool has_next = S.next(ui + 1, nxt);
        const char* nA = has_next ? nxt.a : cA; const char* nB = has_next ? nxt.b : cB;
        const int nt = NTILES > 0 ? NTILES : cur.nt;
#pragma nounroll
        for (int t = 0; t < nt; t += 2) {
            const bool last = (t == nt - 2);
            const char* a1 = cA + (size_t)(t + 1) * kstep;
            const char* a2 = last ? nA : cA + (size_t)(t + 2) * kstep; const char* b2 = last ? nB : cB + (size_t)(t + 2) * kstep;
            const char* a3 = a2 + kstep; const char* b3 = b2 + kstep;
            if (last && has_next) S.a_ready(nxt);
            PG8_LDB(B0, 0, 0); PG8_LDB(B1, 0, 1); PG8_SCHED; PG8_LDA(At, 0, 0); PG8_STAGE_A(PG8_SA(1, 1), a1 + hstep);
            PG8_WAIT_V(8); PG8_WAIT_L(0); PG8_BAR; PG8_MMA(0, 0, At, B0); PG8_MMA(0, 1, At, B1); PG8_BAR; PG8_SCHED;
            PG8_LDA(At, 0, 1); PG8_STAGE_B(PG8_SB(0, 0), b2); PG8_STAGE_B(PG8_SB(0, 1), b2 + hstep); PG8_STAGE_A(PG8_SA(0, 0), a2);
            PG8_WAIT_V(8); PG8_WAIT_L(0); PG8_BAR; PG8_MMA(1, 0, At, B0); PG8_MMA(1, 1, At, B1); PG8_BAR; PG8_SCHED;
            PG8_LDB(B0, 1, 0); PG8_LDB(B1, 1, 1); PG8_SCHED; PG8_LDA(At, 1, 0); PG8_STAGE_A(PG8_SA(0, 1), a2 + hstep);
            PG8_WAIT_V(8); PG8_WAIT_L(0); PG8_BAR; PG8_MMA(0, 0, At, B0); PG8_MMA(0, 1, At, B1); PG8_BAR; PG8_SCHED;
            PG8_LDA(At, 1, 1); PG8_STAGE_B(PG8_SB(1, 0), b3); PG8_STAGE_B(PG8_SB(1, 1), b3 + hstep); PG8_STAGE_A(PG8_SA(1, 0), a3);
            PG8_WAIT_V(8); PG8_WAIT_L(0); PG8_BAR; PG8_MMA(1, 0, At, B0); PG8_MMA(1, 1, At, B1); PG8_BAR; PG8_SCHED;
        }
        if constexpr (FP8) {
            asm volatile("s_nop 15\n\ts_nop 15" : "+v"(acc[0][0][0][0]), "+v"(acc[0][0][0][1]), "+v"(acc[0][0][1][0]), "+v"(acc[0][0][1][1]), "+v"(acc[0][0][2][0]), "+v"(acc[0][0][2][1]), "+v"(acc[0][0][3][0]), "+v"(acc[0][0][3][1]) :: "memory");
            asm volatile("" : "+v"(acc[0][1][0][0]), "+v"(acc[0][1][0][1]), "+v"(acc[0][1][1][0]), "+v"(acc[0][1][1][1]), "+v"(acc[0][1][2][0]), "+v"(acc[0][1][2][1]), "+v"(acc[0][1][3][0]), "+v"(acc[0][1][3][1]));
            asm volatile("" : "+v"(acc[1][0][0][0]), "+v"(acc[1][0][0][1]), "+v"(acc[1][0][1][0]), "+v"(acc[1][0][1][1]), "+v"(acc[1][0][2][0]), "+v"(acc[1][0][2][1]), "+v"(acc[1][0][3][0]), "+v"(acc[1][0][3][1]));
            asm volatile("" : "+v"(acc[1][1][0][0]), "+v"(acc[1][1][0][1]), "+v"(acc[1][1][1][0]), "+v"(acc[1][1][1][1]), "+v"(acc[1][1][2][0]), "+v"(acc[1][1][2][1]), "+v"(acc[1][1][3][0]), "+v"(acc[1][1][3][1]));
        }
        if (wr == 0) PG8_BAR;
        E(acc, cur, wr, wc, fr, fq);
        if (!has_next) break;
#pragma unroll
        for (int a = 0; a < 2; ++a)
#pragma unroll
            for (int b = 0; b < 2; ++b)
#pragma unroll
                for (int m = 0; m < 4; ++m)
#pragma unroll
                    for (int n = 0; n < 2; ++n) acc[a][b][m][n] = (f32x4){0.f, 0.f, 0.f, 0.f};
        cur = nxt; cA = nA; cB = nB; ++ui;
        if (wr == 1) PG8_BAR;
    }
    PG8_WAIT_V(0);
    PG8_BAR;
#undef PG8_SA
#undef PG8_SB
#undef PG8_STAGE_X
#undef PG8_STAGE_A
#undef PG8_STAGE_B
#undef PG8_LDA
#undef PG8_LDB
#undef PG8_MMA
#undef PG8_WAIT_V
#undef PG8_WAIT_L
#undef PG8_BAR
#undef PG8_SCHED
}
}
using pg8::Unit;

#define XB_TMO      128
#define XB_XCNT(j)  (256  + 64 * (j))
#define XB_XSUB(j)  (1280 + 64 * (j))
#define XB_XGEN(j)  (2304 + 64 * (j))
#define XB_TOP      3328
#define XB_TOPGEN   3392
#define XCD_BAR_WORDS 3456
#define XB_SPIN_CAP (1u << 22)
__device__ __forceinline__ unsigned xb_ld(unsigned* p)              { return __hip_atomic_load(p, __ATOMIC_RELAXED, __HIP_MEMORY_SCOPE_AGENT); }
__device__ __forceinline__ unsigned xb_add(unsigned* p, unsigned v) { return __hip_atomic_fetch_add(p, v, __ATOMIC_RELAXED, __HIP_MEMORY_SCOPE_AGENT); }
__device__ __forceinline__ unsigned xb_xcc_id() { return (unsigned)__builtin_amdgcn_s_getreg((3 << 11) | 20) & 0xFu; }
#define XB_SPIN(cond, bar) do { unsigned _sp = 0; while (cond) { __builtin_amdgcn_s_sleep(1); \
    if ((++_sp & 255u) == 0u) { if (xb_ld(&(bar)[XB_TMO])) break; if (_sp > XB_SPIN_CAP) { atomicAdd(&(bar)[XB_TMO], 1u); break; } } } } while (0)
struct XcdBarrier { unsigned* bar; unsigned x; volatile LAS unsigned* st; };
__device__ __forceinline__ XcdBarrier xcd_barrier_post(unsigned* bar, volatile LAS unsigned* st) {
    XcdBarrier b; b.bar = bar; b.x = xb_xcc_id(); b.st = st;
    if (threadIdx.x == 0) (void)xb_add(&bar[XB_XCNT(b.x)], 1u);
    return b;
}
__device__ __forceinline__ void xcd_barrier_complete(unsigned* bar, unsigned x, unsigned& nloc, unsigned& nx) {
    const unsigned G = gridDim.x * gridDim.y * gridDim.z;
    unsigned sum, cnt, mine, sp = 0u;
    for (;;) {
        sum = 0u; cnt = 0u; mine = 0u;
#pragma unroll
        for (unsigned j = 0; j < 16; ++j) { const unsigned c = xb_ld(&bar[XB_XCNT(j)]); sum += c; cnt += (c > 0u) ? 1u : 0u; mine = (j == x) ? c : mine; }
        if (sum == G) break;
        __builtin_amdgcn_s_sleep(1);
        if ((++sp & 255u) == 0u) { if (xb_ld(&bar[XB_TMO])) break; if (sp > XB_SPIN_CAP) { atomicAdd(&bar[XB_TMO], 1u); break; } }
    }
    nloc = mine > 0u ? mine : 1u; nx = cnt > 0u ? cnt : 1u;
}
__device__ __forceinline__ void xcd_barrier(const XcdBarrier& b) {
    asm volatile("s_waitcnt vmcnt(0)" ::: "memory");
    __syncthreads();
    if (threadIdx.x == 0) {
        unsigned* bar = b.bar;
        __builtin_amdgcn_s_waitcnt(0);
        unsigned nloc = b.st[0], nx = b.st[1];
        if (nloc == 0u) { xcd_barrier_complete(bar, b.x, nloc, nx); b.st[0] = nloc; b.st[1] = nx; }
        const unsigned old = xb_add(&bar[XB_XSUB(b.x)], 1u);
        const unsigned gen = old / nloc;
        if (old + 1u == (gen + 1u) * nloc) {
            __builtin_amdgcn_fence(__ATOMIC_RELEASE, "agent");
            asm volatile("s_waitcnt vmcnt(0)" ::: "memory");
            const unsigned og = xb_add(&bar[XB_TOP], 1u);
            const unsigned tg = og / nx;
            if (og + 1u == (tg + 1u) * nx) xb_add(&bar[XB_TOPGEN], 1u);
            else XB_SPIN(xb_ld(&bar[XB_TOPGEN]) == tg, bar);
            __builtin_amdgcn_fence(__ATOMIC_ACQUIRE, "agent");
            xb_add(&bar[XB_XGEN(b.x)], 1u);
            asm volatile("s_waitcnt vmcnt(0)" ::: "memory");
        } else {
            XB_SPIN(xb_ld(&bar[XB_XGEN(b.x)]) == gen, bar);
            __builtin_amdgcn_fence(__ATOMIC_ACQUIRE, "agent");
            asm volatile("s_waitcnt vmcnt(0)" ::: "memory");
        }
    }
    __syncthreads();
}

constexpr size_t MiB = 1u << 20;
constexpr size_t al(size_t x) { return (x + 255) & ~(size_t)255; }
constexpr size_t WS_CTL = 0, CTL_ZERO_BYTES = 1 * MiB;
constexpr size_t WS_WIN = 1 * MiB;
constexpr size_t WS_WLOW = WS_WIN + (size_t)NPROJ * KD * 2;
constexpr size_t WS_WRH = WS_WLOW + 16 * KD * 2;
constexpr size_t WS_WRL = WS_WRH + 32 * KD * 2;
constexpr size_t WS_WOUT = WS_WRL + 32 * KD * 2;
constexpr size_t WS_WCQ = WS_WOUT + (size_t)DM * KD * 2;
constexpr size_t WS_WCKV = WS_WCQ + (size_t)DM * KD * 2;
constexpr size_t WS_WCO = WS_WCKV + (size_t)2 * DM * KD * 2;
constexpr size_t WS_WGU = WS_WCO + (size_t)DM * KD * 2;
constexpr size_t WS_WD = WS_WGU + (size_t)NEXP * 2 * DFF * KD * 2;
constexpr size_t WS_H1 = WS_WD + (size_t)NEXP * DM * KD * 2;
constexpr size_t WS_MEMN = WS_H1 + (size_t)NT * DM * 2;
constexpr size_t WS_SBQ = WS_MEMN + (size_t)NMEM * DM * 2;
constexpr size_t WS_SBK = WS_SBQ + (size_t)NT * 1024 * 2;
constexpr size_t WS_SBVT = WS_SBK + (size_t)NT * 1024 * 2;
constexpr size_t WS_GQ = WS_SBVT + (size_t)NT * 1024 * 2;
constexpr size_t WS_GK = WS_GQ + (size_t)NT * 512 * 2;
constexpr size_t WS_GVT = WS_GK + (size_t)NT * 512 * 2;
constexpr size_t WS_GR = WS_GVT + (size_t)NT * 1024 * 2;
constexpr size_t WS_GLOW = WS_GR + (size_t)NT * 1024 * 2;
constexpr size_t WS_KVK = WS_GLOW + (size_t)NT * 16 * 4;
constexpr size_t WS_KVVT = WS_KVK + (size_t)NMEM * DM * 2;
constexpr size_t WS_QIN = WS_KVVT + (size_t)NMEM * DM * 2;
constexpr size_t WS_OINTRA = WS_QIN + (size_t)NT * 512 * 2;
constexpr size_t WS_KVN = WS_OINTRA + (size_t)512 * 16384 * 4;
constexpr size_t WS_DECAY = WS_KVN + (size_t)512 * 32768 * 4;
constexpr size_t WS_STATE = WS_DECAY + (size_t)512 * 128 * 4;
constexpr size_t WS_MIXO = WS_STATE + (size_t)512 * 32768 * 2;
constexpr size_t WS_X1 = WS_MIXO + (size_t)NT * DM * 2;
constexpr size_t WS_X1B = WS_X1 + (size_t)NT * DM * 4;
constexpr size_t WS_SSQ = WS_X1B + (size_t)NT * DM * 2;
constexpr size_t WS_CQ = WS_SSQ + (size_t)32 * NT * 4;
constexpr size_t WS_ATTO = WS_CQ + (size_t)NT * DM * 2;
constexpr size_t WS_X2 = WS_ATTO + (size_t)NT * DM * 2;
constexpr size_t WS_TOPE = WS_X2 + (size_t)NT * DM * 4;
constexpr size_t WS_TOPW = WS_TOPE + (size_t)NT * 4 * 4;
constexpr size_t WS_RSTD3 = WS_TOPW + (size_t)NT * 4 * 4;
constexpr size_t WS_HIST = WS_RSTD3 + (size_t)NT * 4;
constexpr size_t WS_SLOTW = WS_HIST + (size_t)256 * 32 * 4;
constexpr size_t WS_TOKSLOT = WS_SLOTW + (size_t)(NASSIGN + 256) * 4;
constexpr size_t WS_CNT = WS_TOKSLOT + (size_t)NT * 4 * 4;
constexpr size_t WS_XS = al(WS_CNT + 256);
constexpr size_t WS_ACT = WS_XS + (size_t)(NASSIGN + 256) * DM * 2;
constexpr size_t WS_Y = WS_ACT + (size_t)(NASSIGN + 256) * DM * 2;
constexpr size_t WS_P = WS_Y + (size_t)(NASSIGN + 256) * DM * 2;
constexpr size_t WS_MT = WS_P + (size_t)16 * SEQ * MEMLEN * 2;
constexpr size_t WS_VWT = WS_MT + (size_t)16 * MEMLEN * DM * 2;
constexpr size_t WS_END = WS_VWT + (size_t)NB * DM * 1024 * 2;

constexpr int CW_BAR = 4096;
static_assert((CW_BAR + XCD_BAR_WORDS) * 4 <= (int)CTL_ZERO_BYTES, "ctl");

constexpr int RING_BYTES = 131072, LDSCTL_OFF = RING_BYTES, MISC_OFF = LDSCTL_OFF + 64, TAB_OFF = LDSCTL_OFF + 256;
constexpr int RED1_OFF = LDSCTL_OFF + 2048, RED2_OFF = RED1_OFF + 4096;
constexpr int LDS_BYTES = 147456;

constexpr int NWAVES = 8, NTHR = 512;

struct Args { const float* in[22]; float* out; unsigned char* ws; int ph_lo, ph_hi; };

struct Frame {
    LAS unsigned char* lds;
    int tid, lane, wave, G, bid;
    unsigned char* ws;
};

__device__ __forceinline__ void cvt_tile(const float* __restrict__ W, int ldn, int k0, int n0, bf16* __restrict__ dst, int dst_row0, const float* __restrict__ gk, LAS unsigned* scr, int lane) {
    const int q = lane >> 4, c4 = lane & 15;
    f32x4 v[16];
#pragma unroll
    for (int i = 0; i < 16; ++i) { const int k = k0 + 8 * (i >> 1) + 2 * q + (i & 1); v[i] = *(const f32x4*)(W + (size_t)k * ldn + n0 + 4 * c4); if (gk) v[i] = v[i] * gk[k]; }
#pragma unroll
    for (int p = 0; p < 8; ++p)
#pragma unroll
        for (int j = 0; j < 4; ++j) { const int n = 4 * c4 + j, kd = 4 * p + q; scr[n * 32 + (kd ^ ((c4 & 7) << 2))] = cvt_pk_bf16(v[2 * p][j], v[2 * p + 1][j]); }
    LDS_WAIT();
#pragma unroll
    for (int jj = 0; jj < 8; ++jj) { const int n = 8 * jj + (lane >> 3), ch = lane & 7; const u32x4 w = *(const LAS u32x4*)(scr + n * 32 + ((ch ^ ((n >> 2) & 7)) << 2));
        *(u32x4*)(dst + (size_t)(dst_row0 + n) * KD + k0 + 8 * ch) = w; }
    LDS_WAIT();
}
__device__ __forceinline__ unsigned pk_fp8x4(float a, float b, float c, float d) { int r = __builtin_amdgcn_cvt_pk_fp8_f32(a, b, 0, false); r = __builtin_amdgcn_cvt_pk_fp8_f32(c, d, r, true); return (unsigned)r; }
__device__ __forceinline__ void rms_row_bf16(const float* __restrict__ xrow, const float* __restrict__ g, bf16* __restrict__ orow, int lane) {
    const f32x4* xr = (const f32x4*)xrow + lane; const f32x4* gr = (const f32x4*)g + lane;
    f32x4 v[8]; float s = 0.f;
#pragma unroll
    for (int j = 0; j < 8; ++j) { v[j] = xr[64 * j]; s += (v[j].x * v[j].x + v[j].y * v[j].y) + (v[j].z * v[j].z + v[j].w * v[j].w); }
    const float rstd = 1.0f / sqrtf(wave_sum(s) * (1.f / DM) + EPS);
    u32x2* o8 = (u32x2*)orow + lane;
#pragma unroll
    for (int j = 0; j < 8; ++j) { const f32x4 gg = gr[64 * j]; u32x2 w; w.x = cvt_pk_bf16(v[j].x * rstd * gg.x, v[j].y * rstd * gg.y); w.y = cvt_pk_bf16(v[j].z * rstd * gg.z, v[j].w * rstd * gg.w); o8[64 * j] = w; }
}

constexpr int MOE_ITEMS = NEXP * 64 * 16 + NEXP * 32 * 16;
#ifndef X2_BF16
#define X2_BF16 1
#endif
#ifndef X1_F32
#define X1_F32 0
#endif
static_assert(!(X1_F32 && X2_BF16), "the bf16 x2 store lives in the bf16-x1 form of the phase-8 epilogue");
#ifndef CONV_WGS
#define CONV_WGS 64
#endif
#ifndef E_P1
#define E_P1 9
#endif
constexpr int E_P7 = 7, E_PRE = E_P1 + E_P7;
#ifndef DN_IN_P11
#define DN_IN_P11 16
#endif
#ifndef E_P0
#define E_P0 0
#endif
#ifndef D_P0
#define D_P0 0
#endif
constexpr int NCOMP = 256 - CONV_WGS, CONV_NA = E_P1 * 1024, CONV_NB = E_P7 * 1024;
constexpr int CW_EXP = 8192;
static_assert(E_PRE + E_P0 <= 32 && DN_IN_P11 + D_P0 <= 32, "expert conversion ranges");
struct MoeItem { const float* W; int ldn, k0, n0; unsigned char* dst; int drow; };
__device__ __forceinline__ MoeItem moe_item_desc(const Frame& F, const Args& A, int it) {
    constexpr int J5 = NEXP * 64 * 16; MoeItem m;
    if (it < J5) { const int e = it >> 10, r = it & 1023, kt = r >> 6, n0 = (r & 63) * 64;
        m.W = A.in[17] + (size_t)e * DM * 2 * DFF; m.ldn = 2 * DFF; m.k0 = kt * 128; m.n0 = n0; m.dst = F.ws + WS_WGU + (size_t)e * 2 * DFF * KD;
        m.drow = (n0 < DFF) ? ((n0 >> 7) * 256 + (n0 & 127)) : (((n0 - DFF) >> 7) * 256 + 128 + ((n0 - DFF) & 127)); }
    else { const int q2 = it - J5, e = q2 >> 9, r = q2 & 511, kt = r >> 5, n0 = (r & 31) * 64;
        m.W = A.in[19] + (size_t)e * DFF * DM; m.ldn = DM; m.k0 = kt * 128; m.n0 = n0; m.dst = F.ws + WS_WD + (size_t)e * DM * KD; m.drow = n0; }
    return m;
}
template <bool SLD> __device__ __forceinline__ void moe_ld_half(f32x4 (&v)[16], const MoeItem& m, int half, int lane) {
    const int q = lane >> 4, c4 = lane & 15;
    if constexpr (SLD) { const __amdgpu_buffer_rsrc_t rw = __builtin_amdgcn_make_buffer_rsrc((void*)m.W, 0, 0x7fffffff, 0x00020000);
        const int vo = ((m.k0 + 64 * half + 4 * q) * m.ldn + m.n0 + 4 * c4) * 4;
#pragma unroll
        for (int i = 0; i < 16; ++i) v[i] = __builtin_bit_cast(f32x4, __builtin_amdgcn_raw_buffer_load_b128(rw, vo, (16 * (i >> 2) + (i & 3)) * m.ldn * 4, CONV_LD_AUX)); }
    else {
#pragma unroll
        for (int i = 0; i < 16; ++i) { const int k = m.k0 + 64 * half + 16 * (i >> 2) + 4 * q + (i & 3); v[i] = __builtin_nontemporal_load((const f32x4*)(m.W + (size_t)k * m.ldn + m.n0 + 4 * c4)); } }
}
typedef short v2s16 __attribute__((ext_vector_type(2)));
__device__ __forceinline__ unsigned pk_fp8x4_scaled(float a, float b, float c, float d, float scale) { v2s16 r; asm volatile("" : "=v"(r));
    r = __builtin_amdgcn_cvt_scalef32_pk_fp8_f32(r, a, b, scale, false); r = __builtin_amdgcn_cvt_scalef32_pk_fp8_f32(r, c, d, scale, true); return __builtin_bit_cast(unsigned, r); }
__device__ __forceinline__ void moe_cv_half(const f32x4 (&v)[16], LAS unsigned* scr, int half, int lane) {
    const int q = lane >> 4, c4 = lane & 15;
#pragma unroll
    for (int pp = 0; pp < 4; ++pp)
#pragma unroll
        for (int j = 0; j < 4; ++j) scr[(4 * c4 + j) * 33 + 16 * half + 4 * pp + q] = pk_fp8x4_scaled(v[4 * pp][j], v[4 * pp + 1][j], v[4 * pp + 2][j], v[4 * pp + 3][j], WCVT_SCALE);
}
template <bool SC1> __device__ __forceinline__ void moe_flush(const MoeItem& m, LAS unsigned* scr, int lane) {
#pragma unroll
    for (int jj = 0; jj < 8; ++jj) { const int n = 8 * jj + (lane >> 3), ch = lane & 7; u32x4 w; const LAS unsigned* sp = scr + n * 33 + 4 * ch; w.x = sp[0]; w.y = sp[1]; w.z = sp[2]; w.w = sp[3];
        if constexpr (SC1) { const __amdgpu_buffer_rsrc_t rs = __builtin_amdgcn_make_buffer_rsrc(m.dst, 0, 0x7fffffff, 0x00020000);
            __builtin_amdgcn_raw_buffer_store_b128(w, rs, (m.drow + n) * KD + m.k0 + 16 * ch, 0, 16); }
        else __builtin_nontemporal_store(w, (u32x4*)(m.dst + (size_t)(m.drow + n) * KD + m.k0 + 16 * ch)); }
}
template <bool SC1, bool SLD> __device__ __forceinline__ void moe_items_stream(const Frame& F, const Args& A, int it0, int stride, int count, LAS unsigned* scr) {
    if (count <= 0) return;
    f32x4 va[16], vb[16];
    MoeItem cur = moe_item_desc(F, A, it0);
    moe_ld_half<SLD>(va, cur, 0, F.lane);
    for (int i = 0; i < count; ++i) {
        moe_ld_half<SLD>(vb, cur, 1, F.lane);
        moe_cv_half(va, scr, 0, F.lane);
        MoeItem nxt = cur;
        if (i + 1 < count) { nxt = moe_item_desc(F, A, it0 + (i + 1) * stride); moe_ld_half<SLD>(va, nxt, 0, F.lane); }
        moe_cv_half(vb, scr, 1, F.lane);
        LDS_WAIT();
        moe_flush<SC1>(cur, scr, F.lane);
        LDS_WAIT();
        cur = nxt;
    }
}
template <bool SC1, bool SLD = SC1> __device__ __forceinline__ void moe_item_fp8(const Frame& F, const Args& A, int it, LAS unsigned* scr) { moe_items_stream<SC1, SLD>(F, A, it, 0, 1, scr); }
__device__ __forceinline__ void p0_prologue(const Frame& F, const Args& A) {
    LAS unsigned* scr = (LAS unsigned*)(F.lds + F.wave * 16384);
    const int gw = F.bid * NWAVES + F.wave, NGW = F.G * NWAVES;
    const float* w_in = A.in[3]; const float* w_out = A.in[8]; const float* w_cq = A.in[11]; const float* w_ckv = A.in[12]; const float* w_co = A.in[13];
    const float* w_gu = A.in[17]; const float* w_dn = A.in[19]; (void)w_gu; (void)w_dn;
    constexpr int I0 = 96 * 32, I1 = 32 * 32, I2 = 0, I3 = 64 * 32, I4 = 32 * 32, I5 = MOE_FP8 ? 0 : NEXP * 64 * 32, I6 = MOE_FP8 ? 0 : NEXP * 32 * 32;
    constexpr int NITEMS = I0 + I1 + I2 + I3 + I4 + I5 + I6;
    for (int it = gw; it < NITEMS; it += NGW) {
        int r = it; const float* W; int ldn, nct; bf16* dst; const float* gk = nullptr; int mode = 0;
        if (r < I0) { W = w_in; ldn = INC; nct = 96; dst = (bf16*)(F.ws + WS_WIN); }
        else if ((r -= I0) < I1) { W = w_out; ldn = DM; nct = 32; dst = (bf16*)(F.ws + WS_WOUT); }
        else if ((r -= I1) < I3) { W = w_ckv; ldn = 2 * DM; nct = 64; dst = (bf16*)(F.ws + WS_WCKV); }
        else if ((r -= I3) < I4) { W = w_co; ldn = DM; nct = 32; dst = (bf16*)(F.ws + WS_WCO); }
        else if ((r -= I4) < I5) { const int e = r / (64 * 32); r -= e * (64 * 32); W = w_gu + (size_t)e * DM * 2 * DFF; ldn = 2 * DFF; nct = 64; dst = (bf16*)(F.ws + WS_WGU) + (size_t)e * 2 * DFF * KD; mode = 1; }
        else { r -= I5; const int e = r / (32 * 32); r -= e * (32 * 32); W = w_dn + (size_t)e * DFF * DM; ldn = DM; nct = 32; dst = (bf16*)(F.ws + WS_WD) + (size_t)e * DM * KD; }
        const int kt = r / nct, ct = r - kt * nct; const int n0 = ct * 64;
        int drow = n0;
        if (mode == 1) drow = (n0 < DFF) ? ((n0 >> 7) * 256 + (n0 & 127)) : (((n0 - DFF) >> 7) * 256 + 128 + ((n0 - DFF) & 127));
        cvt_tile(W, ldn, kt * 64, n0, dst, drow, gk, scr, F.lane);
    }
#if MOE_FP8
    if (CONV_WGS) {
        for (int it = (32 - E_P0) * 1024 + gw; it < 32768; it += NGW) moe_item_fp8<false>(F, A, it, scr);
        for (int it = 32768 + (32 - D_P0) * 512 + gw; it < MOE_ITEMS; it += NGW) moe_item_fp8<false>(F, A, it, scr);
    }
#endif
    {
        const int gt = F.bid * NTHR + F.tid, NGT = F.G * NTHR;
        bf16* wlow = (bf16*)(F.ws + WS_WLOW); bf16* wrh = (bf16*)(F.ws + WS_WRH); bf16* wrl = (bf16*)(F.ws + WS_WRL);
        const float* w_r = A.in[15]; const float* g_moe = A.in[14];
        { const float* g_cross = A.in[9]; bf16* wcqn = (bf16*)(F.ws + WS_WCQ);
          for (int i = gt; i < DM * DM / 4; i += NGT) { const int k = i >> 9; const f32x4 v = *((const f32x4*)w_cq + i) * g_cross[k]; st_bf16x4(wcqn + (size_t)i * 4, v); } }
        for (int i = gt; i < 16 * KD; i += NGT) { const int k = i >> 4, r = i & 15; wlow[r * KD + k] = f2bf(w_in[(size_t)k * INC + NPROJ + r]); }
        for (int i = gt; i < 32 * KD; i += NGT) { const int k = i >> 5, e = i & 31; const float w = w_r[k * 32 + e] * g_moe[k]; const bf16 h = f2bf(w); wrh[e * KD + k] = h; wrl[e * KD + k] = f2bf(w - bf2f(h)); }
    }
    for (int m = gw; m < NT + NMEM; m += NGW) {
        if (m < NT) rms_row_bf16(A.in[0] + (size_t)m * DM, A.in[2], (bf16*)(F.ws + WS_H1) + (size_t)m * DM, F.lane);
        else rms_row_bf16(A.in[1] + (size_t)(m - NT) * DM, A.in[10], (bf16*)(F.ws + WS_MEMN) + (size_t)(m - NT) * DM, F.lane);
    }
}

__device__ __forceinline__ void conv_step(const Frame& F, const Args& A, int seq) {
    LAS unsigned* scr = (LAS unsigned*)(F.lds + F.wave * 16384);
    const int cw = F.bid - NCOMP;
    if (seq < 32) moe_items_stream<true, true>(F, A, seq * 1024 + (cw * NWAVES + F.wave) * 2, 1, 2, scr);
    else moe_item_fp8<true>(F, A, 32768 + (seq - 32) * 512 + cw * NWAVES + F.wave, scr);
    VM_WAIT(); __syncthreads();
    if (F.tid == 0) __hip_atomic_fetch_add((unsigned*)(F.ws + WS_CTL) + CW_EXP + 64 * seq, 1u, __ATOMIC_RELAXED, __HIP_MEMORY_SCOPE_AGENT);
}

#define EPI_LOOP(...) _Pragma("unroll") for (int ai = 0; ai < 2; ++ai) _Pragma("unroll") for (int m = 0; m < 4; ++m) { const int rl = ai * 128 + wr * 64 + m * 16 + fr; \
        _Pragma("unroll") for (int bj = 0; bj < 2; ++bj) _Pragma("unroll") for (int n = 0; n < 2; ++n) { const int cl = bj * 128 + wc * 32 + n * 16 + 4 * fq; const f32x4 v = acc[ai][bj][m][n]; __VA_ARGS__ } }
#define EPI_LOOP_P(...) _Pragma("unroll") for (int ai = 0; ai < 2; ++ai) _Pragma("unroll") for (int m = 0; m < 4; ++m) { const int rl = ai * 128 + wr * 64 + m * 16 + fr; \
        _Pragma("unroll") for (int bj = 0; bj < 2; ++bj) { const int cl = bj * 128 + wc * 32 + 8 * fq; const f32x4 v0 = acc[ai][bj][m][0], v1 = acc[ai][bj][m][1]; __VA_ARGS__ } }
__device__ __forceinline__ void st_bf16x8(bf16* p, f32x4 a, f32x4 b) { u32x4 w; w.x = cvt_pk_bf16(a.x, a.y); w.y = cvt_pk_bf16(a.z, a.w); w.z = cvt_pk_bf16(b.x, b.y); w.w = cvt_pk_bf16(b.z, b.w); *(u32x4*)p = w; }

struct EpiInProj {
    static constexpr bool PERM = true;
    unsigned char* ws;
    __device__ __forceinline__ void operator()(f32x4 (&acc)[2][2][4][2], const Unit& u, int wr, int wc, int fr, int fq) const {
        const int c0 = u.c0;
        if (c0 < 2048 || (c0 >= 3072 && c0 < 4096) || c0 >= 5120) {
            bf16* base; int ld, cc;
            if (c0 < 1024) { base = (bf16*)(ws + WS_SBQ); ld = 1024; cc = c0; }
            else if (c0 < 2048) { base = (bf16*)(ws + WS_SBK); ld = 1024; cc = c0 - 1024; }
            else if (c0 < 3584) { base = (bf16*)(ws + WS_GQ); ld = 512; cc = c0 - 3072; }
            else if (c0 < 4096) { base = (bf16*)(ws + WS_GK); ld = 512; cc = c0 - 3584; }
            else { base = (bf16*)(ws + WS_GR); ld = 1024; cc = c0 - 5120; }
            EPI_LOOP_P( st_bf16x8(base + (size_t)(u.r0 + rl) * ld + cc + cl, v0, v1); )
        } else {
            bf16* base = (bf16*)(ws + (c0 < 3072 ? WS_SBVT : WS_GVT)); const int cc = c0 - (c0 < 3072 ? 2048 : 4096);
            EPI_LOOP_P( const int r = u.r0 + rl, b = r >> 11, sq = r & 2047; const int c = cc + cl;
                _Pragma("unroll") for (int j = 0; j < 4; ++j) { base[((size_t)(b * 1024 + c + j)) * SEQ + sq] = f2bf(v0[j]); base[((size_t)(b * 1024 + c + 4 + j)) * SEQ + sq] = f2bf(v1[j]); } )
        }
    }
};
struct EpiKV {
    static constexpr bool PERM = true;
    unsigned char* ws;
    __device__ __forceinline__ void operator()(f32x4 (&acc)[2][2][4][2], const Unit& u, int wr, int wc, int fr, int fq) const {
        bf16* base = (bf16*)(ws + (u.c0 < 2048 ? WS_KVK : WS_KVVT)); const int cc = u.c0 < 2048 ? u.c0 : u.c0 - 2048;
        EPI_LOOP_P( st_bf16x8(base + (size_t)(u.r0 + rl) * DM + cc + cl, v0, v1); )
    }
};
struct EpiRes1 {
    static constexpr bool PERM = true;
    const float* x; float* x1; bf16* x1b; float* ssq;
    __device__ __forceinline__ void operator()(f32x4 (&acc)[2][2][4][2], const Unit& u, int wr, int wc, int fr, int fq) const {
#pragma unroll
        for (int ai = 0; ai < 2; ++ai)
#pragma unroll
            for (int m = 0; m < 4; ++m) { const int r = u.r0 + ai * 128 + wr * 64 + m * 16 + fr; float s = 0.f;
#pragma unroll
                for (int bj = 0; bj < 2; ++bj) { const int c = u.c0 + bj * 128 + wc * 32 + 8 * fq; const size_t o = (size_t)r * DM + c;
                    const f32x4 a = acc[ai][bj][m][0] + *(const f32x4*)(x + o), b = acc[ai][bj][m][1] + *(const f32x4*)(x + o + 4);
                    if constexpr (X1_F32) { *(f32x4*)(x1 + o) = a; *(f32x4*)(x1 + o + 4) = b; } st_bf16x8(x1b + o, a, b);
                    s += ((a.x * a.x + a.y * a.y) + (a.z * a.z + a.w * a.w)) + ((b.x * b.x + b.y * b.y) + (b.z * b.z + b.w * b.w)); }
                s += __shfl_xor(s, 16); s += __shfl_xor(s, 32);
                if (fq == 0) ssq[(size_t)((u.c0 >> 8) * 4 + wc) * NT + r] = s; }
    }
};
#if X1_F32
struct EpiRes2 {
    static constexpr bool PERM = false;
    const float* x1; const bf16* x1b; float* x2;
    __device__ __forceinline__ void operator()(f32x4 (&acc)[2][2][4][2], const Unit& u, int wr, int wc, int fr, int fq) const {
        EPI_LOOP( const size_t o = (size_t)(u.r0 + rl) * DM + u.c0 + cl; *(f32x4*)(x2 + o) = v + *(const f32x4*)(x1 + o); )
    }
};
#else
struct EpiRes2 {
    static constexpr bool PERM = true;
    const float* x1; const bf16* x1b; float* x2;
    __device__ __forceinline__ void operator()(f32x4 (&acc)[2][2][4][2], const Unit& u, int wr, int wc, int fr, int fq) const {
        EPI_LOOP_P( const size_t o = (size_t)(u.r0 + rl) * DM + u.c0 + cl; const u32x4 w = *(const u32x4*)(x1b + o);
            const f32x4 a = v0 + (f32x4){bflo(w.x), bfhi(w.x), bflo(w.y), bfhi(w.y)}, b = v1 + (f32x4){bflo(w.z), bfhi(w.z), bflo(w.w), bfhi(w.w)};
            if constexpr (X2_BF16 != 0) st_bf16x8((bf16*)x2 + o, a, b); else { *(f32x4*)(x2 + o) = a; *(f32x4*)(x2 + o + 4) = b; } )
    }
};
#endif
constexpr float WUNSC = (MOE_FP8 && MX_UNSCALED) ? (1.0f / 64.0f) : 1.0f;
struct EpiAct {
    static constexpr bool PERM = true;
    const float* bgu; bf16* act;
    __device__ __forceinline__ void operator()(f32x4 (&acc)[2][2][4][2], const Unit& u, int wr, int wc, int fr, int fq) const {
        const float* bg = bgu + (size_t)u.e * 2 * DFF; const int j0 = u.c0 + wc * 32 + 8 * fq;
        f32x4 b0[2], b1[2];
#pragma unroll
        for (int n = 0; n < 2; ++n) { b0[n] = *(const f32x4*)(bg + j0 + 4 * n); b1[n] = *(const f32x4*)(bg + DFF + j0 + 4 * n); }
#pragma unroll
        for (int ai = 0; ai < 2; ++ai)
#pragma unroll
            for (int m = 0; m < 4; ++m) { const int rl = ai * 128 + wr * 64 + m * 16 + fr; if (rl < u.rows) { f32x4 a[2];
#pragma unroll
                for (int n = 0; n < 2; ++n) { const f32x4 g = acc[ai][0][m][n] * WUNSC + b0[n], l = acc[ai][1][m][n] * WUNSC + b1[n];
#pragma unroll
                    for (int j = 0; j < 4; ++j) { const float gg = fminf(g[j], 7.0f), ll = fminf(fmaxf(l[j], -7.0f), 7.0f); a[n][j] = gg * frcp(1.0f + fexp2(-1.702f * LOG2E * gg)) * (ll + 1.0f); } }
#if MOE_FP8
                u32x2 w; w.x = pk_fp8x4(a[0].x, a[0].y, a[0].z, a[0].w); w.y = pk_fp8x4(a[1].x, a[1].y, a[1].z, a[1].w);
                *(u32x2*)((unsigned char*)act + (size_t)(u.r0 + rl) * DFF + j0) = w;
#else
                st_bf16x8(act + (size_t)(u.r0 + rl) * DFF + j0, a[0], a[1]);
#endif
                } }
    }
};
struct EpiY {
    static constexpr bool PERM = true;
    const float* bd; const float* sw; bf16* y;
    __device__ __forceinline__ void operator()(f32x4 (&acc)[2][2][4][2], const Unit& u, int wr, int wc, int fr, int fq) const {
        const float* bb = bd + (size_t)u.e * DM;
        f32x4 bv[2][2];
#pragma unroll
        for (int bj = 0; bj < 2; ++bj)
#pragma unroll
            for (int n = 0; n < 2; ++n) bv[bj][n] = *(const f32x4*)(bb + u.c0 + bj * 128 + wc * 32 + 8 * fq + 4 * n);
#pragma unroll
        for (int ai = 0; ai < 2; ++ai)
#pragma unroll
            for (int m = 0; m < 4; ++m) { const int rl = ai * 128 + wr * 64 + m * 16 + fr; if (rl < u.rows) { const float w = sw[u.r0 + rl];
#pragma unroll
                for (int bj = 0; bj < 2; ++bj) { const int c = u.c0 + bj * 128 + wc * 32 + 8 * fq; const f32x4 y0 = (acc[ai][bj][m][0] * WUNSC + bv[bj][0]) * w, y1 = (acc[ai][bj][m][1] * WUNSC + bv[bj][1]) * w;
#if Y_FP8
                    u32x2 yw; yw.x = pk_fp8x4(y0.x * 16.0f, y0.y * 16.0f, y0.z * 16.0f, y0.w * 16.0f); yw.y = pk_fp8x4(y1.x * 16.0f, y1.y * 16.0f, y1.z * 16.0f, y1.w * 16.0f);
                    *(u32x2*)((unsigned char*)y + (size_t)(u.r0 + rl) * DM + c) = yw;
#else
                    st_bf16x8(y + (size_t)(u.r0 + rl) * DM + c, y0, y1);
#endif
                    } } }
    }
};

constexpr int RSC_OFF = RED2_OFF + 4096;
__device__ __forceinline__ void xattn_row_scales(LAS unsigned char* lds, const float* __restrict__ ssq, int r0) {
    const int t = threadIdx.x, row = t >> 1, hf = t & 1; float q = 0.f;
#pragma unroll
    for (int pp = 0; pp < 16; ++pp) q += ssq[(size_t)(16 * hf + pp) * NT + r0 + row];
    q += __shfl_xor(q, 1);
    if (hf == 0) ((LAS float*)(lds + RSC_OFF))[row] = (0.04419417382415922f * LOG2E) / sqrtf(q * (1.f / DM) + EPS);
    __syncthreads();
}
struct EpiSoftmax {
    static constexpr bool PERM = true;
    LAS unsigned char* lds; bf16* P;
    __device__ __forceinline__ void operator()(f32x4 (&acc)[2][2][4][2], const Unit& u, int wr, int wc, int fr, int fq) const {
        LAS float* red1 = (LAS float*)(lds + RED1_OFF); LAS float* red2 = (LAS float*)(lds + RED2_OFF);
        float rs[2][4];
#pragma unroll
        for (int ai = 0; ai < 2; ++ai)
#pragma unroll
            for (int m = 0; m < 4; ++m) rs[ai][m] = ((const LAS float*)(lds + RSC_OFF))[ai * 128 + wr * 64 + m * 16 + fr];
#pragma unroll
        for (int ai = 0; ai < 2; ++ai)
#pragma unroll
            for (int m = 0; m < 4; ++m) { const int rl = ai * 128 + wr * 64 + m * 16 + fr; float mx = -3.0e38f;
#pragma unroll
                for (int bj = 0; bj < 2; ++bj)
#pragma unroll
                    for (int n = 0; n < 2; ++n) { const f32x4 v = acc[ai][bj][m][n]; mx = fmaxf(fmaxf(mx, fmaxf(v.x, v.y)), fmaxf(v.z, v.w)); }
                mx = fmaxf(mx, __shfl_xor(mx, 16)); mx = fmaxf(mx, __shfl_xor(mx, 32));
                if (fq == 0) red1[rl * 4 + wc] = mx; }
        asm volatile("s_waitcnt lgkmcnt(0)" ::: "memory"); __builtin_amdgcn_s_barrier(); asm volatile("" ::: "memory");
#pragma unroll
        for (int ai = 0; ai < 2; ++ai)
#pragma unroll
            for (int m = 0; m < 4; ++m) { const int rl = ai * 128 + wr * 64 + m * 16 + fr; const f32x4 mv = *(const LAS f32x4*)(red1 + rl * 4);
                const float mx = fmaxf(fmaxf(mv.x, mv.y), fmaxf(mv.z, mv.w)); float sum = 0.f;
#pragma unroll
                for (int bj = 0; bj < 2; ++bj)
#pragma unroll
                    for (int n = 0; n < 2; ++n) { f32x4 v = acc[ai][bj][m][n];
#pragma unroll
                        for (int j = 0; j < 4; ++j) { v[j] = fexp2((v[j] - mx) * rs[ai][m]); sum += v[j]; }
                        acc[ai][bj][m][n] = v; }
                sum += __shfl_xor(sum, 16); sum += __shfl_xor(sum, 32);
                if (fq == 0) red2[rl * 4 + wc] = sum; }
        asm volatile("s_waitcnt lgkmcnt(0)" ::: "memory"); __builtin_amdgcn_s_barrier(); asm volatile("" ::: "memory");
#pragma unroll
        for (int ai = 0; ai < 2; ++ai)
#pragma unroll
            for (int m = 0; m < 4; ++m) { const int rl = ai * 128 + wr * 64 + m * 16 + fr; const f32x4 sv = *(const LAS f32x4*)(red2 + rl * 4);
                const float inv = 1.0f / ((sv.x + sv.y) + (sv.z + sv.w));
#pragma unroll
                for (int bj = 0; bj < 2; ++bj) st_bf16x8(P + (size_t)(u.r0 + rl) * 1024 + u.c0 + bj * 128 + wc * 32 + 8 * fq, acc[ai][bj][m][0] * inv, acc[ai][bj][m][1] * inv); }
        asm volatile("s_waitcnt lgkmcnt(0)" ::: "memory"); __builtin_amdgcn_s_barrier(); asm volatile("" ::: "memory");
    }
};
struct XpreOrder {
    const char* Kk; const char* Wcqn; const char* Wcot; const char* Vv; int c;
    __device__ bool next(int i, Unit& u) const { if (i > 0 || c >= 256) return false; u.rows = 256; u.e = 0;
        if (c < 128) { const int bh = c >> 3, nt = c & 7, b = bh >> 2, h = bh & 3;
            u.a = Kk + ((size_t)(b * MEMLEN) * DM + h * 512) * 2; u.b = Wcqn + ((size_t)(nt * 256) * DM + h * 512) * 2; u.r0 = bh * 256; u.c0 = nt * 256; u.e = 0; }
        else { const int q = c - 128, bh = q >> 3, nt = q & 7, b = bh >> 2, h = bh & 3;
            u.a = Wcot + ((size_t)(nt * 256) * DM + h * 512) * 2; u.b = Vv + ((size_t)(b * MEMLEN) * DM + h * 512) * 2; u.r0 = b * DM + nt * 256; u.c0 = h * 256; u.e = 1; }
        return true; }
    __device__ __forceinline__ void a_ready(const Unit&) const {}
};
struct EpiXpre {
    static constexpr bool PERM = true;
    bf16* MT; bf16* VWT;
    __device__ __forceinline__ void operator()(f32x4 (&acc)[2][2][4][2], const Unit& u, int wr, int wc, int fr, int fq) const {
        bf16* O = u.e ? VWT : MT; const int ld = u.e ? 1024 : DM;
        EPI_LOOP_P( st_bf16x8(O + (size_t)(u.r0 + rl) * ld + u.c0 + cl, v0, v1); )
    }
};
struct MixOrder {
    pg8::DenseOrder D; XpreOrder X; int c;
    __device__ bool next(int i, Unit& u) const { if (i > 1) return false; const bool first_dense = true;
        if ((i == 0) == first_dense) { const bool ok = D.next(0, u); u.e = 0; u.nt = 32; return ok; }
        const bool ok = X.next(0, u); u.e = u.e + 1; u.nt = 8; return ok; }
    __device__ __forceinline__ void a_ready(const Unit&) const {}
};
struct EpiMix {
    static constexpr bool PERM = true;
    EpiRes1 R; EpiXpre Xp;
    __device__ __forceinline__ void operator()(f32x4 (&acc)[2][2][4][2], const Unit& u, int wr, int wc, int fr, int fq) const {
        if (u.e == 0) R(acc, u, wr, wc, fr, fq); else { Unit v = u; v.e = u.e - 1; Xp(acc, v, wr, wc, fr, fq); }
    }
};
struct XsOrder {
    const char* X; const char* MT; int c;
    __device__ bool next(int i, Unit& u) const { if (i > 0 || c >= 128) return false; const int bh = c >> 3, qt = c & 7, b = bh >> 2, h = bh & 3;
        u.a = X + ((size_t)(b * SEQ + 256 * qt) * DM) * 2; u.b = MT + ((size_t)(bh * 256) * DM) * 2; u.r0 = b * SEQ + 256 * qt; u.c0 = h * 256; u.rows = 256; u.e = 0; return true; }
    __device__ __forceinline__ void a_ready(const Unit&) const {}
};
struct XoutOrder {
    const char* P; const char* VWT; int c;
    __device__ bool next(int i, Unit& u) const { if (i > 0 || c >= 256) return false; const int b = c >> 6, pm = (c >> 3) & 7, pn = c & 7;
        u.a = P + ((size_t)(b * SEQ + 256 * pm) * 1024) * 2; u.b = VWT + ((size_t)(b * DM + 256 * pn) * 1024) * 2; u.r0 = b * SEQ + 256 * pm; u.c0 = 256 * pn; u.rows = 256; u.e = 0; return true; }
    __device__ __forceinline__ void a_ready(const Unit&) const {}
};
struct KvOrder {
    const char* A; const char* Bt; int c;
    __device__ bool next(int i, Unit& u) const { if (i > 0 || c >= 64) return false; const int pm = c >> 4, pn = c & 15;
        u.a = A + (size_t)pm * 256 * KD * 2; u.b = Bt + (size_t)pn * 256 * KD * 2; u.r0 = pm * 256; u.c0 = pn * 256; u.rows = 256; u.e = 0; return true; }
    __device__ __forceinline__ void a_ready(const Unit&) const {}
};
struct MoeOrder {
    const LAS int* tab; const char* A; const char* Bt; int ntn, G, c; size_t bstride; int ocol; int pitchb;
    __device__ bool next(int i, Unit& u) const {
        const int idx = i * G + c; const int total = __builtin_amdgcn_readfirstlane(tab[32]);
        if (idx >= total) return false;
        int e = 0;
        for (int q = 1; q < 32; ++q) { const int p = __builtin_amdgcn_readfirstlane(tab[q]); if (idx >= p) e = q; }
        const int ue = __builtin_amdgcn_readfirstlane(tab[e]), st = __builtin_amdgcn_readfirstlane(tab[64 + e]), cn = __builtin_amdgcn_readfirstlane(tab[128 + e]);
        const int local = idx - ue, mt = local / ntn, nt = local - mt * ntn;
        u.a = A + (size_t)(st + 256 * mt) * pitchb; u.b = Bt + (size_t)e * bstride + (size_t)nt * 256 * pitchb;
        u.r0 = st + 256 * mt; u.c0 = nt * ocol; u.rows = (cn - 256 * mt) < 256 ? (cn - 256 * mt) : 256; u.e = e; return true;
    }
    const unsigned* ecnt; int* ready; int hi_ready;
    __device__ __forceinline__ void a_ready(const Unit& u) const {
        if (ecnt == nullptr || u.e <= *ready || u.e >= hi_ready) return;
        if (threadIdx.x < 64) { unsigned sp = 0;
            while ((unsigned)__builtin_amdgcn_readfirstlane(__hip_atomic_load(ecnt + 64 * u.e, __ATOMIC_RELAXED, __HIP_MEMORY_SCOPE_AGENT)) < (unsigned)CONV_WGS) { __builtin_amdgcn_s_sleep(4); if (++sp > (1u << 22)) break; }
            __builtin_amdgcn_fence(__ATOMIC_ACQUIRE, "agent");
            asm volatile("s_waitcnt vmcnt(0)" ::: "memory"); }
        asm volatile("" ::: "memory"); __builtin_amdgcn_s_barrier(); asm volatile("" ::: "memory");
        *ready = u.e;
    }
};
__device__ __forceinline__ void moe_table(const Frame& F, int ntn) {
    LAS int* tab = (LAS int*)(F.lds + TAB_OFF); const int* cs = (const int*)(F.ws + WS_CNT);
    if (F.tid < 32) { tab[64 + F.tid] = cs[32 + F.tid]; tab[128 + F.tid] = cs[F.tid]; }
    __syncthreads();
    if (F.tid == 0) { int p = 0; for (int e = 0; e < 32; ++e) { tab[e] = p; p += ((tab[128 + e] + 255) >> 8) * ntn; } tab[32] = p; }
    __syncthreads();
}

__device__ __forceinline__ void gla_low_job(const Frame& F) {
    const bf16* h1 = (const bf16*)(F.ws + WS_H1); const bf16* wl = (const bf16*)(F.ws + WS_WLOW); float* glow = (float*)(F.ws + WS_GLOW);
    LAS float* red = (LAS float*)F.lds;
    const int l = F.lane, r16 = l & 15, quad = l >> 4;
    for (int rb = F.bid; rb < NT / 32; rb += F.G) {
        f32x4 acc[2] = {{0.f, 0.f, 0.f, 0.f}, {0.f, 0.f, 0.f, 0.f}};
#pragma unroll
        for (int st = 0; st < 8; ++st) { const int k0 = 256 * F.wave + 32 * st + 8 * quad;
            const bf16x8 bfr = *(const bf16x8*)(wl + (size_t)r16 * KD + k0);
#pragma unroll
            for (int tb = 0; tb < 2; ++tb) { const bf16x8 afr = *(const bf16x8*)(h1 + (size_t)(rb * 32 + tb * 16 + r16) * KD + k0);
                acc[tb] = __builtin_amdgcn_mfma_f32_16x16x32_bf16(afr, bfr, acc[tb], 0, 0, 0); } }
#pragma unroll
        for (int tb = 0; tb < 2; ++tb)
#pragma unroll
            for (int j = 0; j < 4; ++j) red[(F.wave * 32 + tb * 16 + 4 * quad + j) * 16 + r16] = acc[tb][j];
        __syncthreads();
        { const int tok = F.tid >> 4, r = F.tid & 15; float s = 0.f;
#pragma unroll
          for (int w = 0; w < 8; ++w) s += red[(w * 32 + tok) * 16 + r];
          glow[(size_t)(rb * 32 + tok) * 16 + r] = s; }
        __syncthreads();
    }
}

__device__ __forceinline__ void sb_attn_wave(const Frame& F, const float* __restrict__ sb_g, int wu) {
    const bf16* Q = (const bf16*)(F.ws + WS_SBQ); const bf16* Kp = (const bf16*)(F.ws + WS_SBK); const bf16* VT = (const bf16*)(F.ws + WS_SBVT); bf16* O = (bf16*)(F.ws + WS_MIXO);
    const int l = F.lane, r = l & 31, hh = l >> 5;
    const int qb = 63 - (wu & 63), bh = wu >> 6, b = bh >> 3, h = bh & 7;
    const int t0 = qb * 32;
    bf16x8 qf[8];
#pragma unroll
    for (int st = 0; st < 8; ++st) qf[st] = *(const bf16x8*)(Q + (size_t)(b * SEQ + t0 + r) * 1024 + h * 128 + 16 * st + 8 * hh);
    f32x16 o[4];
#pragma unroll
    for (int d = 0; d < 4; ++d)
#pragma unroll
        for (int i = 0; i < 16; ++i) o[d][i] = 0.f;
    float R = 0.f;
    const float zs = 0.08838834764831845f * LOG2E;
    const int qpos = t0 + r;
    for (int kt = qb; kt >= 0; --kt) {
        f32x16 s;
#pragma unroll
        for (int i = 0; i < 16; ++i) s[i] = 0.f;
#pragma unroll
        for (int st = 0; st < 8; ++st) { const bf16x8 kf = *(const bf16x8*)(Kp + (size_t)(b * SEQ + kt * 32 + r) * 1024 + h * 128 + 16 * st + 8 * hh);
            s = __builtin_amdgcn_mfma_f32_32x32x16_bf16(kf, qf[st], s, 0, 0, 0); }
        float lm[16], lb[16];
#pragma unroll
        for (int i = 0; i < 16; ++i) { const int key = kt * 32 + (i & 3) + 8 * (i >> 2) + 4 * hh; const float z2 = s[i] * zs; const bool valid = key < qpos;
            const float sp = fmaxf(z2, 0.f) + flog2(1.f + fexp2(-fabsf(z2)));
            lm[i] = valid ? -sp : 0.f; lb[i] = z2 - sp; }
        float Gown[4], Gpar[4];
#pragma unroll
        for (int c = 0; c < 4; ++c) { Gown[c] = (lm[4 * c] + lm[4 * c + 1]) + (lm[4 * c + 2] + lm[4 * c + 3]); Gpar[c] = __shfl_xor(Gown[c], 32); }
        float sufT[4]; sufT[3] = 0.f;
#pragma unroll
        for (int c = 2; c >= 0; --c) sufT[c] = sufT[c + 1] + (Gown[c + 1] + Gpar[c + 1]);
        float p[16];
#pragma unroll
        for (int c = 0; c < 4; ++c) { float run = R + sufT[c] + (hh == 0 ? Gpar[c] : 0.f);
#pragma unroll
            for (int e = 3; e >= 0; --e) { const int i = 4 * c + e; const int key = kt * 32 + e + 8 * c + 4 * hh;
                p[i] = (key < qpos) ? fexp2(lb[i] + run) : 0.f; run += lm[i]; } }
        R += (Gown[0] + Gpar[0]) + (Gown[1] + Gpar[1]) + (Gown[2] + Gpar[2]) + (Gown[3] + Gpar[3]);
#pragma unroll
        for (int s2 = 0; s2 < 2; ++s2) {
            u32x4 pw; pw.x = cvt_pk_bf16(p[8 * s2 + 0], p[8 * s2 + 1]); pw.y = cvt_pk_bf16(p[8 * s2 + 2], p[8 * s2 + 3]); pw.z = cvt_pk_bf16(p[8 * s2 + 4], p[8 * s2 + 5]); pw.w = cvt_pk_bf16(p[8 * s2 + 6], p[8 * s2 + 7]);
            const bf16x8 pb = __builtin_bit_cast(bf16x8, pw);
#pragma unroll
            for (int d = 0; d < 4; ++d) { const bf16* vp = VT + ((size_t)(bh * 128 + d * 32 + r)) * SEQ + kt * 32 + 16 * s2 + 4 * hh;
                u32x4 vw; const u32x2 v0 = *(const u32x2*)vp, v1 = *(const u32x2*)(vp + 8); vw.x = v0.x; vw.y = v0.y; vw.z = v1.x; vw.w = v1.y;
                o[d] = __builtin_amdgcn_mfma_f32_32x32x16_bf16(__builtin_bit_cast(bf16x8, vw), pb, o[d], 0, 0, 0); } }
        if (__all(R < -40.f)) break;
    }
    float ss = 0.f;
#pragma unroll
    for (int d = 0; d < 4; ++d)
#pragma unroll
        for (int i = 0; i < 16; ++i) ss += o[d][i] * o[d][i];
    ss += __shfl_xor(ss, 32);
    const float rstd = 1.0f / sqrtf(ss * (1.f / 128.f) + EPS);
#pragma unroll
    for (int d = 0; d < 4; ++d)
#pragma unroll
        for (int c = 0; c < 4; ++c) { const int dim = 32 * d + 8 * c + 4 * hh; const f32x4 g = *(const f32x4*)(sb_g + h * 128 + dim);
            f32x4 v; v.x = o[d][4 * c] * rstd * g.x; v.y = o[d][4 * c + 1] * rstd * g.y; v.z = o[d][4 * c + 2] * rstd * g.z; v.w = o[d][4 * c + 3] * rstd * g.w;
            st_bf16x4(O + (size_t)(b * SEQ + qpos) * DM + h * 128 + dim, v); }
}

constexpr int G1_QIN = 0, G1_KIN = 64 * 136 * 2, G1_KDT = 2 * 64 * 136 * 2, G1_LOW = G1_KDT + 128 * 72 * 2, G1_SEG = G1_LOW + 64 * 16 * 4, G1_QRAW = G1_SEG + 4 * 128 * 4, G1_KRAW = G1_QRAW + 64 * 128 * 2, G1_END = G1_KRAW + 64 * 128 * 2;
constexpr int G1_KVT = G1_QRAW;
static_assert(G1_END <= RING_BYTES && G1_KVT + 65536 <= RING_BYTES && (G1_KVT & 15) == 0, "g1 lds");
__device__ __forceinline__ void gla_g1_unit(const Frame& F, const float* __restrict__ w2, const float* __restrict__ b2, int unit) {
    const int n = unit & 31, bh = unit >> 5, b = bh >> 2, h = bh & 3;
    const int t0 = b * SEQ + 64 * n;
    const bf16* GQ = (const bf16*)(F.ws + WS_GQ); const bf16* GK = (const bf16*)(F.ws + WS_GK); const bf16* GVT = (const bf16*)(F.ws + WS_GVT); const float* GLOW = (const float*)(F.ws + WS_GLOW);
    LAS bf16* qin = (LAS bf16*)(F.lds + G1_QIN); LAS bf16* kin = (LAS bf16*)(F.lds + G1_KIN); LAS bf16* kdt = (LAS bf16*)(F.lds + G1_KDT);
    LAS float* lowl = (LAS float*)(F.lds + G1_LOW); LAS float* seg = (LAS float*)(F.lds + G1_SEG);
    for (int i = F.tid; i < 64 * 16; i += NTHR) lowl[i] = GLOW[(size_t)t0 * 16 + i];
    LAS bf16* qraw = (LAS bf16*)(F.lds + G1_QRAW); LAS bf16* kraw = (LAS bf16*)(F.lds + G1_KRAW);
#pragma unroll
    for (int q2 = 0; q2 < 2; ++q2) { const int id = F.tid + 512 * q2, row = id >> 4, ch = id & 15;
        *(LAS u32x4*)(qraw + row * 128 + ch * 8) = *(const u32x4*)(GQ + (size_t)(t0 + row) * 512 + h * 128 + ch * 8);
        *(LAS u32x4*)(kraw + row * 128 + ch * 8) = *(const u32x4*)(GK + (size_t)(t0 + row) * 512 + h * 128 + ch * 8); }
    __syncthreads();
    const int d = F.tid & 127, sg = F.tid >> 7, dd = h * 128 + d;
    float wcol[16];
#pragma unroll
    for (int r = 0; r < 16; ++r) wcol[r] = w2[r * 512 + dd];
    const float bias = b2[dd];
    float pre[16]; float run = 0.f;
#pragma unroll
    for (int i = 0; i < 16; ++i) { const int c = 16 * sg + i; float z = bias;
#pragma unroll
        for (int r4 = 0; r4 < 4; ++r4) { const f32x4 lv = *(const LAS f32x4*)(lowl + c * 16 + 4 * r4); z += lv.x * wcol[4 * r4] + lv.y * wcol[4 * r4 + 1] + lv.z * wcol[4 * r4 + 2] + lv.w * wcol[4 * r4 + 3]; }
        run += log2_sigmoid2(z * LOG2E) * (1.0f / 16.0f);
        pre[i] = run; }
    seg[sg * 128 + d] = run;
    __syncthreads();
    float off = 0.f, tot = 0.f;
#pragma unroll
    for (int s = 0; s < 4; ++s) { const float v = seg[s * 128 + d]; tot += v; if (s < sg) off += v; }
    bf16* QIN = (bf16*)(F.ws + WS_QIN);
#pragma unroll
    for (int i = 0; i < 16; ++i) { const int c = 16 * sg + i; const float g = off + pre[i];
        const float qv = bf2f(qraw[c * 128 + d]), kv = bf2f(kraw[c * 128 + d]);
        const bf16 qi = f2bf(qv * 0.08838834764831845f * fexp2(g));
        qin[c * 136 + d] = qi;
        kin[c * 136 + d] = f2bf(kv * fexp2(-g));
        kdt[d * 72 + c] = f2bf(kv * fexp2(tot - g)); }
    if (sg == 0) ((float*)(F.ws + WS_DECAY))[(size_t)unit * 128 + d] = fexp2(tot);
    __syncthreads();
#pragma unroll
    for (int q2 = 0; q2 < 2; ++q2) { const int id = F.tid + 512 * q2, row = id >> 4, ch = id & 15;
        *(u32x4*)(QIN + (size_t)(t0 + row) * 512 + h * 128 + ch * 8) = *(const LAS u32x4*)(qin + row * 136 + ch * 8); }
    const int w = F.wave, l = F.lane, r = l & 31, hh = l >> 5, cb = w & 1, dvp = w >> 1;
    f32x16 X[2];
#pragma unroll
    for (int sb = 0; sb < 2; ++sb) {
#pragma unroll
        for (int i = 0; i < 16; ++i) X[sb][i] = 0.f;
#pragma unroll
        for (int st = 0; st < 8; ++st) { const bf16x8 af = *(const LAS bf16x8*)(kin + (32 * sb + r) * 136 + 16 * st + 8 * hh), bfq = *(const LAS bf16x8*)(qin + (32 * cb + r) * 136 + 16 * st + 8 * hh);
            X[sb] = __builtin_amdgcn_mfma_f32_32x32x16_bf16(af, bfq, X[sb], 0, 0, 0); }
#pragma unroll
        for (int i = 0; i < 16; ++i) { const int s = 32 * sb + (i & 3) + 8 * (i >> 2) + 4 * hh; if (32 * cb + r < s) X[sb][i] = 0.f; }
    }
    u32x4* OI = (u32x4*)(F.ws + WS_OINTRA) + ((size_t)unit * 8 + w) * 256;
#pragma unroll
    for (int dbi = 0; dbi < 2; ++dbi) { const int db = 2 * dvp + dbi; f32x16 oacc;
#pragma unroll
        for (int i = 0; i < 16; ++i) oacc[i] = 0.f;
#pragma unroll
        for (int sb = 0; sb < 2; ++sb)
#pragma unroll
            for (int s2 = 0; s2 < 2; ++s2) {
                u32x4 pw; pw.x = cvt_pk_bf16(X[sb][8 * s2 + 0], X[sb][8 * s2 + 1]); pw.y = cvt_pk_bf16(X[sb][8 * s2 + 2], X[sb][8 * s2 + 3]); pw.z = cvt_pk_bf16(X[sb][8 * s2 + 4], X[sb][8 * s2 + 5]); pw.w = cvt_pk_bf16(X[sb][8 * s2 + 6], X[sb][8 * s2 + 7]);
                const bf16* vp = GVT + ((size_t)(bh * 256 + db * 32 + r)) * SEQ + 64 * n + 32 * sb + 16 * s2 + 4 * hh;
                u32x4 vw; const u32x2 v0 = *(const u32x2*)vp, v1 = *(const u32x2*)(vp + 8); vw.x = v0.x; vw.y = v0.y; vw.z = v1.x; vw.w = v1.y;
                oacc = __builtin_amdgcn_mfma_f32_32x32x16_bf16(__builtin_bit_cast(bf16x8, vw), __builtin_bit_cast(bf16x8, pw), oacc, 0, 0, 0); }
#pragma unroll
        for (int q4 = 0; q4 < 2; ++q4) { u32x4 ow; ow.x = cvt_pk_bf16(oacc[8 * q4], oacc[8 * q4 + 1]); ow.y = cvt_pk_bf16(oacc[8 * q4 + 2], oacc[8 * q4 + 3]); ow.z = cvt_pk_bf16(oacc[8 * q4 + 4], oacc[8 * q4 + 5]); ow.w = cvt_pk_bf16(oacc[8 * q4 + 6], oacc[8 * q4 + 7]);
            OI[(dbi * 2 + q4) * 64 + l] = ow; } }
    bf16* KVN = (bf16*)(F.ws + WS_KVN) + (size_t)unit * 32768; LAS bf16* kvt = (LAS bf16*)(F.lds + G1_KVT);
    bf16x8 vf[4];
#pragma unroll
    for (int st = 0; st < 4; ++st) vf[st] = *(const bf16x8*)(GVT + ((size_t)(bh * 256 + w * 32 + r)) * SEQ + 64 * n + 16 * st + 8 * hh);
#pragma unroll
    for (int dkb = 0; dkb < 4; ++dkb) { f32x16 kacc;
#pragma unroll
        for (int i = 0; i < 16; ++i) kacc[i] = 0.f;
#pragma unroll
        for (int st = 0; st < 4; ++st) { const bf16x8 bk = *(const LAS bf16x8*)(kdt + (32 * dkb + r) * 72 + 16 * st + 8 * hh);
            kacc = __builtin_amdgcn_mfma_f32_32x32x16_bf16(vf[st], bk, kacc, 0, 0, 0); }
#pragma unroll
        for (int i = 0; i < 16; ++i) kvt[(32 * w + (i & 3) + 8 * (i >> 2) + 4 * hh) * 128 + 32 * dkb + r] = f2bf(kacc[i]); }
    LDS_WAIT();
#pragma unroll
    for (int q8 = 0; q8 < 8; ++q8) { const int row = 32 * w + 4 * q8 + (l >> 4), ch = l & 15;
        *(u32x4*)(KVN + (size_t)row * 128 + ch * 8) = *(const LAS u32x4*)(kvt + row * 128 + ch * 8); }
    __syncthreads();
}

__device__ __forceinline__ void gla_scan(const Frame& F) {
    const bf16* KVN = (const bf16*)(F.ws + WS_KVN); const float* DEC = (const float*)(F.ws + WS_DECAY); bf16* ST = (bf16*)(F.ws + WS_STATE);
    for (int g = F.bid * NTHR + F.tid; g < 16 * 8192; g += F.G * NTHR) {
        const int bh = g >> 13, e4 = (g & 8191) * 4, dk = e4 & 127;
        f32x4 S = {0.f, 0.f, 0.f, 0.f};
#pragma unroll 8
        for (int n = 0; n < 32; ++n) { const size_t u = (size_t)(bh * 32 + n);
            st_bf16x4(ST + u * 32768 + e4, S);
            const u32x2 kw = *(const u32x2*)(KVN + u * 32768 + e4); const f32x4 kv = {bflo(kw.x), bfhi(kw.x), bflo(kw.y), bfhi(kw.y)}, dc = *(const f32x4*)(DEC + u * 128 + dk);
            S = S * dc + kv; }
    }
}

__device__ __forceinline__ void gla_g3_unit(const Frame& F, const float* __restrict__ gn, int unit) {
    const int n = unit & 31, bh = unit >> 5, b = bh >> 2, h = bh & 3; const int t0 = b * SEQ + 64 * n;
    const int w = F.wave, l = F.lane, r = l & 31, hh = l >> 5, cb = w & 1, dvp = w >> 1;
    const bf16* QIN = (const bf16*)(F.ws + WS_QIN); const bf16* ST = (const bf16*)(F.ws + WS_STATE) + (size_t)unit * 32768; const bf16* GR = (const bf16*)(F.ws + WS_GR); bf16* O = (bf16*)(F.ws + WS_MIXO);
    const u32x4* OI = (const u32x4*)(F.ws + WS_OINTRA) + ((size_t)unit * 8 + w) * 256;
    LAS float* part = (LAS float*)F.lds;
    bf16x8 qf[8];
#pragma unroll
    for (int st = 0; st < 8; ++st) qf[st] = *(const bf16x8*)(QIN + (size_t)(t0 + 32 * cb + r) * 512 + h * 128 + 16 * st + 8 * hh);
    f32x16 o[2]; float ss = 0.f;
#pragma unroll
    for (int dbi = 0; dbi < 2; ++dbi) { const int db = 2 * dvp + dbi;
#pragma unroll
        for (int q4 = 0; q4 < 2; ++q4) { const u32x4 ow = OI[(dbi * 2 + q4) * 64 + l];
            o[dbi][8 * q4] = bflo(ow.x); o[dbi][8 * q4 + 1] = bfhi(ow.x); o[dbi][8 * q4 + 2] = bflo(ow.y); o[dbi][8 * q4 + 3] = bfhi(ow.y); o[dbi][8 * q4 + 4] = bflo(ow.z); o[dbi][8 * q4 + 5] = bfhi(ow.z); o[dbi][8 * q4 + 6] = bflo(ow.w); o[dbi][8 * q4 + 7] = bfhi(ow.w); }
#pragma unroll
        for (int st = 0; st < 8; ++st) { const bf16x8 sf = *(const bf16x8*)(ST + (size_t)(32 * db + r) * 128 + 16 * st + 8 * hh);
            o[dbi] = __builtin_amdgcn_mfma_f32_32x32x16_bf16(sf, qf[st], o[dbi], 0, 0, 0); }
#pragma unroll
        for (int i = 0; i < 16; ++i) ss += o[dbi][i] * o[dbi][i]; }
    ss += __shfl_xor(ss, 32);
    if (hh == 0) part[w * 32 + r] = ss;
    __syncthreads();
    float tot = 0.f;
#pragma unroll
    for (int q = 0; q < 4; ++q) tot += part[(2 * q + cb) * 32 + r];
    const float rstd = 1.0f / sqrtf(tot * (1.f / 256.f) + EPS);
    const int tok = t0 + 32 * cb + r;
#pragma unroll
    for (int dbi = 0; dbi < 2; ++dbi)
#pragma unroll
        for (int c = 0; c < 4; ++c) { const int dv = 32 * (2 * dvp + dbi) + 8 * c + 4 * hh; const f32x4 g = *(const f32x4*)(gn + h * 256 + dv);
            const u32x2 rw = *(const u32x2*)(GR + (size_t)tok * 1024 + h * 256 + dv);
            const float r0 = bflo(rw.x), r1 = bfhi(rw.x), r2 = bflo(rw.y), r3 = bfhi(rw.y);
            f32x4 v; v.x = o[dbi][4 * c] * rstd * g.x * (r0 * frcp(1.f + fexp2(-r0 * LOG2E))); v.y = o[dbi][4 * c + 1] * rstd * g.y * (r1 * frcp(1.f + fexp2(-r1 * LOG2E)));
            v.z = o[dbi][4 * c + 2] * rstd * g.z * (r2 * frcp(1.f + fexp2(-r2 * LOG2E))); v.w = o[dbi][4 * c + 3] * rstd * g.w * (r3 * frcp(1.f + fexp2(-r3 * LOG2E)));
            st_bf16x4(O + (size_t)tok * DM + 1024 + h * 256 + dv, v); }
    __syncthreads();
}
__device__ __forceinline__ void gla_g3_pair(const Frame& F, const float* __restrict__ gn, int uA, int uB) {
    const int w = F.wave, l = F.lane, r = l & 31, hh = l >> 5, w4 = w & 3, cb = w4 & 1, dvh = w4 >> 1;
    const int unit = (w < 4) ? uA : uB; const bool act = unit >= 0;
    const int uu = act ? unit : 0, n = uu & 31, bh = uu >> 5, b = bh >> 2, h = bh & 3; const int t0 = b * SEQ + 64 * n;
    const bf16* QIN = (const bf16*)(F.ws + WS_QIN); const bf16* ST = (const bf16*)(F.ws + WS_STATE) + (size_t)uu * 32768; const bf16* GR = (const bf16*)(F.ws + WS_GR); bf16* O = (bf16*)(F.ws + WS_MIXO);
    LAS float* part = (LAS float*)F.lds;
    f32x16 o[4]; float ss = 0.f;
    if (act) {
        bf16x8 qf[8];
#pragma unroll
        for (int st = 0; st < 8; ++st) qf[st] = *(const bf16x8*)(QIN + (size_t)(t0 + 32 * cb + r) * 512 + h * 128 + 16 * st + 8 * hh);
#pragma unroll
        for (int dbi = 0; dbi < 4; ++dbi) { const int db = 4 * dvh + dbi;
            const u32x4* OI = (const u32x4*)(F.ws + WS_OINTRA) + ((size_t)uu * 8 + (2 * (db >> 1) + cb)) * 256 + ((db & 1) * 2) * 64 + l;
#pragma unroll
            for (int q4 = 0; q4 < 2; ++q4) { const u32x4 ow = OI[q4 * 64];
                o[dbi][8 * q4] = bflo(ow.x); o[dbi][8 * q4 + 1] = bfhi(ow.x); o[dbi][8 * q4 + 2] = bflo(ow.y); o[dbi][8 * q4 + 3] = bfhi(ow.y); o[dbi][8 * q4 + 4] = bflo(ow.z); o[dbi][8 * q4 + 5] = bfhi(ow.z); o[dbi][8 * q4 + 6] = bflo(ow.w); o[dbi][8 * q4 + 7] = bfhi(ow.w); }
#pragma unroll
            for (int st = 0; st < 8; ++st) { const bf16x8 sf = *(const bf16x8*)(ST + (size_t)(32 * db + r) * 128 + 16 * st + 8 * hh);
                o[dbi] = __builtin_amdgcn_mfma_f32_32x32x16_bf16(sf, qf[st], o[dbi], 0, 0, 0); }
#pragma unroll
            for (int i = 0; i < 16; ++i) ss += o[dbi][i] * o[dbi][i]; }
        ss += __shfl_xor(ss, 32);
        if (hh == 0) part[w * 32 + r] = ss;
    }
    __syncthreads();
    if (act) {
        const float tot = part[((w & 4) + cb) * 32 + r] + part[((w & 4) + cb + 2) * 32 + r];
        const float rstd = 1.0f / sqrtf(tot * (1.f / 256.f) + EPS);
        const int tok = t0 + 32 * cb + r;
#pragma unroll
        for (int dbi = 0; dbi < 4; ++dbi)
#pragma unroll
            for (int c = 0; c < 4; ++c) { const int dv = 32 * (4 * dvh + dbi) + 8 * c + 4 * hh; const f32x4 g = *(const f32x4*)(gn + h * 256 + dv);
                const u32x2 rw = *(const u32x2*)(GR + (size_t)tok * 1024 + h * 256 + dv);
                const float r0 = bflo(rw.x), r1 = bfhi(rw.x), r2 = bflo(rw.y), r3 = bfhi(rw.y);
                f32x4 v; v.x = o[dbi][4 * c] * rstd * g.x * (r0 * frcp(1.f + fexp2(-r0 * LOG2E))); v.y = o[dbi][4 * c + 1] * rstd * g.y * (r1 * frcp(1.f + fexp2(-r1 * LOG2E)));
                v.z = o[dbi][4 * c + 2] * rstd * g.z * (r2 * frcp(1.f + fexp2(-r2 * LOG2E))); v.w = o[dbi][4 * c + 3] * rstd * g.w * (r3 * frcp(1.f + fexp2(-r3 * LOG2E)));
                st_bf16x4(O + (size_t)tok * DM + 1024 + h * 256 + dv, v); }
    }
    __syncthreads();
}

__device__ __forceinline__ void router_phase(const Frame& F, const float* __restrict__ b_router) {
    const float* X2 = (const float*)(F.ws + WS_X2); const bf16* WH = (const bf16*)(F.ws + WS_WRH); const bf16* WL = (const bf16*)(F.ws + WS_WRL);
    int* TOPE = (int*)(F.ws + WS_TOPE); float* TOPW = (float*)(F.ws + WS_TOPW); float* RSTD = (float*)(F.ws + WS_RSTD3); int* HIST = (int*)(F.ws + WS_HIST);
    LAS float* part = (LAS float*)F.lds;
    LAS float* sq = (LAS float*)(F.lds + 32768);
    LAS int* hist = (LAS int*)(F.lds + 33792);
    const int w = F.wave, l = F.lane, r16 = l & 15, quad = l >> 4;
    for (int rb = F.bid; rb < NT / 32; rb += F.G) {
        if (F.tid < 32) hist[F.tid] = 0;
        f32x4 acc[2][2] = {{{0.f, 0.f, 0.f, 0.f}, {0.f, 0.f, 0.f, 0.f}}, {{0.f, 0.f, 0.f, 0.f}, {0.f, 0.f, 0.f, 0.f}}}; float ssq[2] = {0.f, 0.f};
#pragma unroll 4
        for (int st = 0; st < 8; ++st) { const int k0 = 256 * w + 32 * st + 8 * quad;
            bf16x8 bh[2], bl[2];
#pragma unroll
            for (int eb = 0; eb < 2; ++eb) { bh[eb] = *(const bf16x8*)(WH + (size_t)(16 * eb + r16) * KD + k0); bl[eb] = *(const bf16x8*)(WL + (size_t)(16 * eb + r16) * KD + k0); }
#pragma unroll
            for (int tg = 0; tg < 2; ++tg) { const int row = rb * 32 + 16 * tg + r16;
#if X2_BF16
                const u32x4 xw = *(const u32x4*)((const bf16*)X2 + (size_t)row * DM + k0);
                { const float x0 = bflo(xw.x), x1 = bfhi(xw.x), x2 = bflo(xw.y), x3 = bfhi(xw.y), x4 = bflo(xw.z), x5 = bfhi(xw.z), x6 = bflo(xw.w), x7 = bfhi(xw.w);
                  ssq[tg] += (x0 * x0 + x1 * x1) + (x2 * x2 + x3 * x3) + (x4 * x4 + x5 * x5) + (x6 * x6 + x7 * x7); }
                const bf16x8 ah = __builtin_bit_cast(bf16x8, xw);
#pragma unroll
                for (int eb = 0; eb < 2; ++eb) {
                    acc[tg][eb] = __builtin_amdgcn_mfma_f32_16x16x32_bf16(ah, bh[eb], acc[tg][eb], 0, 0, 0);
                    acc[tg][eb] = __builtin_amdgcn_mfma_f32_16x16x32_bf16(ah, bl[eb], acc[tg][eb], 0, 0, 0); } } }
#else
                const f32x4 xa = *(const f32x4*)(X2 + (size_t)row * DM + k0), xb = *(const f32x4*)(X2 + (size_t)row * DM + k0 + 4);
                ssq[tg] += (xa.x * xa.x + xa.y * xa.y) + (xa.z * xa.z + xa.w * xa.w) + (xb.x * xb.x + xb.y * xb.y) + (xb.z * xb.z + xb.w * xb.w);
                u32x4 hw; hw.x = cvt_pk_bf16(xa.x, xa.y); hw.y = cvt_pk_bf16(xa.z, xa.w); hw.z = cvt_pk_bf16(xb.x, xb.y); hw.w = cvt_pk_bf16(xb.z, xb.w);
                u32x4 lw; lw.x = cvt_pk_bf16(xa.x - bflo(hw.x), xa.y - bfhi(hw.x)); lw.y = cvt_pk_bf16(xa.z - bflo(hw.y), xa.w - bfhi(hw.y));
                lw.z = cvt_pk_bf16(xb.x - bflo(hw.z), xb.y - bfhi(hw.z)); lw.w = cvt_pk_bf16(xb.z - bflo(hw.w), xb.w - bfhi(hw.w));
                const bf16x8 ah = __builtin_bit_cast(bf16x8, hw), alo = __builtin_bit_cast(bf16x8, lw);
#pragma unroll
                for (int eb = 0; eb < 2; ++eb) {
                    acc[tg][eb] = __builtin_amdgcn_mfma_f32_16x16x32_bf16(ah, bh[eb], acc[tg][eb], 0, 0, 0);
                    acc[tg][eb] = __builtin_amdgcn_mfma_f32_16x16x32_bf16(ah, bl[eb], acc[tg][eb], 0, 0, 0);
                    acc[tg][eb] = __builtin_amdgcn_mfma_f32_16x16x32_bf16(alo, bh[eb], acc[tg][eb], 0, 0, 0); } } }
#endif
#pragma unroll
        for (int tg = 0; tg < 2; ++tg) { float q = ssq[tg]; q += __shfl_xor(q, 16); q += __shfl_xor(q, 32);
            if (quad == 0) sq[w * 32 + 16 * tg + r16] = q;
#pragma unroll
            for (int eb = 0; eb < 2; ++eb)
#pragma unroll
                for (int j = 0; j < 4; ++j) part[(w * 32 + 16 * tg + 4 * quad + j) * 32 + 16 * eb + r16] = acc[tg][eb][j]; }
        __syncthreads();
        for (int q2 = 0; q2 < 2; ++q2) { const int hf = l >> 5, e = l & 31; const int ti = 4 * w + 2 * q2 + hf; const int tok = rb * 32 + ti;
            LAS float* lg = (LAS float*)(F.lds + 36864) + (w * 2 + hf) * 32; LAS float* tvr = (LAS float*)(F.lds + 40960) + (w * 2 + hf) * 4;
            float s2 = 0.f, a = 0.f;
#pragma unroll
            for (int k = 0; k < 8; ++k) { s2 += sq[k * 32 + ti]; a += part[(k * 32 + ti) * 32 + e]; }
            const float rstd = 1.0f / sqrtf(s2 * (1.f / DM) + EPS);
            float v = a * rstd + b_router[e]; v = (v == v) ? v : -3.0e38f;
            lg[e] = v;
            LDS_WAIT();
            int rank = 0;
#pragma unroll
            for (int j4 = 0; j4 < 8; ++j4) { const f32x4 o = *(const LAS f32x4*)(lg + 4 * j4);
                rank += (o.x > v || (o.x == v && 4 * j4 + 0 < e)) ? 1 : 0; rank += (o.y > v || (o.y == v && 4 * j4 + 1 < e)) ? 1 : 0;
                rank += (o.z > v || (o.z == v && 4 * j4 + 2 < e)) ? 1 : 0; rank += (o.w > v || (o.w == v && 4 * j4 + 3 < e)) ? 1 : 0; }
            if (rank < 4) tvr[rank] = v;
            LDS_WAIT();
            const f32x4 t = *(const LAS f32x4*)tvr;
            const float e1 = fexp2((t.y - t.x) * LOG2E), e2 = fexp2((t.z - t.x) * LOG2E), e3 = fexp2((t.w - t.x) * LOG2E); const float inv = 1.0f / (1.0f + e1 + e2 + e3);
            if (rank < 4) { TOPE[tok * 4 + rank] = e; TOPW[tok * 4 + rank] = fexp2((v - t.x) * LOG2E) * inv; atomicAdd((int*)&hist[e], 1); }
            if (e == 0) RSTD[tok] = rstd;
            LDS_WAIT(); }
        __syncthreads();
        if (F.tid < 32) HIST[rb * 32 + F.tid] = hist[F.tid];
        __syncthreads();
    }
}

__device__ __forceinline__ void slots_phase(const Frame& F, const float* __restrict__ g_moe) {
    const float* X2 = (const float*)(F.ws + WS_X2); const int* TOPE = (const int*)(F.ws + WS_TOPE); const float* TOPW = (const float*)(F.ws + WS_TOPW); const float* RSTD = (const float*)(F.ws + WS_RSTD3);
    const int* HIST = (const int*)(F.ws + WS_HIST); float* SLOTW = (float*)(F.ws + WS_SLOTW); int* TOKSLOT = (int*)(F.ws + WS_TOKSLOT); int* CNT = (int*)(F.ws + WS_CNT); bf16* XS = (bf16*)(F.ws + WS_XS);
    LAS int* ptot = (LAS int*)F.lds;
    LAS int* pbel = ptot + 512;
    LAS int* base = pbel + 512;
    LAS int* asg = base + 32;
    LAS int* aslot = asg + 128;
    for (int rb = F.bid; rb < NT / 32; rb += F.G) {
        { const int e = F.tid & 31, p = F.tid >> 5; int t = 0, bl = 0;
          for (int q = 0; q < 16; ++q) { const int bb = 16 * p + q; const int hv = HIST[bb * 32 + e]; t += hv; if (bb < rb) bl += hv; }
          ptot[p * 32 + e] = t; pbel[p * 32 + e] = bl; }
        if (F.tid < 128) asg[F.tid] = TOPE[rb * 128 + F.tid];
        __syncthreads();
        if (F.tid < 32) { int t = 0, bl = 0; for (int p = 0; p < 16; ++p) { t += ptot[p * 32 + F.tid]; bl += pbel[p * 32 + F.tid]; }
            ptot[F.tid] = t; pbel[F.tid] = bl; }
        __syncthreads();
        if (F.tid < 32) { int st = 0; for (int e = 0; e < F.tid; ++e) st += ptot[e]; base[F.tid] = st + pbel[F.tid];
            if (rb == 0) { CNT[F.tid] = ptot[F.tid]; CNT[32 + F.tid] = st; }
            int run = base[F.tid]; for (int i = 0; i < 128; ++i) if (asg[i] == F.tid) { aslot[i] = run; ++run; } }
        __syncthreads();
        if (F.tid < 128) { const int sl = aslot[F.tid]; TOKSLOT[rb * 128 + F.tid] = sl; SLOTW[sl] = TOPW[rb * 128 + F.tid]; }
        for (int q = 0; q < 4; ++q) { const int ti = 4 * F.wave + q, tok = rb * 32 + ti; const float rstd = RSTD[tok];
            const f32x4* xr = (const f32x4*)(X2 + (size_t)tok * DM) + F.lane; const f32x4* gr = (const f32x4*)g_moe + F.lane; (void)xr;
#if MOE_FP8
            unsigned hw[8];
#if X2_BF16
            const u32x2* xh = (const u32x2*)((const bf16*)X2 + (size_t)tok * DM) + F.lane;
#pragma unroll
            for (int j = 0; j < 8; ++j) { const u32x2 xw = xh[64 * j]; const f32x4 g = gr[64 * j]; hw[j] = pk_fp8x4(bflo(xw.x) * rstd * g.x, bfhi(xw.x) * rstd * g.y, bflo(xw.y) * rstd * g.z, bfhi(xw.y) * rstd * g.w); }
#else
#pragma unroll
            for (int j = 0; j < 8; ++j) { const f32x4 v = xr[64 * j], g = gr[64 * j]; hw[j] = pk_fp8x4(v.x * rstd * g.x, v.y * rstd * g.y, v.z * rstd * g.z, v.w * rstd * g.w); }
#endif
            LAS unsigned* rowb = (LAS unsigned*)(F.lds + 16384 + F.wave * 2048);
#pragma unroll
            for (int j = 0; j < 8; ++j) rowb[64 * j + F.lane] = hw[j];
            LDS_WAIT();
            const u32x4 w0 = *(const LAS u32x4*)(rowb + 4 * F.lane), w1 = *(const LAS u32x4*)(rowb + 256 + 4 * F.lane);
#pragma unroll
            for (int k = 0; k < 4; ++k) { const int sl = aslot[ti * 4 + k]; u32x4* o16 = (u32x4*)((unsigned char*)XS + (size_t)sl * DM) + F.lane;
                o16[0] = w0; o16[64] = w1; }
            LDS_WAIT();
#else
            u32x2 hw[8];
#pragma unroll
            for (int j = 0; j < 8; ++j) { const f32x4 v = xr[64 * j], g = gr[64 * j]; hw[j].x = cvt_pk_bf16(v.x * rstd * g.x, v.y * rstd * g.y); hw[j].y = cvt_pk_bf16(v.z * rstd * g.z, v.w * rstd * g.w); }
#pragma unroll
            for (int k = 0; k < 4; ++k) { const int sl = aslot[ti * 4 + k]; u32x2* o8 = (u32x2*)(XS + (size_t)sl * DM) + F.lane;
#pragma unroll
                for (int j = 0; j < 8; ++j) o8[64 * j] = hw[j]; }
#endif
            }
        __syncthreads();
    }
}

__device__ __forceinline__ void final_phase(const Frame& F, const float* __restrict__ g_fin, float* __restrict__ out) {
    const float* X2 = (const float*)(F.ws + WS_X2); const bf16* Y = (const bf16*)(F.ws + WS_Y); const int* TOKSLOT = (const int*)(F.ws + WS_TOKSLOT);
    const int gw = F.bid * NWAVES + F.wave, NGW = F.G * NWAVES;
    for (int tok = gw; tok < NT; tok += NGW) {
        const f32x4* xr = (const f32x4*)(X2 + (size_t)tok * DM) + F.lane;
        f32x4 v[8];
#if X2_BF16
        { const u32x2* xh = (const u32x2*)((const bf16*)X2 + (size_t)tok * DM) + F.lane; (void)xr;
#pragma unroll
          for (int j = 0; j < 8; ++j) { const u32x2 xw = xh[64 * j]; v[j] = (f32x4){bflo(xw.x), bfhi(xw.x), bflo(xw.y), bfhi(xw.y)}; } }
#else
#pragma unroll
        for (int j = 0; j < 8; ++j) v[j] = xr[64 * j];
#endif
#pragma unroll
#if Y_FP8
        for (int k = 0; k < 4; ++k) { const int sl = TOKSLOT[tok * 4 + k]; const unsigned* yr = (const unsigned*)((const unsigned char*)Y + (size_t)sl * DM) + F.lane;
#pragma unroll
            for (int j = 0; j < 8; ++j) { const int yw = (int)yr[64 * j]; const f32x2 lo = __builtin_amdgcn_cvt_pk_f32_fp8(yw, false), hi = __builtin_amdgcn_cvt_pk_f32_fp8(yw, true);
                v[j].x += lo.x * 0.0625f; v[j].y += lo.y * 0.0625f; v[j].z += hi.x * 0.0625f; v[j].w += hi.y * 0.0625f; } }
#else
        for (int k = 0; k < 4; ++k) { const int sl = TOKSLOT[tok * 4 + k]; const u32x2* yr = (const u32x2*)(Y + (size_t)sl * DM) + F.lane;
#pragma unroll
            for (int j = 0; j < 8; ++j) { const u32x2 yw = yr[64 * j]; v[j].x += bflo(yw.x); v[j].y += bfhi(yw.x); v[j].z += bflo(yw.y); v[j].w += bfhi(yw.y); } }
#endif
        float s = 0.f;
#pragma unroll
        for (int j = 0; j < 8; ++j) s += (v[j].x * v[j].x + v[j].y * v[j].y) + (v[j].z * v[j].z + v[j].w * v[j].w);
        const float rstd = 1.0f / sqrtf(wave_sum(s) * (1.f / DM) + EPS);
        f32x4* orow = (f32x4*)(out + (size_t)tok * DM) + F.lane; const f32x4* gr = (const f32x4*)g_fin + F.lane;
#pragma unroll
        for (int j = 0; j < 8; ++j) orow[64 * j] = v[j] * rstd * gr[64 * j];
    }
}

constexpr int N_PHASES = 14;
__global__ void __launch_bounds__(NTHR, 2) fwd_kernel(Args args) {
    extern __shared__ __attribute__((aligned(16))) unsigned char lds[];
    Frame F;
    F.lds = (LAS unsigned char*)lds;
    F.tid = threadIdx.x; F.lane = F.tid & 63; F.wave = __builtin_amdgcn_readfirstlane(F.tid >> 6);
    F.G = gridDim.x; F.bid = blockIdx.x; F.ws = args.ws;
    for (int u = F.tid; u < (LDS_BYTES - LDSCTL_OFF) / 4; u += NTHR) ((LAS unsigned*)(F.lds + LDSCTL_OFF))[u] = 0u;
    __syncthreads();
    unsigned* ctl = (unsigned*)(args.ws + WS_CTL);
    XcdBarrier bar; bar.bar = ctl + CW_BAR; bar.x = 0; bar.st = nullptr;
    const bool fused = (args.ph_hi - args.ph_lo) > 1;
    if (fused) bar = xcd_barrier_post(ctl + CW_BAR, (volatile LAS unsigned*)(F.lds + MISC_OFF));
    const int lo = args.ph_lo, hi = args.ph_hi;
    const bool conv_on = fused && CONV_WGS > 0 && F.G == 256;
    const bool conv_wg = conv_on && F.bid >= NCOMP;
    Frame FC = F; if (conv_on) FC.G = NCOMP;
#define IN(k) (lo <= (k) && (k) < hi)
#define REP(k) _Pragma("unroll") for (int _r = 0; _r < 1 + ((DUP_MASK >> (k)) & 1); ++_r)
#define SEAM(k) do { if (IN(k) && IN((k) + 1)) xcd_barrier(bar); } while (0)

    if (IN(0)) REP(0) { p0_prologue(F, args);
        if (!conv_on) { LAS unsigned* scr = (LAS unsigned*)(F.lds + F.wave * 16384);
            for (int it = F.bid * NWAVES + F.wave; it < MOE_ITEMS; it += F.G * NWAVES) if (!CONV_WGS || !((it >= (32 - E_P0) * 1024 && it < 32768) || it >= 32768 + (32 - D_P0) * 512)) moe_item_fp8<false>(F, args, it, scr); }
    } SEAM(0);

    if (IN(1)) REP(1) {
        if (conv_wg) {
            { KvOrder S{(const char*)(F.ws + WS_MEMN), (const char*)(F.ws + WS_WCKV), F.bid - NCOMP}; EpiKV E{F.ws}; pg8::gemm_phase<4096, 32, false>(F.lds, S, E); }
            LAS unsigned* scr = (LAS unsigned*)(F.lds + F.wave * 16384); const int w2 = (F.bid - NCOMP) * NWAVES + F.wave;
            moe_items_stream<false, true>(F, args, w2, CONV_WGS * NWAVES, CONV_NA / (CONV_WGS * NWAVES), scr); }
        else {
        pg8::DenseOrder S; S.init(F.ws + WS_H1, F.ws + WS_WIN, NT, NPROJ, FC.G, F.bid);
        EpiInProj E{F.ws};
        pg8::gemm_phase<4096, 32, false>(F.lds, S, E);
        gla_low_job(FC);
        }
    } SEAM(1);

    if (IN(2)) REP(2) {
        {
        const bool kv_here = !(conv_on && CONV_WGS == 64);
        if (kv_here && F.bid < 64) { KvOrder S{(const char*)(F.ws + WS_MEMN), (const char*)(F.ws + WS_WCKV), F.bid}; EpiKV E{F.ws}; pg8::gemm_phase<4096, 32, false>(F.lds, S, E); }
        REP(14) { if (kv_here && F.G > 64) { if (F.bid >= 64) for (int u = F.bid - 64; u < 512; u += F.G - 64) gla_g1_unit(F, args.in[4], args.in[5], u); }
        else { for (int u = F.bid; u < 512; u += F.G) gla_g1_unit(F, args.in[4], args.in[5], u); } }
        REP(15) { for (int wu = F.bid * NWAVES + F.wave; wu < 2048; wu += F.G * NWAVES) sb_attn_wave(F, args.in[6], wu); }
        }
    } SEAM(2);

    if (IN(3)) REP(3) { gla_scan(F); } SEAM(3);

    if (IN(4)) REP(4) { for (int u = F.bid; u < 512; u += 2 * F.G) gla_g3_pair(F, args.in[7], u, (u + F.G < 512) ? u + F.G : -1); } SEAM(4);

    if (IN(5)) REP(5) {
        if (F.G == 256) {
            MixOrder S; S.D.init(F.ws + WS_MIXO, F.ws + WS_WOUT, NT, DM, F.G, F.bid); S.X = XpreOrder{(const char*)(F.ws + WS_KVK), (const char*)(F.ws + WS_WCQ), (const char*)(F.ws + WS_WCO), (const char*)(F.ws + WS_KVVT), F.bid}; S.c = F.bid;
            EpiMix E{EpiRes1{args.in[0], (float*)(F.ws + WS_X1), (bf16*)(F.ws + WS_X1B), (float*)(F.ws + WS_SSQ)}, EpiXpre{(bf16*)(F.ws + WS_MT), (bf16*)(F.ws + WS_VWT)}};
            pg8::gemm_phase<4096, 0, false>(F.lds, S, E);
        } else {
            { pg8::DenseOrder S; S.init(F.ws + WS_MIXO, F.ws + WS_WOUT, NT, DM, F.G, F.bid); EpiRes1 E{args.in[0], (float*)(F.ws + WS_X1), (bf16*)(F.ws + WS_X1B), (float*)(F.ws + WS_SSQ)}; pg8::gemm_phase<4096, 32, false>(F.lds, S, E); }
            for (int c = F.bid; c < 256; c += F.G) { XpreOrder S{(const char*)(F.ws + WS_KVK), (const char*)(F.ws + WS_WCQ), (const char*)(F.ws + WS_WCO), (const char*)(F.ws + WS_KVVT), c}; EpiXpre E{(bf16*)(F.ws + WS_MT), (bf16*)(F.ws + WS_VWT)}; pg8::gemm_phase<4096, 8, false>(F.lds, S, E); }
        }
    } SEAM(5);

    if (IN(7)) REP(7) {
        if (F.bid < 128) { const int bh = F.bid >> 3, qt = F.bid & 7; xattn_row_scales(F.lds, (const float*)(F.ws + WS_SSQ), (bh >> 2) * SEQ + 256 * qt); }
        { XsOrder S{(const char*)(F.ws + WS_X1B), (const char*)(F.ws + WS_MT), F.bid}; EpiSoftmax E{F.lds, (bf16*)(F.ws + WS_P)};
          pg8::gemm_phase<4096, 32, false>(F.lds, S, E); }
        if (conv_on && F.bid >= 128) {
            LAS unsigned* scr = (LAS unsigned*)(F.lds + F.wave * 16384); const int w2 = (F.bid - 128) * NWAVES + F.wave;
            moe_items_stream<false, true>(F, args, CONV_NA + w2, 1024, CONV_NB / 1024, scr); }
    } SEAM(7);

    if (IN(8)) REP(8) {
        XoutOrder S{(const char*)(F.ws + WS_P), (const char*)(F.ws + WS_VWT), F.bid};
        EpiRes2 E{(const float*)(F.ws + WS_X1), (const bf16*)(F.ws + WS_X1B), (float*)(F.ws + WS_X2)};
        pg8::gemm_phase<2048, 16, false>(F.lds, S, E);
    } SEAM(8);

    if (IN(9)) REP(9) { router_phase(F, args.in[16]); } SEAM(9);

    if (IN(10)) REP(10) { slots_phase(F, args.in[14]); } SEAM(10);

    if (IN(11)) REP(11) {
        moe_table(F, 16);
        constexpr int PB = MOE_FP8 ? 2048 : 4096;
        if (conv_wg) { for (int seq = E_PRE; seq < 32 - E_P0; ++seq) conv_step(F, args, seq); for (int seq = 32; seq < 32 + DN_IN_P11; ++seq) conv_step(F, args, seq); }
        else {
        int ready = conv_on ? E_PRE - 1 : 31;
        MoeOrder S{(const LAS int*)(F.lds + TAB_OFF), (const char*)(F.ws + WS_XS), (const char*)(F.ws + WS_WGU), 16, FC.G, F.bid, (size_t)2 * DFF * PB, 128, PB, conv_on ? (const unsigned*)(F.ws + WS_CTL) + CW_EXP : nullptr, &ready, 32 - E_P0};
        EpiAct E{args.in[18], (bf16*)(F.ws + WS_ACT)};
        pg8::gemm_phase<PB, MOE_FP8 ? 16 : 32, MOE_FP8 != 0>(F.lds, S, E);
        }
    } SEAM(11);

    if (IN(12)) REP(12) {
        moe_table(F, 8);
        constexpr int PB = MOE_FP8 ? 2048 : 4096;
        if (conv_wg) { for (int seq = 32 + DN_IN_P11; seq < 64 - D_P0; ++seq) conv_step(F, args, seq); }
        else {
        int ready = conv_on ? DN_IN_P11 - 1 : 31;
        MoeOrder S{(const LAS int*)(F.lds + TAB_OFF), (const char*)(F.ws + WS_ACT), (const char*)(F.ws + WS_WD), 8, FC.G, F.bid, (size_t)DM * PB, 256, PB, conv_on ? (const unsigned*)(F.ws + WS_CTL) + CW_EXP + 64 * 32 : nullptr, &ready, 32 - D_P0};
        EpiY E{args.in[20], (const float*)(F.ws + WS_SLOTW), (bf16*)(F.ws + WS_Y)};
        pg8::gemm_phase<PB, MOE_FP8 ? 16 : 32, MOE_FP8 != 0>(F.lds, S, E);
        }
    } SEAM(12);

#ifdef EXTRA_BARS
    if (fused) { for (int i = 0; i < EXTRA_BARS; ++i) xcd_barrier(bar); }
#endif
    if (IN(13)) REP(13) { final_phase(F, args.in[21], args.out); }
#undef IN
#undef SEAM
}

extern "C" void kernel_launch(void* const* d_in, const int* in_sizes, int n_in, void* d_out, int out_size, void* d_ws, size_t ws_size, hipStream_t stream) {
    static int grid = 0;
    if (grid == 0) {
        if (n_in != 22 || out_size != NT * DM || ws_size < WS_END) { fprintf(stderr, "kernel_launch: unexpected problem (n_in %d out %d ws %zu need %zu)\n", n_in, out_size, ws_size, (size_t)WS_END); grid = -1; return; }
        int dev = 0, cus = 0, per_cu = 0;
        if (hipGetDevice(&dev) != hipSuccess || hipDeviceGetAttribute(&cus, hipDeviceAttributeMultiprocessorCount, dev) != hipSuccess) { grid = -1; return; }
        if (hipFuncSetAttribute((const void*)fwd_kernel, hipFuncAttributeMaxDynamicSharedMemorySize, LDS_BYTES) != hipSuccess) { fprintf(stderr, "kernel_launch: hipFuncSetAttribute failed\n"); grid = -1; return; }
        if (hipOccupancyMaxActiveBlocksPerMultiprocessor(&per_cu, (const void*)fwd_kernel, NTHR, LDS_BYTES) != hipSuccess || per_cu < 1) fprintf(stderr, "kernel_launch: occupancy query reports %d\n", per_cu);
        (void)hipGetLastError();
        grid = cus;
    }
    if (grid < 0) return;
    (void)hipMemsetAsync((char*)d_ws + WS_CTL, 0, CTL_ZERO_BYTES, stream);
    Args a{};
    for (int i = 0; i < 22; ++i) a.in[i] = (const float*)d_in[i];
    a.out = (float*)d_out; a.ws = (unsigned char*)d_ws;
#if MK_N_LAUNCHES == 1
    a.ph_lo = 0; a.ph_hi = N_PHASES;
    hipLaunchKernelGGL(fwd_kernel, dim3(grid), dim3(NTHR), LDS_BYTES, stream, a);
#else
    for (int p = 0; p < N_PHASES; ++p) { a.ph_lo = p; a.ph_hi = p + 1; hipLaunchKernelGGL(fwd_kernel, dim3(grid), dim3(NTHR), LDS_BYTES, stream, a); }
#endif
}
```

```cpp
#include <hip/hip_runtime.h>
#include <cstdio>
#include <cstdint>

#ifndef MK_N_LAUNCHES
#define MK_N_LAUNCHES 1
#endif
#ifndef MOE_FP8
#define MOE_FP8 1
#endif
#ifndef CONV_LD_AUX
#define CONV_LD_AUX 2
#endif
#ifndef Y_FP8
#define Y_FP8 1
#endif
#ifndef MX_UNSCALED
#define MX_UNSCALED 1
#endif
#ifndef WCVT_SCALE
#define WCVT_SCALE 0.015625f
#endif
#ifndef DUP_MASK
#define DUP_MASK 0
#endif

#define GAS __attribute__((address_space(1)))
#define LAS __attribute__((address_space(3)))
typedef unsigned short bf16;
typedef short bf16x8 __attribute__((ext_vector_type(8)));
typedef float f32x2 __attribute__((ext_vector_type(2)));
typedef float f32x4 __attribute__((ext_vector_type(4)));
typedef float f32x16 __attribute__((ext_vector_type(16)));
typedef unsigned u32x2 __attribute__((ext_vector_type(2)));
typedef unsigned u32x4 __attribute__((ext_vector_type(4)));
typedef GAS unsigned gu32;

#define LDS_WAIT() asm volatile("s_waitcnt lgkmcnt(0)" ::: "memory")
#define VM_WAIT() asm volatile("s_waitcnt vmcnt(0)" ::: "memory")

constexpr int DM = 2048, NB = 4, SEQ = 2048, NT = NB * SEQ;
constexpr int INC = 6160, NPROJ = 6144;
constexpr int MEMLEN = 256, NMEM = NB * MEMLEN;
constexpr int NEXP = 32, TOPK = 4, NASSIGN = NT * TOPK, DFF = 2048;
constexpr float EPS = 1e-6f;
constexpr float LOG2E = 1.4426950408889634f, LN2 = 0.6931471805599453f;
constexpr int KD = 2048;

typedef __bf16 bf16x2_t __attribute__((ext_vector_type(2)));
__device__ __forceinline__ unsigned cvt_pk_bf16(float lo, float hi) { const f32x2 v = {lo, hi}; const bf16x2_t b = __builtin_convertvector(v, bf16x2_t); return __builtin_bit_cast(unsigned, b); }
__device__ __forceinline__ bf16 f2bf(float f) { return (bf16)(cvt_pk_bf16(f, 0.f) & 0xffffu); }
__device__ __forceinline__ float bf2f(unsigned b) { return __uint_as_float(b << 16); }
__device__ __forceinline__ float bflo(unsigned w) { return __uint_as_float(w << 16); }
__device__ __forceinline__ float bfhi(unsigned w) { return __uint_as_float(w & 0xffff0000u); }
__device__ __forceinline__ void st_bf16x4(bf16* p, f32x4 v) { u32x2 w; w.x = cvt_pk_bf16(v.x, v.y); w.y = cvt_pk_bf16(v.z, v.w); *(u32x2*)p = w; }
__device__ __forceinline__ float wave_sum(float v) {
#pragma unroll
    for (int o = 1; o < 64; o <<= 1) v += __shfl_xor(v, o);
    return v;
}
__device__ __forceinline__ float fexp2(float x) { return __builtin_amdgcn_exp2f(x); }
__device__ __forceinline__ float flog2(float x) { return __builtin_amdgcn_logf(x); }
__device__ __forceinline__ float frcp(float x) { return __builtin_amdgcn_rcpf(x); }
__device__ __forceinline__ float log2_sigmoid2(float z2) { return -(fmaxf(-z2, 0.f) + flog2(1.f + fexp2(-fabsf(z2)))); }

namespace pg8 {
constexpr int BM = 256, BK = 64, HALF = 128, HTB = HALF * BK * 2, STAGE_BYTES = 8 * HTB, NXCD = 8, WGM = 8;
__host__ __device__ __forceinline__ int lds_byte(int r, int c) { const int st = (r >> 4) * 2 + (c >> 5), rr = r & 15, cc = c & 31, ob = rr * 64 + cc * 2; return st * 1024 + (ob ^ (((ob >> 9) & 1) << 5)); }
__host__ __device__ __forceinline__ void stage_rc(int b, int& R, int& C) { const int st = b / 1024, sb = b % 1024, swz = sb ^ (((sb >> 9) & 1) << 5); R = (st >> 1) * 16 + swz / 64; C = (st & 1) * 32 + (swz % 64) / 2; }

typedef int v8i __attribute__((ext_vector_type(8)));
typedef int v4i __attribute__((ext_vector_type(4)));
__device__ __forceinline__ v8i cat8(bf16x8 lo, bf16x8 hi) { const v4i a = __builtin_bit_cast(v4i, lo), b = __builtin_bit_cast(v4i, hi); return (v8i){a.x, a.y, a.z, a.w, b.x, b.y, b.z, b.w}; }
__host__ __device__ __forceinline__ int perm32(int rho) { const int n = rho >> 4, i = rho & 15; return 8 * (i >> 2) + 4 * n + (i & 3); }
struct Unit { const char* a; const char* b; int r0, c0, rows, e, nt; };

struct DenseOrder {
    const char* A; const char* Bt; int nM, nN, nwg, G, c;
    __device__ void init(const void* A_, const void* Bt_, int M, int N, int G_, int c_) { A = (const char*)A_; Bt = (const char*)Bt_; nM = M / BM; nN = N / BM; nwg = nM * nN; G = G_; c = c_; }
    __device__ bool next(int i, Unit& u) const {
        const long L = (long)i * G + c; if (L >= nwg) return false;
        int wgid = (int)L; { const int q = nwg / NXCD, r = nwg % NXCD, xcd = wgid % NXCD, off = wgid / NXCD; wgid = (xcd < r ? xcd * (q + 1) : r * (q + 1) + (xcd - r) * q) + off; }
        const int nig = WGM * nN, gid = wgid / nig, fm = gid * WGM, gsz = (nM - fm) < WGM ? (nM - fm) : WGM;
        const int pm = fm + ((wgid % nig) % gsz), pn = (wgid % nig) / gsz;
        u.a = A + (size_t)pm * BM * KD * 2; u.b = Bt + (size_t)pn * BM * KD * 2; u.r0 = pm * BM; u.c0 = pn * BM; u.rows = BM; u.e = 0; return true;
    }
    __device__ __forceinline__ void a_ready(const Unit&) const {}
};

template <int PITCHB, int NTILES, bool FP8, class Epi, class Sched>
__device__ __forceinline__ void gemm_phase(LAS unsigned char* lds, const Sched& S, const Epi& E) {
    const int tid = threadIdx.x, wid = __builtin_amdgcn_readfirstlane(tid >> 6), lane = tid & 63, wr = wid >> 2, wc = wid & 3, fr = lane & 15, fq = lane >> 4;
    unsigned voffA[2], voffB[2];
#pragma unroll
    for (int i = 0; i < 2; ++i) { int R, C; stage_rc(tid * 16 + i * 8192, R, C); const int Rb = Epi::PERM ? ((R & ~31) + perm32(R & 31)) : R;
        voffA[i] = (unsigned)(R * PITCHB + C * 2); voffB[i] = (unsigned)(Rb * PITCHB + C * 2); }
    const size_t kstep = (size_t)(BK * 2);
    const size_t hstep = (size_t)HALF * PITCHB;
    const unsigned ldsw = (unsigned)wid * 1024u;
    const int aoff = lds_byte(wr * 64 + fr, fq * 8), boff = lds_byte(wc * 32 + fr, fq * 8);
#define PG8_SA(b, h) (((b) * 2 + (h)) * HTB)
#define PG8_SB(b, h) ((4 + (b) * 2 + (h)) * HTB)
#define PG8_STAGE_X(bufoff, gbase, voff) do { _Pragma("unroll") for (int _i = 0; _i < 2; ++_i) \
        __builtin_amdgcn_global_load_lds((const unsigned*)((const char*)(gbase) + (voff)[_i]), (LAS unsigned*)(lds + (bufoff) + ldsw + _i * 8192), 16, 0, 0); } while (0)
#define PG8_STAGE_A(bufoff, gbase) PG8_STAGE_X(bufoff, gbase, voffA)
#define PG8_STAGE_B(bufoff, gbase) PG8_STAGE_X(bufoff, gbase, voffB)
#define PG8_LDA(dst, b, h) do { _Pragma("unroll") for (int m = 0; m < 4; ++m) { if constexpr (FP8) { const v4i _lo = *(const LAS v4i*)(lds + PG8_SA(b, h) + aoff + m * 2048), _hi = *(const LAS v4i*)(lds + PG8_SA(b, h) + aoff + m * 2048 + 1024); \
            dst##8[m] = (v8i){_lo.x, _lo.y, _lo.z, _lo.w, _hi.x, _hi.y, _hi.z, _hi.w}; } \
        else { _Pragma("unroll") for (int k = 0; k < 2; ++k) dst[m][k] = *(const LAS bf16x8*)(lds + PG8_SA(b, h) + aoff + m * 2048 + k * 1024); } } } while (0)
#define PG8_LDB(dst, b, h) do { _Pragma("unroll") for (int n = 0; n < 2; ++n) { if constexpr (FP8) { const v4i _lo = *(const LAS v4i*)(lds + PG8_SB(b, h) + boff + n * 2048), _hi = *(const LAS v4i*)(lds + PG8_SB(b, h) + boff + n * 2048 + 1024); \
            dst##8[n] = (v8i){_lo.x, _lo.y, _lo.z, _lo.w, _hi.x, _hi.y, _hi.z, _hi.w}; } \
        else { _Pragma("unroll") for (int k = 0; k < 2; ++k) dst[n][k] = *(const LAS bf16x8*)(lds + PG8_SB(b, h) + boff + n * 2048 + k * 1024); } } } while (0)
#define PG8_MMA(ai, bj, At, Bt) do { __builtin_amdgcn_s_setprio(1); _Pragma("unroll") for (int m = 0; m < 4; ++m) _Pragma("unroll") for (int n = 0; n < 2; ++n) { \
        if constexpr (FP8) { if constexpr (MX_UNSCALED != 0) asm volatile("v_mfma_f32_16x16x128_f8f6f4 %0, %1, %2, %0" : "+v"(acc[ai][bj][m][n]) : "v"(Bt##8[n]), "v"(At##8[m])); \
            else asm volatile("v_mfma_scale_f32_16x16x128_f8f6f4 %0, %1, %2, %0, %3, %4 op_sel_hi:[0,0,0]" : "+v"(acc[ai][bj][m][n]) : "v"(Bt##8[n]), "v"(At##8[m]), "v"(sclW), "v"(sclA)); } \
        else { _Pragma("unroll") for (int k = 0; k < 2; ++k) acc[ai][bj][m][n] = __builtin_amdgcn_mfma_f32_16x16x32_bf16(Bt[n][k], At[m][k], acc[ai][bj][m][n], 0, 0, 0); } } \
        __builtin_amdgcn_s_setprio(0); } while (0)
#define PG8_WAIT_V(n) asm volatile("s_waitcnt vmcnt(" #n ")" ::: "memory")
#define PG8_WAIT_L(n) asm volatile("s_waitcnt lgkmcnt(" #n ")" ::: "memory")
#define PG8_BAR __builtin_amdgcn_s_barrier()
#define PG8_SCHED __builtin_amdgcn_sched_barrier(0)
    Unit cur, nxt; int ui = 0;
    if (!S.next(0, cur)) return;
    f32x4 acc[2][2][4][2];
#pragma unroll
    for (int a = 0; a < 2; ++a)
#pragma unroll
        for (int b = 0; b < 2; ++b)
#pragma unroll
            for (int m = 0; m < 4; ++m)
#pragma unroll
                for (int n = 0; n < 2; ++n) acc[a][b][m][n] = (f32x4){0.f, 0.f, 0.f, 0.f};
    const int sclW = 0x79797979, sclA = 0x7f7f7f7f;
    bf16x8 At[4][2], B0[2][2], B1[2][2]; v8i At8[4], B08[2], B18[2];
    const char* cA = cur.a; const char* cB = cur.b;
    S.a_ready(cur);
    PG8_STAGE_B(PG8_SB(0, 0), cB); PG8_STAGE_B(PG8_SB(0, 1), cB + hstep); PG8_STAGE_A(PG8_SA(0, 0), cA); PG8_STAGE_A(PG8_SA(0, 1), cA + hstep);
    if (wr == 1) PG8_BAR;
    PG8_WAIT_V(2); PG8_BAR;
    PG8_STAGE_B(PG8_SB(1, 0), cB + kstep); PG8_STAGE_A(PG8_SA(1, 0), cA + kstep); PG8_STAGE_B(PG8_SB(1, 1), cB + hstep + kstep);
    PG8_WAIT_V(6); PG8_BAR;
    for (;;) {
        const bool has_next = S.next(ui + 1, nxt);
        const char* nA = has_next ? nxt.a : cA; const char* nB = has_next ? nxt.b : cB;
        const int nt = NTILES > 0 ? NTILES : cur.nt;
#pragma nounroll
        for (int t = 0; t < nt; t += 2) {
            const bool last = (t == nt - 2);
            const char* a1 = cA + (size_t)(t + 1) * kstep;
            const char* a2 = last ? nA : cA + (size_t)(t + 2) * kstep; const char* b2 = last ? nB : cB + (size_t)(t + 2) * kstep;
            const char* a3 = a2 + kstep; const char* b3 = b2 + kstep;
            if (last && has_next) S.a_ready(nxt);
            PG8_LDB(B0, 0, 0); PG8_LDB(B1, 0, 1); PG8_SCHED; PG8_LDA(At, 0, 0); PG8_STAGE_A(PG8_SA(1, 1), a1 + hstep);
            PG8_WAIT_V(8); PG8_WAIT_L(0); PG8_BAR; PG8_MMA(0, 0, At, B0); PG8_MMA(0, 1, At, B1); PG8_BAR; PG8_SCHED;
            PG8_LDA(At, 0, 1); PG8_STAGE_B(PG8_SB(0, 0), b2); PG8_STAGE_B(PG8_SB(0, 1), b2 + hstep); PG8_STAGE_A(PG8_SA(0, 0), a2);
            PG8_WAIT_V(8); PG8_WAIT_L(0); PG8_BAR; PG8_MMA(1, 0, At, B0); PG8_MMA(1, 1, At, B1); PG8_BAR; PG8_SCHED;
            PG8_LDB(B0, 1, 0); PG8_LDB(B1, 1, 1); PG8_SCHED; PG8_LDA(At, 1, 0); PG8_STAGE_A(PG8_SA(0, 1), a2 + hstep);
            PG8_WAIT_V(8); PG8_WAIT_L(0); PG8_BAR; PG8_MMA(0, 0, At, B0); PG8_MMA(0, 1, At, B1); PG8_BAR; PG8_SCHED;
            PG8_LDA(At, 1, 1); PG8_STAGE_B(PG8_SB(1, 0), b3); PG8_STAGE_B(PG8_SB(1, 1), b3 + hstep); PG8_STAGE_A(PG8_SA(1, 0), a3);
            PG8_WAIT_V(8); PG8_WAIT_L(0); PG8_BAR; PG8_MMA(1, 0, At, B0); PG8_MMA(1, 1, At, B1); PG8_BAR; PG8_SCHED;
        }
        if constexpr (FP8) {
            asm volatile("s_nop 15\n\ts_nop 15" : "+v"(acc[0][0][0][0]), "+v"(acc[0][0][0][1]), "+v"(acc[0][0][1][0]), "+v"(acc[0][0][1][1]), "+v"(acc[0][0][2][0]), "+v"(acc[0][0][2][1]), "+v"(acc[0][0][3][0]), "+v"(acc[0][0][3][1]) :: "memory");
            asm volatile("" : "+v"(acc[0][1][0][0]), "+v"(acc[0][1][0][1]), "+v"(acc[0][1][1][0]), "+v"(acc[0][1][1][1]), "+v"(acc[0][1][2][0]), "+v"(acc[0][1][2][1]), "+v"(acc[0][1][3][0]), "+v"(acc[0][1][3][1]));
            asm volatile("" : "+v"(acc[1][0][0][0]), "+v"(acc[1][0][0][1]), "+v"(acc[1][0][1][0]), "+v"(acc[1][0][1][1]), "+v"(acc[1][0][2][0]), "+v"(acc[1][0][2][1]), "+v"(acc[1][0][3][0]), "+v"(acc[1][0][3][1]));
            asm volatile("" : "+v"(acc[1][1][0][0]), "+v"(acc[1][1][0][1]), "+v"(acc[1][1][1][0]), "+v"(acc[1][1][1][1]), "+v"(acc[1][1][2][0]), "+v"(acc[1][1][2][1]), "+v"(acc[1][1][3][0]), "+v"(acc[1][1][3][1]));
        }
        if (wr == 0) PG8_BAR;
        E(acc, cur, wr, wc, fr, fq);
        if (!has_next) break;
#pragma unroll
        for (int a = 0; a < 2; ++a)
#pragma unroll
            for (int b = 0; b < 2; ++b)
#pragma unroll
                for (int m = 0; m < 4; ++m)
#pragma unroll
                    for (int n = 0; n < 2; ++n) acc[a][b][m][n] = (f32x4){0.f, 0.f, 0.f, 0.f};
        cur = nxt; cA = nA; cB = nB; ++ui;
        if (wr == 1) PG8_BAR;
    }
    PG8_WAIT_V(0);
    PG8_BAR;
#undef PG8_SA
#undef PG8_SB
#undef PG8_STAGE_X
#undef PG8_STAGE_A
#undef PG8_STAGE_B
#undef PG8_LDA
#undef PG8_LDB
#undef PG8_MMA
#undef PG8_WAIT_V
#undef PG8_WAIT_L
#undef PG8_BAR
#undef PG8_SCHED
}
}
using pg8::Unit;

#define XB_TMO      128
#define XB_XCNT(j)  (256  + 64 * (j))
#define XB_XSUB(j)  (1280 + 64 * (j))
#define XB_XGEN(j)  (2304 + 64 * (j))
#define XB_TOP      3328
#define XB_TOPGEN   3392
#define XCD_BAR_WORDS 3456
#define XB_SPIN_CAP (1u << 22)
__device__ __forceinline__ unsigned xb_ld(unsigned* p)              { return __hip_atomic_load(p, __ATOMIC_RELAXED, __HIP_MEMORY_SCOPE_AGENT); }
__device__ __forceinline__ unsigned xb_add(unsigned* p, unsigned v) { return __hip_atomic_fetch_add(p, v, __ATOMIC_RELAXED, __HIP_MEMORY_SCOPE_AGENT); }
__device__ __forceinline__ unsigned xb_xcc_id() { return (unsigned)__builtin_amdgcn_s_getreg((3 << 11) | 20) & 0xFu; }
#define XB_SPIN(cond, bar) do { unsigned _sp = 0; while (cond) { __builtin_amdgcn_s_sleep(1); \
    if ((++_sp & 255u) == 0u) { if (xb_ld(&(bar)[XB_TMO])) break; if (_sp > XB_SPIN_CAP) { atomicAdd(&(bar)[XB_TMO], 1u); break; } } } } while (0)
struct XcdBarrier { unsigned* bar; unsigned x; volatile LAS unsigned* st; };
__device__ __forceinline__ XcdBarrier xcd_barrier_post(unsigned* bar, volatile LAS unsigned* st) {
    XcdBarrier b; b.bar = bar; b.x = xb_xcc_id(); b.st = st;
    if (threadIdx.x == 0) (void)xb_add(&bar[XB_XCNT(b.x)], 1u);
    return b;
}
__device__ __forceinline__ void xcd_barrier_complete(unsigned* bar, unsigned x, unsigned& nloc, unsigned& nx) {
    const unsigned G = gridDim.x * gridDim.y * gridDim.z;
    unsigned sum, cnt, mine, sp = 0u;
    for (;;) {
        sum = 0u; cnt = 0u; mine = 0u;
#pragma unroll
        for (unsigned j = 0; j < 16; ++j) { const unsigned c = xb_ld(&bar[XB_XCNT(j)]); sum += c; cnt += (c > 0u) ? 1u : 0u; mine = (j == x) ? c : mine; }
        if (sum == G) break;
        __builtin_amdgcn_s_sleep(1);
        if ((++sp & 255u) == 0u) { if (xb_ld(&bar[XB_TMO])) break; if (sp > XB_SPIN_CAP) { atomicAdd(&bar[XB_TMO], 1u); break; } }
    }
    nloc = mine > 0u ? mine : 1u; nx = cnt > 0u ? cnt : 1u;
}
__device__ __forceinline__ void xcd_barrier(const XcdBarrier& b) {
    asm volatile("s_waitcnt vmcnt(0)" ::: "memory");
    __syncthreads();
    if (threadIdx.x == 0) {
        unsigned* bar = b.bar;
        __builtin_amdgcn_s_waitcnt(0);
        unsigned nloc = b.st[0], nx = b.st[1];
        if (nloc == 0u) { xcd_barrier_complete(bar, b.x, nloc, nx); b.st[0] = nloc; b.st[1] = nx; }
        const unsigned old = xb_add(&bar[XB_XSUB(b.x)], 1u);
        const unsigned gen = old / nloc;
        if (old + 1u == (gen + 1u) * nloc) {
            __builtin_amdgcn_fence(__ATOMIC_RELEASE, "agent");
            asm volatile("s_waitcnt vmcnt(0)" ::: "memory");
            const unsigned og = xb_add(&bar[XB_TOP], 1u);
            const unsigned tg = og / nx;
            if (og + 1u == (tg + 1u) * nx) xb_add(&bar[XB_TOPGEN], 1u);
            else XB_SPIN(xb_ld(&bar[XB_TOPGEN]) == tg, bar);
            __builtin_amdgcn_fence(__ATOMIC_ACQUIRE, "agent");
            xb_add(&bar[XB_XGEN(b.x)], 1u);
            asm volatile("s_waitcnt vmcnt(0)" ::: "memory");
        } else {
            XB_SPIN(xb_ld(&bar[XB_XGEN(b.x)]) == gen, bar);
            __builtin_amdgcn_fence(__ATOMIC_ACQUIRE, "agent");
            asm volatile("s_waitcnt vmcnt(0)" ::: "memory");
        }
    }
    __syncthreads();
}

constexpr size_t MiB = 1u << 20;
constexpr size_t al(size_t x) { return (x + 255) & ~(size_t)255; }
constexpr size_t WS_CTL = 0, CTL_ZERO_BYTES = 1 * MiB;
constexpr size_t WS_WIN = 1 * MiB;
constexpr size_t WS_WLOW = WS_WIN + (size_t)NPROJ * KD * 2;
constexpr size_t WS_WRH = WS_WLOW + 16 * KD * 2;
constexpr size_t WS_WRL = WS_WRH + 32 * KD * 2;
constexpr size_t WS_WOUT = WS_WRL + 32 * KD * 2;
constexpr size_t WS_WCQ = WS_WOUT + (size_t)DM * KD * 2;
constexpr size_t WS_WCKV = WS_WCQ + (size_t)DM * KD * 2;
constexpr size_t WS_WCO = WS_WCKV + (size_t)2 * DM * KD * 2;
constexpr size_t WS_WGU = WS_WCO + (size_t)DM * KD * 2;
constexpr size_t WS_WD = WS_WGU + (size_t)NEXP * 2 * DFF * KD * 2;
constexpr size_t WS_H1 = WS_WD + (size_t)NEXP * DM * KD * 2;
constexpr size_t WS_MEMN = WS_H1 + (size_t)NT * DM * 2;
constexpr size_t WS_SBQ = WS_MEMN + (size_t)NMEM * DM * 2;
constexpr size_t WS_SBK = WS_SBQ + (size_t)NT * 1024 * 2;
constexpr size_t WS_SBVT = WS_SBK + (size_t)NT * 1024 * 2;
constexpr size_t WS_GQ = WS_SBVT + (size_t)NT * 1024 * 2;
constexpr size_t WS_GK = WS_GQ + (size_t)NT * 512 * 2;
constexpr size_t WS_GVT = WS_GK + (size_t)NT * 512 * 2;
constexpr size_t WS_GR = WS_GVT + (size_t)NT * 1024 * 2;
constexpr size_t WS_GLOW = WS_GR + (size_t)NT * 1024 * 2;
constexpr size_t WS_KVK = WS_GLOW + (size_t)NT * 16 * 4;
constexpr size_t WS_KVVT = WS_KVK + (size_t)NMEM * DM * 2;
constexpr size_t WS_QIN = WS_KVVT + (size_t)NMEM * DM * 2;
constexpr size_t WS_OINTRA = WS_QIN + (size_t)NT * 512 * 2;
constexpr size_t WS_KVN = WS_OINTRA + (size_t)512 * 16384 * 4;
constexpr size_t WS_DECAY = WS_KVN + (size_t)512 * 32768 * 4;
constexpr size_t WS_STATE = WS_DECAY + (size_t)512 * 128 * 4;
constexpr size_t WS_MIXO = WS_STATE + (size_t)512 * 32768 * 2;
constexpr size_t WS_X1 = WS_MIXO + (size_t)NT * DM * 2;
constexpr size_t WS_X1B = WS_X1 + (size_t)NT * DM * 4;
constexpr size_t WS_SSQ = WS_X1B + (size_t)NT * DM * 2;
constexpr size_t WS_CQ = WS_SSQ + (size_t)32 * NT * 4;
constexpr size_t WS_ATTO = WS_CQ + (size_t)NT * DM * 2;
constexpr size_t WS_X2 = WS_ATTO + (size_t)NT * DM * 2;
constexpr size_t WS_TOPE = WS_X2 + (size_t)NT * DM * 4;
constexpr size_t WS_TOPW = WS_TOPE + (size_t)NT * 4 * 4;
constexpr size_t WS_RSTD3 = WS_TOPW + (size_t)NT * 4 * 4;
constexpr size_t WS_HIST = WS_RSTD3 + (size_t)NT * 4;
constexpr size_t WS_SLOTW = WS_HIST + (size_t)256 * 32 * 4;
constexpr size_t WS_TOKSLOT = WS_SLOTW + (size_t)(NASSIGN + 256) * 4;
constexpr size_t WS_CNT = WS_TOKSLOT + (size_t)NT * 4 * 4;
constexpr size_t WS_XS = al(WS_CNT + 256);
constexpr size_t WS_ACT = WS_XS + (size_t)(NASSIGN + 256) * DM * 2;
constexpr size_t WS_Y = WS_ACT + (size_t)(NASSIGN + 256) * DM * 2;
constexpr size_t WS_P = WS_Y + (size_t)(NASSIGN + 256) * DM * 2;
constexpr size_t WS_MT = WS_P + (size_t)16 * SEQ * MEMLEN * 2;
constexpr size_t WS_VWT = WS_MT + (size_t)16 * MEMLEN * DM * 2;
constexpr size_t WS_END = WS_VWT + (size_t)NB * DM * 1024 * 2;

constexpr int CW_BAR = 4096;
static_assert((CW_BAR + XCD_BAR_WORDS) * 4 <= (int)CTL_ZERO_BYTES, "ctl");

constexpr int RING_BYTES = 131072, LDSCTL_OFF = RING_BYTES, MISC_OFF = LDSCTL_OFF + 64, TAB_OFF = LDSCTL_OFF + 256;
constexpr int RED1_OFF = LDSCTL_OFF + 2048, RED2_OFF = RED1_OFF + 4096;
constexpr int LDS_BYTES = 147456;

constexpr int NWAVES = 8, NTHR = 512;

struct Args { const float* in[22]; float* out; unsigned char* ws; int ph_lo, ph_hi; };

struct Frame {
    LAS unsigned char* lds;
    int tid, lane, wave, G, bid;
    unsigned char* ws;
};

__device__ __forceinline__ void cvt_tile(const float* __restrict__ W, int ldn, int k0, int n0, bf16* __restrict__ dst, int dst_row0, const float* __restrict__ gk, LAS unsigned* scr, int lane) {
    const int q = lane >> 4, c4 = lane & 15;
    f32x4 v[16];
#pragma unroll
    for (int i = 0; i < 16; ++i) { const int k = k0 + 8 * (i >> 1) + 2 * q + (i & 1); v[i] = *(const f32x4*)(W + (size_t)k * ldn + n0 + 4 * c4); if (gk) v[i] = v[i] * gk[k]; }
#pragma unroll
    for (int p = 0; p < 8; ++p)
#pragma unroll
        for (int j = 0; j < 4; ++j) { const int n = 4 * c4 + j, kd = 4 * p + q; scr[n * 32 + (kd ^ ((c4 & 7) << 2))] = cvt_pk_bf16(v[2 * p][j], v[2 * p + 1][j]); }
    LDS_WAIT();
#pragma unroll
    for (int jj = 0; jj < 8; ++jj) { const int n = 8 * jj + (lane >> 3), ch = lane & 7; const u32x4 w = *(const LAS u32x4*)(scr + n * 32 + ((ch ^ ((n >> 2) & 7)) << 2));
        *(u32x4*)(dst + (size_t)(dst_row0 + n) * KD + k0 + 8 * ch) = w; }
    LDS_WAIT();
}
__device__ __forceinline__ unsigned pk_fp8x4(float a, float b, float c, float d) { int r = __builtin_amdgcn_cvt_pk_fp8_f32(a, b, 0, false); r = __builtin_amdgcn_cvt_pk_fp8_f32(c, d, r, true); return (unsigned)r; }
__device__ __forceinline__ void rms_row_bf16(const float* __restrict__ xrow, const float* __restrict__ g, bf16* __restrict__ orow, int lane) {
    const f32x4* xr = (const f32x4*)xrow + lane; const f32x4* gr = (const f32x4*)g + lane;
    f32x4 v[8]; float s = 0.f;
#pragma unroll
    for (int j = 0; j < 8; ++j) { v[j] = xr[64 * j]; s += (v[j].x * v[j].x + v[j].y * v[j].y) + (v[j].z * v[j].z + v[j].w * v[j].w); }
    const float rstd = 1.0f / sqrtf(wave_sum(s) * (1.f / DM) + EPS);
    u32x2* o8 = (u32x2*)orow + lane;
#pragma unroll
    for (int j = 0; j < 8; ++j) { const f32x4 gg = gr[64 * j]; u32x2 w; w.x = cvt_pk_bf16(v[j].x * rstd * gg.x, v[j].y * rstd * gg.y); w.y = cvt_pk_bf16(v[j].z * rstd * gg.z, v[j].w * rstd * gg.w); o8[64 * j] = w; }
}

constexpr int MOE_ITEMS = NEXP * 64 * 16 + NEXP * 32 * 16;
#ifndef CONV_ST_AUX
#define CONV_ST_AUX 16
#endif
#ifndef CVT_DUP
#define CVT_DUP 0
#endif
#ifndef X2_BF16
#define X2_BF16 1
#endif
#ifndef X1_F32
#define X1_F32 0
#endif
static_assert(!(X1_F32 && X2_BF16), "the bf16 x2 store lives in the bf16-x1 form of the phase-8 epilogue");
#ifndef CONV_WGS
#define CONV_WGS 64
#endif
#ifndef E_P1
#define E_P1 9
#endif
constexpr int E_P7 = 7, E_PRE = E_P1 + E_P7;
#ifndef DN_IN_P11
#define DN_IN_P11 16
#endif
#ifndef E_P0
#define E_P0 0
#endif
#ifndef D_P0
#define D_P0 0
#endif
constexpr int NCOMP = 256 - CONV_WGS, CONV_NA = E_P1 * 1024, CONV_NB = E_P7 * 1024;
constexpr int CW_EXP = 8192;
static_assert(E_PRE + E_P0 <= 32 && DN_IN_P11 + D_P0 <= 32, "expert conversion ranges");
struct MoeItem { const float* W; int ldn, k0, n0; unsigned char* dst; int drow; };
__device__ __forceinline__ MoeItem moe_item_desc(const Frame& F, const Args& A, int it) {
    constexpr int J5 = NEXP * 64 * 16; MoeItem m;
    if (it < J5) { const int e = it >> 10, r = it & 1023, kt = r >> 6, n0 = (r & 63) * 64;
        m.W = A.in[17] + (size_t)e * DM * 2 * DFF; m.ldn = 2 * DFF; m.k0 = kt * 128; m.n0 = n0; m.dst = F.ws + WS_WGU + (size_t)e * 2 * DFF * KD;
        m.drow = (n0 < DFF) ? ((n0 >> 7) * 256 + (n0 & 127)) : (((n0 - DFF) >> 7) * 256 + 128 + ((n0 - DFF) & 127)); }
    else { const int q2 = it - J5, e = q2 >> 9, r = q2 & 511, kt = r >> 5, n0 = (r & 31) * 64;
        m.W = A.in[19] + (size_t)e * DFF * DM; m.ldn = DM; m.k0 = kt * 128; m.n0 = n0; m.dst = F.ws + WS_WD + (size_t)e * DM * KD; m.drow = n0; }
    return m;
}
template <bool SLD> __device__ __forceinline__ void moe_ld_half(f32x4 (&v)[16], const MoeItem& m, int half, int lane) {
    const int q = lane >> 4, c4 = lane & 15;
    if constexpr (SLD) { const __amdgpu_buffer_rsrc_t rw = __builtin_amdgcn_make_buffer_rsrc((void*)m.W, 0, 0x7fffffff, 0x00020000);
        const int vo = ((m.k0 + 64 * half + 4 * q) * m.ldn + m.n0 + 4 * c4) * 4;
#pragma unroll
        for (int i = 0; i < 16; ++i) v[i] = __builtin_bit_cast(f32x4, __builtin_amdgcn_raw_buffer_load_b128(rw, vo, (16 * (i >> 2) + (i & 3)) * m.ldn * 4, CONV_LD_AUX)); }
    else {
#pragma unroll
        for (int i = 0; i < 16; ++i) { const int k = m.k0 + 64 * half + 16 * (i >> 2) + 4 * q + (i & 3); v[i] = __builtin_nontemporal_load((const f32x4*)(m.W + (size_t)k * m.ldn + m.n0 + 4 * c4)); } }
}
typedef short v2s16 __attribute__((ext_vector_type(2)));
__device__ __forceinline__ unsigned pk_fp8x4_scaled(float a, float b, float c, float d, float scale) { v2s16 r; asm volatile("" : "=v"(r));
    r = __builtin_amdgcn_cvt_scalef32_pk_fp8_f32(r, a, b, scale, false); r = __builtin_amdgcn_cvt_scalef32_pk_fp8_f32(r, c, d, scale, true); return __builtin_bit_cast(unsigned, r); }
__device__ __forceinline__ void moe_cv_half(const f32x4 (&v)[16], LAS unsigned* scr, int half, int lane) {
    const int q = lane >> 4, c4 = lane & 15;
#pragma unroll
    for (int pp = 0; pp < 4; ++pp)
#pragma unroll
#if CVT_DUP
        for (int j = 0; j < 4; ++j) { float a0 = v[4 * pp][j], a1 = v[4 * pp + 1][j], a2 = v[4 * pp + 2][j], a3 = v[4 * pp + 3][j];
            const unsigned r1 = pk_fp8x4_scaled(a0, a1, a2, a3, WCVT_SCALE); asm volatile("" : "+v"(a0), "+v"(a1), "+v"(a2), "+v"(a3));
            const unsigned r2 = pk_fp8x4_scaled(a0, a1, a2, a3, WCVT_SCALE); scr[(4 * c4 + j) * 33 + 16 * half + 4 * pp + q] = r1 & r2; }
#else
        for (int j = 0; j < 4; ++j) scr[(4 * c4 + j) * 33 + 16 * half + 4 * pp + q] = pk_fp8x4_scaled(v[4 * pp][j], v[4 * pp + 1][j], v[4 * pp + 2][j], v[4 * pp + 3][j], WCVT_SCALE);
#endif
}
template <bool SC1> __device__ __forceinline__ void moe_flush(const MoeItem& m, LAS unsigned* scr, int lane) {
#pragma unroll
    for (int jj = 0; jj < 8; ++jj) { const int n = 8 * jj + (lane >> 3), ch = lane & 7; u32x4 w; const LAS unsigned* sp = scr + n * 33 + 4 * ch; w.x = sp[0]; w.y = sp[1]; w.z = sp[2]; w.w = sp[3];
        if constexpr (SC1) { const __amdgpu_buffer_rsrc_t rs = __builtin_amdgcn_make_buffer_rsrc(m.dst, 0, 0x7fffffff, 0x00020000);
            __builtin_amdgcn_raw_buffer_store_b128(w, rs, (m.drow + n) * KD + m.k0 + 16 * ch, 0, CONV_ST_AUX); }
        else __builtin_nontemporal_store(w, (u32x4*)(m.dst + (size_t)(m.drow + n) * KD + m.k0 + 16 * ch)); }
}
template <bool SC1, bool SLD> __device__ __forceinline__ void moe_items_stream(const Frame& F, const Args& A, int it0, int stride, int count, LAS unsigned* scr) {
    if (count <= 0) return;
    f32x4 va[16], vb[16];
    MoeItem cur = moe_item_desc(F, A, it0);
    moe_ld_half<SLD>(va, cur, 0, F.lane);
    for (int i = 0; i < count; ++i) {
        moe_ld_half<SLD>(vb, cur, 1, F.lane);
        moe_cv_half(va, scr, 0, F.lane);
        MoeItem nxt = cur;
        if (i + 1 < count) { nxt = moe_item_desc(F, A, it0 + (i + 1) * stride); moe_ld_half<SLD>(va, nxt, 0, F.lane); }
        moe_cv_half(vb, scr, 1, F.lane);
        LDS_WAIT();
        moe_flush<SC1>(cur, scr, F.lane);
        LDS_WAIT();
        cur = nxt;
    }
}
template <bool SC1, bool SLD = SC1> __device__ __forceinline__ void moe_item_fp8(const Frame& F, const Args& A, int it, LAS unsigned* scr) { moe_items_stream<SC1, SLD>(F, A, it, 0, 1, scr); }
__device__ __forceinline__ void p0_prologue(const Frame& F, const Args& A) {
    LAS unsigned* scr = (LAS unsigned*)(F.lds + F.wave * 16384);
    const int gw = F.bid * NWAVES + F.wave, NGW = F.G * NWAVES;
    const float* w_in = A.in[3]; const float* w_out = A.in[8]; const float* w_cq = A.in[11]; const float* w_ckv = A.in[12]; const float* w_co = A.in[13];
    const float* w_gu = A.in[17]; const float* w_dn = A.in[19]; (void)w_gu; (void)w_dn;
    constexpr int I0 = 96 * 32, I1 = 32 * 32, I2 = 0, I3 = 64 * 32, I4 = 32 * 32, I5 = MOE_FP8 ? 0 : NEXP * 64 * 32, I6 = MOE_FP8 ? 0 : NEXP * 32 * 32;
    constexpr int NITEMS = I0 + I1 + I2 + I3 + I4 + I5 + I6;
    for (int it = gw; it < NITEMS; it += NGW) {
        int r = it; const float* W; int ldn, nct; bf16* dst; const float* gk = nullptr; int mode = 0;
        if (r < I0) { W = w_in; ldn = INC; nct = 96; dst = (bf16*)(F.ws + WS_WIN); }
        else if ((r -= I0) < I1) { W = w_out; ldn = DM; nct = 32; dst = (bf16*)(F.ws + WS_WOUT); }
        else if ((r -= I1) < I3) { W = w_ckv; ldn = 2 * DM; nct = 64; dst = (bf16*)(F.ws + WS_WCKV); }
        else if ((r -= I3) < I4) { W = w_co; ldn = DM; nct = 32; dst = (bf16*)(F.ws + WS_WCO); }
        else if ((r -= I4) < I5) { const int e = r / (64 * 32); r -= e * (64 * 32); W = w_gu + (size_t)e * DM * 2 * DFF; ldn = 2 * DFF; nct = 64; dst = (bf16*)(F.ws + WS_WGU) + (size_t)e * 2 * DFF * KD; mode = 1; }
        else { r -= I5; const int e = r / (32 * 32); r -= e * (32 * 32); W = w_dn + (size_t)e * DFF * DM; ldn = DM; nct = 32; dst = (bf16*)(F.ws + WS_WD) + (size_t)e * DM * KD; }
        const int kt = r / nct, ct = r - kt * nct; const int n0 = ct * 64;
        int drow = n0;
        if (mode == 1) drow = (n0 < DFF) ? ((n0 >> 7) * 256 + (n0 & 127)) : (((n0 - DFF) >> 7) * 256 + 128 + ((n0 - DFF) & 127));
        cvt_tile(W, ldn, kt * 64, n0, dst, drow, gk, scr, F.lane);
    }
#if MOE_FP8
    if (CONV_WGS) {
        for (int it = (32 - E_P0) * 1024 + gw; it < 32768; it += NGW) moe_item_fp8<false>(F, A, it, scr);
        for (int it = 32768 + (32 - D_P0) * 512 + gw; it < MOE_ITEMS; it += NGW) moe_item_fp8<false>(F, A, it, scr);
    }
#endif
    {
        const int gt = F.bid * NTHR + F.tid, NGT = F.G * NTHR;
        bf16* wlow = (bf16*)(F.ws + WS_WLOW); bf16* wrh = (bf16*)(F.ws + WS_WRH); bf16* wrl = (bf16*)(F.ws + WS_WRL);
        const float* w_r = A.in[15]; const float* g_moe = A.in[14];
        { const float* g_cross = A.in[9]; bf16* wcqn = (bf16*)(F.ws + WS_WCQ);
          for (int i = gt; i < DM * DM / 4; i += NGT) { const int k = i >> 9; const f32x4 v = *((const f32x4*)w_cq + i) * g_cross[k]; st_bf16x4(wcqn + (size_t)i * 4, v); } }
        for (int i = gt; i < 16 * KD; i += NGT) { const int k = i >> 4, r = i & 15; wlow[r * KD + k] = f2bf(w_in[(size_t)k * INC + NPROJ + r]); }
        for (int i = gt; i < 32 * KD; i += NGT) { const int k = i >> 5, e = i & 31; const float w = w_r[k * 32 + e] * g_moe[k]; const bf16 h = f2bf(w); wrh[e * KD + k] = h; wrl[e * KD + k] = f2bf(w - bf2f(h)); }
    }
    for (int m = gw; m < NT + NMEM; m += NGW) {
        if (m < NT) rms_row_bf16(A.in[0] + (size_t)m * DM, A.in[2], (bf16*)(F.ws + WS_H1) + (size_t)m * DM, F.lane);
        else rms_row_bf16(A.in[1] + (size_t)(m - NT) * DM, A.in[10], (bf16*)(F.ws + WS_MEMN) + (size_t)(m - NT) * DM, F.lane);
    }
}

__device__ __forceinline__ void conv_step(const Frame& F, const Args& A, int seq) {
    LAS unsigned* scr = (LAS unsigned*)(F.lds + F.wave * 16384);
    const int cw = F.bid - NCOMP;
    if (seq < 32) moe_items_stream<true, true>(F, A, seq * 1024 + (cw * NWAVES + F.wave) * 2, 1, 2, scr);
    else moe_item_fp8<true>(F, A, 32768 + (seq - 32) * 512 + cw * NWAVES + F.wave, scr);
    VM_WAIT(); __syncthreads();
    if (F.tid == 0) __hip_atomic_fetch_add((unsigned*)(F.ws + WS_CTL) + CW_EXP + 64 * seq, 1u, __ATOMIC_RELAXED, __HIP_MEMORY_SCOPE_AGENT);
}

#define EPI_LOOP(...) _Pragma("unroll") for (int ai = 0; ai < 2; ++ai) _Pragma("unroll") for (int m = 0; m < 4; ++m) { const int rl = ai * 128 + wr * 64 + m * 16 + fr; \
        _Pragma("unroll") for (int bj = 0; bj < 2; ++bj) _Pragma("unroll") for (int n = 0; n < 2; ++n) { const int cl = bj * 128 + wc * 32 + n * 16 + 4 * fq; const f32x4 v = acc[ai][bj][m][n]; __VA_ARGS__ } }
#define EPI_LOOP_P(...) _Pragma("unroll") for (int ai = 0; ai < 2; ++ai) _Pragma("unroll") for (int m = 0; m < 4; ++m) { const int rl = ai * 128 + wr * 64 + m * 16 + fr; \
        _Pragma("unroll") for (int bj = 0; bj < 2; ++bj) { const int cl = bj * 128 + wc * 32 + 8 * fq; const f32x4 v0 = acc[ai][bj][m][0], v1 = acc[ai][bj][m][1]; __VA_ARGS__ } }
__device__ __forceinline__ void st_bf16x8(bf16* p, f32x4 a, f32x4 b) { u32x4 w; w.x = cvt_pk_bf16(a.x, a.y); w.y = cvt_pk_bf16(a.z, a.w); w.z = cvt_pk_bf16(b.x, b.y); w.w = cvt_pk_bf16(b.z, b.w); *(u32x4*)p = w; }

struct EpiInProj {
    static constexpr bool PERM = true;
    unsigned char* ws;
    __device__ __forceinline__ void operator()(f32x4 (&acc)[2][2][4][2], const Unit& u, int wr, int wc, int fr, int fq) const {
        const int c0 = u.c0;
        if (c0 < 2048 || (c0 >= 3072 && c0 < 4096) || c0 >= 5120) {
            bf16* base; int ld, cc;
            if (c0 < 1024) { base = (bf16*)(ws + WS_SBQ); ld = 1024; cc = c0; }
            else if (c0 < 2048) { base = (bf16*)(ws + WS_SBK); ld = 1024; cc = c0 - 1024; }
            else if (c0 < 3584) { base = (bf16*)(ws + WS_GQ); ld = 512; cc = c0 - 3072; }
            else if (c0 < 4096) { base = (bf16*)(ws + WS_GK); ld = 512; cc = c0 - 3584; }
            else { base = (bf16*)(ws + WS_GR); ld = 1024; cc = c0 - 5120; }
            EPI_LOOP_P( st_bf16x8(base + (size_t)(u.r0 + rl) * ld + cc + cl, v0, v1); )
        } else {
            bf16* base = (bf16*)(ws + (c0 < 3072 ? WS_SBVT : WS_GVT)); const int cc = c0 - (c0 < 3072 ? 2048 : 4096);
            EPI_LOOP_P( const int r = u.r0 + rl, b = r >> 11, sq = r & 2047; const int c = cc + cl;
                _Pragma("unroll") for (int j = 0; j < 4; ++j) { base[((size_t)(b * 1024 + c + j)) * SEQ + sq] = f2bf(v0[j]); base[((size_t)(b * 1024 + c + 4 + j)) * SEQ + sq] = f2bf(v1[j]); } )
        }
    }
};
struct EpiKV {
    static constexpr bool PERM = true;
    unsigned char* ws;
    __device__ __forceinline__ void operator()(f32x4 (&acc)[2][2][4][2], const Unit& u, int wr, int wc, int fr, int fq) const {
        bf16* base = (bf16*)(ws + (u.c0 < 2048 ? WS_KVK : WS_KVVT)); const int cc = u.c0 < 2048 ? u.c0 : u.c0 - 2048;
        EPI_LOOP_P( st_bf16x8(base + (size_t)(u.r0 + rl) * DM + cc + cl, v0, v1); )
    }
};
struct EpiRes1 {
    static constexpr bool PERM = true;
    const float* x; float* x1; bf16* x1b; float* ssq;
    __device__ __forceinline__ void operator()(f32x4 (&acc)[2][2][4][2], const Unit& u, int wr, int wc, int fr, int fq) const {
#pragma unroll
        for (int ai = 0; ai < 2; ++ai)
#pragma unroll
            for (int m = 0; m < 4; ++m) { const int r = u.r0 + ai * 128 + wr * 64 + m * 16 + fr; float s = 0.f;
#pragma unroll
                for (int bj = 0; bj < 2; ++bj) { const int c = u.c0 + bj * 128 + wc * 32 + 8 * fq; const size_t o = (size_t)r * DM + c;
                    const f32x4 a = acc[ai][bj][m][0] + *(const f32x4*)(x + o), b = acc[ai][bj][m][1] + *(const f32x4*)(x + o + 4);
                    if constexpr (X1_F32) { *(f32x4*)(x1 + o) = a; *(f32x4*)(x1 + o + 4) = b; } st_bf16x8(x1b + o, a, b);
                    s += ((a.x * a.x + a.y * a.y) + (a.z * a.z + a.w * a.w)) + ((b.x * b.x + b.y * b.y) + (b.z * b.z + b.w * b.w)); }
                s += __shfl_xor(s, 16); s += __shfl_xor(s, 32);
                if (fq == 0) ssq[(size_t)((u.c0 >> 8) * 4 + wc) * NT + r] = s; }
    }
};
#if X1_F32
struct EpiRes2 {
    static constexpr bool PERM = false;
    const float* x1; const bf16* x1b; float* x2;
    __device__ __forceinline__ void operator()(f32x4 (&acc)[2][2][4][2], const Unit& u, int wr, int wc, int fr, int fq) const {
        EPI_LOOP( const size_t o = (size_t)(u.r0 + rl) * DM + u.c0 + cl; *(f32x4*)(x2 + o) = v + *(const f32x4*)(x1 + o); )
    }
};
#else
struct EpiRes2 {
    static constexpr bool PERM = true;
    const float* x1; const bf16* x1b; float* x2;
    __device__ __forceinline__ void operator()(f32x4 (&acc)[2][2][4][2], const Unit& u, int wr, int wc, int fr, int fq) const {
        EPI_LOOP_P( const size_t o = (size_t)(u.r0 + rl) * DM + u.c0 + cl; const u32x4 w = *(const u32x4*)(x1b + o);
            const f32x4 a = v0 + (f32x4){bflo(w.x), bfhi(w.x), bflo(w.y), bfhi(w.y)}, b = v1 + (f32x4){bflo(w.z), bfhi(w.z), bflo(w.w), bfhi(w.w)};
            if constexpr (X2_BF16 != 0) st_bf16x8((bf16*)x2 + o, a, b); else { *(f32x4*)(x2 + o) = a; *(f32x4*)(x2 + o + 4) = b; } )
    }
};
#endif
constexpr float WUNSC = (MOE_FP8 && MX_UNSCALED) ? (1.0f / 64.0f) : 1.0f;
struct EpiAct {
    static constexpr bool PERM = true;
    const float* bgu; bf16* act;
    __device__ __forceinline__ void operator()(f32x4 (&acc)[2][2][4][2], const Unit& u, int wr, int wc, int fr, int fq) const {
        const float* bg = bgu + (size_t)u.e * 2 * DFF; const int j0 = u.c0 + wc * 32 + 8 * fq;
        f32x4 b0[2], b1[2];
#pragma unroll
        for (int n = 0; n < 2; ++n) { b0[n] = *(const f32x4*)(bg + j0 + 4 * n); b1[n] = *(const f32x4*)(bg + DFF + j0 + 4 * n); }
#pragma unroll
        for (int ai = 0; ai < 2; ++ai)
#pragma unroll
            for (int m = 0; m < 4; ++m) { const int rl = ai * 128 + wr * 64 + m * 16 + fr; if (rl < u.rows) { f32x4 a[2];
#pragma unroll
                for (int n = 0; n < 2; ++n) { const f32x4 g = acc[ai][0][m][n] * WUNSC + b0[n], l = acc[ai][1][m][n] * WUNSC + b1[n];
#pragma unroll
                    for (int j = 0; j < 4; ++j) { const float gg = fminf(g[j], 7.0f), ll = fminf(fmaxf(l[j], -7.0f), 7.0f); a[n][j] = gg * frcp(1.0f + fexp2(-1.702f * LOG2E * gg)) * (ll + 1.0f); } }
#if MOE_FP8
                u32x2 w; w.x = pk_fp8x4(a[0].x, a[0].y, a[0].z, a[0].w); w.y = pk_fp8x4(a[1].x, a[1].y, a[1].z, a[1].w);
                *(u32x2*)((unsigned char*)act + (size_t)(u.r0 + rl) * DFF + j0) = w;
#else
                st_bf16x8(act + (size_t)(u.r0 + rl) * DFF + j0, a[0], a[1]);
#endif
                } }
    }
};
struct EpiY {
    static constexpr bool PERM = true;
    const float* bd; const float* sw; bf16* y;
    __device__ __forceinline__ void operator()(f32x4 (&acc)[2][2][4][2], const Unit& u, int wr, int wc, int fr, int fq) const {
        const float* bb = bd + (size_t)u.e * DM;
        f32x4 bv[2][2];
#pragma unroll
        for (int bj = 0; bj < 2; ++bj)
#pragma unroll
            for (int n = 0; n < 2; ++n) bv[bj][n] = *(const f32x4*)(bb + u.c0 + bj * 128 + wc * 32 + 8 * fq + 4 * n);
#pragma unroll
        for (int ai = 0; ai < 2; ++ai)
#pragma unroll
            for (int m = 0; m < 4; ++m) { const int rl = ai * 128 + wr * 64 + m * 16 + fr; if (rl < u.rows) { const float w = sw[u.r0 + rl];
#pragma unroll
                for (int bj = 0; bj < 2; ++bj) { const int c = u.c0 + bj * 128 + wc * 32 + 8 * fq; const f32x4 y0 = (acc[ai][bj][m][0] * WUNSC + bv[bj][0]) * w, y1 = (acc[ai][bj][m][1] * WUNSC + bv[bj][1]) * w;
#if Y_FP8
                    u32x2 yw; yw.x = pk_fp8x4(y0.x * 16.0f, y0.y * 16.0f, y0.z * 16.0f, y0.w * 16.0f); yw.y = pk_fp8x4(y1.x * 16.0f, y1.y * 16.0f, y1.z * 16.0f, y1.w * 16.0f);
                    *(u32x2*)((unsigned char*)y + (size_t)(u.r0 + rl) * DM + c) = yw;
#else
                    st_bf16x8(y + (size_t)(u.r0 + rl) * DM + c, y0, y1);
#endif
                    } } }
    }
};

constexpr int RSC_OFF = RED2_OFF + 4096;
__device__ __forceinline__ void xattn_row_scales(LAS unsigned char* lds, const float* __restrict__ ssq, int r0) {
    const int t = threadIdx.x, row = t >> 1, hf = t & 1; float q = 0.f;
#pragma unroll
    for (int pp = 0; pp < 16; ++pp) q += ssq[(size_t)(16 * hf + pp) * NT + r0 + row];
    q += __shfl_xor(q, 1);
    if (hf == 0) ((LAS float*)(lds + RSC_OFF))[row] = (0.04419417382415922f * LOG2E) / sqrtf(q * (1.f / DM) + EPS);
    __syncthreads();
}
struct EpiSoftmax {
    static constexpr bool PERM = true;
    LAS unsigned char* lds; bf16* P;
    __device__ __forceinline__ void operator()(f32x4 (&acc)[2][2][4][2], const Unit& u, int wr, int wc, int fr, int fq) const {
        LAS float* red1 = (LAS float*)(lds + RED1_OFF); LAS float* red2 = (LAS float*)(lds + RED2_OFF);
        float rs[2][4];
#pragma unroll
        for (int ai = 0; ai < 2; ++ai)
#pragma unroll
            for (int m = 0; m < 4; ++m) rs[ai][m] = ((const LAS float*)(lds + RSC_OFF))[ai * 128 + wr * 64 + m * 16 + fr];
#pragma unroll
        for (int ai = 0; ai < 2; ++ai)
#pragma unroll
            for (int m = 0; m < 4; ++m) { const int rl = ai * 128 + wr * 64 + m * 16 + fr; float mx = -3.0e38f;
#pragma unroll
                for (int bj = 0; bj < 2; ++bj)
#pragma unroll
                    for (int n = 0; n < 2; ++n) { const f32x4 v = acc[ai][bj][m][n]; mx = fmaxf(fmaxf(mx, fmaxf(v.x, v.y)), fmaxf(v.z, v.w)); }
                mx = fmaxf(mx, __shfl_xor(mx, 16)); mx = fmaxf(mx, __shfl_xor(mx, 32));
                if (fq == 0) red1[rl * 4 + wc] = mx; }
        asm volatile("s_waitcnt lgkmcnt(0)" ::: "memory"); __builtin_amdgcn_s_barrier(); asm volatile("" ::: "memory");
#pragma unroll
        for (int ai = 0; ai < 2; ++ai)
#pragma unroll
            for (int m = 0; m < 4; ++m) { const int rl = ai * 128 + wr * 64 + m * 16 + fr; const f32x4 mv = *(const LAS f32x4*)(red1 + rl * 4);
                const float mx = fmaxf(fmaxf(mv.x, mv.y), fmaxf(mv.z, mv.w)); float sum = 0.f;
#pragma unroll
                for (int bj = 0; bj < 2; ++bj)
#pragma unroll
                    for (int n = 0; n < 2; ++n) { f32x4 v = acc[ai][bj][m][n];
#pragma unroll
                        for (int j = 0; j < 4; ++j) { v[j] = fexp2((v[j] - mx) * rs[ai][m]); sum += v[j]; }
                        acc[ai][bj][m][n] = v; }
                sum += __shfl_xor(sum, 16); sum += __shfl_xor(sum, 32);
                if (fq == 0) red2[rl * 4 + wc] = sum; }
        asm volatile("s_waitcnt lgkmcnt(0)" ::: "memory"); __builtin_amdgcn_s_barrier(); asm volatile("" ::: "memory");
#pragma unroll
        for (int ai = 0; ai < 2; ++ai)
#pragma unroll
            for (int m = 0; m < 4; ++m) { const int rl = ai * 128 + wr * 64 + m * 16 + fr; const f32x4 sv = *(const LAS f32x4*)(red2 + rl * 4);
                const float inv = 1.0f / ((sv.x + sv.y) + (sv.z + sv.w));
#pragma unroll
                for (int bj = 0; bj < 2; ++bj) st_bf16x8(P + (size_t)(u.r0 + rl) * 1024 + u.c0 + bj * 128 + wc * 32 + 8 * fq, acc[ai][bj][m][0] * inv, acc[ai][bj][m][1] * inv); }
        asm volatile("s_waitcnt lgkmcnt(0)" ::: "memory"); __builtin_amdgcn_s_barrier(); asm volatile("" ::: "memory");
    }
};
struct XpreOrder {
    const char* Kk; const char* Wcqn; const char* Wcot; const char* Vv; int c;
    __device__ bool next(int i, Unit& u) const { if (i > 0 || c >= 256) return false; u.rows = 256; u.e = 0;
        if (c < 128) { const int bh = c >> 3, nt = c & 7, b = bh >> 2, h = bh & 3;
            u.a = Kk + ((size_t)(b * MEMLEN) * DM + h * 512) * 2; u.b = Wcqn + ((size_t)(nt * 256) * DM + h * 512) * 2; u.r0 = bh * 256; u.c0 = nt * 256; u.e = 0; }
        else { const int q = c - 128, bh = q >> 3, nt = q & 7, b = bh >> 2, h = bh & 3;
            u.a = Wcot + ((size_t)(nt * 256) * DM + h * 512) * 2; u.b = Vv + ((size_t)(b * MEMLEN) * DM + h * 512) * 2; u.r0 = b * DM + nt * 256; u.c0 = h * 256; u.e = 1; }
        return true; }
    __device__ __forceinline__ void a_ready(const Unit&) const {}
};
struct EpiXpre {
    static constexpr bool PERM = true;
    bf16* MT; bf16* VWT;
    __device__ __forceinline__ void operator()(f32x4 (&acc)[2][2][4][2], const Unit& u, int wr, int wc, int fr, int fq) const {
        bf16* O = u.e ? VWT : MT; const int ld = u.e ? 1024 : DM;
        EPI_LOOP_P( st_bf16x8(O + (size_t)(u.r0 + rl) * ld + u.c0 + cl, v0, v1); )
    }
};
struct MixOrder {
    pg8::DenseOrder D; XpreOrder X; int c;
    __device__ bool next(int i, Unit& u) const { if (i > 1) return false; const bool first_dense = true;
        if ((i == 0) == first_dense) { const bool ok = D.next(0, u); u.e = 0; u.nt = 32; return ok; }
        const bool ok = X.next(0, u); u.e = u.e + 1; u.nt = 8; return ok; }
    __device__ __forceinline__ void a_ready(const Unit&) const {}
};
struct EpiMix {
    static constexpr bool PERM = true;
    EpiRes1 R; EpiXpre Xp;
    __device__ __forceinline__ void operator()(f32x4 (&acc)[2][2][4][2], const Unit& u, int wr, int wc, int fr, int fq) const {
        if (u.e == 0) R(acc, u, wr, wc, fr, fq); else { Unit v = u; v.e = u.e - 1; Xp(acc, v, wr, wc, fr, fq); }
    }
};
struct XsOrder {
    const char* X; const char* MT; int c;
    __device__ bool next(int i, Unit& u) const { if (i > 0 || c >= 128) return false; const int bh = c >> 3, qt = c & 7, b = bh >> 2, h = bh & 3;
        u.a = X + ((size_t)(b * SEQ + 256 * qt) * DM) * 2; u.b = MT + ((size_t)(bh * 256) * DM) * 2; u.r0 = b * SEQ + 256 * qt; u.c0 = h * 256; u.rows = 256; u.e = 0; return true; }
    __device__ __forceinline__ void a_ready(const Unit&) const {}
};
struct XoutOrder {
    const char* P; const char* VWT; int c;
    __device__ bool next(int i, Unit& u) const { if (i > 0 || c >= 256) return false; const int b = c >> 6, pm = (c >> 3) & 7, pn = c & 7;
        u.a = P + ((size_t)(b * SEQ + 256 * pm) * 1024) * 2; u.b = VWT + ((size_t)(b * DM + 256 * pn) * 1024) * 2; u.r0 = b * SEQ + 256 * pm; u.c0 = 256 * pn; u.rows = 256; u.e = 0; return true; }
    __device__ __forceinline__ void a_ready(const Unit&) const {}
};
struct KvOrder {
    const char* A; const char* Bt; int c;
    __device__ bool next(int i, Unit& u) const { if (i > 0 || c >= 64) return false; const int pm = c >> 4, pn = c & 15;
        u.a = A + (size_t)pm * 256 * KD * 2; u.b = Bt + (size_t)pn * 256 * KD * 2; u.r0 = pm * 256; u.c0 = pn * 256; u.rows = 256; u.e = 0; return true; }
    __device__ __forceinline__ void a_ready(const Unit&) const {}
};
struct MoeOrder {
    const LAS int* tab; const char* A; const char* Bt; int ntn, G, c; size_t bstride; int ocol; int pitchb;
    __device__ bool next(int i, Unit& u) const {
        const int idx = i * G + c; const int total = __builtin_amdgcn_readfirstlane(tab[32]);
        if (idx >= total) return false;
        int e = 0;
        for (int q = 1; q < 32; ++q) { const int p = __builtin_amdgcn_readfirstlane(tab[q]); if (idx >= p) e = q; }
        const int ue = __builtin_amdgcn_readfirstlane(tab[e]), st = __builtin_amdgcn_readfirstlane(tab[64 + e]), cn = __builtin_amdgcn_readfirstlane(tab[128 + e]);
        const int local = idx - ue, mt = local / ntn, nt = local - mt * ntn;
        u.a = A + (size_t)(st + 256 * mt) * pitchb; u.b = Bt + (size_t)e * bstride + (size_t)nt * 256 * pitchb;
        u.r0 = st + 256 * mt; u.c0 = nt * ocol; u.rows = (cn - 256 * mt) < 256 ? (cn - 256 * mt) : 256; u.e = e; return true;
    }
    const unsigned* ecnt; int* ready; int hi_ready;
    __device__ __forceinline__ void a_ready(const Unit& u) const {
        if (ecnt == nullptr || u.e <= *ready || u.e >= hi_ready) return;
        if (threadIdx.x < 64) { unsigned sp = 0;
            while ((unsigned)__builtin_amdgcn_readfirstlane(__hip_atomic_load(ecnt + 64 * u.e, __ATOMIC_RELAXED, __HIP_MEMORY_SCOPE_AGENT)) < (unsigned)CONV_WGS) { __builtin_amdgcn_s_sleep(4); if (++sp > (1u << 22)) break; }
            __builtin_amdgcn_fence(__ATOMIC_ACQUIRE, "agent");
            asm volatile("s_waitcnt vmcnt(0)" ::: "memory"); }
        asm volatile("" ::: "memory"); __builtin_amdgcn_s_barrier(); asm volatile("" ::: "memory");
        *ready = u.e;
    }
};
__device__ __forceinline__ void moe_table(const Frame& F, int ntn) {
    LAS int* tab = (LAS int*)(F.lds + TAB_OFF); const int* cs = (const int*)(F.ws + WS_CNT);
    if (F.tid < 32) { tab[64 + F.tid] = cs[32 + F.tid]; tab[128 + F.tid] = cs[F.tid]; }
    __syncthreads();
    if (F.tid == 0) { int p = 0; for (int e = 0; e < 32; ++e) { tab[e] = p; p += ((tab[128 + e] + 255) >> 8) * ntn; } tab[32] = p; }
    __syncthreads();
}

__device__ __forceinline__ void gla_low_job(const Frame& F) {
    const bf16* h1 = (const bf16*)(F.ws + WS_H1); const bf16* wl = (const bf16*)(F.ws + WS_WLOW); float* glow = (float*)(F.ws + WS_GLOW);
    LAS float* red = (LAS float*)F.lds;
    const int l = F.lane, r16 = l & 15, quad = l >> 4;
    for (int rb = F.bid; rb < NT / 32; rb += F.G) {
        f32x4 acc[2] = {{0.f, 0.f, 0.f, 0.f}, {0.f, 0.f, 0.f, 0.f}};
#pragma unroll
        for (int st = 0; st < 8; ++st) { const int k0 = 256 * F.wave + 32 * st + 8 * quad;
            const bf16x8 bfr = *(const bf16x8*)(wl + (size_t)r16 * KD + k0);
#pragma unroll
            for (int tb = 0; tb < 2; ++tb) { const bf16x8 afr = *(const bf16x8*)(h1 + (size_t)(rb * 32 + tb * 16 + r16) * KD + k0);
                acc[tb] = __builtin_amdgcn_mfma_f32_16x16x32_bf16(afr, bfr, acc[tb], 0, 0, 0); } }
#pragma unroll
        for (int tb = 0; tb < 2; ++tb)
#pragma unroll
            for (int j = 0; j < 4; ++j) red[(F.wave * 32 + tb * 16 + 4 * quad + j) * 16 + r16] = acc[tb][j];
        __syncthreads();
        { const int tok = F.tid >> 4, r = F.tid & 15; float s = 0.f;
#pragma unroll
          for (int w = 0; w < 8; ++w) s += red[(w * 32 + tok) * 16 + r];
          glow[(size_t)(rb * 32 + tok) * 16 + r] = s; }
        __syncthreads();
    }
}

__device__ __forceinline__ void sb_attn_wave(const Frame& F, const float* __restrict__ sb_g, int wu) {
    const bf16* Q = (const bf16*)(F.ws + WS_SBQ); const bf16* Kp = (const bf16*)(F.ws + WS_SBK); const bf16* VT = (const bf16*)(F.ws + WS_SBVT); bf16* O = (bf16*)(F.ws + WS_MIXO);
    const int l = F.lane, r = l & 31, hh = l >> 5;
    const int qb = 63 - (wu & 63), bh = wu >> 6, b = bh >> 3, h = bh & 7;
    const int t0 = qb * 32;
    bf16x8 qf[8];
#pragma unroll
    for (int st = 0; st < 8; ++st) qf[st] = *(const bf16x8*)(Q + (size_t)(b * SEQ + t0 + r) * 1024 + h * 128 + 16 * st + 8 * hh);
    f32x16 o[4];
#pragma unroll
    for (int d = 0; d < 4; ++d)
#pragma unroll
        for (int i = 0; i < 16; ++i) o[d][i] = 0.f;
    float R = 0.f;
    const float zs = 0.08838834764831845f * LOG2E;
    const int qpos = t0 + r;
    for (int kt = qb; kt >= 0; --kt) {
        f32x16 s;
#pragma unroll
        for (int i = 0; i < 16; ++i) s[i] = 0.f;
#pragma unroll
        for (int st = 0; st < 8; ++st) { const bf16x8 kf = *(const bf16x8*)(Kp + (size_t)(b * SEQ + kt * 32 + r) * 1024 + h * 128 + 16 * st + 8 * hh);
            s = __builtin_amdgcn_mfma_f32_32x32x16_bf16(kf, qf[st], s, 0, 0, 0); }
        float lm[16], lb[16];
#pragma unroll
        for (int i = 0; i < 16; ++i) { const int key = kt * 32 + (i & 3) + 8 * (i >> 2) + 4 * hh; const float z2 = s[i] * zs; const bool valid = key < qpos;
            const float sp = fmaxf(z2, 0.f) + flog2(1.f + fexp2(-fabsf(z2)));
            lm[i] = valid ? -sp : 0.f; lb[i] = z2 - sp; }
        float Gown[4], Gpar[4];
#pragma unroll
        for (int c = 0; c < 4; ++c) { Gown[c] = (lm[4 * c] + lm[4 * c + 1]) + (lm[4 * c + 2] + lm[4 * c + 3]); Gpar[c] = __shfl_xor(Gown[c], 32); }
        float sufT[4]; sufT[3] = 0.f;
#pragma unroll
        for (int c = 2; c >= 0; --c) sufT[c] = sufT[c + 1] + (Gown[c + 1] + Gpar[c + 1]);
        float p[16];
#pragma unroll
        for (int c = 0; c < 4; ++c) { float run = R + sufT[c] + (hh == 0 ? Gpar[c] : 0.f);
#pragma unroll
            for (int e = 3; e >= 0; --e) { const int i = 4 * c + e; const int key = kt * 32 + e + 8 * c + 4 * hh;
                p[i] = (key < qpos) ? fexp2(lb[i] + run) : 0.f; run += lm[i]; } }
        R += (Gown[0] + Gpar[0]) + (Gown[1] + Gpar[1]) + (Gown[2] + Gpar[2]) + (Gown[3] + Gpar[3]);
#pragma unroll
        for (int s2 = 0; s2 < 2; ++s2) {
            u32x4 pw; pw.x = cvt_pk_bf16(p[8 * s2 + 0], p[8 * s2 + 1]); pw.y = cvt_pk_bf16(p[8 * s2 + 2], p[8 * s2 + 3]); pw.z = cvt_pk_bf16(p[8 * s2 + 4], p[8 * s2 + 5]); pw.w = cvt_pk_bf16(p[8 * s2 + 6], p[8 * s2 + 7]);
            const bf16x8 pb = __builtin_bit_cast(bf16x8, pw);
#pragma unroll
            for (int d = 0; d < 4; ++d) { const bf16* vp = VT + ((size_t)(bh * 128 + d * 32 + r)) * SEQ + kt * 32 + 16 * s2 + 4 * hh;
                u32x4 vw; const u32x2 v0 = *(const u32x2*)vp, v1 = *(const u32x2*)(vp + 8); vw.x = v0.x; vw.y = v0.y; vw.z = v1.x; vw.w = v1.y;
                o[d] = __builtin_amdgcn_mfma_f32_32x32x16_bf16(__builtin_bit_cast(bf16x8, vw), pb, o[d], 0, 0, 0); } }
        if (__all(R < -40.f)) break;
    }
    float ss = 0.f;
#pragma unroll
    for (int d = 0; d < 4; ++d)
#pragma unroll
        for (int i = 0; i < 16; ++i) ss += o[d][i] * o[d][i];
    ss += __shfl_xor(ss, 32);
    const float rstd = 1.0f / sqrtf(ss * (1.f / 128.f) + EPS);
#pragma unroll
    for (int d = 0; d < 4; ++d)
#pragma unroll
        for (int c = 0; c < 4; ++c) { const int dim = 32 * d + 8 * c + 4 * hh; const f32x4 g = *(const f32x4*)(sb_g + h * 128 + dim);
            f32x4 v; v.x = o[d][4 * c] * rstd * g.x; v.y = o[d][4 * c + 1] * rstd * g.y; v.z = o[d][4 * c + 2] * rstd * g.z; v.w = o[d][4 * c + 3] * rstd * g.w;
            st_bf16x4(O + (size_t)(b * SEQ + qpos) * DM + h * 128 + dim, v); }
}

constexpr int G1_QIN = 0, G1_KIN = 64 * 136 * 2, G1_KDT = 2 * 64 * 136 * 2, G1_LOW = G1_KDT + 128 * 72 * 2, G1_SEG = G1_LOW + 64 * 16 * 4, G1_QRAW = G1_SEG + 4 * 128 * 4, G1_KRAW = G1_QRAW + 64 * 128 * 2, G1_END = G1_KRAW + 64 * 128 * 2;
constexpr int G1_KVT = G1_QRAW;
static_assert(G1_END <= RING_BYTES && G1_KVT + 65536 <= RING_BYTES && (G1_KVT & 15) == 0, "g1 lds");
__device__ __forceinline__ void gla_g1_unit(const Frame& F, const float* __restrict__ w2, const float* __restrict__ b2, int unit) {
    const int n = unit & 31, bh = unit >> 5, b = bh >> 2, h = bh & 3;
    const int t0 = b * SEQ + 64 * n;
    const bf16* GQ = (const bf16*)(F.ws + WS_GQ); const bf16* GK = (const bf16*)(F.ws + WS_GK); const bf16* GVT = (const bf16*)(F.ws + WS_GVT); const float* GLOW = (const float*)(F.ws + WS_GLOW);
    LAS bf16* qin = (LAS bf16*)(F.lds + G1_QIN); LAS bf16* kin = (LAS bf16*)(F.lds + G1_KIN); LAS bf16* kdt = (LAS bf16*)(F.lds + G1_KDT);
    LAS float* lowl = (LAS float*)(F.lds + G1_LOW); LAS float* seg = (LAS float*)(F.lds + G1_SEG);
    for (int i = F.tid; i < 64 * 16; i += NTHR) lowl[i] = GLOW[(size_t)t0 * 16 + i];
    LAS bf16* qraw = (LAS bf16*)(F.lds + G1_QRAW); LAS bf16* kraw = (LAS bf16*)(F.lds + G1_KRAW);
#pragma unroll
    for (int q2 = 0; q2 < 2; ++q2) { const int id = F.tid + 512 * q2, row = id >> 4, ch = id & 15;
        *(LAS u32x4*)(qraw + row * 128 + ch * 8) = *(const u32x4*)(GQ + (size_t)(t0 + row) * 512 + h * 128 + ch * 8);
        *(LAS u32x4*)(kraw + row * 128 + ch * 8) = *(const u32x4*)(GK + (size_t)(t0 + row) * 512 + h * 128 + ch * 8); }
    __syncthreads();
    const int d = F.tid & 127, sg = F.tid >> 7, dd = h * 128 + d;
    float wcol[16];
#pragma unroll
    for (int r = 0; r < 16; ++r) wcol[r] = w2[r * 512 + dd];
    const float bias = b2[dd];
    float pre[16]; float run = 0.f;
#pragma unroll
    for (int i = 0; i < 16; ++i) { const int c = 16 * sg + i; float z = bias;
#pragma unroll
        for (int r4 = 0; r4 < 4; ++r4) { const f32x4 lv = *(const LAS f32x4*)(lowl + c * 16 + 4 * r4); z += lv.x * wcol[4 * r4] + lv.y * wcol[4 * r4 + 1] + lv.z * wcol[4 * r4 + 2] + lv.w * wcol[4 * r4 + 3]; }
        run += log2_sigmoid2(z * LOG2E) * (1.0f / 16.0f);
        pre[i] = run; }
    seg[sg * 128 + d] = run;
    __syncthreads();
    float off = 0.f, tot = 0.f;
#pragma unroll
    for (int s = 0; s < 4; ++s) { const float v = seg[s * 128 + d]; tot += v; if (s < sg) off += v; }
    bf16* QIN = (bf16*)(F.ws + WS_QIN);
#pragma unroll
    for (int i = 0; i < 16; ++i) { const int c = 16 * sg + i; const float g = off + pre[i];
        const float qv = bf2f(qraw[c * 128 + d]), kv = bf2f(kraw[c * 128 + d]);
        const bf16 qi = f2bf(qv * 0.08838834764831845f * fexp2(g));
        qin[c * 136 + d] = qi;
        kin[c * 136 + d] = f2bf(kv * fexp2(-g));
        kdt[d * 72 + c] = f2bf(kv * fexp2(tot - g)); }
    if (sg == 0) ((float*)(F.ws + WS_DECAY))[(size_t)unit * 128 + d] = fexp2(tot);
    __syncthreads();
#pragma unroll
    for (int q2 = 0; q2 < 2; ++q2) { const int id = F.tid + 512 * q2, row = id >> 4, ch = id & 15;
        *(u32x4*)(QIN + (size_t)(t0 + row) * 512 + h * 128 + ch * 8) = *(const LAS u32x4*)(qin + row * 136 + ch * 8); }
    const int w = F.wave, l = F.lane, r = l & 31, hh = l >> 5, cb = w & 1, dvp = w >> 1;
    f32x16 X[2];
#pragma unroll
    for (int sb = 0; sb < 2; ++sb) {
#pragma unroll
        for (int i = 0; i < 16; ++i) X[sb][i] = 0.f;
#pragma unroll
        for (int st = 0; st < 8; ++st) { const bf16x8 af = *(const LAS bf16x8*)(kin + (32 * sb + r) * 136 + 16 * st + 8 * hh), bfq = *(const LAS bf16x8*)(qin + (32 * cb + r) * 136 + 16 * st + 8 * hh);
            X[sb] = __builtin_amdgcn_mfma_f32_32x32x16_bf16(af, bfq, X[sb], 0, 0, 0); }
#pragma unroll
        for (int i = 0; i < 16; ++i) { const int s = 32 * sb + (i & 3) + 8 * (i >> 2) + 4 * hh; if (32 * cb + r < s) X[sb][i] = 0.f; }
    }
    u32x4* OI = (u32x4*)(F.ws + WS_OINTRA) + ((size_t)unit * 8 + w) * 256;
#pragma unroll
    for (int dbi = 0; dbi < 2; ++dbi) { const int db = 2 * dvp + dbi; f32x16 oacc;
#pragma unroll
        for (int i = 0; i < 16; ++i) oacc[i] = 0.f;
#pragma unroll
        for (int sb = 0; sb < 2; ++sb)
#pragma unroll
            for (int s2 = 0; s2 < 2; ++s2) {
                u32x4 pw; pw.x = cvt_pk_bf16(X[sb][8 * s2 + 0], X[sb][8 * s2 + 1]); pw.y = cvt_pk_bf16(X[sb][8 * s2 + 2], X[sb][8 * s2 + 3]); pw.z = cvt_pk_bf16(X[sb][8 * s2 + 4], X[sb][8 * s2 + 5]); pw.w = cvt_pk_bf16(X[sb][8 * s2 + 6], X[sb][8 * s2 + 7]);
                const bf16* vp = GVT + ((size_t)(bh * 256 + db * 32 + r)) * SEQ + 64 * n + 32 * sb + 16 * s2 + 4 * hh;
                u32x4 vw; const u32x2 v0 = *(const u32x2*)vp, v1 = *(const u32x2*)(vp + 8); vw.x = v0.x; vw.y = v0.y; vw.z = v1.x; vw.w = v1.y;
                oacc = __builtin_amdgcn_mfma_f32_32x32x16_bf16(__builtin_bit_cast(bf16x8, vw), __builtin_bit_cast(bf16x8, pw), oacc, 0, 0, 0); }
#pragma unroll
        for (int q4 = 0; q4 < 2; ++q4) { u32x4 ow; ow.x = cvt_pk_bf16(oacc[8 * q4], oacc[8 * q4 + 1]); ow.y = cvt_pk_bf16(oacc[8 * q4 + 2], oacc[8 * q4 + 3]); ow.z = cvt_pk_bf16(oacc[8 * q4 + 4], oacc[8 * q4 + 5]); ow.w = cvt_pk_bf16(oacc[8 * q4 + 6], oacc[8 * q4 + 7]);
            OI[(dbi * 2 + q4) * 64 + l] = ow; } }
    bf16* KVN = (bf16*)(F.ws + WS_KVN) + (size_t)unit * 32768; LAS bf16* kvt = (LAS bf16*)(F.lds + G1_KVT);
    bf16x8 vf[4];
#pragma unroll
    for (int st = 0; st < 4; ++st) vf[st] = *(const bf16x8*)(GVT + ((size_t)(bh * 256 + w * 32 + r)) * SEQ + 64 * n + 16 * st + 8 * hh);
#pragma unroll
    for (int dkb = 0; dkb < 4; ++dkb) { f32x16 kacc;
#pragma unroll
        for (int i = 0; i < 16; ++i) kacc[i] = 0.f;
#pragma unroll
        for (int st = 0; st < 4; ++st) { const bf16x8 bk = *(const LAS bf16x8*)(kdt + (32 * dkb + r) * 72 + 16 * st + 8 * hh);
            kacc = __builtin_amdgcn_mfma_f32_32x32x16_bf16(vf[st], bk, kacc, 0, 0, 0); }
#pragma unroll
        for (int i = 0; i < 16; ++i) kvt[(32 * w + (i & 3) + 8 * (i >> 2) + 4 * hh) * 128 + 32 * dkb + r] = f2bf(kacc[i]); }
    LDS_WAIT();
#pragma unroll
    for (int q8 = 0; q8 < 8; ++q8) { const int row = 32 * w + 4 * q8 + (l >> 4), ch = l & 15;
        *(u32x4*)(KVN + (size_t)row * 128 + ch * 8) = *(const LAS u32x4*)(kvt + row * 128 + ch * 8); }
    __syncthreads();
}

__device__ __forceinline__ void gla_scan(const Frame& F) {
    const bf16* KVN = (const bf16*)(F.ws + WS_KVN); const float* DEC = (const float*)(F.ws + WS_DECAY); bf16* ST = (bf16*)(F.ws + WS_STATE);
    for (int g = F.bid * NTHR + F.tid; g < 16 * 8192; g += F.G * NTHR) {
        const int bh = g >> 13, e4 = (g & 8191) * 4, dk = e4 & 127;
        f32x4 S = {0.f, 0.f, 0.f, 0.f};
#pragma unroll 8
        for (int n = 0; n < 32; ++n) { const size_t u = (size_t)(bh * 32 + n);
            st_bf16x4(ST + u * 32768 + e4, S);
            const u32x2 kw = *(const u32x2*)(KVN + u * 32768 + e4); const f32x4 kv = {bflo(kw.x), bfhi(kw.x), bflo(kw.y), bfhi(kw.y)}, dc = *(const f32x4*)(DEC + u * 128 + dk);
            S = S * dc + kv; }
    }
}

__device__ __forceinline__ void gla_g3_unit(const Frame& F, const float* __restrict__ gn, int unit) {
    const int n = unit & 31, bh = unit >> 5, b = bh >> 2, h = bh & 3; const int t0 = b * SEQ + 64 * n;
    const int w = F.wave, l = F.lane, r = l & 31, hh = l >> 5, cb = w & 1, dvp = w >> 1;
    const bf16* QIN = (const bf16*)(F.ws + WS_QIN); const bf16* ST = (const bf16*)(F.ws + WS_STATE) + (size_t)unit * 32768; const bf16* GR = (const bf16*)(F.ws + WS_GR); bf16* O = (bf16*)(F.ws + WS_MIXO);
    const u32x4* OI = (const u32x4*)(F.ws + WS_OINTRA) + ((size_t)unit * 8 + w) * 256;
    LAS float* part = (LAS float*)F.lds;
    bf16x8 qf[8];
#pragma unroll
    for (int st = 0; st < 8; ++st) qf[st] = *(const bf16x8*)(QIN + (size_t)(t0 + 32 * cb + r) * 512 + h * 128 + 16 * st + 8 * hh);
    f32x16 o[2]; float ss = 0.f;
#pragma unroll
    for (int dbi = 0; dbi < 2; ++dbi) { const int db = 2 * dvp + dbi;
#pragma unroll
        for (int q4 = 0; q4 < 2; ++q4) { const u32x4 ow = OI[(dbi * 2 + q4) * 64 + l];
            o[dbi][8 * q4] = bflo(ow.x); o[dbi][8 * q4 + 1] = bfhi(ow.x); o[dbi][8 * q4 + 2] = bflo(ow.y); o[dbi][8 * q4 + 3] = bfhi(ow.y); o[dbi][8 * q4 + 4] = bflo(ow.z); o[dbi][8 * q4 + 5] = bfhi(ow.z); o[dbi][8 * q4 + 6] = bflo(ow.w); o[dbi][8 * q4 + 7] = bfhi(ow.w); }
#pragma unroll
        for (int st = 0; st < 8; ++st) { const bf16x8 sf = *(const bf16x8*)(ST + (size_t)(32 * db + r) * 128 + 16 * st + 8 * hh);
            o[dbi] = __builtin_amdgcn_mfma_f32_32x32x16_bf16(sf, qf[st], o[dbi], 0, 0, 0); }
#pragma unroll
        for (int i = 0; i < 16; ++i) ss += o[dbi][i] * o[dbi][i]; }
    ss += __shfl_xor(ss, 32);
    if (hh == 0) part[w * 32 + r] = ss;
    __syncthreads();
    float tot = 0.f;
#pragma unroll
    for (int q = 0; q < 4; ++q) tot += part[(2 * q + cb) * 32 + r];
    const float rstd = 1.0f / sqrtf(tot * (1.f / 256.f) + EPS);
    const int tok = t0 + 32 * cb + r;
#pragma unroll
    for (int dbi = 0; dbi < 2; ++dbi)
#pragma unroll
        for (int c = 0; c < 4; ++c) { const int dv = 32 * (2 * dvp + dbi) + 8 * c + 4 * hh; const f32x4 g = *(const f32x4*)(gn + h * 256 + dv);
            const u32x2 rw = *(const u32x2*)(GR + (size_t)tok * 1024 + h * 256 + dv);
            const float r0 = bflo(rw.x), r1 = bfhi(rw.x), r2 = bflo(rw.y), r3 = bfhi(rw.y);
            f32x4 v; v.x = o[dbi][4 * c] * rstd * g.x * (r0 * frcp(1.f + fexp2(-r0 * LOG2E))); v.y = o[dbi][4 * c + 1] * rstd * g.y * (r1 * frcp(1.f + fexp2(-r1 * LOG2E)));
            v.z = o[dbi][4 * c + 2] * rstd * g.z * (r2 * frcp(1.f + fexp2(-r2 * LOG2E))); v.w = o[dbi][4 * c + 3] * rstd * g.w * (r3 * frcp(1.f + fexp2(-r3 * LOG2E)));
            st_bf16x4(O + (size_t)tok * DM + 1024 + h * 256 + dv, v); }
    __syncthreads();
}
__device__ __forceinline__ void gla_g3_pair(const Frame& F, const float* __restrict__ gn, int uA, int uB) {
    const int w = F.wave, l = F.lane, r = l & 31, hh = l >> 5, w4 = w & 3, cb = w4 & 1, dvh = w4 >> 1;
    const int unit = (w < 4) ? uA : uB; const bool act = unit >= 0;
    const int uu = act ? unit : 0, n = uu & 31, bh = uu >> 5, b = bh >> 2, h = bh & 3; const int t0 = b * SEQ + 64 * n;
    const bf16* QIN = (const bf16*)(F.ws + WS_QIN); const bf16* ST = (const bf16*)(F.ws + WS_STATE) + (size_t)uu * 32768; const bf16* GR = (const bf16*)(F.ws + WS_GR); bf16* O = (bf16*)(F.ws + WS_MIXO);
    LAS float* part = (LAS float*)F.lds;
    f32x16 o[4]; float ss = 0.f;
    if (act) {
        bf16x8 qf[8];
#pragma unroll
        for (int st = 0; st < 8; ++st) qf[st] = *(const bf16x8*)(QIN + (size_t)(t0 + 32 * cb + r) * 512 + h * 128 + 16 * st + 8 * hh);
#pragma unroll
        for (int dbi = 0; dbi < 4; ++dbi) { const int db = 4 * dvh + dbi;
            const u32x4* OI = (const u32x4*)(F.ws + WS_OINTRA) + ((size_t)uu * 8 + (2 * (db >> 1) + cb)) * 256 + ((db & 1) * 2) * 64 + l;
#pragma unroll
            for (int q4 = 0; q4 < 2; ++q4) { const u32x4 ow = OI[q4 * 64];
                o[dbi][8 * q4] = bflo(ow.x); o[dbi][8 * q4 + 1] = bfhi(ow.x); o[dbi][8 * q4 + 2] = bflo(ow.y); o[dbi][8 * q4 + 3] = bfhi(ow.y); o[dbi][8 * q4 + 4] = bflo(ow.z); o[dbi][8 * q4 + 5] = bfhi(ow.z); o[dbi][8 * q4 + 6] = bflo(ow.w); o[dbi][8 * q4 + 7] = bfhi(ow.w); }
#pragma unroll
            for (int st = 0; st < 8; ++st) { const bf16x8 sf = *(const bf16x8*)(ST + (size_t)(32 * db + r) * 128 + 16 * st + 8 * hh);
                o[dbi] = __builtin_amdgcn_mfma_f32_32x32x16_bf16(sf, qf[st], o[dbi], 0, 0, 0); }
#pragma unroll
            for (int i = 0; i < 16; ++i) ss += o[dbi][i] * o[dbi][i]; }
        ss += __shfl_xor(ss, 32);
        if (hh == 0) part[w * 32 + r] = ss;
    }
    __syncthreads();
    if (act) {
        const float tot = part[((w & 4) + cb) * 32 + r] + part[((w & 4) + cb + 2) * 32 + r];
        const float rstd = 1.0f / sqrtf(tot * (1.f / 256.f) + EPS);
        const int tok = t0 + 32 * cb + r;
#pragma unroll
        for (int dbi = 0; dbi < 4; ++dbi)
#pragma unroll
            for (int c = 0; c < 4; ++c) { const int dv = 32 * (4 * dvh + dbi) + 8 * c + 4 * hh; const f32x4 g = *(const f32x4*)(gn + h * 256 + dv);
                const u32x2 rw = *(const u32x2*)(GR + (size_t)tok * 1024 + h * 256 + dv);
                const float r0 = bflo(rw.x), r1 = bfhi(rw.x), r2 = bflo(rw.y), r3 = bfhi(rw.y);
                f32x4 v; v.x = o[dbi][4 * c] * rstd * g.x * (r0 * frcp(1.f + fexp2(-r0 * LOG2E))); v.y = o[dbi][4 * c + 1] * rstd * g.y * (r1 * frcp(1.f + fexp2(-r1 * LOG2E)));
                v.z = o[dbi][4 * c + 2] * rstd * g.z * (r2 * frcp(1.f + fexp2(-r2 * LOG2E))); v.w = o[dbi][4 * c + 3] * rstd * g.w * (r3 * frcp(1.f + fexp2(-r3 * LOG2E)));
                st_bf16x4(O + (size_t)tok * DM + 1024 + h * 256 + dv, v); }
    }
    __syncthreads();
}

__device__ __forceinline__ void router_phase(const Frame& F, const float* __restrict__ b_router) {
    const float* X2 = (const float*)(F.ws + WS_X2); const bf16* WH = (const bf16*)(F.ws + WS_WRH); const bf16* WL = (const bf16*)(F.ws + WS_WRL);
    int* TOPE = (int*)(F.ws + WS_TOPE); float* TOPW = (float*)(F.ws + WS_TOPW); float* RSTD = (float*)(F.ws + WS_RSTD3); int* HIST = (int*)(F.ws + WS_HIST);
    LAS float* part = (LAS float*)F.lds;
    LAS float* sq = (LAS float*)(F.lds + 32768);
    LAS int* hist = (LAS int*)(F.lds + 33792);
    const int w = F.wave, l = F.lane, r16 = l & 15, quad = l >> 4;
    for (int rb = F.bid; rb < NT / 32; rb += F.G) {
        if (F.tid < 32) hist[F.tid] = 0;
        f32x4 acc[2][2] = {{{0.f, 0.f, 0.f, 0.f}, {0.f, 0.f, 0.f, 0.f}}, {{0.f, 0.f, 0.f, 0.f}, {0.f, 0.f, 0.f, 0.f}}}; float ssq[2] = {0.f, 0.f};
#pragma unroll 4
        for (int st = 0; st < 8; ++st) { const int k0 = 256 * w + 32 * st + 8 * quad;
            bf16x8 bh[2], bl[2];
#pragma unroll
            for (int eb = 0; eb < 2; ++eb) { bh[eb] = *(const bf16x8*)(WH + (size_t)(16 * eb + r16) * KD + k0); bl[eb] = *(const bf16x8*)(WL + (size_t)(16 * eb + r16) * KD + k0); }
#pragma unroll
            for (int tg = 0; tg < 2; ++tg) { const int row = rb * 32 + 16 * tg + r16;
#if X2_BF16
                const u32x4 xw = *(const u32x4*)((const bf16*)X2 + (size_t)row * DM + k0);
                { const float x0 = bflo(xw.x), x1 = bfhi(xw.x), x2 = bflo(xw.y), x3 = bfhi(xw.y), x4 = bflo(xw.z), x5 = bfhi(xw.z), x6 = bflo(xw.w), x7 = bfhi(xw.w);
                  ssq[tg] += (x0 * x0 + x1 * x1) + (x2 * x2 + x3 * x3) + (x4 * x4 + x5 * x5) + (x6 * x6 + x7 * x7); }
                const bf16x8 ah = __builtin_bit_cast(bf16x8, xw);
#pragma unroll
                for (int eb = 0; eb < 2; ++eb) {
                    acc[tg][eb] = __builtin_amdgcn_mfma_f32_16x16x32_bf16(ah, bh[eb], acc[tg][eb], 0, 0, 0);
                    acc[tg][eb] = __builtin_amdgcn_mfma_f32_16x16x32_bf16(ah, bl[eb], acc[tg][eb], 0, 0, 0); } } }
#else
                const f32x4 xa = *(const f32x4*)(X2 + (size_t)row * DM + k0), xb = *(const f32x4*)(X2 + (size_t)row * DM + k0 + 4);
                ssq[tg] += (xa.x * xa.x + xa.y * xa.y) + (xa.z * xa.z + xa.w * xa.w) + (xb.x * xb.x + xb.y * xb.y) + (xb.z * xb.z + xb.w * xb.w);
                u32x4 hw; hw.x = cvt_pk_bf16(xa.x, xa.y); hw.y = cvt_pk_bf16(xa.z, xa.w); hw.z = cvt_pk_bf16(xb.x, xb.y); hw.w = cvt_pk_bf16(xb.z, xb.w);
                u32x4 lw; lw.x = cvt_pk_bf16(xa.x - bflo(hw.x), xa.y - bfhi(hw.x)); lw.y = cvt_pk_bf16(xa.z - bflo(hw.y), xa.w - bfhi(hw.y));
                lw.z = cvt_pk_bf16(xb.x - bflo(hw.z), xb.y - bfhi(hw.z)); lw.w = cvt_pk_bf16(xb.z - bflo(hw.w), xb.w - bfhi(hw.w));
                const bf16x8 ah = __builtin_bit_cast(bf16x8, hw), alo = __builtin_bit_cast(bf16x8, lw);
#pragma unroll
                for (int eb = 0; eb < 2; ++eb) {
                    acc[tg][eb] = __builtin_amdgcn_mfma_f32_16x16x32_bf16(ah, bh[eb], acc[tg][eb], 0, 0, 0);
                    acc[tg][eb] = __builtin_amdgcn_mfma_f32_16x16x32_bf16(ah, bl[eb], acc[tg][eb], 0, 0, 0);
                    acc[tg][eb] = __builtin_amdgcn_mfma_f32_16x16x32_bf16(alo, bh[eb], acc[tg][eb], 0, 0, 0); } } }
#endif
#pragma unroll
        for (int tg = 0; tg < 2; ++tg) { float q = ssq[tg]; q += __shfl_xor(q, 16); q += __shfl_xor(q, 32);
            if (quad == 0) sq[w * 32 + 16 * tg + r16] = q;
#pragma unroll
            for (int eb = 0; eb < 2; ++eb)
#pragma unroll
                for (int j = 0; j < 4; ++j) part[(w * 32 + 16 * tg + 4 * quad + j) * 32 + 16 * eb + r16] = acc[tg][eb][j]; }
        __syncthreads();
        for (int q2 = 0; q2 < 2; ++q2) { const int hf = l >> 5, e = l & 31; const int ti = 4 * w + 2 * q2 + hf; const int tok = rb * 32 + ti;
            LAS float* lg = (LAS float*)(F.lds + 36864) + (w * 2 + hf) * 32; LAS float* tvr = (LAS float*)(F.lds + 40960) + (w * 2 + hf) * 4;
            float s2 = 0.f, a = 0.f;
#pragma unroll
            for (int k = 0; k < 8; ++k) { s2 += sq[k * 32 + ti]; a += part[(k * 32 + ti) * 32 + e]; }
            const float rstd = 1.0f / sqrtf(s2 * (1.f / DM) + EPS);
            float v = a * rstd + b_router[e]; v = (v == v) ? v : -3.0e38f;
            lg[e] = v;
            LDS_WAIT();
            int rank = 0;
#pragma unroll
            for (int j4 = 0; j4 < 8; ++j4) { const f32x4 o = *(const LAS f32x4*)(lg + 4 * j4);
                rank += (o.x > v || (o.x == v && 4 * j4 + 0 < e)) ? 1 : 0; rank += (o.y > v || (o.y == v && 4 * j4 + 1 < e)) ? 1 : 0;
                rank += (o.z > v || (o.z == v && 4 * j4 + 2 < e)) ? 1 : 0; rank += (o.w > v || (o.w == v && 4 * j4 + 3 < e)) ? 1 : 0; }
            if (rank < 4) tvr[rank] = v;
            LDS_WAIT();
            const f32x4 t = *(const LAS f32x4*)tvr;
            const float e1 = fexp2((t.y - t.x) * LOG2E), e2 = fexp2((t.z - t.x) * LOG2E), e3 = fexp2((t.w - t.x) * LOG2E); const float inv = 1.0f / (1.0f + e1 + e2 + e3);
            if (rank < 4) { TOPE[tok * 4 + rank] = e; TOPW[tok * 4 + rank] = fexp2((v - t.x) * LOG2E) * inv; atomicAdd((int*)&hist[e], 1); }
            if (e == 0) RSTD[tok] = rstd;
            LDS_WAIT(); }
        __syncthreads();
        if (F.tid < 32) HIST[rb * 32 + F.tid] = hist[F.tid];
        __syncthreads();
    }
}

__device__ __forceinline__ void slots_phase(const Frame& F, const float* __restrict__ g_moe) {
    const float* X2 = (const float*)(F.ws + WS_X2); const int* TOPE = (const int*)(F.ws + WS_TOPE); const float* TOPW = (const float*)(F.ws + WS_TOPW); const float* RSTD = (const float*)(F.ws + WS_RSTD3);
    const int* HIST = (const int*)(F.ws + WS_HIST); float* SLOTW = (float*)(F.ws + WS_SLOTW); int* TOKSLOT = (int*)(F.ws + WS_TOKSLOT); int* CNT = (int*)(F.ws + WS_CNT); bf16* XS = (bf16*)(F.ws + WS_XS);
    LAS int* ptot = (LAS int*)F.lds;
    LAS int* pbel = ptot + 512;
    LAS int* base = pbel + 512;
    LAS int* asg = base + 32;
    LAS int* aslot = asg + 128;
    for (int rb = F.bid; rb < NT / 32; rb += F.G) {
        { const int e = F.tid & 31, p = F.tid >> 5; int t = 0, bl = 0;
          for (int q = 0; q < 16; ++q) { const int bb = 16 * p + q; const int hv = HIST[bb * 32 + e]; t += hv; if (bb < rb) bl += hv; }
          ptot[p * 32 + e] = t; pbel[p * 32 + e] = bl; }
        if (F.tid < 128) asg[F.tid] = TOPE[rb * 128 + F.tid];
        __syncthreads();
        if (F.tid < 32) { int t = 0, bl = 0; for (int p = 0; p < 16; ++p) { t += ptot[p * 32 + F.tid]; bl += pbel[p * 32 + F.tid]; }
            ptot[F.tid] = t; pbel[F.tid] = bl; }
        __syncthreads();
        if (F.tid < 32) { int st = 0; for (int e = 0; e < F.tid; ++e) st += ptot[e]; base[F.tid] = st + pbel[F.tid];
            if (rb == 0) { CNT[F.tid] = ptot[F.tid]; CNT[32 + F.tid] = st; }
            int run = base[F.tid]; for (int i = 0; i < 128; ++i) if (asg[i] == F.tid) { aslot[i] = run; ++run; } }
        __syncthreads();
        if (F.tid < 128) { const int sl = aslot[F.tid]; TOKSLOT[rb * 128 + F.tid] = sl; SLOTW[sl] = TOPW[rb * 128 + F.tid]; }
        for (int q = 0; q < 4; ++q) { const int ti = 4 * F.wave + q, tok = rb * 32 + ti; const float rstd = RSTD[tok];
            const f32x4* xr = (const f32x4*)(X2 + (size_t)tok * DM) + F.lane; const f32x4* gr = (const f32x4*)g_moe + F.lane; (void)xr;
#if MOE_FP8
            unsigned hw[8];
#if X2_BF16
            const u32x2* xh = (const u32x2*)((const bf16*)X2 + (size_t)tok * DM) + F.lane;
#pragma unroll
            for (int j = 0; j < 8; ++j) { const u32x2 xw = xh[64 * j]; const f32x4 g = gr[64 * j]; hw[j] = pk_fp8x4(bflo(xw.x) * rstd * g.x, bfhi(xw.x) * rstd * g.y, bflo(xw.y) * rstd * g.z, bfhi(xw.y) * rstd * g.w); }
#else
#pragma unroll
            for (int j = 0; j < 8; ++j) { const f32x4 v = xr[64 * j], g = gr[64 * j]; hw[j] = pk_fp8x4(v.x * rstd * g.x, v.y * rstd * g.y, v.z * rstd * g.z, v.w * rstd * g.w); }
#endif
            LAS unsigned* rowb = (LAS unsigned*)(F.lds + 16384 + F.wave * 2048);
#pragma unroll
            for (int j = 0; j < 8; ++j) rowb[64 * j + F.lane] = hw[j];
            LDS_WAIT();
            const u32x4 w0 = *(const LAS u32x4*)(rowb + 4 * F.lane), w1 = *(const LAS u32x4*)(rowb + 256 + 4 * F.lane);
#pragma unroll
            for (int k = 0; k < 4; ++k) { const int sl = aslot[ti * 4 + k]; u32x4* o16 = (u32x4*)((unsigned char*)XS + (size_t)sl * DM) + F.lane;
                o16[0] = w0; o16[64] = w1; }
            LDS_WAIT();
#else
            u32x2 hw[8];
#pragma unroll
            for (int j = 0; j < 8; ++j) { const f32x4 v = xr[64 * j], g = gr[64 * j]; hw[j].x = cvt_pk_bf16(v.x * rstd * g.x, v.y * rstd * g.y); hw[j].y = cvt_pk_bf16(v.z * rstd * g.z, v.w * rstd * g.w); }
#pragma unroll
            for (int k = 0; k < 4; ++k) { const int sl = aslot[ti * 4 + k]; u32x2* o8 = (u32x2*)(XS + (size_t)sl * DM) + F.lane;
#pragma unroll
                for (int j = 0; j < 8; ++j) o8[64 * j] = hw[j]; }
#endif
            }
        __syncthreads();
    }
}

__device__ __forceinline__ void final_phase(const Frame& F, const float* __restrict__ g_fin, float* __restrict__ out) {
    const float* X2 = (const float*)(F.ws + WS_X2); const bf16* Y = (const bf16*)(F.ws + WS_Y); const int* TOKSLOT = (const int*)(F.ws + WS_TOKSLOT);
    const int gw = F.bid * NWAVES + F.wave, NGW = F.G * NWAVES;
    for (int tok = gw; tok < NT; tok += NGW) {
        const f32x4* xr = (const f32x4*)(X2 + (size_t)tok * DM) + F.lane;
        f32x4 v[8];
#if X2_BF16
        { const u32x2* xh = (const u32x2*)((const bf16*)X2 + (size_t)tok * DM) + F.lane; (void)xr;
#pragma unroll
          for (int j = 0; j < 8; ++j) { const u32x2 xw = xh[64 * j]; v[j] = (f32x4){bflo(xw.x), bfhi(xw.x), bflo(xw.y), bfhi(xw.y)}; } }
#else
#pragma unroll
        for (int j = 0; j < 8; ++j) v[j] = xr[64 * j];
#endif
#pragma unroll
#if Y_FP8
        for (int k = 0; k < 4; ++k) { const int sl = TOKSLOT[tok * 4 + k]; const unsigned* yr = (const unsigned*)((const unsigned char*)Y + (size_t)sl * DM) + F.lane;
#pragma unroll
            for (int j = 0; j < 8; ++j) { const int yw = (int)yr[64 * j]; const f32x2 lo = __builtin_amdgcn_cvt_pk_f32_fp8(yw, false), hi = __builtin_amdgcn_cvt_pk_f32_fp8(yw, true);
                v[j].x += lo.x * 0.0625f; v[j].y += lo.y * 0.0625f; v[j].z += hi.x * 0.0625f; v[j].w += hi.y * 0.0625f; } }
#else
        for (int k = 0; k < 4; ++k) { const int sl = TOKSLOT[tok * 4 + k]; const u32x2* yr = (const u32x2*)(Y + (size_t)sl * DM) + F.lane;
#pragma unroll
            for (int j = 0; j < 8; ++j) { const u32x2 yw = yr[64 * j]; v[j].x += bflo(yw.x); v[j].y += bfhi(yw.x); v[j].z += bflo(yw.y); v[j].w += bfhi(yw.y); } }
#endif
        float s = 0.f;
#pragma unroll
        for (int j = 0; j < 8; ++j) s += (v[j].x * v[j].x + v[j].y * v[j].y) + (v[j].z * v[j].z + v[j].w * v[j].w);
        const float rstd = 1.0f / sqrtf(wave_sum(s) * (1.f / DM) + EPS);
        f32x4* orow = (f32x4*)(out + (size_t)tok * DM) + F.lane; const f32x4* gr = (const f32x4*)g_fin + F.lane;
#pragma unroll
        for (int j = 0; j < 8; ++j) orow[64 * j] = v[j] * rstd * gr[64 * j];
    }
}

constexpr int N_PHASES = 14;
__global__ void __launch_bounds__(NTHR, 2) fwd_kernel(Args args) {
    extern __shared__ __attribute__((aligned(16))) unsigned char lds[];
    Frame F;
    F.lds = (LAS unsigned char*)lds;
    F.tid = threadIdx.x; F.lane = F.tid & 63; F.wave = __builtin_amdgcn_readfirstlane(F.tid >> 6);
    F.G = gridDim.x; F.bid = blockIdx.x; F.ws = args.ws;
    for (int u = F.tid; u < (LDS_BYTES - LDSCTL_OFF) / 4; u += NTHR) ((LAS unsigned*)(F.lds + LDSCTL_OFF))[u] = 0u;
    __syncthreads();
    unsigned* ctl = (unsigned*)(args.ws + WS_CTL);
    XcdBarrier bar; bar.bar = ctl + CW_BAR; bar.x = 0; bar.st = nullptr;
    const bool fused = (args.ph_hi - args.ph_lo) > 1;
    if (fused) bar = xcd_barrier_post(ctl + CW_BAR, (volatile LAS unsigned*)(F.lds + MISC_OFF));
    const int lo = args.ph_lo, hi = args.ph_hi;
    const bool conv_on = fused && CONV_WGS > 0 && F.G == 256;
    const bool conv_wg = conv_on && F.bid >= NCOMP;
    Frame FC = F; if (conv_on) FC.G = NCOMP;
#define IN(k) (lo <= (k) && (k) < hi)
#define REP(k) _Pragma("unroll") for (int _r = 0; _r < 1 + ((DUP_MASK >> (k)) & 1); ++_r)
#define SEAM(k) do { if (IN(k) && IN((k) + 1)) xcd_barrier(bar); } while (0)

    if (IN(0)) REP(0) { p0_prologue(F, args);
        if (!conv_on) { LAS unsigned* scr = (LAS unsigned*)(F.lds + F.wave * 16384);
            for (int it = F.bid * NWAVES + F.wave; it < MOE_ITEMS; it += F.G * NWAVES) if (!CONV_WGS || !((it >= (32 - E_P0) * 1024 && it < 32768) || it >= 32768 + (32 - D_P0) * 512)) moe_item_fp8<false>(F, args, it, scr); }
    } SEAM(0);

    if (IN(1)) REP(1) {
        if (conv_wg) {
            { KvOrder S{(const char*)(F.ws + WS_MEMN), (const char*)(F.ws + WS_WCKV), F.bid - NCOMP}; EpiKV E{F.ws}; pg8::gemm_phase<4096, 32, false>(F.lds, S, E); }
            LAS unsigned* scr = (LAS unsigned*)(F.lds + F.wave * 16384); const int w2 = (F.bid - NCOMP) * NWAVES + F.wave;
            moe_items_stream<false, true>(F, args, w2, CONV_WGS * NWAVES, CONV_NA / (CONV_WGS * NWAVES), scr); }
        else {
        pg8::DenseOrder S; S.init(F.ws + WS_H1, F.ws + WS_WIN, NT, NPROJ, FC.G, F.bid);
        EpiInProj E{F.ws};
        pg8::gemm_phase<4096, 32, false>(F.lds, S, E);
        gla_low_job(FC);
        }
    } SEAM(1);

    if (IN(2)) REP(2) {
        {
        const bool kv_here = !(conv_on && CONV_WGS == 64);
        if (kv_here && F.bid < 64) { KvOrder S{(const char*)(F.ws + WS_MEMN), (const char*)(F.ws + WS_WCKV), F.bid}; EpiKV E{F.ws}; pg8::gemm_phase<4096, 32, false>(F.lds, S, E); }
        REP(14) { if (kv_here && F.G > 64) { if (F.bid >= 64) for (int u = F.bid - 64; u < 512; u += F.G - 64) gla_g1_unit(F, args.in[4], args.in[5], u); }
        else { for (int u = F.bid; u < 512; u += F.G) gla_g1_unit(F, args.in[4], args.in[5], u); } }
        REP(15) { for (int wu = F.bid * NWAVES + F.wave; wu < 2048; wu += F.G * NWAVES) sb_attn_wave(F, args.in[6], wu); }
        }
    } SEAM(2);

    if (IN(3)) REP(3) { gla_scan(F); } SEAM(3);

    if (IN(4)) REP(4) { for (int u = F.bid; u < 512; u += 2 * F.G) gla_g3_pair(F, args.in[7], u, (u + F.G < 512) ? u + F.G : -1); } SEAM(4);

    if (IN(5)) REP(5) {
        if (F.G == 256) {
            MixOrder S; S.D.init(F.ws + WS_MIXO, F.ws + WS_WOUT, NT, DM, F.G, F.bid); S.X = XpreOrder{(const char*)(F.ws + WS_KVK), (const char*)(F.ws + WS_WCQ), (const char*)(F.ws + WS_WCO), (const char*)(F.ws + WS_KVVT), F.bid}; S.c = F.bid;
            EpiMix E{EpiRes1{args.in[0], (float*)(F.ws + WS_X1), (bf16*)(F.ws + WS_X1B), (float*)(F.ws + WS_SSQ)}, EpiXpre{(bf16*)(F.ws + WS_MT), (bf16*)(F.ws + WS_VWT)}};
            pg8::gemm_phase<4096, 0, false>(F.lds, S, E);
        } else {
            { pg8::DenseOrder S; S.init(F.ws + WS_MIXO, F.ws + WS_WOUT, NT, DM, F.G, F.bid); EpiRes1 E{args.in[0], (float*)(F.ws + WS_X1), (bf16*)(F.ws + WS_X1B), (float*)(F.ws + WS_SSQ)}; pg8::gemm_phase<4096, 32, false>(F.lds, S, E); }
            for (int c = F.bid; c < 256; c += F.G) { XpreOrder S{(const char*)(F.ws + WS_KVK), (const char*)(F.ws + WS_WCQ), (const char*)(F.ws + WS_WCO), (const char*)(F.ws + WS_KVVT), c}; EpiXpre E{(bf16*)(F.ws + WS_MT), (bf16*)(F.ws + WS_VWT)}; pg8::gemm_phase<4096, 8, false>(F.lds, S, E); }
        }
    } SEAM(5);

    if (IN(7)) REP(7) {
        if (F.bid < 128) { const int bh = F.bid >> 3, qt = F.bid & 7; xattn_row_scales(F.lds, (const float*)(F.ws + WS_SSQ), (bh >> 2) * SEQ + 256 * qt); }
        { XsOrder S{(const char*)(F.ws + WS_X1B), (const char*)(F.ws + WS_MT), F.bid}; EpiSoftmax E{F.lds, (bf16*)(F.ws + WS_P)};
          pg8::gemm_phase<4096, 32, false>(F.lds, S, E); }
        if (conv_on && F.bid >= 128) {
            LAS unsigned* scr = (LAS unsigned*)(F.lds + F.wave * 16384); const int w2 = (F.bid - 128) * NWAVES + F.wave;
            moe_items_stream<false, true>(F, args, CONV_NA + w2, 1024, CONV_NB / 1024, scr); }
    } SEAM(7);

    if (IN(8)) REP(8) {
        XoutOrder S{(const char*)(F.ws + WS_P), (const char*)(F.ws + WS_VWT), F.bid};
        EpiRes2 E{(const float*)(F.ws + WS_X1), (const bf16*)(F.ws + WS_X1B), (float*)(F.ws + WS_X2)};
        pg8::gemm_phase<2048, 16, false>(F.lds, S, E);
    } SEAM(8);

    if (IN(9)) REP(9) { router_phase(F, args.in[16]); } SEAM(9);

    if (IN(10)) REP(10) { slots_phase(F, args.in[14]); } SEAM(10);

    if (IN(11)) REP(11) {
        moe_table(F, 16);
        constexpr int PB = MOE_FP8 ? 2048 : 4096;
        if (conv_wg) { for (int seq = E_PRE; seq < 32 - E_P0; ++seq) conv_step(F, args, seq); for (int seq = 32; seq < 32 + DN_IN_P11; ++seq) conv_step(F, args, seq); }
        else {
        int ready = conv_on ? E_PRE - 1 : 31;
        MoeOrder S{(const LAS int*)(F.lds + TAB_OFF), (const char*)(F.ws + WS_XS), (const char*)(F.ws + WS_WGU), 16, FC.G, F.bid, (size_t)2 * DFF * PB, 128, PB, conv_on ? (const unsigned*)(F.ws + WS_CTL) + CW_EXP : nullptr, &ready, 32 - E_P0};
        EpiAct E{args.in[18], (bf16*)(F.ws + WS_ACT)};
        pg8::gemm_phase<PB, MOE_FP8 ? 16 : 32, MOE_FP8 != 0>(F.lds, S, E);
        }
    } SEAM(11);

    if (IN(12)) REP(12) {
        moe_table(F, 8);
        constexpr int PB = MOE_FP8 ? 2048 : 4096;
        if (conv_wg) { for (int seq = 32 + DN_IN_P11; seq < 64 - D_P0; ++seq) conv_step(F, args, seq); }
        else {
        int ready = conv_on ? DN_IN_P11 - 1 : 31;
        MoeOrder S{(const LAS int*)(F.lds + TAB_OFF), (const char*)(F.ws + WS_ACT), (const char*)(F.ws + WS_WD), 8, FC.G, F.bid, (size_t)DM * PB, 256, PB, conv_on ? (const unsigned*)(F.ws + WS_CTL) + CW_EXP + 64 * 32 : nullptr, &ready, 32 - D_P0};
        EpiY E{args.in[20], (const float*)(F.ws + WS_SLOTW), (bf16*)(F.ws + WS_Y)};
        pg8::gemm_phase<PB, MOE_FP8 ? 16 : 32, MOE_FP8 != 0>(F.lds, S, E);
        }
    } SEAM(12);

#ifdef EXTRA_BARS
    if (fused) { for (int i = 0; i < EXTRA_BARS; ++i) xcd_barrier(bar); }
#endif
    if (IN(13)) REP(13) { final_phase(F, args.in[21], args.out); }
#undef IN
#undef SEAM
}

extern "C" void kernel_launch(void* const* d_in, const int* in_sizes, int n_in, void* d_out, int out_size, void* d_ws, size_t ws_size, hipStream_t stream) {
    static int grid = 0;
    if (grid == 0) {
        if (n_in != 22 || out_size != NT * DM || ws_size < WS_END) { fprintf(stderr, "kernel_launch: unexpected problem (n_in %d out %d ws %zu need %zu)\n", n_in, out_size, ws_size, (size_t)WS_END); grid = -1; return; }
        int dev = 0, cus = 0, per_cu = 0;
        if (hipGetDevice(&dev) != hipSuccess || hipDeviceGetAttribute(&cus, hipDeviceAttributeMultiprocessorCount, dev) != hipSuccess) { grid = -1; return; }
        if (hipFuncSetAttribute((const void*)fwd_kernel, hipFuncAttributeMaxDynamicSharedMemorySize, LDS_BYTES) != hipSuccess) { fprintf(stderr, "kernel_launch: hipFuncSetAttribute failed\n"); grid = -1; return; }
        if (hipOccupancyMaxActiveBlocksPerMultiprocessor(&per_cu, (const void*)fwd_kernel, NTHR, LDS_BYTES) != hipSuccess || per_cu < 1) fprintf(stderr, "kernel_launch: occupancy query reports %d\n", per_cu);
        (void)hipGetLastError();
        grid = cus;
    }
    if (grid < 0) return;
    (void)hipMemsetAsync((char*)d_ws + WS_CTL, 0, CTL_ZERO_BYTES, stream);
    Args a{};
    for (int i = 0; i < 22; ++i) a.in[i] = (const float*)d_in[i];
    a.out = (float*)d_out; a.ws = (unsigned char*)d_ws;
#if MK_N_LAUNCHES == 1
    a.ph_lo = 0; a.ph_hi = N_PHASES;
    hipLaunchKernelGGL(fwd_kernel, dim3(grid), dim3(NTHR), LDS_BYTES, stream, a);
#else
    for (int p = 0; p < N_PHASES; ++p) { a.ph_lo = p; a.ph_hi = p + 1; hipLaunchKernelGGL(fwd_kernel, dim3(grid), dim3(NTHR), LDS_BYTES, stream, a); }
#endif
}
```

```cpp
#include <hip/hip_runtime.h>
#include <cstdio>
#include <cstdint>

#ifndef MK_N_LAUNCHES
#define MK_N_LAUNCHES 1
#endif
#ifndef MOE_FP8
#define MOE_FP8 1
#endif
#ifndef CONV_LD_AUX
#define CONV_LD_AUX 2
#endif
#ifndef Y_FP8
#define Y_FP8 1
#endif
#ifndef MX_UNSCALED
#define MX_UNSCALED 1
#endif
#ifndef WCVT_SCALE
#define WCVT_SCALE 0.015625f
#endif
#ifndef DUP_MASK
#define DUP_MASK 0
#endif

#define GAS __attribute__((address_space(1)))
#define LAS __attribute__((address_space(3)))
typedef unsigned short bf16;
typedef short bf16x8 __attribute__((ext_vector_type(8)));
typedef float f32x2 __attribute__((ext_vector_type(2)));
typedef float f32x4 __attribute__((ext_vector_type(4)));
typedef float f32x16 __attribute__((ext_vector_type(16)));
typedef unsigned u32x2 __attribute__((ext_vector_type(2)));
typedef unsigned u32x4 __attribute__((ext_vector_type(4)));
typedef GAS unsigned gu32;

#define LDS_WAIT() asm volatile("s_waitcnt lgkmcnt(0)" ::: "memory")
#define VM_WAIT() asm volatile("s_waitcnt vmcnt(0)" ::: "memory")

constexpr int DM = 2048, NB = 4, SEQ = 2048, NT = NB * SEQ;
constexpr int INC = 6160, NPROJ = 6144;
constexpr int MEMLEN = 256, NMEM = NB * MEMLEN;
constexpr int NEXP = 32, TOPK = 4, NASSIGN = NT * TOPK, DFF = 2048;
constexpr float EPS = 1e-6f;
constexpr float LOG2E = 1.4426950408889634f, LN2 = 0.6931471805599453f;
constexpr int KD = 2048;

typedef __bf16 bf16x2_t __attribute__((ext_vector_type(2)));
__device__ __forceinline__ unsigned cvt_pk_bf16(float lo, float hi) { const f32x2 v = {lo, hi}; const bf16x2_t b = __builtin_convertvector(v, bf16x2_t); return __builtin_bit_cast(unsigned, b); }
__device__ __forceinline__ bf16 f2bf(float f) { return (bf16)(cvt_pk_bf16(f, 0.f) & 0xffffu); }
__device__ __forceinline__ float bf2f(unsigned b) { return __uint_as_float(b << 16); }
__device__ __forceinline__ float bflo(unsigned w) { return __uint_as_float(w << 16); }
__device__ __forceinline__ float bfhi(unsigned w) { return __uint_as_float(w & 0xffff0000u); }
__device__ __forceinline__ void st_bf16x4(bf16* p, f32x4 v) { u32x2 w; w.x = cvt_pk_bf16(v.x, v.y); w.y = cvt_pk_bf16(v.z, v.w); *(u32x2*)p = w; }
__device__ __forceinline__ float wave_sum(float v) {
#pragma unroll
    for (int o = 1; o < 64; o <<= 1) v += __shfl_xor(v, o);
    return v;
}
__device__ __forceinline__ float fexp2(float x) { return __builtin_amdgcn_exp2f(x); }
__device__ __forceinline__ float flog2(float x) { return __builtin_amdgcn_logf(x); }
__device__ __forceinline__ float frcp(float x) { return __builtin_amdgcn_rcpf(x); }
__device__ __forceinline__ float log2_sigmoid2(float z2) { return -(fmaxf(-z2, 0.f) + flog2(1.f + fexp2(-fabsf(z2)))); }

#ifndef ACC_C0
#define ACC_C0 1
#endif
namespace pg8 {
constexpr int GTAB_OFF = 131072 + 2048;
constexpr int BM = 256, BK = 64, HALF = 128, HTB = HALF * BK * 2, STAGE_BYTES = 8 * HTB, NXCD = 8, WGM = 8;
__host__ __device__ __forceinline__ int lds_byte(int r, int c) { const int st = (r >> 4) * 2 + (c >> 5), rr = r & 15, cc = c & 31, ob = rr * 64 + cc * 2; return st * 1024 + (ob ^ (((ob >> 9) & 1) << 5)); }
__host__ __device__ __forceinline__ void stage_rc(int b, int& R, int& C) { const int st = b / 1024, sb = b % 1024, swz = sb ^ (((sb >> 9) & 1) << 5); R = (st >> 1) * 16 + swz / 64; C = (st & 1) * 32 + (swz % 64) / 2; }

typedef int v8i __attribute__((ext_vector_type(8)));
typedef int v4i __attribute__((ext_vector_type(4)));
__device__ __forceinline__ v8i cat8(bf16x8 lo, bf16x8 hi) { const v4i a = __builtin_bit_cast(v4i, lo), b = __builtin_bit_cast(v4i, hi); return (v8i){a.x, a.y, a.z, a.w, b.x, b.y, b.z, b.w}; }
__host__ __device__ __forceinline__ int perm32(int rho) { const int n = rho >> 4, i = rho & 15; return 8 * (i >> 2) + 4 * n + (i & 3); }
struct Unit { const char* a; const char* b; int r0, c0, rows, e, nt; };

struct DenseOrder {
    const char* A; const char* Bt; int nM, nN, nwg, G, c;
    __device__ void init(const void* A_, const void* Bt_, int M, int N, int G_, int c_) { A = (const char*)A_; Bt = (const char*)Bt_; nM = M / BM; nN = N / BM; nwg = nM * nN; G = G_; c = c_; }
    __device__ bool next(int i, Unit& u) const {
        const long L = (long)i * G + c; if (L >= nwg) return false;
        int wgid = (int)L; { const int q = nwg / NXCD, r = nwg % NXCD, xcd = wgid % NXCD, off = wgid / NXCD; wgid = (xcd < r ? xcd * (q + 1) : r * (q + 1) + (xcd - r) * q) + off; }
        const int nig = WGM * nN, gid = wgid / nig, fm = gid * WGM, gsz = (nM - fm) < WGM ? (nM - fm) : WGM;
        const int pm = fm + ((wgid % nig) % gsz), pn = (wgid % nig) / gsz;
        u.a = A + (size_t)pm * BM * KD * 2; u.b = Bt + (size_t)pn * BM * KD * 2; u.r0 = pm * BM; u.c0 = pn * BM; u.rows = BM; u.e = 0; return true;
    }
    __device__ __forceinline__ void a_ready(const Unit&) const {}
};

template <int PITCHB, int NTILES, bool FP8, bool GATHER, class Epi, class Sched>
__device__ __forceinline__ void gemm_phase_g(LAS unsigned char* lds, const Sched& S, const Epi& E) {
    const int tid = threadIdx.x, wid = __builtin_amdgcn_readfirstlane(tid >> 6), lane = tid & 63, wr = wid >> 2, wc = wid & 3, fr = lane & 15, fq = lane >> 4;
    unsigned voffA[2], voffB[2];
    unsigned goff[2][2]; int gR[2];
#pragma unroll
    for (int i = 0; i < 2; ++i) { int R, C; stage_rc(tid * 16 + i * 8192, R, C); const int Rb = Epi::PERM ? ((R & ~31) + perm32(R & 31)) : R;
        voffA[i] = (unsigned)(R * PITCHB + C * 2); voffB[i] = (unsigned)(Rb * PITCHB + C * 2); gR[i] = R; goff[0][i] = goff[1][i] = 0u; }
    auto gt_issue = [&](int slot0, int buf) { if constexpr (GATHER) { if (wid < 4) __builtin_amdgcn_global_load_lds((const unsigned*)(S.gtab + slot0 + 64 * wid + lane), (LAS unsigned*)(lds + GTAB_OFF + 1024 * buf + 256 * wid), 4, 0, 0); } };
    auto gt_read = [&](int buf) { const LAS int* tb = (const LAS int*)(lds + GTAB_OFF + 1024 * buf); (void)gR;
        _Pragma("unroll") for (int h = 0; h < 2; ++h) _Pragma("unroll") for (int i = 0; i < 2; ++i) goff[h][i] = (unsigned)tb[128 * h + gR[i]] * (unsigned)PITCHB + (voffA[i] - (unsigned)(gR[i] * PITCHB)); };
    const size_t kstep = (size_t)(BK * 2);
    const size_t hstep = (size_t)HALF * PITCHB;
    const unsigned ldsw = (unsigned)wid * 1024u;
    const int aoff = lds_byte(wr * 64 + fr, fq * 8), boff = lds_byte(wc * 32 + fr, fq * 8);
#define PG8_SA(b, h) (((b) * 2 + (h)) * HTB)
#define PG8_SB(b, h) ((4 + (b) * 2 + (h)) * HTB)
#define PG8_STAGE_X(bufoff, gbase, voff) do { _Pragma("unroll") for (int _i = 0; _i < 2; ++_i) \
        __builtin_amdgcn_global_load_lds((const unsigned*)((const char*)(gbase) + (voff)[_i]), (LAS unsigned*)(lds + (bufoff) + ldsw + _i * 8192), 16, 0, 0); } while (0)
#define PG8_STAGE_A(bufoff, gbase) PG8_STAGE_X(bufoff, gbase, voffA)
#define PG8_STAGE_AH(bufoff, gbase, h) do { if constexpr (GATHER) PG8_STAGE_X(bufoff, gbase, goff[h]); else PG8_STAGE_X(bufoff, (gbase) + (h) * hstep, voffA); } while (0)
#define PG8_STAGE_B(bufoff, gbase) PG8_STAGE_X(bufoff, gbase, voffB)
#define PG8_LDA(dst, b, h) do { _Pragma("unroll") for (int m = 0; m < 4; ++m) { if constexpr (FP8) { const v4i _lo = *(const LAS v4i*)(lds + PG8_SA(b, h) + aoff + m * 2048), _hi = *(const LAS v4i*)(lds + PG8_SA(b, h) + aoff + m * 2048 + 1024); \
            dst##8[m] = (v8i){_lo.x, _lo.y, _lo.z, _lo.w, _hi.x, _hi.y, _hi.z, _hi.w}; } \
        else { _Pragma("unroll") for (int k = 0; k < 2; ++k) dst[m][k] = *(const LAS bf16x8*)(lds + PG8_SA(b, h) + aoff + m * 2048 + k * 1024); } } } while (0)
#define PG8_LDB(dst, b, h) do { _Pragma("unroll") for (int n = 0; n < 2; ++n) { if constexpr (FP8) { const v4i _lo = *(const LAS v4i*)(lds + PG8_SB(b, h) + boff + n * 2048), _hi = *(const LAS v4i*)(lds + PG8_SB(b, h) + boff + n * 2048 + 1024); \
            dst##8[n] = (v8i){_lo.x, _lo.y, _lo.z, _lo.w, _hi.x, _hi.y, _hi.z, _hi.w}; } \
        else { _Pragma("unroll") for (int k = 0; k < 2; ++k) dst[n][k] = *(const LAS bf16x8*)(lds + PG8_SB(b, h) + boff + n * 2048 + k * 1024); } } } while (0)
#define PG8_MMA(ai, bj, At, Bt) do { __builtin_amdgcn_s_setprio(1); _Pragma("unroll") for (int m = 0; m < 4; ++m) _Pragma("unroll") for (int n = 0; n < 2; ++n) { \
        if constexpr (FP8) { if constexpr (MX_UNSCALED != 0) asm volatile("v_mfma_f32_16x16x128_f8f6f4 %0, %1, %2, %0" : "+v"(acc[ai][bj][m][n]) : "v"(Bt##8[n]), "v"(At##8[m])); \
            else asm volatile("v_mfma_scale_f32_16x16x128_f8f6f4 %0, %1, %2, %0, %3, %4 op_sel_hi:[0,0,0]" : "+v"(acc[ai][bj][m][n]) : "v"(Bt##8[n]), "v"(At##8[m]), "v"(sclW), "v"(sclA)); } \
        else { _Pragma("unroll") for (int k = 0; k < 2; ++k) acc[ai][bj][m][n] = __builtin_amdgcn_mfma_f32_16x16x32_bf16(Bt[n][k], At[m][k], acc[ai][bj][m][n], 0, 0, 0); } } \
        __builtin_amdgcn_s_setprio(0); } while (0)
#define PG8_MMAZ(ai, bj, At, Bt) do { __builtin_amdgcn_s_setprio(1); _Pragma("unroll") for (int m = 0; m < 4; ++m) _Pragma("unroll") for (int n = 0; n < 2; ++n) { \
        if constexpr (FP8) { if constexpr (MX_UNSCALED != 0) asm volatile("v_mfma_f32_16x16x128_f8f6f4 %0, %1, %2, 0" : "=&v"(acc[ai][bj][m][n]) : "v"(Bt##8[n]), "v"(At##8[m])); \
            else asm volatile("v_mfma_scale_f32_16x16x128_f8f6f4 %0, %1, %2, 0, %3, %4 op_sel_hi:[0,0,0]" : "=&v"(acc[ai][bj][m][n]) : "v"(Bt##8[n]), "v"(At##8[m]), "v"(sclW), "v"(sclA)); } \
        else { acc[ai][bj][m][n] = __builtin_amdgcn_mfma_f32_16x16x32_bf16(Bt[n][0], At[m][0], (f32x4){0.f, 0.f, 0.f, 0.f}, 0, 0, 0); acc[ai][bj][m][n] = __builtin_amdgcn_mfma_f32_16x16x32_bf16(Bt[n][1], At[m][1], acc[ai][bj][m][n], 0, 0, 0); } } \
        __builtin_amdgcn_s_setprio(0); } while (0)
#define PG8_WAIT_V(n) asm volatile("s_waitcnt vmcnt(" #n ")" ::: "memory")
#define PG8_WAIT_L(n) asm volatile("s_waitcnt lgkmcnt(" #n ")" ::: "memory")
#define PG8_BAR __builtin_amdgcn_s_barrier()
#define PG8_SCHED __builtin_amdgcn_sched_barrier(0)
    Unit cur, nxt; int ui = 0;
    if (!S.next(0, cur)) return;
    f32x4 acc[2][2][4][2];
#pragma unroll
    for (int a = 0; a < 2; ++a)
#pragma unroll
        for (int b = 0; b < 2; ++b)
#pragma unroll
            for (int m = 0; m < 4; ++m)
#pragma unroll
                for (int n = 0; n < 2; ++n) { if (!ACC_C0) acc[a][b][m][n] = (f32x4){0.f, 0.f, 0.f, 0.f}; }
    const int sclW = 0x79797979, sclA = 0x7f7f7f7f;
    bf16x8 At[4][2], B0[2][2], B1[2][2]; v8i At8[4], B08[2], B18[2];
    const char* cA = cur.a; const char* cB = cur.b;
    S.a_ready(cur);
    if constexpr (GATHER) { gt_issue(cur.r0, 0); PG8_WAIT_V(0); PG8_BAR; gt_read(0); PG8_WAIT_L(0); }
    PG8_STAGE_B(PG8_SB(0, 0), cB); PG8_STAGE_B(PG8_SB(0, 1), cB + hstep); PG8_STAGE_AH(PG8_SA(0, 0), cA, 0); PG8_STAGE_AH(PG8_SA(0, 1), cA, 1);
    if (wr == 1) PG8_BAR;
    PG8_WAIT_V(2); PG8_BAR;
    PG8_STAGE_B(PG8_SB(1, 0), cB + kstep); PG8_STAGE_AH(PG8_SA(1, 0), cA + kstep, 0); PG8_STAGE_B(PG8_SB(1, 1), cB + hstep + kstep);
    PG8_WAIT_V(6); PG8_BAR;
    for (;;) {
        const bool has_next = S.next(ui + 1, nxt);
        const char* nA = has_next ? nxt.a : cA; const char* nB = has_next ? nxt.b : cB;
        const int nt = NTILES > 0 ? NTILES : cur.nt;
        if constexpr (GATHER) { if (has_next) gt_issue(nxt.r0, (ui + 1) & 1); }
#pragma nounroll
        for (int t = 0; t < nt; t += 2) {
            const bool last = (t == nt - 2);
            const char* a1 = cA + (size_t)(t + 1) * kstep;
            const char* a2 = last ? nA : cA + (size_t)(t + 2) * kstep; const char* b2 = last ? nB : cB + (size_t)(t + 2) * kstep;
            const char* a3 = a2 + kstep; const char* b3 = b2 + kstep;
            if (last && has_next) S.a_ready(nxt);
            PG8_LDB(B0, 0, 0); PG8_LDB(B1, 0, 1); PG8_SCHED; PG8_LDA(At, 0, 0); PG8_STAGE_AH(PG8_SA(1, 1), a1, 1);
            if constexpr (GATHER) { if (last && has_next) gt_read((ui + 1) & 1); }
            PG8_WAIT_V(8); PG8_WAIT_L(0); PG8_BAR; if (t == 0) { PG8_MMAZ(0, 0, At, B0); PG8_MMAZ(0, 1, At, B1); } else { PG8_MMA(0, 0, At, B0); PG8_MMA(0, 1, At, B1); } PG8_BAR; PG8_SCHED;
            PG8_LDA(At, 0, 1); PG8_STAGE_B(PG8_SB(0, 0), b2); PG8_STAGE_B(PG8_SB(0, 1), b2 + hstep); PG8_STAGE_AH(PG8_SA(0, 0), a2, 0);
            PG8_WAIT_V(8); PG8_WAIT_L(0); PG8_BAR; if (t == 0) { PG8_MMAZ(1, 0, At, B0); PG8_MMAZ(1, 1, At, B1); } else { PG8_MMA(1, 0, At, B0); PG8_MMA(1, 1, At, B1); } PG8_BAR; PG8_SCHED;
            PG8_LDB(B0, 1, 0); PG8_LDB(B1, 1, 1); PG8_SCHED; PG8_LDA(At, 1, 0); PG8_STAGE_AH(PG8_SA(0, 1), a2, 1);
            PG8_WAIT_V(8); PG8_WAIT_L(0); PG8_BAR; PG8_MMA(0, 0, At, B0); PG8_MMA(0, 1, At, B1); PG8_BAR; PG8_SCHED;
            PG8_LDA(At, 1, 1); PG8_STAGE_B(PG8_SB(1, 0), b3); PG8_STAGE_B(PG8_SB(1, 1), b3 + hstep); PG8_STAGE_AH(PG8_SA(1, 0), a3, 0);
            PG8_WAIT_V(8); PG8_WAIT_L(0); PG8_BAR; PG8_MMA(1, 0, At, B0); PG8_MMA(1, 1, At, B1); PG8_BAR; PG8_SCHED;
        }
        if constexpr (FP8) {
            asm volatile("s_nop 15\n\ts_nop 15" : "+v"(acc[0][0][0][0]), "+v"(acc[0][0][0][1]), "+v"(acc[0][0][1][0]), "+v"(acc[0][0][1][1]), "+v"(acc[0][0][2][0]), "+v"(acc[0][0][2][1]), "+v"(acc[0][0][3][0]), "+v"(acc[0][0][3][1]) :: "memory");
            asm volatile("" : "+v"(acc[0][1][0][0]), "+v"(acc[0][1][0][1]), "+v"(acc[0][1][1][0]), "+v"(acc[0][1][1][1]), "+v"(acc[0][1][2][0]), "+v"(acc[0][1][2][1]), "+v"(acc[0][1][3][0]), "+v"(acc[0][1][3][1]));
            asm volatile("" : "+v"(acc[1][0][0][0]), "+v"(acc[1][0][0][1]), "+v"(acc[1][0][1][0]), "+v"(acc[1][0][1][1]), "+v"(acc[1][0][2][0]), "+v"(acc[1][0][2][1]), "+v"(acc[1][0][3][0]), "+v"(acc[1][0][3][1]));
            asm volatile("" : "+v"(acc[1][1][0][0]), "+v"(acc[1][1][0][1]), "+v"(acc[1][1][1][0]), "+v"(acc[1][1][1][1]), "+v"(acc[1][1][2][0]), "+v"(acc[1][1][2][1]), "+v"(acc[1][1][3][0]), "+v"(acc[1][1][3][1]));
        }
        if (wr == 0) PG8_BAR;
        E(acc, cur, wr, wc, fr, fq);
        if (!has_next) break;
#pragma unroll
        for (int a = 0; a < 2; ++a)
#pragma unroll
            for (int b = 0; b < 2; ++b)
#pragma unroll
                for (int m = 0; m < 4; ++m)
#pragma unroll
                    for (int n = 0; n < 2; ++n) { if (!ACC_C0) acc[a][b][m][n] = (f32x4){0.f, 0.f, 0.f, 0.f}; }
        cur = nxt; cA = nA; cB = nB; ++ui;
        if (wr == 1) PG8_BAR;
    }
    PG8_WAIT_V(0);
    PG8_BAR;
#undef PG8_SA
#undef PG8_SB
#undef PG8_STAGE_X
#undef PG8_STAGE_A
#undef PG8_STAGE_AH
#undef PG8_STAGE_B
#undef PG8_LDA
#undef PG8_LDB
#undef PG8_MMA
#undef PG8_MMAZ
#undef PG8_WAIT_V
#undef PG8_WAIT_L
#undef PG8_BAR
#undef PG8_SCHED
}
template <int PITCHB, int NTILES, bool FP8, class Epi, class Sched> __device__ __forceinline__ void gemm_phase(LAS unsigned char* lds, const Sched& S, const Epi& E) { gemm_phase_g<PITCHB, NTILES, FP8, false>(lds, S, E); }
}
using pg8::Unit;

#define XB_TMO      128
#define XB_XCNT(j)  (256  + 64 * (j))
#define XB_XSUB(j)  (1280 + 64 * (j))
#define XB_XGEN(j)  (2304 + 64 * (j))
#define XB_TOP      3328
#define XB_TOPGEN   3392
#define XCD_BAR_WORDS 3456
#define XB_SPIN_CAP (1u << 22)
__device__ __forceinline__ unsigned xb_ld(unsigned* p)              { return __hip_atomic_load(p, __ATOMIC_RELAXED, __HIP_MEMORY_SCOPE_AGENT); }
__device__ __forceinline__ unsigned xb_add(unsigned* p, unsigned v) { return __hip_atomic_fetch_add(p, v, __ATOMIC_RELAXED, __HIP_MEMORY_SCOPE_AGENT); }
__device__ __forceinline__ unsigned xb_xcc_id() { return (unsigned)__builtin_amdgcn_s_getreg((3 << 11) | 20) & 0xFu; }
#define XB_SPIN(cond, bar) do { unsigned _sp = 0; while (cond) { __builtin_amdgcn_s_sleep(1); \
    if ((++_sp & 255u) == 0u) { if (xb_ld(&(bar)[XB_TMO])) break; if (_sp > XB_SPIN_CAP) { atomicAdd(&(bar)[XB_TMO], 1u); break; } } } } while (0)
struct XcdBarrier { unsigned* bar; unsigned x; volatile LAS unsigned* st; };
__device__ __forceinline__ XcdBarrier xcd_barrier_post(unsigned* bar, volatile LAS unsigned* st) {
    XcdBarrier b; b.bar = bar; b.x = xb_xcc_id(); b.st = st;
    if (threadIdx.x == 0) (void)xb_add(&bar[XB_XCNT(b.x)], 1u);
    return b;
}
__device__ __forceinline__ void xcd_barrier_complete(unsigned* bar, unsigned x, unsigned& nloc, unsigned& nx) {
    const unsigned G = gridDim.x * gridDim.y * gridDim.z;
    unsigned sum, cnt, mine, sp = 0u;
    for (;;) {
        sum = 0u; cnt = 0u; mine = 0u;
#pragma unroll
        for (unsigned j = 0; j < 16; ++j) { const unsigned c = xb_ld(&bar[XB_XCNT(j)]); sum += c; cnt += (c > 0u) ? 1u : 0u; mine = (j == x) ? c : mine; }
        if (sum == G) break;
        __builtin_amdgcn_s_sleep(1);
        if ((++sp & 255u) == 0u) { if (xb_ld(&bar[XB_TMO])) break; if (sp > XB_SPIN_CAP) { atomicAdd(&bar[XB_TMO], 1u); break; } }
    }
    nloc = mine > 0u ? mine : 1u; nx = cnt > 0u ? cnt : 1u;
}
__device__ __forceinline__ void xcd_barrier(const XcdBarrier& b) {
    asm volatile("s_waitcnt vmcnt(0)" ::: "memory");
    __syncthreads();
    if (threadIdx.x == 0) {
        unsigned* bar = b.bar;
        __builtin_amdgcn_s_waitcnt(0);
        unsigned nloc = b.st[0], nx = b.st[1];
        if (nloc == 0u) { xcd_barrier_complete(bar, b.x, nloc, nx); b.st[0] = nloc; b.st[1] = nx; }
        const unsigned old = xb_add(&bar[XB_XSUB(b.x)], 1u);
        const unsigned gen = old / nloc;
        if (old + 1u == (gen + 1u) * nloc) {
            __builtin_amdgcn_fence(__ATOMIC_RELEASE, "agent");
            asm volatile("s_waitcnt vmcnt(0)" ::: "memory");
            const unsigned og = xb_add(&bar[XB_TOP], 1u);
            const unsigned tg = og / nx;
            if (og + 1u == (tg + 1u) * nx) xb_add(&bar[XB_TOPGEN], 1u);
            else XB_SPIN(xb_ld(&bar[XB_TOPGEN]) == tg, bar);
            __builtin_amdgcn_fence(__ATOMIC_ACQUIRE, "agent");
            xb_add(&bar[XB_XGEN(b.x)], 1u);
            asm volatile("s_waitcnt vmcnt(0)" ::: "memory");
        } else {
            XB_SPIN(xb_ld(&bar[XB_XGEN(b.x)]) == gen, bar);
            __builtin_amdgcn_fence(__ATOMIC_ACQUIRE, "agent");
            asm volatile("s_waitcnt vmcnt(0)" ::: "memory");
        }
    }
    __syncthreads();
}

constexpr size_t MiB = 1u << 20;
constexpr size_t al(size_t x) { return (x + 255) & ~(size_t)255; }
constexpr size_t WS_CTL = 0, CTL_ZERO_BYTES = 1 * MiB;
constexpr size_t WS_WIN = 1 * MiB;
constexpr size_t WS_WLOW = WS_WIN + (size_t)NPROJ * KD * 2;
constexpr size_t WS_WRH = WS_WLOW + 16 * KD * 2;
constexpr size_t WS_WRL = WS_WRH + 32 * KD * 2;
constexpr size_t WS_WOUT = WS_WRL + 32 * KD * 2;
constexpr size_t WS_WCQ = WS_WOUT + (size_t)DM * KD * 2;
constexpr size_t WS_WCKV = WS_WCQ + (size_t)DM * KD * 2;
constexpr size_t WS_WCO = WS_WCKV + (size_t)2 * DM * KD * 2;
constexpr size_t WS_WGU = WS_WCO + (size_t)DM * KD * 2;
constexpr size_t WS_WD = WS_WGU + (size_t)NEXP * 2 * DFF * KD * 2;
constexpr size_t WS_H1 = WS_WD + (size_t)NEXP * DM * KD * 2;
constexpr size_t WS_MEMN = WS_H1 + (size_t)NT * DM * 2;
constexpr size_t WS_SBQ = WS_MEMN + (size_t)NMEM * DM * 2;
constexpr size_t WS_SBK = WS_SBQ + (size_t)NT * 1024 * 2;
constexpr size_t WS_SBVT = WS_SBK + (size_t)NT * 1024 * 2;
constexpr size_t WS_GQ = WS_SBVT + (size_t)NT * 1024 * 2;
constexpr size_t WS_GK = WS_GQ + (size_t)NT * 512 * 2;
constexpr size_t WS_GVT = WS_GK + (size_t)NT * 512 * 2;
constexpr size_t WS_GR = WS_GVT + (size_t)NT * 1024 * 2;
constexpr size_t WS_GLOW = WS_GR + (size_t)NT * 1024 * 2;
constexpr size_t WS_KVK = WS_GLOW + (size_t)NT * 16 * 4;
constexpr size_t WS_KVVT = WS_KVK + (size_t)NMEM * DM * 2;
constexpr size_t WS_QIN = WS_KVVT + (size_t)NMEM * DM * 2;
constexpr size_t WS_OINTRA = WS_QIN + (size_t)NT * 512 * 2;
constexpr size_t WS_KVN = WS_OINTRA + (size_t)512 * 16384 * 4;
constexpr size_t WS_DECAY = WS_KVN + (size_t)512 * 32768 * 4;
constexpr size_t WS_STATE = WS_DECAY + (size_t)512 * 128 * 4;
constexpr size_t WS_MIXO = WS_STATE + (size_t)512 * 32768 * 2;
constexpr size_t WS_X1 = WS_MIXO + (size_t)NT * DM * 2;
constexpr size_t WS_X1B = WS_X1 + (size_t)NT * DM * 4;
constexpr size_t WS_SSQ = WS_X1B + (size_t)NT * DM * 2;
constexpr size_t WS_CQ = WS_SSQ + (size_t)32 * NT * 4;
constexpr size_t WS_ATTO = WS_CQ + (size_t)NT * DM * 2;
constexpr size_t WS_X2 = WS_ATTO + (size_t)NT * DM * 2;
constexpr size_t WS_TOPE = WS_X2 + (size_t)NT * DM * 4;
constexpr size_t WS_TOPW = WS_TOPE + (size_t)NT * 4 * 4;
constexpr size_t WS_RSTD3 = WS_TOPW + (size_t)NT * 4 * 4;
constexpr size_t WS_HIST = WS_RSTD3 + (size_t)NT * 4;
constexpr size_t WS_SLOTW = WS_HIST + (size_t)256 * 32 * 4;
constexpr size_t WS_TOKSLOT = WS_SLOTW + (size_t)(NASSIGN + 256) * 4;
#ifndef XS_GATHER
#define XS_GATHER 1
#endif
constexpr size_t WS_CNT = WS_TOKSLOT + (size_t)NT * 4 * 4;
constexpr size_t WS_SLOTTOK = al(WS_CNT + 256) + ((size_t)32 << 20);
constexpr size_t WS_XS = al(WS_CNT + 256);
constexpr size_t WS_ACT = WS_XS + (size_t)(NASSIGN + 256) * DM * 2;
constexpr size_t WS_Y = WS_ACT + (size_t)(NASSIGN + 256) * DM * 2;
constexpr size_t WS_P = WS_Y + (size_t)(NASSIGN + 256) * DM * 2;
constexpr size_t WS_MT = WS_P + (size_t)16 * SEQ * MEMLEN * 2;
constexpr size_t WS_VWT = WS_MT + (size_t)16 * MEMLEN * DM * 2;
constexpr size_t WS_END = WS_VWT + (size_t)NB * DM * 1024 * 2;

constexpr int CW_BAR = 4096;
static_assert((CW_BAR + XCD_BAR_WORDS) * 4 <= (int)CTL_ZERO_BYTES, "ctl");

constexpr int RING_BYTES = 131072, LDSCTL_OFF = RING_BYTES, MISC_OFF = LDSCTL_OFF + 64, TAB_OFF = LDSCTL_OFF + 256;
static_assert(pg8::GTAB_OFF == LDSCTL_OFF + 2048, "gather tables");
constexpr int RED1_OFF = LDSCTL_OFF + 2048, RED2_OFF = RED1_OFF + 4096;
constexpr int LDS_BYTES = 147456;

constexpr int NWAVES = 8, NTHR = 512;

struct Args { const float* in[22]; float* out; unsigned char* ws; int ph_lo, ph_hi; };

struct Frame {
    LAS unsigned char* lds;
    int tid, lane, wave, G, bid;
    unsigned char* ws;
};

__device__ __forceinline__ void cvt_tile(const float* __restrict__ W, int ldn, int k0, int n0, bf16* __restrict__ dst, int dst_row0, const float* __restrict__ gk, LAS unsigned* scr, int lane) {
    const int q = lane >> 4, c4 = lane & 15;
    f32x4 v[16];
#pragma unroll
    for (int i = 0; i < 16; ++i) { const int k = k0 + 8 * (i >> 1) + 2 * q + (i & 1); v[i] = *(const f32x4*)(W + (size_t)k * ldn + n0 + 4 * c4); if (gk) v[i] = v[i] * gk[k]; }
#pragma unroll
    for (int p = 0; p < 8; ++p)
#pragma unroll
        for (int j = 0; j < 4; ++j) { const int n = 4 * c4 + j, kd = 4 * p + q; scr[n * 32 + (kd ^ ((c4 & 7) << 2))] = cvt_pk_bf16(v[2 * p][j], v[2 * p + 1][j]); }
    LDS_WAIT();
#pragma unroll
    for (int jj = 0; jj < 8; ++jj) { const int n = 8 * jj + (lane >> 3), ch = lane & 7; const u32x4 w = *(const LAS u32x4*)(scr + n * 32 + ((ch ^ ((n >> 2) & 7)) << 2));
        *(u32x4*)(dst + (size_t)(dst_row0 + n) * KD + k0 + 8 * ch) = w; }
    LDS_WAIT();
}
__device__ __forceinline__ unsigned pk_fp8x4(float a, float b, float c, float d) { int r = __builtin_amdgcn_cvt_pk_fp8_f32(a, b, 0, false); r = __builtin_amdgcn_cvt_pk_fp8_f32(c, d, r, true); return (unsigned)r; }
__device__ __forceinline__ void rms_row_bf16(const float* __restrict__ xrow, const float* __restrict__ g, bf16* __restrict__ orow, int lane) {
    const f32x4* xr = (const f32x4*)xrow + lane; const f32x4* gr = (const f32x4*)g + lane;
    f32x4 v[8]; float s = 0.f;
#pragma unroll
    for (int j = 0; j < 8; ++j) { v[j] = xr[64 * j]; s += (v[j].x * v[j].x + v[j].y * v[j].y) + (v[j].z * v[j].z + v[j].w * v[j].w); }
    const float rstd = 1.0f / sqrtf(wave_sum(s) * (1.f / DM) + EPS);
    u32x2* o8 = (u32x2*)orow + lane;
#pragma unroll
    for (int j = 0; j < 8; ++j) { const f32x4 gg = gr[64 * j]; u32x2 w; w.x = cvt_pk_bf16(v[j].x * rstd * gg.x, v[j].y * rstd * gg.y); w.y = cvt_pk_bf16(v[j].z * rstd * gg.z, v[j].w * rstd * gg.w); o8[64 * j] = w; }
}

constexpr int MOE_ITEMS = NEXP * 64 * 16 + NEXP * 32 * 16;
#ifndef CONV_ST_AUX
#define CONV_ST_AUX 16
#endif
#ifndef ROUTE_MAX11
#define ROUTE_MAX11 64
#endif
#ifndef ROUTE_MAX
#define ROUTE_MAX 64
#endif
#ifndef DN_SHIFT
#define DN_SHIFT 4
#endif
#ifndef ROUTE_TEST
#define ROUTE_TEST 0
#endif
#ifndef MOE_XCD
#define MOE_XCD 1
#endif
#ifndef CVT_DUP
#define CVT_DUP 0
#endif
#ifndef X2_BF16
#define X2_BF16 1
#endif
#ifndef X1_F32
#define X1_F32 0
#endif
static_assert(!(X1_F32 && X2_BF16), "the bf16 x2 store lives in the bf16-x1 form of the phase-8 epilogue");
#ifndef CONV_WGS
#define CONV_WGS 64
#endif
#ifndef E_P1
#define E_P1 10
#endif
constexpr int E_P7 = 6, E_PRE = E_P1 + E_P7;
#ifndef DN_IN_P11
#define DN_IN_P11 14
#endif
#ifndef E_P0
#define E_P0 0
#endif
#ifndef D_P0
#define D_P0 0
#endif
constexpr int NCOMP = 256 - CONV_WGS, CONV_NA = E_P1 * 1024, CONV_NB = E_P7 * 1024;
constexpr int CW_EXP = 8192;
static_assert(E_PRE + E_P0 <= 32 && DN_IN_P11 + D_P0 <= 32, "expert conversion ranges");
static_assert(DN_IN_P11 >= DN_SHIFT, "DN_SHIFT");
struct MoeItem { const float* W; int ldn, k0, n0; unsigned char* dst; int drow; };
__device__ __forceinline__ MoeItem moe_item_desc(const Frame& F, const Args& A, int it) {
    constexpr int J5 = NEXP * 64 * 16; MoeItem m;
    if (it < J5) { const int e = it >> 10, r = it & 1023, kt = r >> 6, n0 = (r & 63) * 64;
        m.W = A.in[17] + (size_t)e * DM * 2 * DFF; m.ldn = 2 * DFF; m.k0 = kt * 128; m.n0 = n0; m.dst = F.ws + WS_WGU + (size_t)e * 2 * DFF * KD;
        m.drow = (n0 < DFF) ? ((n0 >> 7) * 256 + (n0 & 127)) : (((n0 - DFF) >> 7) * 256 + 128 + ((n0 - DFF) & 127)); }
    else { const int q2 = it - J5, e = q2 >> 9, r = q2 & 511, kt = r >> 5, n0 = (r & 31) * 64;
        m.W = A.in[19] + (size_t)e * DFF * DM; m.ldn = DM; m.k0 = kt * 128; m.n0 = n0; m.dst = F.ws + WS_WD + (size_t)e * DM * KD; m.drow = n0; }
    return m;
}
template <bool SLD> __device__ __forceinline__ void moe_ld_half(f32x4 (&v)[16], const MoeItem& m, int half, int lane) {
    const int q = lane >> 4, c4 = lane & 15;
    if constexpr (SLD) { const __amdgpu_buffer_rsrc_t rw = __builtin_amdgcn_make_buffer_rsrc((void*)m.W, 0, 0x7fffffff, 0x00020000);
        const int vo = ((m.k0 + 64 * half + 4 * q) * m.ldn + m.n0 + 4 * c4) * 4;
#pragma unroll
        for (int i = 0; i < 16; ++i) v[i] = __builtin_bit_cast(f32x4, __builtin_amdgcn_raw_buffer_load_b128(rw, vo, (16 * (i >> 2) + (i & 3)) * m.ldn * 4, CONV_LD_AUX)); }
    else {
#pragma unroll
        for (int i = 0; i < 16; ++i) { const int k = m.k0 + 64 * half + 16 * (i >> 2) + 4 * q + (i & 3); v[i] = __builtin_nontemporal_load((const f32x4*)(m.W + (size_t)k * m.ldn + m.n0 + 4 * c4)); } }
}
typedef short v2s16 __attribute__((ext_vector_type(2)));
__device__ __forceinline__ unsigned pk_fp8x4_scaled(float a, float b, float c, float d, float scale) { v2s16 r; asm volatile("" : "=v"(r));
    r = __builtin_amdgcn_cvt_scalef32_pk_fp8_f32(r, a, b, scale, false); r = __builtin_amdgcn_cvt_scalef32_pk_fp8_f32(r, c, d, scale, true); return __builtin_bit_cast(unsigned, r); }
__device__ __forceinline__ void moe_cv_half(const f32x4 (&v)[16], LAS unsigned* scr, int half, int lane) {
    const int q = lane >> 4, c4 = lane & 15;
#pragma unroll
    for (int pp = 0; pp < 4; ++pp)
#pragma unroll
#if CVT_DUP
        for (int j = 0; j < 4; ++j) { float a0 = v[4 * pp][j], a1 = v[4 * pp + 1][j], a2 = v[4 * pp + 2][j], a3 = v[4 * pp + 3][j];
            const unsigned r1 = pk_fp8x4_scaled(a0, a1, a2, a3, WCVT_SCALE); asm volatile("" : "+v"(a0), "+v"(a1), "+v"(a2), "+v"(a3));
            const unsigned r2 = pk_fp8x4_scaled(a0, a1, a2, a3, WCVT_SCALE); scr[(4 * c4 + j) * 33 + 16 * half + 4 * pp + q] = r1 & r2; }
#else
        for (int j = 0; j < 4; ++j) scr[(4 * c4 + j) * 33 + 16 * half + 4 * pp + q] = pk_fp8x4_scaled(v[4 * pp][j], v[4 * pp + 1][j], v[4 * pp + 2][j], v[4 * pp + 3][j], WCVT_SCALE);
#endif
}
template <bool SC1> __device__ __forceinline__ void moe_flush(const MoeItem& m, LAS unsigned* scr, int lane) {
#pragma unroll
    for (int jj = 0; jj < 8; ++jj) { const int n = 8 * jj + (lane >> 3), ch = lane & 7; u32x4 w; const LAS unsigned* sp = scr + n * 33 + 4 * ch; w.x = sp[0]; w.y = sp[1]; w.z = sp[2]; w.w = sp[3];
        if constexpr (SC1) { const __amdgpu_buffer_rsrc_t rs = __builtin_amdgcn_make_buffer_rsrc(m.dst, 0, 0x7fffffff, 0x00020000);
            __builtin_amdgcn_raw_buffer_store_b128(w, rs, (m.drow + n) * KD + m.k0 + 16 * ch, 0, CONV_ST_AUX); }
        else __builtin_nontemporal_store(w, (u32x4*)(m.dst + (size_t)(m.drow + n) * KD + m.k0 + 16 * ch)); }
}
template <bool SC1, bool SLD> __device__ __forceinline__ void moe_items_stream(const Frame& F, const Args& A, int it0, int stride, int count, LAS unsigned* scr) {
    if (count <= 0) return;
    f32x4 va[16], vb[16];
    MoeItem cur = moe_item_desc(F, A, it0);
    moe_ld_half<SLD>(va, cur, 0, F.lane);
    for (int i = 0; i < count; ++i) {
        moe_ld_half<SLD>(vb, cur, 1, F.lane);
        moe_cv_half(va, scr, 0, F.lane);
        MoeItem nxt = cur;
        if (i + 1 < count) { nxt = moe_item_desc(F, A, it0 + (i + 1) * stride); moe_ld_half<SLD>(va, nxt, 0, F.lane); }
        moe_cv_half(vb, scr, 1, F.lane);
        LDS_WAIT();
        moe_flush<SC1>(cur, scr, F.lane);
        LDS_WAIT();
        cur = nxt;
    }
}
template <bool SC1, bool SLD = SC1> __device__ __forceinline__ void moe_item_fp8(const Frame& F, const Args& A, int it, LAS unsigned* scr) { moe_items_stream<SC1, SLD>(F, A, it, 0, 1, scr); }
__device__ __forceinline__ void p0_prologue(const Frame& F, const Args& A) {
    LAS unsigned* scr = (LAS unsigned*)(F.lds + F.wave * 16384);
    const int gw = F.bid * NWAVES + F.wave, NGW = F.G * NWAVES;
    const float* w_in = A.in[3]; const float* w_out = A.in[8]; const float* w_cq = A.in[11]; const float* w_ckv = A.in[12]; const float* w_co = A.in[13];
    const float* w_gu = A.in[17]; const float* w_dn = A.in[19]; (void)w_gu; (void)w_dn;
    constexpr int I0 = 96 * 32, I1 = 32 * 32, I2 = 0, I3 = 64 * 32, I4 = 32 * 32, I5 = MOE_FP8 ? 0 : NEXP * 64 * 32, I6 = MOE_FP8 ? 0 : NEXP * 32 * 32;
    constexpr int NITEMS = I0 + I1 + I2 + I3 + I4 + I5 + I6;
    for (int it = gw; it < NITEMS; it += NGW) {
        int r = it; const float* W; int ldn, nct; bf16* dst; const float* gk = nullptr; int mode = 0;
        if (r < I0) { W = w_in; ldn = INC; nct = 96; dst = (bf16*)(F.ws + WS_WIN); }
        else if ((r -= I0) < I1) { W = w_out; ldn = DM; nct = 32; dst = (bf16*)(F.ws + WS_WOUT); }
        else if ((r -= I1) < I3) { W = w_ckv; ldn = 2 * DM; nct = 64; dst = (bf16*)(F.ws + WS_WCKV); }
        else if ((r -= I3) < I4) { W = w_co; ldn = DM; nct = 32; dst = (bf16*)(F.ws + WS_WCO); }
        else if ((r -= I4) < I5) { const int e = r / (64 * 32); r -= e * (64 * 32); W = w_gu + (size_t)e * DM * 2 * DFF; ldn = 2 * DFF; nct = 64; dst = (bf16*)(F.ws + WS_WGU) + (size_t)e * 2 * DFF * KD; mode = 1; }
        else { r -= I5; const int e = r / (32 * 32); r -= e * (32 * 32); W = w_dn + (size_t)e * DFF * DM; ldn = DM; nct = 32; dst = (bf16*)(F.ws + WS_WD) + (size_t)e * DM * KD; }
        const int kt = r / nct, ct = r - kt * nct; const int n0 = ct * 64;
        int drow = n0;
        if (mode == 1) drow = (n0 < DFF) ? ((n0 >> 7) * 256 + (n0 & 127)) : (((n0 - DFF) >> 7) * 256 + 128 + ((n0 - DFF) & 127));
        cvt_tile(W, ldn, kt * 64, n0, dst, drow, gk, scr, F.lane);
    }
#if MOE_FP8
    if (CONV_WGS) {
        for (int it = (32 - E_P0) * 1024 + gw; it < 32768; it += NGW) moe_item_fp8<false>(F, A, it, scr);
        for (int it = 32768 + (32 - D_P0) * 512 + gw; it < MOE_ITEMS; it += NGW) moe_item_fp8<false>(F, A, it, scr);
    }
#endif
    {
        const int gt = F.bid * NTHR + F.tid, NGT = F.G * NTHR;
        bf16* wlow = (bf16*)(F.ws + WS_WLOW); bf16* wrh = (bf16*)(F.ws + WS_WRH); bf16* wrl = (bf16*)(F.ws + WS_WRL);
        const float* w_r = A.in[15]; const float* g_moe = A.in[14];
        { const float* g_cross = A.in[9]; bf16* wcqn = (bf16*)(F.ws + WS_WCQ);
          for (int i = gt; i < DM * DM / 4; i += NGT) { const int k = i >> 9; const f32x4 v = *((const f32x4*)w_cq + i) * g_cross[k]; st_bf16x4(wcqn + (size_t)i * 4, v); } }
        for (int i = gt; i < 16 * KD; i += NGT) { const int k = i >> 4, r = i & 15; wlow[r * KD + k] = f2bf(w_in[(size_t)k * INC + NPROJ + r]); }
        for (int i = gt; i < 32 * KD; i += NGT) { const int k = i >> 5, e = i & 31; const float w = w_r[k * 32 + e] * g_moe[k]; const bf16 h = f2bf(w); wrh[e * KD + k] = h; wrl[e * KD + k] = f2bf(w - bf2f(h)); }
    }
    for (int m = gw; m < NT + NMEM; m += NGW) {
        if (m < NT) rms_row_bf16(A.in[0] + (size_t)m * DM, A.in[2], (bf16*)(F.ws + WS_H1) + (size_t)m * DM, F.lane);
        else rms_row_bf16(A.in[1] + (size_t)(m - NT) * DM, A.in[10], (bf16*)(F.ws + WS_MEMN) + (size_t)(m - NT) * DM, F.lane);
    }
}

__device__ __forceinline__ void conv_step(const Frame& F, const Args& A, int seq) {
    LAS unsigned* scr = (LAS unsigned*)(F.lds + F.wave * 16384);
    const int cw = F.bid - NCOMP;
    if (seq < 32) moe_items_stream<true, true>(F, A, seq * 1024 + (cw * NWAVES + F.wave) * 2, 1, 2, scr);
    else moe_item_fp8<true>(F, A, 32768 + (seq - 32) * 512 + cw * NWAVES + F.wave, scr);
    VM_WAIT(); __syncthreads();
    if (F.tid == 0) __hip_atomic_fetch_add((unsigned*)(F.ws + WS_CTL) + CW_EXP + 64 * seq, 1u, __ATOMIC_RELAXED, __HIP_MEMORY_SCOPE_AGENT);
}

__device__ __forceinline__ void conv_stream(const Frame& F, const Args& A, int gu0, int ngu, int dn0, int ndn) {
    LAS unsigned* scr = (LAS unsigned*)(F.lds + F.wave * 16384);
    const int w = (F.bid - NCOMP) * NWAVES + F.wave, count = 2 * ngu + ndn;
    if (count <= 0) return;
    unsigned* cnt = (unsigned*)(F.ws + WS_CTL) + CW_EXP;
    auto item = [&](int j, int& seq, bool& last) -> int {
        if (j < 2 * ngu) { seq = gu0 + (j >> 1); last = (j & 1) != 0; return seq * 1024 + w * 2 + (j & 1); }
        const int d = dn0 + j - 2 * ngu; seq = 32 + d; last = true; return 32768 + d * 512 + w; };
    f32x4 va[16], vb[16];
    int seq, pend = -1; bool last;
    MoeItem cur = moe_item_desc(F, A, item(0, seq, last));
    moe_ld_half<true>(va, cur, 0, F.lane);
    for (int j = 0; j < count; ++j) {
        moe_ld_half<true>(vb, cur, 1, F.lane);
        if (pend >= 0) { asm volatile("s_waitcnt vmcnt(16)" ::: "memory"); __builtin_amdgcn_s_barrier();
            if (F.tid == 0) __hip_atomic_fetch_add(cnt + 64 * pend, 1u, __ATOMIC_RELAXED, __HIP_MEMORY_SCOPE_AGENT);
            pend = -1; }
        moe_cv_half(va, scr, 0, F.lane);
        MoeItem nxt = cur; int nseq = seq; bool nlast = last;
        if (j + 1 < count) { nxt = moe_item_desc(F, A, item(j + 1, nseq, nlast)); moe_ld_half<true>(va, nxt, 0, F.lane); }
        moe_cv_half(vb, scr, 1, F.lane);
        LDS_WAIT();
        moe_flush<true>(cur, scr, F.lane);
        LDS_WAIT();
        if (last) pend = seq;
        cur = nxt; seq = nseq; last = nlast;
    }
    VM_WAIT(); __builtin_amdgcn_s_barrier();
    if (F.tid == 0 && pend >= 0) __hip_atomic_fetch_add(cnt + 64 * pend, 1u, __ATOMIC_RELAXED, __HIP_MEMORY_SCOPE_AGENT);
}

#define EPI_LOOP(...) _Pragma("unroll") for (int ai = 0; ai < 2; ++ai) _Pragma("unroll") for (int m = 0; m < 4; ++m) { const int rl = ai * 128 + wr * 64 + m * 16 + fr; \
        _Pragma("unroll") for (int bj = 0; bj < 2; ++bj) _Pragma("unroll") for (int n = 0; n < 2; ++n) { const int cl = bj * 128 + wc * 32 + n * 16 + 4 * fq; const f32x4 v = acc[ai][bj][m][n]; __VA_ARGS__ } }
#define EPI_LOOP_P(...) _Pragma("unroll") for (int ai = 0; ai < 2; ++ai) _Pragma("unroll") for (int m = 0; m < 4; ++m) { const int rl = ai * 128 + wr * 64 + m * 16 + fr; \
        _Pragma("unroll") for (int bj = 0; bj < 2; ++bj) { const int cl = bj * 128 + wc * 32 + 8 * fq; const f32x4 v0 = acc[ai][bj][m][0], v1 = acc[ai][bj][m][1]; __VA_ARGS__ } }
__device__ __forceinline__ void st_bf16x8(bf16* p, f32x4 a, f32x4 b) { u32x4 w; w.x = cvt_pk_bf16(a.x, a.y); w.y = cvt_pk_bf16(a.z, a.w); w.z = cvt_pk_bf16(b.x, b.y); w.w = cvt_pk_bf16(b.z, b.w); *(u32x4*)p = w; }

struct EpiInProj {
    static constexpr bool PERM = true;
    unsigned char* ws;
    __device__ __forceinline__ void operator()(f32x4 (&acc)[2][2][4][2], const Unit& u, int wr, int wc, int fr, int fq) const {
        const int c0 = u.c0;
        if (c0 < 2048 || (c0 >= 3072 && c0 < 4096) || c0 >= 5120) {
            bf16* base; int ld, cc;
            if (c0 < 1024) { base = (bf16*)(ws + WS_SBQ); ld = 1024; cc = c0; }
            else if (c0 < 2048) { base = (bf16*)(ws + WS_SBK); ld = 1024; cc = c0 - 1024; }
            else if (c0 < 3584) { base = (bf16*)(ws + WS_GQ); ld = 512; cc = c0 - 3072; }
            else if (c0 < 4096) { base = (bf16*)(ws + WS_GK); ld = 512; cc = c0 - 3584; }
            else { base = (bf16*)(ws + WS_GR); ld = 1024; cc = c0 - 5120; }
            EPI_LOOP_P( st_bf16x8(base + (size_t)(u.r0 + rl) * ld + cc + cl, v0, v1); )
        } else {
            bf16* base = (bf16*)(ws + (c0 < 3072 ? WS_SBVT : WS_GVT)); const int cc = c0 - (c0 < 3072 ? 2048 : 4096);
            EPI_LOOP_P( const int r = u.r0 + rl, b = r >> 11, sq = r & 2047; const int c = cc + cl;
                _Pragma("unroll") for (int j = 0; j < 4; ++j) { base[((size_t)(b * 1024 + c + j)) * SEQ + sq] = f2bf(v0[j]); base[((size_t)(b * 1024 + c + 4 + j)) * SEQ + sq] = f2bf(v1[j]); } )
        }
    }
};
struct EpiKV {
    static constexpr bool PERM = true;
    unsigned char* ws;
    __device__ __forceinline__ void operator()(f32x4 (&acc)[2][2][4][2], const Unit& u, int wr, int wc, int fr, int fq) const {
        bf16* base = (bf16*)(ws + (u.c0 < 2048 ? WS_KVK : WS_KVVT)); const int cc = u.c0 < 2048 ? u.c0 : u.c0 - 2048;
        EPI_LOOP_P( st_bf16x8(base + (size_t)(u.r0 + rl) * DM + cc + cl, v0, v1); )
    }
};
struct EpiRes1 {
    static constexpr bool PERM = true;
    const float* x; float* x1; bf16* x1b; float* ssq;
    __device__ __forceinline__ void operator()(f32x4 (&acc)[2][2][4][2], const Unit& u, int wr, int wc, int fr, int fq) const {
#pragma unroll
        for (int ai = 0; ai < 2; ++ai) {
            f32x4 xv[4][2][2];
#pragma unroll
            for (int m = 0; m < 4; ++m)
#pragma unroll
                for (int bj = 0; bj < 2; ++bj) { const size_t o = (size_t)(u.r0 + ai * 128 + wr * 64 + m * 16 + fr) * DM + u.c0 + bj * 128 + wc * 32 + 8 * fq; xv[m][bj][0] = *(const f32x4*)(x + o); xv[m][bj][1] = *(const f32x4*)(x + o + 4); }
#pragma unroll
            for (int m = 0; m < 4; ++m) { const int r = u.r0 + ai * 128 + wr * 64 + m * 16 + fr; float s = 0.f;
#pragma unroll
                for (int bj = 0; bj < 2; ++bj) { const int c = u.c0 + bj * 128 + wc * 32 + 8 * fq; const size_t o = (size_t)r * DM + c;
                    const f32x4 a = acc[ai][bj][m][0] + xv[m][bj][0], b = acc[ai][bj][m][1] + xv[m][bj][1];
                    if constexpr (X1_F32) { *(f32x4*)(x1 + o) = a; *(f32x4*)(x1 + o + 4) = b; } st_bf16x8(x1b + o, a, b);
                    s += ((a.x * a.x + a.y * a.y) + (a.z * a.z + a.w * a.w)) + ((b.x * b.x + b.y * b.y) + (b.z * b.z + b.w * b.w)); }
                s += __shfl_xor(s, 16); s += __shfl_xor(s, 32);
                if (fq == 0) ssq[(size_t)((u.c0 >> 8) * 4 + wc) * NT + r] = s; } }
    }
};
#if X1_F32
struct EpiRes2 {
    static constexpr bool PERM = false;
    const float* x1; const bf16* x1b; float* x2;
    __device__ __forceinline__ void operator()(f32x4 (&acc)[2][2][4][2], const Unit& u, int wr, int wc, int fr, int fq) const {
        EPI_LOOP( const size_t o = (size_t)(u.r0 + rl) * DM + u.c0 + cl; *(f32x4*)(x2 + o) = v + *(const f32x4*)(x1 + o); )
    }
};
#else
struct EpiRes2 {
    static constexpr bool PERM = true;
    const float* x1; const bf16* x1b; float* x2;
    __device__ __forceinline__ void operator()(f32x4 (&acc)[2][2][4][2], const Unit& u, int wr, int wc, int fr, int fq) const {
        u32x4 xw[2][4][2];
#pragma unroll
        for (int ai = 0; ai < 2; ++ai)
#pragma unroll
            for (int m = 0; m < 4; ++m)
#pragma unroll
                for (int bj = 0; bj < 2; ++bj) xw[ai][m][bj] = *(const u32x4*)(x1b + (size_t)(u.r0 + ai * 128 + wr * 64 + m * 16 + fr) * DM + u.c0 + bj * 128 + wc * 32 + 8 * fq);
        EPI_LOOP_P( const size_t o = (size_t)(u.r0 + rl) * DM + u.c0 + cl; const u32x4 w = xw[ai][m][bj];
            const f32x4 a = v0 + (f32x4){bflo(w.x), bfhi(w.x), bflo(w.y), bfhi(w.y)}, b = v1 + (f32x4){bflo(w.z), bfhi(w.z), bflo(w.w), bfhi(w.w)};
            if constexpr (X2_BF16 != 0) st_bf16x8((bf16*)x2 + o, a, b); else { *(f32x4*)(x2 + o) = a; *(f32x4*)(x2 + o + 4) = b; } )
    }
};
#endif
constexpr float WUNSC = (MOE_FP8 && MX_UNSCALED) ? (1.0f / 64.0f) : 1.0f;
struct EpiAct {
    static constexpr bool PERM = true;
    const float* bgu; bf16* act;
    __device__ __forceinline__ void operator()(f32x4 (&acc)[2][2][4][2], const Unit& u, int wr, int wc, int fr, int fq) const {
        const float* bg = bgu + (size_t)u.e * 2 * DFF; const int j0 = u.c0 + wc * 32 + 8 * fq;
        f32x4 b0[2], b1[2];
        constexpr float CS = 1.702f * LOG2E, ICS = 1.0f / CS;
#pragma unroll
        for (int n = 0; n < 2; ++n) { b0[n] = *(const f32x4*)(bg + j0 + 4 * n) * CS; b1[n] = (*(const f32x4*)(bg + DFF + j0 + 4 * n) + 1.0f) * ICS; }
#pragma unroll
        for (int ai = 0; ai < 2; ++ai)
#pragma unroll
            for (int m = 0; m < 4; ++m) { const int rl = ai * 128 + wr * 64 + m * 16 + fr; if (rl < u.rows) { f32x4 a[2];
                { float t[8], e[8], l1[8];
#pragma unroll
                for (int n = 0; n < 2; ++n) { const f32x4 g = acc[ai][0][m][n] * (WUNSC * CS) + b0[n], l = acc[ai][1][m][n] * (WUNSC * ICS) + b1[n];
#pragma unroll
                    for (int j = 0; j < 4; ++j) { t[4 * n + j] = fminf(g[j], 7.0f * CS); l1[4 * n + j] = fminf(fmaxf(l[j], -6.0f * ICS), 8.0f * ICS); } }
#pragma unroll
                for (int k = 0; k < 8; ++k) e[k] = fexp2(-t[k]);
#pragma unroll
                for (int k = 0; k < 8; ++k) e[k] = 1.0f + e[k];
#pragma unroll
                for (int k = 0; k < 8; ++k) e[k] = frcp(e[k]);
#pragma unroll
                for (int k = 0; k < 8; ++k) a[k >> 2][k & 3] = t[k] * e[k] * l1[k]; }
#if MOE_FP8
                u32x2 w; w.x = pk_fp8x4(a[0].x, a[0].y, a[0].z, a[0].w); w.y = pk_fp8x4(a[1].x, a[1].y, a[1].z, a[1].w);
                *(u32x2*)((unsigned char*)act + (size_t)(u.r0 + rl) * DFF + j0) = w;
#else
                st_bf16x8(act + (size_t)(u.r0 + rl) * DFF + j0, a[0], a[1]);
#endif
                } }
    }
};
struct EpiY {
    static constexpr bool PERM = true;
    const float* bd; const float* sw; bf16* y;
    __device__ __forceinline__ void operator()(f32x4 (&acc)[2][2][4][2], const Unit& u, int wr, int wc, int fr, int fq) const {
        const float* bb = bd + (size_t)u.e * DM;
        f32x4 bv[2][2];
#pragma unroll
        for (int bj = 0; bj < 2; ++bj)
#pragma unroll
            for (int n = 0; n < 2; ++n) bv[bj][n] = *(const f32x4*)(bb + u.c0 + bj * 128 + wc * 32 + 8 * fq + 4 * n);
        float wrow[2][4];
#pragma unroll
        for (int ai = 0; ai < 2; ++ai)
#pragma unroll
            for (int m = 0; m < 4; ++m) wrow[ai][m] = sw[u.r0 + ai * 128 + wr * 64 + m * 16 + fr];
#pragma unroll
        for (int ai = 0; ai < 2; ++ai)
#pragma unroll
            for (int m = 0; m < 4; ++m) { const int rl = ai * 128 + wr * 64 + m * 16 + fr; if (rl < u.rows) { const float w = wrow[ai][m];
#pragma unroll
                for (int bj = 0; bj < 2; ++bj) { const int c = u.c0 + bj * 128 + wc * 32 + 8 * fq; const float w16 = w * (Y_FP8 ? 16.0f : 1.0f), ws = w16 * WUNSC; const f32x4 y0 = acc[ai][bj][m][0] * ws + bv[bj][0] * w16, y1 = acc[ai][bj][m][1] * ws + bv[bj][1] * w16;
#if Y_FP8
                    u32x2 yw; yw.x = pk_fp8x4(y0.x, y0.y, y0.z, y0.w); yw.y = pk_fp8x4(y1.x, y1.y, y1.z, y1.w);
                    *(u32x2*)((unsigned char*)y + (size_t)(u.r0 + rl) * DM + c) = yw;
#else
                    st_bf16x8(y + (size_t)(u.r0 + rl) * DM + c, y0, y1);
#endif
                    } } }
    }
};

constexpr int RSC_OFF = RED2_OFF + 4096;
__device__ __forceinline__ void xattn_row_scales(LAS unsigned char* lds, const float* __restrict__ ssq, int r0) {
    const int t = threadIdx.x, row = t >> 1, hf = t & 1; float q = 0.f;
#pragma unroll
    for (int pp = 0; pp < 16; ++pp) q += ssq[(size_t)(16 * hf + pp) * NT + r0 + row];
    q += __shfl_xor(q, 1);
    if (hf == 0) ((LAS float*)(lds + RSC_OFF))[row] = (0.04419417382415922f * LOG2E) / sqrtf(q * (1.f / DM) + EPS);
    __syncthreads();
}
struct EpiSoftmax {
    static constexpr bool PERM = true;
    LAS unsigned char* lds; bf16* P;
    __device__ __forceinline__ void operator()(f32x4 (&acc)[2][2][4][2], const Unit& u, int wr, int wc, int fr, int fq) const {
        LAS float* red1 = (LAS float*)(lds + RED1_OFF); LAS float* red2 = (LAS float*)(lds + RED2_OFF);
        float rs[2][4];
#pragma unroll
        for (int ai = 0; ai < 2; ++ai)
#pragma unroll
            for (int m = 0; m < 4; ++m) rs[ai][m] = ((const LAS float*)(lds + RSC_OFF))[ai * 128 + wr * 64 + m * 16 + fr];
#pragma unroll
        for (int ai = 0; ai < 2; ++ai)
#pragma unroll
            for (int m = 0; m < 4; ++m) { const int rl = ai * 128 + wr * 64 + m * 16 + fr; float mx = -3.0e38f;
#pragma unroll
                for (int bj = 0; bj < 2; ++bj)
#pragma unroll
                    for (int n = 0; n < 2; ++n) { const f32x4 v = acc[ai][bj][m][n]; mx = fmaxf(fmaxf(mx, fmaxf(v.x, v.y)), fmaxf(v.z, v.w)); }
                mx = fmaxf(mx, __shfl_xor(mx, 16)); mx = fmaxf(mx, __shfl_xor(mx, 32));
                if (fq == 0) red1[rl * 4 + wc] = mx; }
        asm volatile("s_waitcnt lgkmcnt(0)" ::: "memory"); __builtin_amdgcn_s_barrier(); asm volatile("" ::: "memory");
#pragma unroll
        for (int ai = 0; ai < 2; ++ai)
#pragma unroll
            for (int m = 0; m < 4; ++m) { const int rl = ai * 128 + wr * 64 + m * 16 + fr; const f32x4 mv = *(const LAS f32x4*)(red1 + rl * 4);
                const float mx = fmaxf(fmaxf(mv.x, mv.y), fmaxf(mv.z, mv.w)); float sum = 0.f;
#pragma unroll
                for (int bj = 0; bj < 2; ++bj)
#pragma unroll
                    for (int n = 0; n < 2; ++n) { f32x4 v = acc[ai][bj][m][n];
#pragma unroll
                        for (int j = 0; j < 4; ++j) { v[j] = fexp2((v[j] - mx) * rs[ai][m]); sum += v[j]; }
                        acc[ai][bj][m][n] = v; }
                sum += __shfl_xor(sum, 16); sum += __shfl_xor(sum, 32);
                if (fq == 0) red2[rl * 4 + wc] = sum; }
        asm volatile("s_waitcnt lgkmcnt(0)" ::: "memory"); __builtin_amdgcn_s_barrier(); asm volatile("" ::: "memory");
#pragma unroll
        for (int ai = 0; ai < 2; ++ai)
#pragma unroll
            for (int m = 0; m < 4; ++m) { const int rl = ai * 128 + wr * 64 + m * 16 + fr; const f32x4 sv = *(const LAS f32x4*)(red2 + rl * 4);
                const float inv = 1.0f / ((sv.x + sv.y) + (sv.z + sv.w));
#pragma unroll
                for (int bj = 0; bj < 2; ++bj) st_bf16x8(P + (size_t)(u.r0 + rl) * 1024 + u.c0 + bj * 128 + wc * 32 + 8 * fq, acc[ai][bj][m][0] * inv, acc[ai][bj][m][1] * inv); }
        asm volatile("s_waitcnt lgkmcnt(0)" ::: "memory"); __builtin_amdgcn_s_barrier(); asm volatile("" ::: "memory");
    }
};
struct XpreOrder {
    const char* Kk; const char* Wcqn; const char* Wcot; const char* Vv; int c;
    __device__ bool next(int i, Unit& u) const { if (i > 0 || c >= 256) return false; u.rows = 256; u.e = 0;
        if (c < 128) { const int h = c & 3, b = (((c & 7) >> 2) << 1) + (c >> 6), nt = (c >> 3) & 7, bh = b * 4 + h;
            u.a = Kk + ((size_t)(b * MEMLEN) * DM + h * 512) * 2; u.b = Wcqn + ((size_t)(nt * 256) * DM + h * 512) * 2; u.r0 = bh * 256; u.c0 = nt * 256; u.e = 0; }
        else { const int q = c - 128, h = q & 3, b = (((q & 7) >> 2) << 1) + (q >> 6), nt = (q >> 3) & 7;
            u.a = Wcot + ((size_t)(nt * 256) * DM + h * 512) * 2; u.b = Vv + ((size_t)(b * MEMLEN) * DM + h * 512) * 2; u.r0 = b * DM + nt * 256; u.c0 = h * 256; u.e = 1; }
        return true; }
    __device__ __forceinline__ void a_ready(const Unit&) const {}
};
struct EpiXpre {
    static constexpr bool PERM = true;
    bf16* MT; bf16* VWT;
    __device__ __forceinline__ void operator()(f32x4 (&acc)[2][2][4][2], const Unit& u, int wr, int wc, int fr, int fq) const {
        bf16* O = u.e ? VWT : MT; const int ld = u.e ? 1024 : DM;
        EPI_LOOP_P( st_bf16x8(O + (size_t)(u.r0 + rl) * ld + u.c0 + cl, v0, v1); )
    }
};
struct MixOrder {
    pg8::DenseOrder D; XpreOrder X; int c;
    __device__ bool next(int i, Unit& u) const { if (i > 1) return false; const bool first_dense = true;
        if ((i == 0) == first_dense) { const bool ok = D.next(0, u); u.e = 0; u.nt = 32; return ok; }
        const bool ok = X.next(0, u); u.e = u.e + 1; u.nt = 8; return ok; }
    __device__ __forceinline__ void a_ready(const Unit&) const {}
};
struct EpiMix {
    static constexpr bool PERM = true;
    EpiRes1 R; EpiXpre Xp;
    __device__ __forceinline__ void operator()(f32x4 (&acc)[2][2][4][2], const Unit& u, int wr, int wc, int fr, int fq) const {
        if (u.e == 0) R(acc, u, wr, wc, fr, fq); else { Unit v = u; v.e = u.e - 1; Xp(acc, v, wr, wc, fr, fq); }
    }
};
__device__ __forceinline__ int xs_b(int c) { return (c & 7) >> 1; }
__device__ __forceinline__ int xs_h(int c) { return ((c & 1) << 1) + (c >> 6); }
__device__ __forceinline__ int xs_qt(int c) { return (c >> 3) & 7; }
struct XsOrder {
    const char* X; const char* MT; int c;
    __device__ bool next(int i, Unit& u) const { if (i > 0 || c >= 128) return false; const int b = xs_b(c), h = xs_h(c), qt = xs_qt(c), bh = b * 4 + h;
        u.a = X + ((size_t)(b * SEQ + 256 * qt) * DM) * 2; u.b = MT + ((size_t)(bh * 256) * DM) * 2; u.r0 = b * SEQ + 256 * qt; u.c0 = h * 256; u.rows = 256; u.e = 0; return true; }
    __device__ __forceinline__ void a_ready(const Unit&) const {}
};
struct XoutOrder {
    const char* P; const char* VWT; int c;
    __device__ bool next(int i, Unit& u) const { if (i > 0 || c >= 256) return false; const int b = (c & 7) >> 1, pm = ((c & 1) << 2) + (c >> 6), pn = (c >> 3) & 7;
        u.a = P + ((size_t)(b * SEQ + 256 * pm) * 1024) * 2; u.b = VWT + ((size_t)(b * DM + 256 * pn) * 1024) * 2; u.r0 = b * SEQ + 256 * pm; u.c0 = 256 * pn; u.rows = 256; u.e = 0; return true; }
    __device__ __forceinline__ void a_ready(const Unit&) const {}
};
struct KvOrder {
    const char* A; const char* Bt; int c;
    __device__ bool next(int i, Unit& u) const { if (i > 0 || c >= 64) return false; const int pm = c >> 4, pn = c & 15;
        u.a = A + (size_t)pm * 256 * KD * 2; u.b = Bt + (size_t)pn * 256 * KD * 2; u.r0 = pm * 256; u.c0 = pn * 256; u.rows = 256; u.e = 0; return true; }
    __device__ __forceinline__ void a_ready(const Unit&) const {}
};
struct MoeOrder {
    const LAS int* tab; const char* A; const char* Bt; int ntn, G, c; size_t bstride; int ocol; int pitchb;
    __device__ bool next(int i, Unit& u) const {
        const int cc = MOE_XCD ? (c & 7) * (G >> 3) + (c >> 3) : c;
        const int idx = base + i * G + cc; const int total = __builtin_amdgcn_readfirstlane(tab[32]);
        if (idx >= total || idx >= lim) return false;
        int e = 0;
        for (int q = 1; q < 32; ++q) { const int p = __builtin_amdgcn_readfirstlane(tab[q]); if (idx >= p) e = q; }
        const int ue = __builtin_amdgcn_readfirstlane(tab[e]), st = __builtin_amdgcn_readfirstlane(tab[64 + e]), cn = __builtin_amdgcn_readfirstlane(tab[128 + e]);
        const int local = idx - ue, MTe = (cn + 255) >> 8;
        int mt, nt; if (MOE_XCD) { nt = local / MTe; mt = local - nt * MTe; } else { mt = local / ntn; nt = local - mt * ntn; }
        u.a = gtab ? A : A + (size_t)(st + 256 * mt) * pitchb; u.b = Bt + (size_t)e * bstride + (size_t)nt * 256 * pitchb;
        u.r0 = st + 256 * mt; u.c0 = nt * ocol; u.rows = (cn - 256 * mt) < 256 ? (cn - 256 * mt) : 256; u.e = e; return true;
    }
    const unsigned* ecnt; int* ready; int hi_ready; int base = 0, lim = 0x7fffffff; const int* gtab = nullptr;
    __device__ __forceinline__ void a_ready(const Unit& u) const {
        if (ecnt == nullptr || u.e <= *ready || u.e >= hi_ready) return;
        if (threadIdx.x < 64) { unsigned sp = 0;
            while ((unsigned)__builtin_amdgcn_readfirstlane(__hip_atomic_load(ecnt + 64 * u.e, __ATOMIC_RELAXED, __HIP_MEMORY_SCOPE_AGENT)) < (unsigned)CONV_WGS) { __builtin_amdgcn_s_sleep(4); if (++sp > (1u << 22)) break; }
            __builtin_amdgcn_fence(__ATOMIC_ACQUIRE, "agent");
            asm volatile("s_waitcnt vmcnt(0)" ::: "memory"); }
        asm volatile("" ::: "memory"); __builtin_amdgcn_s_barrier(); asm volatile("" ::: "memory");
        *ready = u.e;
    }
};
__device__ __forceinline__ void moe_table(const Frame& F, int ntn) {
    LAS int* tab = (LAS int*)(F.lds + TAB_OFF); const int* cs = (const int*)(F.ws + WS_CNT);
    if (F.tid < 32) { tab[64 + F.tid] = cs[32 + F.tid]; tab[128 + F.tid] = cs[F.tid]; }
    __syncthreads();
    if (F.tid == 0) { int p = 0; for (int e = 0; e < 32; ++e) { tab[e] = p; p += ((tab[128 + e] + 255) >> 8) * ntn; } tab[32] = p; }
    __syncthreads();
}

__device__ __forceinline__ void gla_low_job(const Frame& F) {
    const bf16* h1 = (const bf16*)(F.ws + WS_H1); const bf16* wl = (const bf16*)(F.ws + WS_WLOW); float* glow = (float*)(F.ws + WS_GLOW);
    LAS float* red = (LAS float*)F.lds;
    const int l = F.lane, r16 = l & 15, quad = l >> 4;
    for (int rb = F.bid; rb < NT / 32; rb += F.G) {
        f32x4 acc[2] = {{0.f, 0.f, 0.f, 0.f}, {0.f, 0.f, 0.f, 0.f}};
#pragma unroll
        for (int st = 0; st < 8; ++st) { const int k0 = 256 * F.wave + 32 * st + 8 * quad;
            const bf16x8 bfr = *(const bf16x8*)(wl + (size_t)r16 * KD + k0);
#pragma unroll
            for (int tb = 0; tb < 2; ++tb) { const bf16x8 afr = *(const bf16x8*)(h1 + (size_t)(rb * 32 + tb * 16 + r16) * KD + k0);
                acc[tb] = __builtin_amdgcn_mfma_f32_16x16x32_bf16(afr, bfr, acc[tb], 0, 0, 0); } }
#pragma unroll
        for (int tb = 0; tb < 2; ++tb)
#pragma unroll
            for (int j = 0; j < 4; ++j) red[(F.wave * 32 + tb * 16 + 4 * quad + j) * 16 + r16] = acc[tb][j];
        __syncthreads();
        { const int tok = F.tid >> 4, r = F.tid & 15; float s = 0.f;
#pragma unroll
          for (int w = 0; w < 8; ++w) s += red[(w * 32 + tok) * 16 + r];
          glow[(size_t)(rb * 32 + tok) * 16 + r] = s; }
        __syncthreads();
    }
}

__device__ __forceinline__ void sb_attn_wave(const Frame& F, const float* __restrict__ sb_g, int wu) {
    const bf16* Q = (const bf16*)(F.ws + WS_SBQ); const bf16* Kp = (const bf16*)(F.ws + WS_SBK); const bf16* VT = (const bf16*)(F.ws + WS_SBVT); bf16* O = (bf16*)(F.ws + WS_MIXO);
    const int l = F.lane, r = l & 31, hh = l >> 5;
    const int qb = 63 - (wu & 63), bh = wu >> 6, b = bh >> 3, h = bh & 7;
    const int t0 = qb * 32;
    bf16x8 qf[8];
#pragma unroll
    for (int st = 0; st < 8; ++st) qf[st] = *(const bf16x8*)(Q + (size_t)(b * SEQ + t0 + r) * 1024 + h * 128 + 16 * st + 8 * hh);
    f32x16 o[4];
#pragma unroll
    for (int d = 0; d < 4; ++d)
#pragma unroll
        for (int i = 0; i < 16; ++i) o[d][i] = 0.f;
    float R = 0.f;
    const float zs = 0.08838834764831845f * LOG2E;
    const int qpos = t0 + r;
    for (int kt = qb; kt >= 0; --kt) {
        f32x16 s;
#pragma unroll
        for (int i = 0; i < 16; ++i) s[i] = 0.f;
#pragma unroll
        for (int st = 0; st < 8; ++st) { const bf16x8 kf = *(const bf16x8*)(Kp + (size_t)(b * SEQ + kt * 32 + r) * 1024 + h * 128 + 16 * st + 8 * hh);
            s = __builtin_amdgcn_mfma_f32_32x32x16_bf16(kf, qf[st], s, 0, 0, 0); }
        float lm[16], lb[16];
#pragma unroll
        for (int i = 0; i < 16; ++i) { const int key = kt * 32 + (i & 3) + 8 * (i >> 2) + 4 * hh; const float z2 = s[i] * zs; const bool valid = key < qpos;
            const float sp = fmaxf(z2, 0.f) + flog2(1.f + fexp2(-fabsf(z2)));
            lm[i] = valid ? -sp : 0.f; lb[i] = z2 - sp; }
        float Gown[4], Gpar[4];
#pragma unroll
        for (int c = 0; c < 4; ++c) { Gown[c] = (lm[4 * c] + lm[4 * c + 1]) + (lm[4 * c + 2] + lm[4 * c + 3]); Gpar[c] = __shfl_xor(Gown[c], 32); }
        float sufT[4]; sufT[3] = 0.f;
#pragma unroll
        for (int c = 2; c >= 0; --c) sufT[c] = sufT[c + 1] + (Gown[c + 1] + Gpar[c + 1]);
        float p[16];
#pragma unroll
        for (int c = 0; c < 4; ++c) { float run = R + sufT[c] + (hh == 0 ? Gpar[c] : 0.f);
#pragma unroll
            for (int e = 3; e >= 0; --e) { const int i = 4 * c + e; const int key = kt * 32 + e + 8 * c + 4 * hh;
                p[i] = (key < qpos) ? fexp2(lb[i] + run) : 0.f; run += lm[i]; } }
        R += (Gown[0] + Gpar[0]) + (Gown[1] + Gpar[1]) + (Gown[2] + Gpar[2]) + (Gown[3] + Gpar[3]);
#pragma unroll
        for (int s2 = 0; s2 < 2; ++s2) {
            u32x4 pw; pw.x = cvt_pk_bf16(p[8 * s2 + 0], p[8 * s2 + 1]); pw.y = cvt_pk_bf16(p[8 * s2 + 2], p[8 * s2 + 3]); pw.z = cvt_pk_bf16(p[8 * s2 + 4], p[8 * s2 + 5]); pw.w = cvt_pk_bf16(p[8 * s2 + 6], p[8 * s2 + 7]);
            const bf16x8 pb = __builtin_bit_cast(bf16x8, pw);
#pragma unroll
            for (int d = 0; d < 4; ++d) { const bf16* vp = VT + ((size_t)(bh * 128 + d * 32 + r)) * SEQ + kt * 32 + 16 * s2 + 4 * hh;
                u32x4 vw; const u32x2 v0 = *(const u32x2*)vp, v1 = *(const u32x2*)(vp + 8); vw.x = v0.x; vw.y = v0.y; vw.z = v1.x; vw.w = v1.y;
                o[d] = __builtin_amdgcn_mfma_f32_32x32x16_bf16(__builtin_bit_cast(bf16x8, vw), pb, o[d], 0, 0, 0); } }
        if (__all(R < -40.f)) break;
    }
    float ss = 0.f;
#pragma unroll
    for (int d = 0; d < 4; ++d)
#pragma unroll
        for (int i = 0; i < 16; ++i) ss += o[d][i] * o[d][i];
    ss += __shfl_xor(ss, 32);
    const float rstd = 1.0f / sqrtf(ss * (1.f / 128.f) + EPS);
#pragma unroll
    for (int d = 0; d < 4; ++d)
#pragma unroll
        for (int c = 0; c < 4; ++c) { const int dim = 32 * d + 8 * c + 4 * hh; const f32x4 g = *(const f32x4*)(sb_g + h * 128 + dim);
            f32x4 v; v.x = o[d][4 * c] * rstd * g.x; v.y = o[d][4 * c + 1] * rstd * g.y; v.z = o[d][4 * c + 2] * rstd * g.z; v.w = o[d][4 * c + 3] * rstd * g.w;
            st_bf16x4(O + (size_t)(b * SEQ + qpos) * DM + h * 128 + dim, v); }
}

constexpr int G1_QIN = 0, G1_KIN = 64 * 136 * 2, G1_KDT = 2 * 64 * 136 * 2, G1_LOW = G1_KDT + 128 * 72 * 2, G1_SEG = G1_LOW + 64 * 16 * 4, G1_QRAW = G1_SEG + 4 * 128 * 4, G1_KRAW = G1_QRAW + 64 * 128 * 2, G1_END = G1_KRAW + 64 * 128 * 2;
constexpr int G1_KVT = G1_QRAW;
static_assert(G1_END <= RING_BYTES && G1_KVT + 65536 <= RING_BYTES && (G1_KVT & 15) == 0, "g1 lds");
__device__ __forceinline__ void gla_g1_unit(const Frame& F, const float* __restrict__ w2, const float* __restrict__ b2, int unit) {
    const int n = unit & 31, bh = unit >> 5, b = bh >> 2, h = bh & 3;
    const int t0 = b * SEQ + 64 * n;
    const bf16* GQ = (const bf16*)(F.ws + WS_GQ); const bf16* GK = (const bf16*)(F.ws + WS_GK); const bf16* GVT = (const bf16*)(F.ws + WS_GVT); const float* GLOW = (const float*)(F.ws + WS_GLOW);
    LAS bf16* qin = (LAS bf16*)(F.lds + G1_QIN); LAS bf16* kin = (LAS bf16*)(F.lds + G1_KIN); LAS bf16* kdt = (LAS bf16*)(F.lds + G1_KDT);
    LAS float* lowl = (LAS float*)(F.lds + G1_LOW); LAS float* seg = (LAS float*)(F.lds + G1_SEG);
    for (int i = F.tid; i < 64 * 16; i += NTHR) lowl[i] = GLOW[(size_t)t0 * 16 + i];
    LAS bf16* qraw = (LAS bf16*)(F.lds + G1_QRAW); LAS bf16* kraw = (LAS bf16*)(F.lds + G1_KRAW);
#pragma unroll
    for (int q2 = 0; q2 < 2; ++q2) { const int id = F.tid + 512 * q2, row = id >> 4, ch = id & 15;
        *(LAS u32x4*)(qraw + row * 128 + ch * 8) = *(const u32x4*)(GQ + (size_t)(t0 + row) * 512 + h * 128 + ch * 8);
        *(LAS u32x4*)(kraw + row * 128 + ch * 8) = *(const u32x4*)(GK + (size_t)(t0 + row) * 512 + h * 128 + ch * 8); }
    __syncthreads();
    const int d = F.tid & 127, sg = F.tid >> 7, dd = h * 128 + d;
    float wcol[16];
#pragma unroll
    for (int r = 0; r < 16; ++r) wcol[r] = w2[r * 512 + dd];
    const float bias = b2[dd];
    float pre[16]; float run = 0.f;
#pragma unroll
    for (int i = 0; i < 16; ++i) { const int c = 16 * sg + i; float z = bias;
#pragma unroll
        for (int r4 = 0; r4 < 4; ++r4) { const f32x4 lv = *(const LAS f32x4*)(lowl + c * 16 + 4 * r4); z += lv.x * wcol[4 * r4] + lv.y * wcol[4 * r4 + 1] + lv.z * wcol[4 * r4 + 2] + lv.w * wcol[4 * r4 + 3]; }
        run += log2_sigmoid2(z * LOG2E) * (1.0f / 16.0f);
        pre[i] = run; }
    seg[sg * 128 + d] = run;
    __syncthreads();
    float off = 0.f, tot = 0.f;
#pragma unroll
    for (int s = 0; s < 4; ++s) { const float v = seg[s * 128 + d]; tot += v; if (s < sg) off += v; }
    bf16* QIN = (bf16*)(F.ws + WS_QIN);
#pragma unroll
    for (int i = 0; i < 16; ++i) { const int c = 16 * sg + i; const float g = off + pre[i];
        const float qv = bf2f(qraw[c * 128 + d]), kv = bf2f(kraw[c * 128 + d]);
        const bf16 qi = f2bf(qv * 0.08838834764831845f * fexp2(g));
        qin[c * 136 + d] = qi;
        kin[c * 136 + d] = f2bf(kv * fexp2(-g));
        kdt[d * 72 + c] = f2bf(kv * fexp2(tot - g)); }
    if (sg == 0) ((float*)(F.ws + WS_DECAY))[(size_t)unit * 128 + d] = fexp2(tot);
    __syncthreads();
#pragma unroll
    for (int q2 = 0; q2 < 2; ++q2) { const int id = F.tid + 512 * q2, row = id >> 4, ch = id & 15;
        *(u32x4*)(QIN + (size_t)(t0 + row) * 512 + h * 128 + ch * 8) = *(const LAS u32x4*)(qin + row * 136 + ch * 8); }
    const int w = F.wave, l = F.lane, r = l & 31, hh = l >> 5, cb = w & 1, dvp = w >> 1;
    f32x16 X[2];
#pragma unroll
    for (int sb = 0; sb < 2; ++sb) {
#pragma unroll
        for (int i = 0; i < 16; ++i) X[sb][i] = 0.f;
#pragma unroll
        for (int st = 0; st < 8; ++st) { const bf16x8 af = *(const LAS bf16x8*)(kin + (32 * sb + r) * 136 + 16 * st + 8 * hh), bfq = *(const LAS bf16x8*)(qin + (32 * cb + r) * 136 + 16 * st + 8 * hh);
            X[sb] = __builtin_amdgcn_mfma_f32_32x32x16_bf16(af, bfq, X[sb], 0, 0, 0); }
#pragma unroll
        for (int i = 0; i < 16; ++i) { const int s = 32 * sb + (i & 3) + 8 * (i >> 2) + 4 * hh; if (32 * cb + r < s) X[sb][i] = 0.f; }
    }
    u32x4* OI = (u32x4*)(F.ws + WS_OINTRA) + ((size_t)unit * 8 + w) * 256;
#pragma unroll
    for (int dbi = 0; dbi < 2; ++dbi) { const int db = 2 * dvp + dbi; f32x16 oacc;
#pragma unroll
        for (int i = 0; i < 16; ++i) oacc[i] = 0.f;
#pragma unroll
        for (int sb = 0; sb < 2; ++sb)
#pragma unroll
            for (int s2 = 0; s2 < 2; ++s2) {
                u32x4 pw; pw.x = cvt_pk_bf16(X[sb][8 * s2 + 0], X[sb][8 * s2 + 1]); pw.y = cvt_pk_bf16(X[sb][8 * s2 + 2], X[sb][8 * s2 + 3]); pw.z = cvt_pk_bf16(X[sb][8 * s2 + 4], X[sb][8 * s2 + 5]); pw.w = cvt_pk_bf16(X[sb][8 * s2 + 6], X[sb][8 * s2 + 7]);
                const bf16* vp = GVT + ((size_t)(bh * 256 + db * 32 + r)) * SEQ + 64 * n + 32 * sb + 16 * s2 + 4 * hh;
                u32x4 vw; const u32x2 v0 = *(const u32x2*)vp, v1 = *(const u32x2*)(vp + 8); vw.x = v0.x; vw.y = v0.y; vw.z = v1.x; vw.w = v1.y;
                oacc = __builtin_amdgcn_mfma_f32_32x32x16_bf16(__builtin_bit_cast(bf16x8, vw), __builtin_bit_cast(bf16x8, pw), oacc, 0, 0, 0); }
#pragma unroll
        for (int q4 = 0; q4 < 2; ++q4) { u32x4 ow; ow.x = cvt_pk_bf16(oacc[8 * q4], oacc[8 * q4 + 1]); ow.y = cvt_pk_bf16(oacc[8 * q4 + 2], oacc[8 * q4 + 3]); ow.z = cvt_pk_bf16(oacc[8 * q4 + 4], oacc[8 * q4 + 5]); ow.w = cvt_pk_bf16(oacc[8 * q4 + 6], oacc[8 * q4 + 7]);
            OI[(dbi * 2 + q4) * 64 + l] = ow; } }
    bf16* KVN = (bf16*)(F.ws + WS_KVN) + (size_t)unit * 32768; LAS bf16* kvt = (LAS bf16*)(F.lds + G1_KVT);
    bf16x8 vf[4];
#pragma unroll
    for (int st = 0; st < 4; ++st) vf[st] = *(const bf16x8*)(GVT + ((size_t)(bh * 256 + w * 32 + r)) * SEQ + 64 * n + 16 * st + 8 * hh);
#pragma unroll
    for (int dkb = 0; dkb < 4; ++dkb) { f32x16 kacc;
#pragma unroll
        for (int i = 0; i < 16; ++i) kacc[i] = 0.f;
#pragma unroll
        for (int st = 0; st < 4; ++st) { const bf16x8 bk = *(const LAS bf16x8*)(kdt + (32 * dkb + r) * 72 + 16 * st + 8 * hh);
            kacc = __builtin_amdgcn_mfma_f32_32x32x16_bf16(vf[st], bk, kacc, 0, 0, 0); }
#pragma unroll
        for (int i = 0; i < 16; ++i) kvt[(32 * w + (i & 3) + 8 * (i >> 2) + 4 * hh) * 128 + 32 * dkb + r] = f2bf(kacc[i]); }
    LDS_WAIT();
#pragma unroll
    for (int q8 = 0; q8 < 8; ++q8) { const int row = 32 * w + 4 * q8 + (l >> 4), ch = l & 15;
        *(u32x4*)(KVN + (size_t)row * 128 + ch * 8) = *(const LAS u32x4*)(kvt + row * 128 + ch * 8); }
    __syncthreads();
}

__device__ __forceinline__ void gla_scan(const Frame& F) {
    const bf16* KVN = (const bf16*)(F.ws + WS_KVN); const float* DEC = (const float*)(F.ws + WS_DECAY); bf16* ST = (bf16*)(F.ws + WS_STATE);
    for (int g = F.bid * NTHR + F.tid; g < 16 * 8192; g += F.G * NTHR) {
        const int bh = g >> 13, e4 = (g & 8191) * 4, dk = e4 & 127;
        f32x4 S = {0.f, 0.f, 0.f, 0.f};
#pragma unroll 8
        for (int n = 0; n < 32; ++n) { const size_t u = (size_t)(bh * 32 + n);
            st_bf16x4(ST + u * 32768 + e4, S);
            const u32x2 kw = *(const u32x2*)(KVN + u * 32768 + e4); const f32x4 kv = {bflo(kw.x), bfhi(kw.x), bflo(kw.y), bfhi(kw.y)}, dc = *(const f32x4*)(DEC + u * 128 + dk);
            S = S * dc + kv; }
    }
}

__device__ __forceinline__ void gla_g3_unit(const Frame& F, const float* __restrict__ gn, int unit) {
    const int n = unit & 31, bh = unit >> 5, b = bh >> 2, h = bh & 3; const int t0 = b * SEQ + 64 * n;
    const int w = F.wave, l = F.lane, r = l & 31, hh = l >> 5, cb = w & 1, dvp = w >> 1;
    const bf16* QIN = (const bf16*)(F.ws + WS_QIN); const bf16* ST = (const bf16*)(F.ws + WS_STATE) + (size_t)unit * 32768; const bf16* GR = (const bf16*)(F.ws + WS_GR); bf16* O = (bf16*)(F.ws + WS_MIXO);
    const u32x4* OI = (const u32x4*)(F.ws + WS_OINTRA) + ((size_t)unit * 8 + w) * 256;
    LAS float* part = (LAS float*)F.lds;
    bf16x8 qf[8];
#pragma unroll
    for (int st = 0; st < 8; ++st) qf[st] = *(const bf16x8*)(QIN + (size_t)(t0 + 32 * cb + r) * 512 + h * 128 + 16 * st + 8 * hh);
    f32x16 o[2]; float ss = 0.f;
#pragma unroll
    for (int dbi = 0; dbi < 2; ++dbi) { const int db = 2 * dvp + dbi;
#pragma unroll
        for (int q4 = 0; q4 < 2; ++q4) { const u32x4 ow = OI[(dbi * 2 + q4) * 64 + l];
            o[dbi][8 * q4] = bflo(ow.x); o[dbi][8 * q4 + 1] = bfhi(ow.x); o[dbi][8 * q4 + 2] = bflo(ow.y); o[dbi][8 * q4 + 3] = bfhi(ow.y); o[dbi][8 * q4 + 4] = bflo(ow.z); o[dbi][8 * q4 + 5] = bfhi(ow.z); o[dbi][8 * q4 + 6] = bflo(ow.w); o[dbi][8 * q4 + 7] = bfhi(ow.w); }
#pragma unroll
        for (int st = 0; st < 8; ++st) { const bf16x8 sf = *(const bf16x8*)(ST + (size_t)(32 * db + r) * 128 + 16 * st + 8 * hh);
            o[dbi] = __builtin_amdgcn_mfma_f32_32x32x16_bf16(sf, qf[st], o[dbi], 0, 0, 0); }
#pragma unroll
        for (int i = 0; i < 16; ++i) ss += o[dbi][i] * o[dbi][i]; }
    ss += __shfl_xor(ss, 32);
    if (hh == 0) part[w * 32 + r] = ss;
    __syncthreads();
    float tot = 0.f;
#pragma unroll
    for (int q = 0; q < 4; ++q) tot += part[(2 * q + cb) * 32 + r];
    const float rstd = 1.0f / sqrtf(tot * (1.f / 256.f) + EPS);
    const int tok = t0 + 32 * cb + r;
#pragma unroll
    for (int dbi = 0; dbi < 2; ++dbi)
#pragma unroll
        for (int c = 0; c < 4; ++c) { const int dv = 32 * (2 * dvp + dbi) + 8 * c + 4 * hh; const f32x4 g = *(const f32x4*)(gn + h * 256 + dv);
            const u32x2 rw = *(const u32x2*)(GR + (size_t)tok * 1024 + h * 256 + dv);
            const float r0 = bflo(rw.x), r1 = bfhi(rw.x), r2 = bflo(rw.y), r3 = bfhi(rw.y);
            f32x4 v; v.x = o[dbi][4 * c] * rstd * g.x * (r0 * frcp(1.f + fexp2(-r0 * LOG2E))); v.y = o[dbi][4 * c + 1] * rstd * g.y * (r1 * frcp(1.f + fexp2(-r1 * LOG2E)));
            v.z = o[dbi][4 * c + 2] * rstd * g.z * (r2 * frcp(1.f + fexp2(-r2 * LOG2E))); v.w = o[dbi][4 * c + 3] * rstd * g.w * (r3 * frcp(1.f + fexp2(-r3 * LOG2E)));
            st_bf16x4(O + (size_t)tok * DM + 1024 + h * 256 + dv, v); }
    __syncthreads();
}
__device__ __forceinline__ void gla_g3_pair(const Frame& F, const float* __restrict__ gn, int uA, int uB) {
    const int w = F.wave, l = F.lane, r = l & 31, hh = l >> 5, w4 = w & 3, cb = w4 & 1, dvh = w4 >> 1;
    const int unit = (w < 4) ? uA : uB; const bool act = unit >= 0;
    const int uu = act ? unit : 0, n = uu & 31, bh = uu >> 5, b = bh >> 2, h = bh & 3; const int t0 = b * SEQ + 64 * n;
    const bf16* QIN = (const bf16*)(F.ws + WS_QIN); const bf16* ST = (const bf16*)(F.ws + WS_STATE) + (size_t)uu * 32768; const bf16* GR = (const bf16*)(F.ws + WS_GR); bf16* O = (bf16*)(F.ws + WS_MIXO);
    LAS float* part = (LAS float*)F.lds;
    f32x16 o[4]; float ss = 0.f;
    u32x2 grw[4][4];
    if (act) {
#pragma unroll
        for (int dbi = 0; dbi < 4; ++dbi)
#pragma unroll
            for (int c = 0; c < 4; ++c) grw[dbi][c] = *(const u32x2*)(GR + (size_t)(t0 + 32 * cb + r) * 1024 + h * 256 + 32 * (4 * dvh + dbi) + 8 * c + 4 * hh);
        bf16x8 qf[8];
#pragma unroll
        for (int st = 0; st < 8; ++st) qf[st] = *(const bf16x8*)(QIN + (size_t)(t0 + 32 * cb + r) * 512 + h * 128 + 16 * st + 8 * hh);
#pragma unroll
        for (int dbi = 0; dbi < 4; ++dbi) { const int db = 4 * dvh + dbi;
            const u32x4* OI = (const u32x4*)(F.ws + WS_OINTRA) + ((size_t)uu * 8 + (2 * (db >> 1) + cb)) * 256 + ((db & 1) * 2) * 64 + l;
#pragma unroll
            for (int q4 = 0; q4 < 2; ++q4) { const u32x4 ow = OI[q4 * 64];
                o[dbi][8 * q4] = bflo(ow.x); o[dbi][8 * q4 + 1] = bfhi(ow.x); o[dbi][8 * q4 + 2] = bflo(ow.y); o[dbi][8 * q4 + 3] = bfhi(ow.y); o[dbi][8 * q4 + 4] = bflo(ow.z); o[dbi][8 * q4 + 5] = bfhi(ow.z); o[dbi][8 * q4 + 6] = bflo(ow.w); o[dbi][8 * q4 + 7] = bfhi(ow.w); }
#pragma unroll
            for (int st = 0; st < 8; ++st) { const bf16x8 sf = *(const bf16x8*)(ST + (size_t)(32 * db + r) * 128 + 16 * st + 8 * hh);
                o[dbi] = __builtin_amdgcn_mfma_f32_32x32x16_bf16(sf, qf[st], o[dbi], 0, 0, 0); }
#pragma unroll
            for (int i = 0; i < 16; ++i) ss += o[dbi][i] * o[dbi][i]; }
        ss += __shfl_xor(ss, 32);
        if (hh == 0) part[w * 32 + r] = ss;
    }
    __syncthreads();
    if (act) {
        const float tot = part[((w & 4) + cb) * 32 + r] + part[((w & 4) + cb + 2) * 32 + r];
        const float rstd = 1.0f / sqrtf(tot * (1.f / 256.f) + EPS);
        const int tok = t0 + 32 * cb + r;
#pragma unroll
        for (int dbi = 0; dbi < 4; ++dbi)
#pragma unroll
            for (int c = 0; c < 4; ++c) { const int dv = 32 * (4 * dvh + dbi) + 8 * c + 4 * hh; const f32x4 g = *(const f32x4*)(gn + h * 256 + dv);
                const u32x2 rw = grw[dbi][c];
                const float r0 = bflo(rw.x), r1 = bfhi(rw.x), r2 = bflo(rw.y), r3 = bfhi(rw.y);
                f32x4 v; v.x = o[dbi][4 * c] * rstd * g.x * (r0 * frcp(1.f + fexp2(-r0 * LOG2E))); v.y = o[dbi][4 * c + 1] * rstd * g.y * (r1 * frcp(1.f + fexp2(-r1 * LOG2E)));
                v.z = o[dbi][4 * c + 2] * rstd * g.z * (r2 * frcp(1.f + fexp2(-r2 * LOG2E))); v.w = o[dbi][4 * c + 3] * rstd * g.w * (r3 * frcp(1.f + fexp2(-r3 * LOG2E)));
                st_bf16x4(O + (size_t)tok * DM + 1024 + h * 256 + dv, v); }
    }
    __syncthreads();
}

__device__ __forceinline__ void router_phase(const Frame& F, const float* __restrict__ b_router) {
    const float* X2 = (const float*)(F.ws + WS_X2); const bf16* WH = (const bf16*)(F.ws + WS_WRH); const bf16* WL = (const bf16*)(F.ws + WS_WRL);
    int* TOPE = (int*)(F.ws + WS_TOPE); float* TOPW = (float*)(F.ws + WS_TOPW); float* RSTD = (float*)(F.ws + WS_RSTD3); int* HIST = (int*)(F.ws + WS_HIST);
    LAS float* part = (LAS float*)F.lds;
    LAS float* sq = (LAS float*)(F.lds + 32768);
    LAS int* hist = (LAS int*)(F.lds + 33792);
    const int w = F.wave, l = F.lane, r16 = l & 15, quad = l >> 4;
    for (int rb = F.bid; rb < NT / 32; rb += F.G) {
        if (F.tid < 32) hist[F.tid] = 0;
        f32x4 acc[2][2] = {{{0.f, 0.f, 0.f, 0.f}, {0.f, 0.f, 0.f, 0.f}}, {{0.f, 0.f, 0.f, 0.f}, {0.f, 0.f, 0.f, 0.f}}}; float ssq[2] = {0.f, 0.f};
#pragma unroll 4
        for (int st = 0; st < 8; ++st) { const int k0 = 256 * w + 32 * st + 8 * quad;
            bf16x8 bh[2], bl[2];
#pragma unroll
            for (int eb = 0; eb < 2; ++eb) { bh[eb] = *(const bf16x8*)(WH + (size_t)(16 * eb + r16) * KD + k0); bl[eb] = *(const bf16x8*)(WL + (size_t)(16 * eb + r16) * KD + k0); }
#pragma unroll
            for (int tg = 0; tg < 2; ++tg) { const int row = rb * 32 + 16 * tg + r16;
#if X2_BF16
                const u32x4 xw = *(const u32x4*)((const bf16*)X2 + (size_t)row * DM + k0);
                { const float x0 = bflo(xw.x), x1 = bfhi(xw.x), x2 = bflo(xw.y), x3 = bfhi(xw.y), x4 = bflo(xw.z), x5 = bfhi(xw.z), x6 = bflo(xw.w), x7 = bfhi(xw.w);
                  ssq[tg] += (x0 * x0 + x1 * x1) + (x2 * x2 + x3 * x3) + (x4 * x4 + x5 * x5) + (x6 * x6 + x7 * x7); }
                const bf16x8 ah = __builtin_bit_cast(bf16x8, xw);
#pragma unroll
                for (int eb = 0; eb < 2; ++eb) {
                    acc[tg][eb] = __builtin_amdgcn_mfma_f32_16x16x32_bf16(ah, bh[eb], acc[tg][eb], 0, 0, 0);
                    acc[tg][eb] = __builtin_amdgcn_mfma_f32_16x16x32_bf16(ah, bl[eb], acc[tg][eb], 0, 0, 0); } } }
#else
                const f32x4 xa = *(const f32x4*)(X2 + (size_t)row * DM + k0), xb = *(const f32x4*)(X2 + (size_t)row * DM + k0 + 4);
                ssq[tg] += (xa.x * xa.x + xa.y * xa.y) + (xa.z * xa.z + xa.w * xa.w) + (xb.x * xb.x + xb.y * xb.y) + (xb.z * xb.z + xb.w * xb.w);
                u32x4 hw; hw.x = cvt_pk_bf16(xa.x, xa.y); hw.y = cvt_pk_bf16(xa.z, xa.w); hw.z = cvt_pk_bf16(xb.x, xb.y); hw.w = cvt_pk_bf16(xb.z, xb.w);
                u32x4 lw; lw.x = cvt_pk_bf16(xa.x - bflo(hw.x), xa.y - bfhi(hw.x)); lw.y = cvt_pk_bf16(xa.z - bflo(hw.y), xa.w - bfhi(hw.y));
                lw.z = cvt_pk_bf16(xb.x - bflo(hw.z), xb.y - bfhi(hw.z)); lw.w = cvt_pk_bf16(xb.z - bflo(hw.w), xb.w - bfhi(hw.w));
                const bf16x8 ah = __builtin_bit_cast(bf16x8, hw), alo = __builtin_bit_cast(bf16x8, lw);
#pragma unroll
                for (int eb = 0; eb < 2; ++eb) {
                    acc[tg][eb] = __builtin_amdgcn_mfma_f32_16x16x32_bf16(ah, bh[eb], acc[tg][eb], 0, 0, 0);
                    acc[tg][eb] = __builtin_amdgcn_mfma_f32_16x16x32_bf16(ah, bl[eb], acc[tg][eb], 0, 0, 0);
                    acc[tg][eb] = __builtin_amdgcn_mfma_f32_16x16x32_bf16(alo, bh[eb], acc[tg][eb], 0, 0, 0); } } }
#endif
#pragma unroll
        for (int tg = 0; tg < 2; ++tg) { float q = ssq[tg]; q += __shfl_xor(q, 16); q += __shfl_xor(q, 32);
            if (quad == 0) sq[w * 32 + 16 * tg + r16] = q;
#pragma unroll
            for (int eb = 0; eb < 2; ++eb)
#pragma unroll
                for (int j = 0; j < 4; ++j) part[(w * 32 + 16 * tg + 4 * quad + j) * 32 + 16 * eb + r16] = acc[tg][eb][j]; }
        __syncthreads();
        for (int q2 = 0; q2 < 2; ++q2) { const int hf = l >> 5, e = l & 31; const int ti = 4 * w + 2 * q2 + hf; const int tok = rb * 32 + ti;
            LAS float* lg = (LAS float*)(F.lds + 36864) + (w * 2 + hf) * 32; LAS float* tvr = (LAS float*)(F.lds + 40960) + (w * 2 + hf) * 4;
            float s2 = 0.f, a = 0.f;
#pragma unroll
            for (int k = 0; k < 8; ++k) { s2 += sq[k * 32 + ti]; a += part[(k * 32 + ti) * 32 + e]; }
            const float rstd = 1.0f / sqrtf(s2 * (1.f / DM) + EPS);
            float v = a * rstd + b_router[e]; v = (v == v) ? v : -3.0e38f;
            lg[e] = v;
            LDS_WAIT();
            int rank = 0;
#pragma unroll
            for (int j4 = 0; j4 < 8; ++j4) { const f32x4 o = *(const LAS f32x4*)(lg + 4 * j4);
                rank += (o.x > v || (o.x == v && 4 * j4 + 0 < e)) ? 1 : 0; rank += (o.y > v || (o.y == v && 4 * j4 + 1 < e)) ? 1 : 0;
                rank += (o.z > v || (o.z == v && 4 * j4 + 2 < e)) ? 1 : 0; rank += (o.w > v || (o.w == v && 4 * j4 + 3 < e)) ? 1 : 0; }
            if (rank < 4) tvr[rank] = v;
            LDS_WAIT();
            const f32x4 t = *(const LAS f32x4*)tvr;
            const float e1 = fexp2((t.y - t.x) * LOG2E), e2 = fexp2((t.z - t.x) * LOG2E), e3 = fexp2((t.w - t.x) * LOG2E); const float inv = 1.0f / (1.0f + e1 + e2 + e3);
            if (rank < 4) { TOPE[tok * 4 + rank] = e; TOPW[tok * 4 + rank] = fexp2((v - t.x) * LOG2E) * inv; atomicAdd((int*)&hist[e], 1); }
            if (e == 0) RSTD[tok] = rstd;
            LDS_WAIT(); }
        __syncthreads();
        if (F.tid < 32) HIST[rb * 32 + F.tid] = hist[F.tid];
        __syncthreads();
    }
}

__device__ __forceinline__ void slots_phase(const Frame& F, const float* __restrict__ g_moe) {
    const float* X2 = (const float*)(F.ws + WS_X2); const int* TOPE = (const int*)(F.ws + WS_TOPE); const float* TOPW = (const float*)(F.ws + WS_TOPW); const float* RSTD = (const float*)(F.ws + WS_RSTD3);
    const int* HIST = (const int*)(F.ws + WS_HIST); float* SLOTW = (float*)(F.ws + WS_SLOTW); int* TOKSLOT = (int*)(F.ws + WS_TOKSLOT); int* CNT = (int*)(F.ws + WS_CNT); bf16* XS = (bf16*)(F.ws + WS_XS);
    LAS int* ptot = (LAS int*)F.lds;
    LAS int* pbel = ptot + 512;
    LAS int* base = pbel + 512;
    LAS int* asg = base + 32;
    LAS int* aslot = asg + 128;
    for (int rb = F.bid; rb < NT / 32; rb += F.G) {
#if XS_GATHER && X2_BF16 && MOE_FP8
        {
            const f32x4* gr = (const f32x4*)g_moe + F.lane; u32x2 xw[4][8]; float rs[4];
#pragma unroll
            for (int q = 0; q < 4; ++q) { const int tok = rb * 32 + 4 * F.wave + q; rs[q] = RSTD[tok]; const u32x2* xh = (const u32x2*)((const bf16*)X2 + (size_t)tok * DM) + F.lane;
#pragma unroll
                for (int j = 0; j < 8; ++j) xw[q][j] = xh[64 * j]; }
            f32x4 g[8];
#pragma unroll
            for (int j = 0; j < 8; ++j) g[j] = gr[64 * j];
#pragma unroll
            for (int q = 0; q < 4; ++q) { LAS unsigned* rowb = (LAS unsigned*)(F.lds + 16384 + F.wave * 8192 + q * 2048);
#pragma unroll
                for (int j = 0; j < 8; ++j) rowb[64 * j + F.lane] = pk_fp8x4(bflo(xw[q][j].x) * rs[q] * g[j].x, bfhi(xw[q][j].x) * rs[q] * g[j].y, bflo(xw[q][j].y) * rs[q] * g[j].z, bfhi(xw[q][j].y) * rs[q] * g[j].w); }
            LDS_WAIT();
#pragma unroll
            for (int q = 0; q < 4; ++q) { const LAS unsigned* rowb = (const LAS unsigned*)(F.lds + 16384 + F.wave * 8192 + q * 2048); const int tok = rb * 32 + 4 * F.wave + q;
                u32x4* o16 = (u32x4*)((unsigned char*)XS + (size_t)tok * DM) + F.lane; o16[0] = *(const LAS u32x4*)(rowb + 4 * F.lane); o16[64] = *(const LAS u32x4*)(rowb + 256 + 4 * F.lane); }
        }
#endif
        { const int e = F.tid & 31, p = F.tid >> 5; int t = 0, bl = 0;
          for (int q = 0; q < 16; ++q) { const int bb = 16 * p + q; const int hv = HIST[bb * 32 + e]; t += hv; if (bb < rb) bl += hv; }
          ptot[p * 32 + e] = t; pbel[p * 32 + e] = bl; }
        if (F.tid < 128) asg[F.tid] = TOPE[rb * 128 + F.tid];
        __syncthreads();
        if (F.tid < 32) { int t = 0, bl = 0; for (int p = 0; p < 16; ++p) { t += ptot[p * 32 + F.tid]; bl += pbel[p * 32 + F.tid]; }
            ptot[F.tid] = t; pbel[F.tid] = bl; }
        __syncthreads();
        if (F.tid < 32) { int st = 0; for (int e = 0; e < F.tid; ++e) st += ptot[e]; base[F.tid] = st + pbel[F.tid];
            if (rb == 0) { CNT[F.tid] = ptot[F.tid]; CNT[32 + F.tid] = st; }
            int run = base[F.tid]; for (int i = 0; i < 128; ++i) if (asg[i] == F.tid) { aslot[i] = run; ++run; } }
        __syncthreads();
        if (F.tid < 128) { const int sl = aslot[F.tid]; TOKSLOT[rb * 128 + F.tid] = sl; SLOTW[sl] = TOPW[rb * 128 + F.tid];
            if (XS_GATHER) ((int*)(F.ws + WS_SLOTTOK))[sl] = rb * 32 + (F.tid >> 2); }
        if (XS_GATHER && rb == 0 && F.tid >= 256) ((int*)(F.ws + WS_SLOTTOK))[NASSIGN + F.tid - 256] = 0;
        if (!(XS_GATHER && X2_BF16 && MOE_FP8)) for (int q = 0; q < 4; ++q) { const int ti = 4 * F.wave + q, tok = rb * 32 + ti; const float rstd = RSTD[tok];
            const f32x4* xr = (const f32x4*)(X2 + (size_t)tok * DM) + F.lane; const f32x4* gr = (const f32x4*)g_moe + F.lane; (void)xr;
#if MOE_FP8
            unsigned hw[8];
#if X2_BF16
            const u32x2* xh = (const u32x2*)((const bf16*)X2 + (size_t)tok * DM) + F.lane;
#pragma unroll
            for (int j = 0; j < 8; ++j) { const u32x2 xw = xh[64 * j]; const f32x4 g = gr[64 * j]; hw[j] = pk_fp8x4(bflo(xw.x) * rstd * g.x, bfhi(xw.x) * rstd * g.y, bflo(xw.y) * rstd * g.z, bfhi(xw.y) * rstd * g.w); }
#else
#pragma unroll
            for (int j = 0; j < 8; ++j) { const f32x4 v = xr[64 * j], g = gr[64 * j]; hw[j] = pk_fp8x4(v.x * rstd * g.x, v.y * rstd * g.y, v.z * rstd * g.z, v.w * rstd * g.w); }
#endif
            LAS unsigned* rowb = (LAS unsigned*)(F.lds + 16384 + F.wave * 2048);
#pragma unroll
            for (int j = 0; j < 8; ++j) rowb[64 * j + F.lane] = hw[j];
            LDS_WAIT();
            const u32x4 w0 = *(const LAS u32x4*)(rowb + 4 * F.lane), w1 = *(const LAS u32x4*)(rowb + 256 + 4 * F.lane);
#if XS_GATHER
            { u32x4* o16 = (u32x4*)((unsigned char*)XS + (size_t)tok * DM) + F.lane; o16[0] = w0; o16[64] = w1; }
#else
#pragma unroll
            for (int k = 0; k < 4; ++k) { const int sl = aslot[ti * 4 + k]; u32x4* o16 = (u32x4*)((unsigned char*)XS + (size_t)sl * DM) + F.lane;
                o16[0] = w0; o16[64] = w1; }
#endif
            LDS_WAIT();
#else
            u32x2 hw[8];
#pragma unroll
            for (int j = 0; j < 8; ++j) { const f32x4 v = xr[64 * j], g = gr[64 * j]; hw[j].x = cvt_pk_bf16(v.x * rstd * g.x, v.y * rstd * g.y); hw[j].y = cvt_pk_bf16(v.z * rstd * g.z, v.w * rstd * g.w); }
#pragma unroll
            for (int k = 0; k < 4; ++k) { const int sl = aslot[ti * 4 + k]; u32x2* o8 = (u32x2*)(XS + (size_t)sl * DM) + F.lane;
#pragma unroll
                for (int j = 0; j < 8; ++j) o8[64 * j] = hw[j]; }
#endif
            }
        __syncthreads();
    }
}

__device__ __forceinline__ void final_phase(const Frame& F, const float* __restrict__ g_fin, float* __restrict__ out) {
    const float* X2 = (const float*)(F.ws + WS_X2); const bf16* Y = (const bf16*)(F.ws + WS_Y); const int* TOKSLOT = (const int*)(F.ws + WS_TOKSLOT);
    const int gw = F.bid * NWAVES + F.wave, NGW = F.G * NWAVES;
    for (int tok = gw; tok < NT; tok += NGW) {
        const f32x4* xr = (const f32x4*)(X2 + (size_t)tok * DM) + F.lane;
        f32x4 v[8];
#if X2_BF16
        { const u32x2* xh = (const u32x2*)((const bf16*)X2 + (size_t)tok * DM) + F.lane; (void)xr;
#pragma unroll
          for (int j = 0; j < 8; ++j) { const u32x2 xw = xh[64 * j]; v[j] = (f32x4){bflo(xw.x), bfhi(xw.x), bflo(xw.y), bfhi(xw.y)}; } }
#else
#pragma unroll
        for (int j = 0; j < 8; ++j) v[j] = xr[64 * j];
#endif
#pragma unroll
#if Y_FP8
        for (int k = 0; k < 4; ++k) { const int sl = TOKSLOT[tok * 4 + k]; const unsigned* yr = (const unsigned*)((const unsigned char*)Y + (size_t)sl * DM) + F.lane;
#pragma unroll
            for (int j = 0; j < 8; ++j) { const int yw = (int)yr[64 * j]; const f32x2 lo = __builtin_amdgcn_cvt_pk_f32_fp8(yw, false), hi = __builtin_amdgcn_cvt_pk_f32_fp8(yw, true);
                v[j].x += lo.x * 0.0625f; v[j].y += lo.y * 0.0625f; v[j].z += hi.x * 0.0625f; v[j].w += hi.y * 0.0625f; } }
#else
        for (int k = 0; k < 4; ++k) { const int sl = TOKSLOT[tok * 4 + k]; const u32x2* yr = (const u32x2*)(Y + (size_t)sl * DM) + F.lane;
#pragma unroll
            for (int j = 0; j < 8; ++j) { const u32x2 yw = yr[64 * j]; v[j].x += bflo(yw.x); v[j].y += bfhi(yw.x); v[j].z += bflo(yw.y); v[j].w += bfhi(yw.y); } }
#endif
        float s = 0.f;
#pragma unroll
        for (int j = 0; j < 8; ++j) s += (v[j].x * v[j].x + v[j].y * v[j].y) + (v[j].z * v[j].z + v[j].w * v[j].w);
        const float rstd = 1.0f / sqrtf(wave_sum(s) * (1.f / DM) + EPS);
        f32x4* orow = (f32x4*)(out + (size_t)tok * DM) + F.lane; const f32x4* gr = (const f32x4*)g_fin + F.lane;
#pragma unroll
        for (int j = 0; j < 8; ++j) orow[64 * j] = v[j] * rstd * gr[64 * j];
    }
}

constexpr int N_PHASES = 14;
__global__ void __launch_bounds__(NTHR, 2) fwd_kernel(Args args) {
    extern __shared__ __attribute__((aligned(16))) unsigned char lds[];
    Frame F;
    F.lds = (LAS unsigned char*)lds;
    F.tid = threadIdx.x; F.lane = F.tid & 63; F.wave = __builtin_amdgcn_readfirstlane(F.tid >> 6);
    F.G = gridDim.x; F.bid = blockIdx.x; F.ws = args.ws;
    for (int u = F.tid; u < (LDS_BYTES - LDSCTL_OFF) / 4; u += NTHR) ((LAS unsigned*)(F.lds + LDSCTL_OFF))[u] = 0u;
    __syncthreads();
    unsigned* ctl = (unsigned*)(args.ws + WS_CTL);
    XcdBarrier bar; bar.bar = ctl + CW_BAR; bar.x = 0; bar.st = nullptr;
    const bool fused = (args.ph_hi - args.ph_lo) > 1;
    if (fused) bar = xcd_barrier_post(ctl + CW_BAR, (volatile LAS unsigned*)(F.lds + MISC_OFF));
    const int lo = args.ph_lo, hi = args.ph_hi;
    const bool conv_on = fused && CONV_WGS > 0 && F.G == 256;
    const bool conv_wg = conv_on && F.bid >= NCOMP;
    Frame FC = F; if (conv_on) FC.G = NCOMP;
    const int G2 = FC.G;
#define IN(k) (lo <= (k) && (k) < hi)
#define REP(k) _Pragma("unroll") for (int _r = 0; _r < 1 + ((DUP_MASK >> (k)) & 1); ++_r)
#define SEAM(k) do { if (IN(k) && IN((k) + 1)) xcd_barrier(bar); } while (0)

    if (IN(0)) REP(0) { p0_prologue(F, args);
        if (!conv_on) { LAS unsigned* scr = (LAS unsigned*)(F.lds + F.wave * 16384);
            for (int it = F.bid * NWAVES + F.wave; it < MOE_ITEMS; it += F.G * NWAVES) if (!CONV_WGS || !((it >= (32 - E_P0) * 1024 && it < 32768) || it >= 32768 + (32 - D_P0) * 512)) moe_item_fp8<false>(F, args, it, scr); }
    } SEAM(0);

    if (IN(1)) REP(1) {
        if (conv_wg) {
            { KvOrder S{(const char*)(F.ws + WS_MEMN), (const char*)(F.ws + WS_WCKV), F.bid - NCOMP}; EpiKV E{F.ws}; pg8::gemm_phase<4096, 32, false>(F.lds, S, E); }
            LAS unsigned* scr = (LAS unsigned*)(F.lds + F.wave * 16384); const int w2 = (F.bid - NCOMP) * NWAVES + F.wave;
            moe_items_stream<false, true>(F, args, w2, CONV_WGS * NWAVES, CONV_NA / (CONV_WGS * NWAVES), scr); }
        else {
        pg8::DenseOrder S; S.init(F.ws + WS_H1, F.ws + WS_WIN, NT, NPROJ, FC.G, F.bid);
        EpiInProj E{F.ws};
        pg8::gemm_phase<4096, 32, false>(F.lds, S, E);
        gla_low_job(FC);
        }
    } SEAM(1);

    if (IN(2)) REP(2) {
        {
        const bool kv_here = !(conv_on && CONV_WGS == 64);
        if (kv_here && F.bid < 64) { KvOrder S{(const char*)(F.ws + WS_MEMN), (const char*)(F.ws + WS_WCKV), F.bid}; EpiKV E{F.ws}; pg8::gemm_phase<4096, 32, false>(F.lds, S, E); }
        REP(14) { if (kv_here && F.G > 64) { if (F.bid >= 64) for (int u = F.bid - 64; u < 512; u += F.G - 64) gla_g1_unit(F, args.in[4], args.in[5], u); }
        else { for (int u = F.bid; u < 512; u += F.G) gla_g1_unit(F, args.in[4], args.in[5], u); } }
        REP(15) { if (F.G == 256) sb_attn_wave(F, args.in[6], ((F.bid & 7) * 4 + (F.bid >> 6)) * 64 + ((F.bid >> 3) & 7) * 8 + F.wave);
            else for (int wu = F.bid * NWAVES + F.wave; wu < 2048; wu += F.G * NWAVES) sb_attn_wave(F, args.in[6], wu); }
        }
    } SEAM(2);

    if (IN(3)) REP(3) { gla_scan(F); } SEAM(3);

    if (IN(4)) REP(4) { for (int u = F.bid; u < 512; u += 2 * F.G) gla_g3_pair(F, args.in[7], u, (u + F.G < 512) ? u + F.G : -1); } SEAM(4);

    if (IN(5)) REP(5) {
        if (F.G == 256) {
            MixOrder S; S.D.init(F.ws + WS_MIXO, F.ws + WS_WOUT, NT, DM, F.G, F.bid); S.X = XpreOrder{(const char*)(F.ws + WS_KVK), (const char*)(F.ws + WS_WCQ), (const char*)(F.ws + WS_WCO), (const char*)(F.ws + WS_KVVT), F.bid}; S.c = F.bid;
            EpiMix E{EpiRes1{args.in[0], (float*)(F.ws + WS_X1), (bf16*)(F.ws + WS_X1B), (float*)(F.ws + WS_SSQ)}, EpiXpre{(bf16*)(F.ws + WS_MT), (bf16*)(F.ws + WS_VWT)}};
            pg8::gemm_phase<4096, 0, false>(F.lds, S, E);
        } else {
            { pg8::DenseOrder S; S.init(F.ws + WS_MIXO, F.ws + WS_WOUT, NT, DM, F.G, F.bid); EpiRes1 E{args.in[0], (float*)(F.ws + WS_X1), (bf16*)(F.ws + WS_X1B), (float*)(F.ws + WS_SSQ)}; pg8::gemm_phase<4096, 32, false>(F.lds, S, E); }
            for (int c = F.bid; c < 256; c += F.G) { XpreOrder S{(const char*)(F.ws + WS_KVK), (const char*)(F.ws + WS_WCQ), (const char*)(F.ws + WS_WCO), (const char*)(F.ws + WS_KVVT), c}; EpiXpre E{(bf16*)(F.ws + WS_MT), (bf16*)(F.ws + WS_VWT)}; pg8::gemm_phase<4096, 8, false>(F.lds, S, E); }
        }
    } SEAM(5);

    if (IN(7)) REP(7) {
        if (F.bid < 128) xattn_row_scales(F.lds, (const float*)(F.ws + WS_SSQ), xs_b(F.bid) * SEQ + 256 * xs_qt(F.bid));
        { XsOrder S{(const char*)(F.ws + WS_X1B), (const char*)(F.ws + WS_MT), F.bid}; EpiSoftmax E{F.lds, (bf16*)(F.ws + WS_P)};
          pg8::gemm_phase<4096, 32, false>(F.lds, S, E); }
        if (conv_on && F.bid >= 128) {
            LAS unsigned* scr = (LAS unsigned*)(F.lds + F.wave * 16384); const int w2 = (F.bid - 128) * NWAVES + F.wave;
            moe_items_stream<false, true>(F, args, CONV_NA + w2, 1024, CONV_NB / 1024, scr); }
    } SEAM(7);

    if (IN(8)) REP(8) {
        XoutOrder S{(const char*)(F.ws + WS_P), (const char*)(F.ws + WS_VWT), F.bid};
        EpiRes2 E{(const float*)(F.ws + WS_X1), (const bf16*)(F.ws + WS_X1B), (float*)(F.ws + WS_X2)};
        pg8::gemm_phase<2048, 16, false>(F.lds, S, E);
    } SEAM(8);

    if (IN(9)) REP(9) { router_phase(F, args.in[16]); } SEAM(9);

    if (IN(10)) REP(10) { slots_phase(F, args.in[14]); } SEAM(10);

    if (IN(11)) REP(11) {
        moe_table(F, 16);
        constexpr int PB = MOE_FP8 ? 2048 : 4096;
        const int total = __builtin_amdgcn_readfirstlane(((const LAS int*)(F.lds + TAB_OFF))[32]);
        int full = (total / G2) * G2; bool route = conv_on && total - full > 0 && total - full <= ROUTE_MAX11;
        if (ROUTE_TEST && conv_on && full >= G2) { full -= G2; route = true; }
        const int dn11 = DN_IN_P11 - (route ? DN_SHIFT : 0);
        EpiAct E{args.in[18], (bf16*)(F.ws + WS_ACT)};
        int ready = conv_on ? E_PRE - 1 : 31;
        if (conv_wg) { conv_stream(F, args, E_PRE, 32 - E_P0 - E_PRE, 0, dn11);
            if (route) { MoeOrder S{(const LAS int*)(F.lds + TAB_OFF), (const char*)(F.ws + WS_XS), (const char*)(F.ws + WS_WGU), 16, CONV_WGS, F.bid - NCOMP, (size_t)2 * DFF * PB, 128, PB, (const unsigned*)(F.ws + WS_CTL) + CW_EXP, &ready, 32 - E_P0, full, 0x7fffffff, XS_GATHER ? (const int*)(F.ws + WS_SLOTTOK) : nullptr};
                pg8::gemm_phase_g<PB, MOE_FP8 ? 16 : 32, MOE_FP8 != 0, XS_GATHER != 0>(F.lds, S, E); } }
        else {
        MoeOrder S{(const LAS int*)(F.lds + TAB_OFF), (const char*)(F.ws + WS_XS), (const char*)(F.ws + WS_WGU), 16, FC.G, F.bid, (size_t)2 * DFF * PB, 128, PB, conv_on ? (const unsigned*)(F.ws + WS_CTL) + CW_EXP : nullptr, &ready, 32 - E_P0, 0, route ? full : 0x7fffffff, XS_GATHER ? (const int*)(F.ws + WS_SLOTTOK) : nullptr};
        pg8::gemm_phase_g<PB, MOE_FP8 ? 16 : 32, MOE_FP8 != 0, XS_GATHER != 0>(F.lds, S, E);
        }
    } SEAM(11);

    if (IN(12)) REP(12) {
        moe_table(F, 8);
        constexpr int PB = MOE_FP8 ? 2048 : 4096;
        const int total = __builtin_amdgcn_readfirstlane(((const LAS int*)(F.lds + TAB_OFF))[32]);
        int full = (total / G2) * G2; bool route = conv_on && total - full > 0 && total - full <= ROUTE_MAX;
        if (ROUTE_TEST && conv_on && full >= G2) { full -= G2; route = true; }
        EpiY E{args.in[20], (const float*)(F.ws + WS_SLOTW), (bf16*)(F.ws + WS_Y)};
        int dn11 = DN_IN_P11; { const int t11 = 2 * total; int f11 = (t11 / G2) * G2; bool r11 = conv_on && t11 - f11 > 0 && t11 - f11 <= ROUTE_MAX11;
            if (ROUTE_TEST && conv_on && f11 >= G2) r11 = true; if (r11) dn11 -= DN_SHIFT; }
        int ready = conv_on ? dn11 - 1 : 31;
        if (conv_wg) { conv_stream(F, args, 0, 0, dn11, 32 - D_P0 - dn11);
            if (route) { MoeOrder S{(const LAS int*)(F.lds + TAB_OFF), (const char*)(F.ws + WS_ACT), (const char*)(F.ws + WS_WD), 8, CONV_WGS, F.bid - NCOMP, (size_t)DM * PB, 256, PB, (const unsigned*)(F.ws + WS_CTL) + CW_EXP + 64 * 32, &ready, 32 - D_P0, full, 0x7fffffff};
                pg8::gemm_phase<PB, MOE_FP8 ? 16 : 32, MOE_FP8 != 0>(F.lds, S, E); } }
        else {
        MoeOrder S{(const LAS int*)(F.lds + TAB_OFF), (const char*)(F.ws + WS_ACT), (const char*)(F.ws + WS_WD), 8, FC.G, F.bid, (size_t)DM * PB, 256, PB, conv_on ? (const unsigned*)(F.ws + WS_CTL) + CW_EXP + 64 * 32 : nullptr, &ready, 32 - D_P0, 0, route ? full : 0x7fffffff};
        pg8::gemm_phase<PB, MOE_FP8 ? 16 : 32, MOE_FP8 != 0>(F.lds, S, E);
        }
    } SEAM(12);

#ifdef EXTRA_BARS
    if (fused) { for (int i = 0; i < EXTRA_BARS; ++i) xcd_barrier(bar); }
#endif
    if (IN(13)) REP(13) { final_phase(F, args.in[21], args.out); }
#undef IN
#undef SEAM
}

extern "C" void kernel_launch(void* const* d_in, const int* in_sizes, int n_in, void* d_out, int out_size, void* d_ws, size_t ws_size, hipStream_t stream) {
    static int grid = 0;
    if (grid == 0) {
        if (n_in != 22 || out_size != NT * DM || ws_size < WS_END) { fprintf(stderr, "kernel_launch: unexpected problem (n_in %d out %d ws %zu need %zu)\n", n_in, out_size, ws_size, (size_t)WS_END); grid = -1; return; }
        int dev = 0, cus = 0, per_cu = 0;
        if (hipGetDevice(&dev) != hipSuccess || hipDeviceGetAttribute(&cus, hipDeviceAttributeMultiprocessorCount, dev) != hipSuccess) { grid = -1; return; }
        if (hipFuncSetAttribute((const void*)fwd_kernel, hipFuncAttributeMaxDynamicSharedMemorySize, LDS_BYTES) != hipSuccess) { fprintf(stderr, "kernel_launch: hipFuncSetAttribute failed\n"); grid = -1; return; }
        if (hipOccupancyMaxActiveBlocksPerMultiprocessor(&per_cu, (const void*)fwd_kernel, NTHR, LDS_BYTES) != hipSuccess || per_cu < 1) fprintf(stderr, "kernel_launch: occupancy query reports %d\n", per_cu);
        (void)hipGetLastError();
        grid = cus;
    }
    if (grid < 0) return;
    (void)hipMemsetAsync((char*)d_ws + WS_CTL, 0, CTL_ZERO_BYTES, stream);
    Args a{};
    for (int i = 0; i < 22; ++i) a.in[i] = (const float*)d_in[i];
    a.out = (float*)d_out; a.ws = (unsigned char*)d_ws;
#if MK_N_LAUNCHES == 1
    a.ph_lo = 0; a.ph_hi = N_PHASES;
    hipLaunchKernelGGL(fwd_kernel, dim3(grid), dim3(NTHR), LDS_BYTES, stream, a);
#else
    for (int p = 0; p < N_PHASES; ++p) { a.ph_lo = p; a.ph_hi = p + 1; hipLaunchKernelGGL(fwd_kernel, dim3(grid), dim3(NTHR), LDS_BYTES, stream, a); }
#endif
}
```
